# Optimizing an MI355X kernel written in HIP

```python
import jax, jax.numpy as jnp
from jax import lax
import numpy as np

D_MODEL = 2048
BATCH = 4
SEQ = 2048
DEPTH = 1

HEAD_DIM = 128
GRID_W = 64
NORM_EPS = 1e-6
Q_BLOCK = 128

A_Q_HEADS = 8
A_KV_HEADS = 2
A_WIDTH = A_Q_HEADS * HEAD_DIM
A_KV_WIDTH = A_KV_HEADS * HEAD_DIM
AXIAL_THETA = 10000.0

B_PATTERNS = ((128, 1), (512, 4), (2048, 16))
B_GROUPS = len(B_PATTERNS)
B_HEADS_PER_GROUP = 4
B_WIDTH = B_HEADS_PER_GROUP * HEAD_DIM
PARTIAL_ROPE_DIM = HEAD_DIM // 4
ROPE_THETA = 500000.0

IN_SIZES = (A_WIDTH, A_KV_WIDTH, A_KV_WIDTH, A_WIDTH,
            B_GROUPS * B_WIDTH, B_GROUPS * B_WIDTH, B_GROUPS * B_WIDTH, B_WIDTH,
            D_MODEL, D_MODEL)
IN_COLS = sum(IN_SIZES)

kernel_name = "hybrid_gated_grid_gqa_dilated_attention_encoder"


def rms_norm(x, g):
    xf = x.astype(jnp.float32)
    y = xf * lax.rsqrt(jnp.mean(xf * xf, axis=-1, keepdims=True) + NORM_EPS)
    return (y * g.astype(jnp.float32)).astype(x.dtype)


def rope_angles(pos, dim, theta):
    expo = jnp.arange(0, dim, 2, dtype=jnp.float32) / dim
    inv_freq = 1.0 / jnp.power(jnp.asarray(theta, jnp.float32), expo)
    ang = pos.astype(jnp.float32)[:, None] * inv_freq[None, :]
    return jnp.cos(ang), jnp.sin(ang)


def apply_rotary(x, cos, sin):
    x1, x2 = jnp.split(x, 2, axis=-1)
    c = cos[None, :, None, :].astype(x.dtype)
    s = sin[None, :, None, :].astype(x.dtype)
    return jnp.concatenate([x1 * c - x2 * s, x1 * s + x2 * c], axis=-1)


def axial_rotary(x, row_id, col_id):
    half = HEAD_DIM // 2
    cr, sr = rope_angles(row_id, half, AXIAL_THETA)
    cc, sc = rope_angles(col_id, half, AXIAL_THETA)
    return jnp.concatenate([apply_rotary(x[..., :half], cr, sr),
                            apply_rotary(x[..., half:], cc, sc)], axis=-1)


def partial_rotary(x, pos):
    c, s = rope_angles(pos, PARTIAL_ROPE_DIM, ROPE_THETA)
    return jnp.concatenate([apply_rotary(x[..., :PARTIAL_ROPE_DIM], c, s),
                            x[..., PARTIAL_ROPE_DIM:]], axis=-1)


def grid_gqa_attention(q, k, v):
    B, S, Hq, D = q.shape
    G = Hq // A_KV_HEADS
    nb = S // Q_BLOCK
    scale = D ** -0.5
    qb = q.reshape(B, nb, Q_BLOCK, A_KV_HEADS, G, D).transpose(1, 0, 2, 3, 4, 5)

    def block(q_blk):
        s = jnp.einsum('bqhgd,bkhd->bhgqk', q_blk, k).astype(jnp.float32) * scale
        p = jax.nn.softmax(s, axis=-1).astype(v.dtype)
        return jnp.einsum('bhgqk,bkhd->bqhgd', p, v)

    o = lax.map(block, qb)
    return o.transpose(1, 0, 2, 3, 4, 5).reshape(B, S, Hq * D)


def dilated_band_attention(q, k, v, dilation, half):
    B, S, H, D = q.shape
    L = S // dilation
    C = half
    nblk = -(-L // C)
    Lp = nblk * C
    scale = D ** -0.5

    def by_stride(t):
        return t.reshape(B, L, dilation, H, D).transpose(0, 2, 1, 3, 4)

    qr, kr, vr = by_stride(q), by_stride(k), by_stride(v)
    qr = jnp.pad(qr, ((0, 0), (0, 0), (0, Lp - L), (0, 0), (0, 0)))
    kv_pad = ((0, 0), (0, 0), (C, Lp - L + C), (0, 0), (0, 0))
    kp = jnp.pad(kr, kv_pad).reshape(B, dilation, nblk + 2, C, H, D)
    vp = jnp.pad(vr, kv_pad).reshape(B, dilation, nblk + 2, C, H, D)

    def band(t):
        return jnp.concatenate([t[:, :, :-2], t[:, :, 1:-1], t[:, :, 2:]], axis=3)

    kband, vband = band(kp), band(vp)
    qb = qr.reshape(B, dilation, nblk, C, H, D)

    qi = jnp.arange(C)[:, None]
    kj = jnp.arange(3 * C)[None, :]
    rel = kj - C - qi
    kpos = jnp.arange(nblk)[:, None, None] * C + kj[None] - C
    valid = (jnp.abs(rel) <= half)[None] & (kpos >= 0) & (kpos < L)

    s = jnp.einsum('brnqhe,brnkhe->brnhqk', qb, kband).astype(jnp.float32) * scale
    s = jnp.where(valid[None, None, :, None], s, -1e30)
    m = jnp.max(s, axis=-1, keepdims=True)
    p = jnp.exp(s - m)
    l = jnp.sum(p, axis=-1)
    o = jnp.einsum('brnhqk,brnkhe->brnqhe', p.astype(v.dtype), vband)
    o = o / l.transpose(0, 1, 2, 4, 3)[..., None].astype(o.dtype)
    lse = (m[..., 0] + jnp.log(l)).transpose(0, 1, 2, 4, 3)

    o = o.reshape(B, dilation, Lp, H, D)[:, :, :L].transpose(0, 2, 1, 3, 4).reshape(B, S, H, D)
    lse = lse.reshape(B, dilation, Lp, H)[:, :, :L].transpose(0, 2, 1, 3).reshape(B, S, H)
    return o, lse


def setup_inputs(seed: int = 0) -> dict:
    key = jax.random.key(seed)
    ks = jax.random.split(key, 10)
    f32 = jnp.float32
    x = jax.random.normal(ks[0], (BATCH, SEQ, D_MODEL), f32)
    norm_gain = 1.0 + 0.02 * jax.random.normal(ks[1], (DEPTH, D_MODEL), f32)
    w_in = jax.random.normal(ks[2], (DEPTH, D_MODEL, IN_COLS), f32) * D_MODEL ** -0.5
    q_norm_gain = 1.0 + 0.02 * jax.random.normal(ks[3], (DEPTH, HEAD_DIM), f32)
    k_norm_gain = 1.0 + 0.02 * jax.random.normal(ks[4], (DEPTH, HEAD_DIM), f32)
    merge_gate_bias = 0.01 * jax.random.normal(ks[5], (DEPTH, 2, D_MODEL), f32)
    w_branch_a = jax.random.normal(ks[6], (DEPTH, A_WIDTH, D_MODEL), f32) * A_WIDTH ** -0.5
    w_branch_b = jax.random.normal(ks[7], (DEPTH, B_WIDTH, D_MODEL), f32) * B_WIDTH ** -0.5
    w_out = jax.random.normal(ks[8], (DEPTH, D_MODEL, D_MODEL), f32) * D_MODEL ** -0.5
    final_norm_gain = 1.0 + 0.02 * jax.random.normal(ks[9], (D_MODEL,), f32)
    return {"x": x, "norm_gain": norm_gain, "w_in": w_in, "q_norm_gain": q_norm_gain,
            "k_norm_gain": k_norm_gain, "merge_gate_bias": merge_gate_bias,
            "w_branch_a": w_branch_a, "w_branch_b": w_branch_b, "w_out": w_out,
            "final_norm_gain": final_norm_gain}


def reference(x, norm_gain, w_in, q_norm_gain, k_norm_gain, merge_gate_bias,
              w_branch_a, w_branch_b, w_out, final_norm_gain):
    B, S, _ = x.shape
    rows = S // GRID_W
    row_grid, col_grid = jnp.meshgrid(jnp.arange(rows, dtype=jnp.int32),
                                      jnp.arange(GRID_W, dtype=jnp.int32), indexing='ij')
    row_id, col_id = row_grid.reshape(-1), col_grid.reshape(-1)
    pos = jnp.arange(S, dtype=jnp.int32)
    split_at = [int(c) for c in np.cumsum(IN_SIZES)[:-1]]

    for l in range(DEPTH):
        h = rms_norm(x, norm_gain[l])
        proj = jnp.einsum('bsd,dc->bsc', h, w_in[l])
        qa, ka, va, ga, qb, kb, vb, gb, za, zb = jnp.split(proj, split_at, axis=-1)

        qa = axial_rotary(rms_norm(qa.reshape(B, S, A_Q_HEADS, HEAD_DIM), q_norm_gain[l]), row_id, col_id)
        ka = axial_rotary(rms_norm(ka.reshape(B, S, A_KV_HEADS, HEAD_DIM), k_norm_gain[l]), row_id, col_id)
        va = va.reshape(B, S, A_KV_HEADS, HEAD_DIM)
        ya = grid_gqa_attention(qa, ka, va) * jax.nn.silu(ga)
        pa = jnp.einsum('bsc,cd->bsd', ya, w_branch_a[l])

        nh = B_GROUPS * B_HEADS_PER_GROUP
        qb = partial_rotary(qb.reshape(B, S, nh, HEAD_DIM), pos).reshape(B, S, B_GROUPS, B_HEADS_PER_GROUP, HEAD_DIM)
        kb = partial_rotary(kb.reshape(B, S, nh, HEAD_DIM), pos).reshape(B, S, B_GROUPS, B_HEADS_PER_GROUP, HEAD_DIM)
        vb = vb.reshape(B, S, B_GROUPS, B_HEADS_PER_GROUP, HEAD_DIM)
        outs, lses = [], []
        for g, (window, dilation) in enumerate(B_PATTERNS):
            o_g, lse_g = dilated_band_attention(qb[:, :, g], kb[:, :, g], vb[:, :, g],
                                                dilation, window // (2 * dilation))
            outs.append(o_g)
            lses.append(lse_g)
        wts = jax.nn.softmax(jnp.stack(lses, axis=0), axis=0)
        ob = jnp.sum(wts[..., None].astype(x.dtype) * jnp.stack(outs, axis=0), axis=0)
        yb = ob.reshape(B, S, B_WIDTH) * jax.nn.silu(gb)
        pb = jnp.einsum('bsc,cd->bsd', yb, w_branch_b[l])

        merged = (jax.nn.sigmoid(za + merge_gate_bias[l, 0]) * pa
                  + jax.nn.sigmoid(zb + merge_gate_bias[l, 1]) * pb)
        x = x + jnp.einsum('bsd,de->bse', merged, w_out[l])

    return rms_norm(x, final_norm_gain)
```

```cpp
#include <hip/hip_runtime.h>
#include <hip/hip_cooperative_groups.h>
#include <cstdio>
#include <cstdint>
#include <cmath>
namespace cg = cooperative_groups;
namespace pg8 {
#define PG8_LAS __attribute__((address_space(3)))
typedef unsigned short bf16_t;
typedef short bf16x8 __attribute__((ext_vector_type(8)));
typedef float f32x4 __attribute__((ext_vector_type(4)));
typedef unsigned u32x4 __attribute__((ext_vector_type(4)));
constexpr int BM = 256, BK = 64, HALF = 128, HTB = HALF * BK * 2  , STAGE_BYTES = 8 * HTB, NXCD = 8, WGM = 8;

__host__ __device__ __forceinline__ int lds_byte(int r, int c) { const int st = (r >> 4) * 2 + (c >> 5), rr = r & 15, cc = c & 31, ob = rr * 64 + cc * 2; return st * 1024 + (ob ^ (((ob >> 9) & 1) << 5)); }
__host__ __device__ __forceinline__ void stage_rc(int b, int& R, int& C) { const int st = b / 1024, sb = b % 1024, swz = sb ^ (((sb >> 9) & 1) << 5); R = (st >> 1) * 16 + swz / 64; C = (st & 1) * 32 + (swz % 64) / 2; }
__host__ __device__ __forceinline__ int perm32(int rho) { const int n = rho >> 4, i = rho & 15; return 8 * (i >> 2) + 4 * n + (i & 3); }

struct Unit { int pm, pn; };
struct Gemm { const bf16_t* A; const bf16_t* Bt; int M, N, K; };

struct StaticOrder {
    int nM, nN, nwg, G, c;
    __host__ __device__ void init(int M, int N, int G_, int c_) { nM = M / BM; nN = N / BM; nwg = nM * nN; G = G_; c = c_; }
    __host__ __device__ bool next(int i, Unit& u) const {
        const long L = (long)i * G + c; if (L >= nwg) return false;
        int wgid = (int)L; { const int q = nwg / NXCD, r = nwg % NXCD, xcd = wgid % NXCD, off = wgid / NXCD; wgid = (xcd < r ? xcd * (q + 1) : r * (q + 1) + (xcd - r) * q) + off; }
        const int nig = WGM * nN, gid = wgid / nig, fm = gid * WGM, gsz = (nM - fm) < WGM ? (nM - fm) : WGM;
        u.pm = fm + ((wgid % nig) % gsz); u.pn = (wgid % nig) / gsz; return true;
    }
    __device__ __forceinline__ void a_ready(const Unit&) const {}
    __device__ __forceinline__ void done(const Unit&) const {}
};

__device__ __forceinline__ unsigned cvt_pk_bf16(float lo, float hi) { unsigned r; asm volatile("v_cvt_pk_bf16_f32 %0, %1, %2" : "=v"(r) : "v"(lo), "v"(hi)); return r; }
typedef float f32x2 __attribute__((ext_vector_type(2)));

struct EpiRaw {
    static constexpr bool PERM = false, AFTER_DRAIN = false; static constexpr int HOOK_T = -1;
    bf16_t* O; int ldc;
    __device__ __forceinline__ void operator()(const f32x4 (&acc)[2][2][4][2], const Unit& u, int wr, int wc, int fr, int fq) const {
        const int row0 = u.pm * BM + wr * 64 + fr, col0 = u.pn * BM + wc * 32 + 8 * fq;
#pragma unroll
        for (int ai = 0; ai < 2; ++ai)
#pragma unroll
            for (int m = 0; m < 4; ++m) { bf16_t* rowp = O + (size_t)(row0 + ai * HALF + m * 16) * ldc + col0;
#pragma unroll
                for (int bj = 0; bj < 2; ++bj) { const f32x4 v0 = acc[ai][bj][m][0], v1 = acc[ai][bj][m][1];
                    u32x4 w; w.x = cvt_pk_bf16(v0[0], v0[1]); w.y = cvt_pk_bf16(v0[2], v0[3]); w.z = cvt_pk_bf16(v1[0], v1[1]); w.w = cvt_pk_bf16(v1[2], v1[3]);
                    *(u32x4*)(rowp + bj * HALF) = w; } }
    }
};

struct EpiMerge {
    static constexpr bool PERM = false, AFTER_DRAIN = false; static constexpr int HOOK_T = 16;
    const bf16_t* Pz; int ldp, cza, czb; const float* bias; int nb; bf16_t* O; int ldc;
    __device__ __forceinline__ void mid(f32x4 (&acc)[2][2][4][2], const Unit& u, int wr, int wc, int fr, int fq) const {
        int row0 = u.pm * BM + wr * 64 + fr; asm volatile("" : "+v"(row0));
#pragma unroll
        for (int bj = 0; bj < 2; ++bj) { const int col0 = u.pn * BM + bj * HALF + wc * 32 + 8 * fq;
            const f32x4 ba0 = *(const f32x4*)(bias + col0), ba1 = *(const f32x4*)(bias + col0 + 4), bb0 = *(const f32x4*)(bias + nb + col0), bb1 = *(const f32x4*)(bias + nb + col0 + 4);
#pragma unroll
            for (int ai = 0; ai < 2; ++ai)
#pragma unroll
                for (int m = 0; m < 4; ++m) { const size_t ro = (size_t)(row0 + ai * HALF + m * 16) * ldp + col0;
                    const u32x4 za = *(const u32x4*)(Pz + ro + cza), zb = *(const u32x4*)(Pz + ro + czb);
                    f32x4 r0, r1;
#pragma unroll
                    for (int e = 0; e < 4; ++e) { const unsigned a = za[e], b = zb[e];
                        const float a_lo = __uint_as_float(a << 16), a_hi = __uint_as_float(a & 0xffff0000u), b_lo = __uint_as_float(b << 16), b_hi = __uint_as_float(b & 0xffff0000u);
                        const float ba_lo = (e < 2 ? ba0 : ba1)[(2 * e) & 3], ba_hi = (e < 2 ? ba0 : ba1)[(2 * e + 1) & 3], bb_lo = (e < 2 ? bb0 : bb1)[(2 * e) & 3], bb_hi = (e < 2 ? bb0 : bb1)[(2 * e + 1) & 3];
                        const float q_lo = (1.f + __expf(-(b_lo + bb_lo))) / (1.f + __expf(-(a_lo + ba_lo))), q_hi = (1.f + __expf(-(b_hi + bb_hi))) / (1.f + __expf(-(a_hi + ba_hi)));
                        if (e < 2) { r0[2 * e] = q_lo; r0[2 * e + 1] = q_hi; } else { r1[2 * e - 4] = q_lo; r1[2 * e - 3] = q_hi; } }
                    acc[ai][bj][m][0] *= r0; acc[ai][bj][m][1] *= r1; } }
    }
    __device__ __forceinline__ void operator()(const f32x4 (&acc)[2][2][4][2], const Unit& u, int wr, int wc, int fr, int fq) const {
        const int row0 = u.pm * BM + wr * 64 + fr;
#pragma unroll
        for (int bj = 0; bj < 2; ++bj) { const int col0 = u.pn * BM + bj * HALF + wc * 32 + 8 * fq;
            const f32x4 bb0 = *(const f32x4*)(bias + nb + col0), bb1 = *(const f32x4*)(bias + nb + col0 + 4);
#pragma unroll
            for (int ai = 0; ai < 2; ++ai)
#pragma unroll
                for (int m = 0; m < 4; ++m) { const int row = row0 + ai * HALF + m * 16;
                    const u32x4 zb = *(const u32x4*)(Pz + (size_t)row * ldp + col0 + czb);
                    float s[8];
#pragma unroll
                    for (int e = 0; e < 4; ++e) { const unsigned b = zb[e]; const float b_lo = __uint_as_float(b << 16), b_hi = __uint_as_float(b & 0xffff0000u);
                        const float bb_lo = (e < 2 ? bb0 : bb1)[(2 * e) & 3], bb_hi = (e < 2 ? bb0 : bb1)[(2 * e + 1) & 3];
                        s[2 * e] = 1.f / (1.f + __expf(-(b_lo + bb_lo))); s[2 * e + 1] = 1.f / (1.f + __expf(-(b_hi + bb_hi))); }
                    const f32x4 v0 = acc[ai][bj][m][0], v1 = acc[ai][bj][m][1];
                    u32x4 w; w.x = cvt_pk_bf16(v0[0] * s[0], v0[1] * s[1]); w.y = cvt_pk_bf16(v0[2] * s[2], v0[3] * s[3]); w.z = cvt_pk_bf16(v1[0] * s[4], v1[1] * s[5]); w.w = cvt_pk_bf16(v1[2] * s[6], v1[3] * s[7]);
                    *(u32x4*)(O + (size_t)row * ldc + col0) = w; } }
    }
};
struct EpiResid {
    static constexpr bool PERM = false, AFTER_DRAIN = false; static constexpr int HOOK_T = -1;
    const float* base; float* out; int ldc; float* rowss;
    __device__ __forceinline__ void operator()(const f32x4 (&acc)[2][2][4][2], const Unit& u, int wr, int wc, int fr, int fq) const {
        const int row0 = u.pm * BM + wr * 64 + fr, col0 = u.pn * BM + wc * 32 + 4 * fq;
#pragma unroll
        for (int ai = 0; ai < 2; ++ai)
#pragma unroll
            for (int m = 0; m < 4; ++m) { const int row = row0 + ai * HALF + m * 16; const size_t off = (size_t)row * ldc + col0; float ss = 0.f;
#pragma unroll
                for (int bj = 0; bj < 2; ++bj)
#pragma unroll
                    for (int n = 0; n < 2; ++n) { const f32x4 o = *(const f32x4*)(base + off + bj * HALF + n * 16) + acc[ai][bj][m][n];
                        *(f32x4*)(out + off + bj * HALF + n * 16) = o; ss += (o[0] * o[0] + o[1] * o[1]) + (o[2] * o[2] + o[3] * o[3]); }
                ss += __shfl_xor(ss, 16); ss += __shfl_xor(ss, 32);
                if (fq == 0) atomicAdd(rowss + row, ss); }
    }
};

template <class Epi, class Sched, bool ALIGN_EPI = false, bool SP2 = false>
__device__ __forceinline__ void gemm_phase(PG8_LAS unsigned char* lds, const Gemm g, const Sched& S, const Epi& E) {
    const int tid = threadIdx.x, wid = __builtin_amdgcn_readfirstlane(tid >> 6), lane = tid & 63, wr = wid >> 2, wc = wid & 3, fr = lane & 15, fq = lane >> 4;
    const int K = g.K, nt = K / BK;
    unsigned voffA[2], voffB[2];
#pragma unroll
    for (int i = 0; i < 2; ++i) { int R, C; stage_rc(tid * 16 + i * 8192, R, C); const int Rb = Epi::PERM ? ((R & ~31) + perm32(R & 31)) : R;
        voffA[i] = (unsigned)(R * K + C) * 2u; voffB[i] = (unsigned)(Rb * K + C) * 2u; }
    const size_t kstep = (size_t)(BK * 2);
    const size_t hstep = (size_t)HALF * K * 2;
    const size_t tstep = 2 * hstep;
    const unsigned ldsw = (unsigned)wid * 1024u;
    const int aoff = lds_byte(wr * 64 + fr, fq * 8), boff = lds_byte(wc * 32 + fr, fq * 8);
#define PG8_SA(b, h) (((b) * 2 + (h)) * HTB)
#define PG8_SB(b, h) ((4 + (b) * 2 + (h)) * HTB)
#define PG8_STAGE(bufoff, gbase, voff) do { _Pragma("unroll") for (int _i = 0; _i < 2; ++_i) \
        __builtin_amdgcn_global_load_lds((const unsigned*)((const char*)(gbase) + (voff)[_i]), (PG8_LAS unsigned*)(lds + (bufoff) + ldsw + _i * 8192), 16, 0, 0); } while (0)
#define PG8_LDA(dst, b, h) do { _Pragma("unroll") for (int m = 0; m < 4; ++m) _Pragma("unroll") for (int k = 0; k < 2; ++k) dst[m][k] = *(const PG8_LAS bf16x8*)(lds + PG8_SA(b, h) + aoff + m * 2048 + k * 1024); } while (0)
#define PG8_LDB(dst, b, h) do { _Pragma("unroll") for (int n = 0; n < 2; ++n) _Pragma("unroll") for (int k = 0; k < 2; ++k) dst[n][k] = *(const PG8_LAS bf16x8*)(lds + PG8_SB(b, h) + boff + n * 2048 + k * 1024); } while (0)
#define PG8_MMA(ai, bj, At, Bt) do { __builtin_amdgcn_s_setprio(1); _Pragma("unroll") for (int m = 0; m < 4; ++m) _Pragma("unroll") for (int n = 0; n < 2; ++n) _Pragma("unroll") for (int k = 0; k < 2; ++k) \
        acc[ai][bj][m][n] = __builtin_amdgcn_mfma_f32_16x16x32_bf16(Bt[n][k], At[m][k], acc[ai][bj][m][n], 0, 0, 0); __builtin_amdgcn_s_setprio(0); } while (0)
#define PG8_WAIT_V(n) asm volatile("s_waitcnt vmcnt(" #n ")" ::: "memory")
#define PG8_WAIT_L(n) asm volatile("s_waitcnt lgkmcnt(" #n ")" ::: "memory")
#define PG8_BAR __builtin_amdgcn_s_barrier()
#define PG8_SCHED __builtin_amdgcn_sched_barrier(0)
    Unit cur, nxt; int ui = 0;
    if (!S.next(0, cur)) return;
    f32x4 acc[2][2][4][2];
#pragma unroll
    for (int a = 0; a < 2; ++a)
#pragma unroll
        for (int b = 0; b < 2; ++b)
#pragma unroll
            for (int m = 0; m < 4; ++m)
#pragma unroll
                for (int n = 0; n < 2; ++n) acc[a][b][m][n] = (f32x4){0.f, 0.f, 0.f, 0.f};
    bf16x8 At[4][2], B0[2][2], B1[2][2];
    const char* cA = (const char*)g.A + (size_t)cur.pm * tstep; const char* cB = (const char*)g.Bt + (size_t)cur.pn * tstep;
    S.a_ready(cur);
    if constexpr (SP2) {
        PG8_STAGE(PG8_SB(0, 0), cB, voffB); PG8_STAGE(PG8_SB(0, 1), cB + hstep, voffB); PG8_STAGE(PG8_SA(0, 0), cA, voffA); PG8_STAGE(PG8_SA(0, 1), cA + hstep, voffA);
        if (wr == 1) PG8_BAR;
        PG8_WAIT_V(2); PG8_BAR;
        PG8_STAGE(PG8_SB(1, 0), cB + kstep, voffB); PG8_STAGE(PG8_SA(1, 0), cA + kstep, voffA); PG8_STAGE(PG8_SB(1, 1), cB + hstep + kstep, voffB);
        PG8_WAIT_V(6); PG8_BAR;
    } else {
        PG8_STAGE(PG8_SB(0, 0), cB, voffB); PG8_STAGE(PG8_SA(0, 0), cA, voffA); PG8_STAGE(PG8_SB(0, 1), cB + hstep, voffB); PG8_STAGE(PG8_SA(0, 1), cA + hstep, voffA);
        if (wr == 1) PG8_BAR;
        PG8_WAIT_V(4); PG8_BAR;
        PG8_STAGE(PG8_SB(1, 0), cB + kstep, voffB); PG8_STAGE(PG8_SA(1, 0), cA + kstep, voffA); PG8_STAGE(PG8_SB(1, 1), cB + hstep + kstep, voffB);
        PG8_WAIT_V(6); PG8_BAR;
    }
    for (;;) {
        const bool has_next = S.next(ui + 1, nxt);
        const char* nA = has_next ? (const char*)g.A + (size_t)nxt.pm * tstep : cA; const char* nB = has_next ? (const char*)g.Bt + (size_t)nxt.pn * tstep : cB;
        for (int t = 0; t < nt; t += 2) {
            if constexpr (Epi::HOOK_T >= 0) { if (t == Epi::HOOK_T) E.mid(acc, cur, wr, wc, fr, fq); }
            const bool last = (t == nt - 2);
            const char* a1 = cA + (size_t)(t + 1) * kstep;
            const char* a2 = last ? nA : cA + (size_t)(t + 2) * kstep; const char* b2 = last ? nB : cB + (size_t)(t + 2) * kstep;
            const char* a3 = a2 + kstep; const char* b3 = b2 + kstep;
            if (last && has_next) S.a_ready(nxt);
            if constexpr (SP2) {
            PG8_LDB(B0, 0, 0); PG8_LDB(B1, 0, 1); PG8_SCHED; PG8_LDA(At, 0, 0); PG8_STAGE(PG8_SA(1, 1), a1 + hstep, voffA);
            PG8_WAIT_V(8); PG8_WAIT_L(0); PG8_BAR; PG8_MMA(0, 0, At, B0); PG8_MMA(0, 1, At, B1); PG8_BAR; PG8_SCHED;
            PG8_LDA(At, 0, 1); PG8_STAGE(PG8_SB(0, 0), b2, voffB); PG8_STAGE(PG8_SB(0, 1), b2 + hstep, voffB); PG8_STAGE(PG8_SA(0, 0), a2, voffA);
            PG8_WAIT_V(8); PG8_WAIT_L(0); PG8_BAR; PG8_MMA(1, 0, At, B0); PG8_MMA(1, 1, At, B1); PG8_BAR; PG8_SCHED;
            PG8_LDB(B0, 1, 0); PG8_LDB(B1, 1, 1); PG8_SCHED; PG8_LDA(At, 1, 0); PG8_STAGE(PG8_SA(0, 1), a2 + hstep, voffA);
            PG8_WAIT_V(8); PG8_WAIT_L(0); PG8_BAR; PG8_MMA(0, 0, At, B0); PG8_MMA(0, 1, At, B1); PG8_BAR; PG8_SCHED;
            PG8_LDA(At, 1, 1); PG8_STAGE(PG8_SB(1, 0), b3, voffB); PG8_STAGE(PG8_SB(1, 1), b3 + hstep, voffB); PG8_STAGE(PG8_SA(1, 0), a3, voffA);
            PG8_WAIT_V(8); PG8_WAIT_L(0); PG8_BAR; PG8_MMA(1, 0, At, B0); PG8_MMA(1, 1, At, B1); PG8_BAR; PG8_SCHED;
            } else {
            PG8_LDB(B0, 0, 0); PG8_SCHED; PG8_LDA(At, 0, 0); PG8_STAGE(PG8_SA(1, 1), a1 + hstep, voffA);
            PG8_WAIT_L(8); PG8_BAR; PG8_WAIT_L(0); PG8_MMA(0, 0, At, B0); PG8_BAR; PG8_SCHED;
            PG8_LDB(B1, 0, 1); PG8_STAGE(PG8_SB(0, 0), b2, voffB);
            PG8_BAR; PG8_WAIT_L(0); PG8_MMA(0, 1, At, B1); PG8_BAR;
            PG8_LDA(At, 0, 1); PG8_STAGE(PG8_SA(0, 0), a2, voffA);
            PG8_BAR; PG8_WAIT_L(0); PG8_MMA(1, 0, At, B0); PG8_BAR; PG8_SCHED;
            PG8_STAGE(PG8_SB(0, 1), b2 + hstep, voffB);
            PG8_WAIT_V(6); PG8_BAR; PG8_MMA(1, 1, At, B1); PG8_BAR;
            PG8_LDB(B0, 1, 0); PG8_SCHED; PG8_LDA(At, 1, 0); PG8_STAGE(PG8_SA(0, 1), a2 + hstep, voffA);
            PG8_WAIT_L(8); PG8_BAR; PG8_WAIT_L(0); PG8_MMA(0, 0, At, B0); PG8_BAR; PG8_SCHED;
            PG8_LDB(B1, 1, 1); PG8_STAGE(PG8_SB(1, 0), b3, voffB);
            PG8_BAR; PG8_WAIT_L(0); PG8_MMA(0, 1, At, B1); PG8_BAR;
            PG8_LDA(At, 1, 1); PG8_STAGE(PG8_SA(1, 0), a3, voffA);
            PG8_BAR; PG8_WAIT_L(0); PG8_MMA(1, 0, At, B0); PG8_BAR; PG8_SCHED;
            PG8_STAGE(PG8_SB(1, 1), b3 + hstep, voffB);
            PG8_WAIT_V(6); PG8_BAR; PG8_MMA(1, 1, At, B1); PG8_BAR;
            }
        }
        if constexpr (ALIGN_EPI) { if (wr == 0) PG8_BAR; }
        if constexpr (!Epi::AFTER_DRAIN) { E(acc, cur, wr, wc, fr, fq); S.done(cur); }
        if (!has_next) break;
#pragma unroll
        for (int a = 0; a < 2; ++a)
#pragma unroll
            for (int b = 0; b < 2; ++b)
#pragma unroll
                for (int m = 0; m < 4; ++m)
#pragma unroll
                    for (int n = 0; n < 2; ++n) acc[a][b][m][n] = (f32x4){0.f, 0.f, 0.f, 0.f};
        cur = nxt; cA = nA; cB = nB; ++ui;
        if constexpr (ALIGN_EPI) { if (wr == 1) PG8_BAR; }
    }
    PG8_WAIT_V(0);
    if constexpr (!ALIGN_EPI) { if (wr == 0) PG8_BAR; }
    PG8_BAR;
    if constexpr (Epi::AFTER_DRAIN) { E.fused(acc, cur, wr, wc, fr, fq, lds, wid, lane); S.done(cur); }
#undef PG8_SA
#undef PG8_SB
#undef PG8_STAGE
#undef PG8_LDA
#undef PG8_LDB
#undef PG8_MMA
#undef PG8_WAIT_V
#undef PG8_WAIT_L
#undef PG8_BAR
#undef PG8_SCHED
}
}

namespace att {
using bf16 = unsigned short;
constexpr int   D = 128, NW = 8, QBLK = 32, KVBLK = 64;
constexpr float SCALE = 0.088388347648318440f;
constexpr float THR = 8.f;
constexpr int SDEPTH = 2;
constexpr int LDQ = 11776, LDK = 11776;
constexpr int LDY = 1536;
constexpr size_t SHM_V = KVBLK * D * 2, SHM_K = KVBLK * D * 2, SHM_ATTN = 2 * SHM_V + 2 * SHM_K + NW * 64 * 4;
__device__ __forceinline__ float bf2f_(bf16 h) { return __uint_as_float(((unsigned)h) << 16); }
__device__ __forceinline__ bf16 f2bf_(float f) { unsigned u = __float_as_uint(f); return (bf16)((u + 0x7fffu + ((u >> 16) & 1u)) >> 16); }
using bf16x8 = __attribute__((ext_vector_type(8))) short;
using s16x4  = __attribute__((ext_vector_type(4))) short;
using f32x16 = __attribute__((ext_vector_type(16))) float;
using f32x8  = __attribute__((ext_vector_type(8))) float;
using u32x4  = __attribute__((ext_vector_type(4))) unsigned;
#define KSWZ(row, colB) ((row) * 256 + ((colB) ^ (((row) & 7) << 4)))
#define SBAR() __builtin_amdgcn_sched_barrier(0)
__device__ __forceinline__ int crow(int r, int hi) { return (r & 3) + 8 * (r >> 2) + 4 * hi; }
__device__ __forceinline__ unsigned cvtpk(float lo, float hi) {
  unsigned r; asm volatile("v_cvt_pk_bf16_f32 %0, %1, %2" : "=v"(r) : "v"(lo), "v"(hi)); return r;
}
template <typename TIn> struct Stage;
template <> struct Stage<bf16>  { using T = bf16x8;
  __device__ static __forceinline__ T ld8(const bf16* p) { return *reinterpret_cast<const bf16x8*>(p); }
  __device__ static __forceinline__ bf16x8 tobf(T x) { return x; } };
template <> struct Stage<float> { using T = f32x8;
  __device__ static __forceinline__ T ld8(const float* p) { return *reinterpret_cast<const f32x8*>(p); }
  __device__ static __forceinline__ bf16x8 tobf(T x) {
    u32x4 w = {cvtpk(x[0], x[1]), cvtpk(x[2], x[3]), cvtpk(x[4], x[5]), cvtpk(x[6], x[7])}; return *reinterpret_cast<bf16x8*>(&w); } };

__device__ __forceinline__ void partialSM(f32x16& p0, f32x16& p1, float& m_reg, float& mn, float& alpha) {
  constexpr float C = SCALE * 1.4426950408889634f;
  float pmax = p0[0]; for (int r = 1; r < 16; ++r) pmax = fmaxf(pmax, p0[r]); for (int r = 0; r < 16; ++r) pmax = fmaxf(pmax, p1[r]);
  { auto rr = __builtin_amdgcn_permlane32_swap(__float_as_uint(pmax), __float_as_uint(pmax), false, false);
    pmax = fmaxf(__uint_as_float(rr[0]), __uint_as_float(rr[1])); }
  if (__builtin_expect(__all(pmax - m_reg <= THR / SCALE), 1)) { mn = m_reg; alpha = 1.f; }
  else { mn = fmaxf(m_reg, pmax); alpha = __builtin_amdgcn_exp2f((m_reg - mn) * C); m_reg = mn; }
  float mnC = -mn * C;
  for (int r = 0; r < 16; ++r) p0[r] = fmaf(p0[r], C, mnC); for (int r = 0; r < 16; ++r) p1[r] = fmaf(p1[r], C, mnC);
  for (int r = 0; r < 16; ++r) p0[r] = __builtin_amdgcn_exp2f(p0[r]);
}
__device__ __forceinline__ void finishSM(f32x16& p0, f32x16& p1, float alpha, float& l_reg, bf16x8& pa0, bf16x8& pa1, bf16x8& pa2, bf16x8& pa3) {
  for (int r = 0; r < 16; ++r) p1[r] = __builtin_amdgcn_exp2f(p1[r]);
  float ps = 0; for (int r = 0; r < 16; ++r) ps += p0[r]; for (int r = 0; r < 16; ++r) ps += p1[r];
  { auto rr = __builtin_amdgcn_permlane32_swap(__float_as_uint(ps), __float_as_uint(ps), false, false);
    ps = __uint_as_float(rr[0]) + __uint_as_float(rr[1]); }
  l_reg = l_reg * alpha + ps;
#define PK4(P, BASE, OUT) do { unsigned a0 = cvtpk(P[BASE + 0], P[BASE + 1]), a1 = cvtpk(P[BASE + 2], P[BASE + 3]);   \
    unsigned b0 = cvtpk(P[BASE + 4], P[BASE + 5]), b1 = cvtpk(P[BASE + 6], P[BASE + 7]);                              \
    auto r0 = __builtin_amdgcn_permlane32_swap(a0, b0, false, false); auto r1 = __builtin_amdgcn_permlane32_swap(a1, b1, false, false); \
    u32x4 w = {r0[0], r1[0], r0[1], r1[1]}; OUT = *reinterpret_cast<bf16x8*>(&w); } while (0)
  PK4(p0, 0, pa0); PK4(p0, 8, pa1); PK4(p1, 0, pa2); PK4(p1, 8, pa3);
#undef PK4
}
__device__ __forceinline__ void qkt(f32x16& p0, f32x16& p1, const bf16* Ks, const bf16x8* qr, int r32, int hi) {
  p0 = f32x16{}; p1 = f32x16{};
  for (int d0 = 0; d0 < 8; ++d0) { int cb = (d0 * 16 + hi * 8) * 2;
    bf16x8 b0 = *reinterpret_cast<const bf16x8*>((const char*)Ks + KSWZ(r32, cb));
    bf16x8 b1 = *reinterpret_cast<const bf16x8*>((const char*)Ks + KSWZ(32 + r32, cb));
    p0 = __builtin_amdgcn_mfma_f32_32x32x16_bf16(b0, qr[d0], p0, 0, 0, 0);
    p1 = __builtin_amdgcn_mfma_f32_32x32x16_bf16(b1, qr[d0], p1, 0, 0, 0); }
}
__device__ __forceinline__ int v_st(int k, int c) { const int kk = (k & ~0xC) | ((k & 4) << 1) | ((k & 8) >> 1); return ((kk >> 3) * 4 + (c >> 5)) * 512 + ((kk & 7) * 32 + (c & 31)) * 2; }
__device__ __forceinline__ int v_rd_base(int lane) { return ((lane & 3) << 3) | (((lane >> 2) & 3) << 6) | (((lane >> 4) & 1) << 5) | (((lane >> 5) & 1) << 8); }
constexpr int v_rd_off(int d0, int ks, int half) { return d0 * 512 + ks * 4096 + half * 2048; }
template <int OFF> __device__ __forceinline__ s16x4 tr_read(int vb) {
  s16x4 r; asm volatile("ds_read_b64_tr_b16 %0, %1 offset:%2" : "=&v"(r) : "v"(vb), "i"(OFF) : "memory"); return r;
}
template <int D0> __device__ __forceinline__ void pv_one(f32x16& od, int vb, bf16x8 pa0, bf16x8 pa1, bf16x8 pa2, bf16x8 pa3) {
  const s16x4 l0 = tr_read<v_rd_off(D0, 0, 0)>(vb), h0 = tr_read<v_rd_off(D0, 0, 1)>(vb), l1 = tr_read<v_rd_off(D0, 1, 0)>(vb), h1 = tr_read<v_rd_off(D0, 1, 1)>(vb);
  const s16x4 l2 = tr_read<v_rd_off(D0, 2, 0)>(vb), h2 = tr_read<v_rd_off(D0, 2, 1)>(vb), l3 = tr_read<v_rd_off(D0, 3, 0)>(vb), h3 = tr_read<v_rd_off(D0, 3, 1)>(vb);
  asm volatile("s_waitcnt lgkmcnt(0)" ::: "memory"); SBAR();
#define PK(L, H) (bf16x8){L[0], L[1], L[2], L[3], H[0], H[1], H[2], H[3]}
  od = __builtin_amdgcn_mfma_f32_32x32x16_bf16(pa0, PK(l0, h0), od, 0, 0, 0);
  od = __builtin_amdgcn_mfma_f32_32x32x16_bf16(pa1, PK(l1, h1), od, 0, 0, 0);
  od = __builtin_amdgcn_mfma_f32_32x32x16_bf16(pa2, PK(l2, h2), od, 0, 0, 0);
  od = __builtin_amdgcn_mfma_f32_32x32x16_bf16(pa3, PK(l3, h3), od, 0, 0, 0);
#undef PK
}
__device__ __forceinline__ void pv_d0(f32x16* o, int vb, bf16x8 pa0, bf16x8 pa1, bf16x8 pa2, bf16x8 pa3) {
  pv_one<0>(o[0], vb, pa0, pa1, pa2, pa3); pv_one<1>(o[1], vb, pa0, pa1, pa2, pa3); pv_one<2>(o[2], vb, pa0, pa1, pa2, pa3); pv_one<3>(o[3], vb, pa0, pa1, pa2, pa3);
}

__device__ __forceinline__ void attn_dense_body(const bf16* __restrict__ Qb, const bf16* __restrict__ Kh, const bf16* __restrict__ Vh,
                                                const bf16* __restrict__ Gb, bf16* __restrict__ Yb, int seq, char* lds) {
  using TQ = bf16; using St = Stage<bf16>; using SQ = Stage<TQ>;
  const int tid = threadIdx.x, wid = tid >> 6, lane = tid & 63, r32 = lane & 31, hi = lane >> 5;
  bf16* V_lds = (bf16*)lds; bf16* K_lds = (bf16*)(lds + 2 * SHM_V);
  float* ws = (float*)(lds + 2 * SHM_V + 2 * SHM_K) + wid * 64; float* li_l = ws; float* al_l = ws + 32;
  float m_reg = -1e30f, l_reg = 0; f32x16 o[4] = {}; bf16x8 qr[8];
  const TQ* Qw = Qb + (long)(wid * QBLK + r32) * LDQ + hi * 8;
#pragma unroll
  for (int d0 = 0; d0 < 8; ++d0) qr[d0] = SQ::tobf(SQ::ld8(Qw + d0 * 16));
  const int sr = tid >> 4, sc = (tid & 15) * 8, vst0 = v_st(sr, sc), vst1 = v_st(32 + sr, sc);
  const unsigned toff = (unsigned)(sr * LDK + sc);
  const int vb0 = (int)(uintptr_t)V_lds + v_rd_base(lane);
  struct { typename St::T vs0, vs1, ks0, ks1; } sr_[SDEPTH];
#define SLOAD(i, k0) do { const bf16* vb_ = Vh + (long)(k0) * LDK; const bf16* kb_ = Kh + (long)(k0) * LDK; \
    sr_[i].vs0 = St::ld8(vb_ + toff); sr_[i].vs1 = St::ld8(vb_ + 32 * LDK + toff); \
    sr_[i].ks0 = St::ld8(kb_ + toff); sr_[i].ks1 = St::ld8(kb_ + 32 * LDK + toff); } while (0)
#define SWRITE(b, i) do { *(bf16x8*)((char*)V_lds + (b) * SHM_V + vst0) = St::tobf(sr_[i].vs0);          \
    *(bf16x8*)((char*)V_lds + (b) * SHM_V + vst1) = St::tobf(sr_[i].vs1); int kc = sc * 2;               \
    *(bf16x8*)((char*)K_lds + (b) * SHM_K + KSWZ(sr, kc)) = St::tobf(sr_[i].ks0);                       \
    *(bf16x8*)((char*)K_lds + (b) * SHM_K + KSWZ(32 + sr, kc)) = St::tobf(sr_[i].ks1); } while (0)
#define SWAIT() do { if constexpr (SDEPTH == 2) asm volatile("s_waitcnt vmcnt(4)" ::: "memory"); else asm volatile("s_waitcnt vmcnt(0)" ::: "memory"); } while (0)
#define RESC(a) do { if (__any((a) < 1.f)) { if (hi == 0) al_l[r32] = (a); asm volatile("s_waitcnt lgkmcnt(0)" ::: "memory"); \
    for (int d = 0; d < 4; ++d) for (int r = 0; r < 16; ++r) o[d][r] *= al_l[crow(r, hi)]; } } while (0)
  f32x16 pA0, pA1, pB0, pB1; float mnA, mnB, alA, alB; bf16x8 pa0, pa1, pa2, pa3; const int NT = seq / KVBLK;
  constexpr int SE = 0, SO = SDEPTH - 1;
  SLOAD(SE, 0); asm volatile("s_waitcnt vmcnt(0)" ::: "memory"); SWRITE(0, SE); __syncthreads();
  qkt(pA0, pA1, K_lds, qr, r32, hi); partialSM(pA0, pA1, m_reg, mnA, alA);
  SLOAD(SO, KVBLK); if constexpr (SDEPTH == 2) { if (2 < NT) SLOAD(SE, 2 * KVBLK); }
  SWAIT(); SWRITE(1, SO); __syncthreads();
  for (int j = 1; j + 1 < NT; j += 2) {
    SBAR(); qkt(pB0, pB1, (bf16*)((char*)K_lds + SHM_K), qr, r32, hi);
    finishSM(pA0, pA1, alA, l_reg, pa0, pa1, pa2, pa3); SBAR();
    SLOAD(SO, (j + SDEPTH) * KVBLK); SBAR();
    pv_d0(o, vb0, pa0, pa1, pa2, pa3); partialSM(pB0, pB1, m_reg, mnB, alB);
    __syncthreads(); SWAIT(); SWRITE(0, SE);
    RESC(alB); __syncthreads();
    SBAR(); qkt(pA0, pA1, K_lds, qr, r32, hi);
    finishSM(pB0, pB1, alB, l_reg, pa0, pa1, pa2, pa3); SBAR();
    if (SDEPTH == 1 || j + 3 < NT) SLOAD(SE, (j + 1 + SDEPTH) * KVBLK); SBAR();
    pv_d0(o, vb0 + (int)SHM_V, pa0, pa1, pa2, pa3); partialSM(pA0, pA1, m_reg, mnA, alA);
    __syncthreads(); SWAIT(); SWRITE(1, SO);
    RESC(alA); __syncthreads();
  }
  SBAR(); qkt(pB0, pB1, (bf16*)((char*)K_lds + SHM_K), qr, r32, hi);
  finishSM(pA0, pA1, alA, l_reg, pa0, pa1, pa2, pa3); SBAR();
  pv_d0(o, vb0, pa0, pa1, pa2, pa3); partialSM(pB0, pB1, m_reg, mnB, alB);
  __syncthreads(); RESC(alB);
  finishSM(pB0, pB1, alB, l_reg, pa0, pa1, pa2, pa3); SBAR();
  pv_d0(o, vb0 + (int)SHM_V, pa0, pa1, pa2, pa3);
  if (hi == 0) li_l[r32] = l_reg; asm volatile("s_waitcnt lgkmcnt(0)" ::: "memory");
  float rli[16];
#pragma unroll
  for (int r = 0; r < 16; ++r) rli[r] = __builtin_amdgcn_rcpf(li_l[crow(r, hi)]);
  int eoff = wid * QBLK; asm volatile("" : "+v"(eoff));
  const bf16* Gw = Gb + (long)eoff * LDQ; bf16* Yw = Yb + (long)eoff * LDY;
  int hie = hi; asm volatile("" : "+v"(hie));
#pragma unroll
  for (int r = 0; r < 16; ++r) { const int orow = crow(r, hie);
#pragma unroll
    for (int d0 = 0; d0 < 4; ++d0) { const float gv = bf2f_(Gw[orow * LDQ + d0 * 32 + r32]);
      Yw[orow * LDY + d0 * 32 + r32] = f2bf_(o[d0][r] * rli[r] * (gv / (1.f + __expf(-gv)))); }
    asm volatile("" ::: "memory"); }
  __syncthreads();
#undef SLOAD
#undef SWRITE
#undef SWAIT
#undef RESC
}

__device__ __forceinline__ void attn_band_unit(const bf16* __restrict__ P, bf16* __restrict__ OG, float* __restrict__ LSE, int g, int b, int h, int blk, int cqb, int ckb, int cvb, int seqlen, int ntok, char* lds) {
  using St = Stage<bf16>;
  const int tid = threadIdx.x, lane = tid & 63, r32 = lane & 31, hi = lane >> 5; const int wid = __builtin_amdgcn_readfirstlane(tid >> 6);
  bf16* V_lds = (bf16*)lds; bf16* K_lds = (bf16*)(lds + 2 * SHM_V);
  float* ws = (float*)(lds + 2 * SHM_V + 2 * SHM_K) + wid * 64; float* li_l = ws; float* al_l = ws + 32;
  const int dil = (g == 0) ? 1 : (g == 1 ? 4 : 16), head = g * 4 + h;
  int rq, lq0, ntile, t_lo, res0;
  if (g < 2) { const int kb = (g == 0) ? blk : (blk & 1), nt_all = seqlen / dil / 64; res0 = (g == 0) ? 0 : (blk >> 1);
    rq = res0; lq0 = 256 * kb + 32 * wid; t_lo = (4 * kb - 1 < 0) ? 0 : 4 * kb - 1; const int t_hi = (4 * kb + 5 > nt_all) ? nt_all : 4 * kb + 5; ntile = t_hi - t_lo; }
  else { res0 = 2 * blk; rq = res0 + (wid >> 2); lq0 = 32 * (wid & 3); t_lo = 0; ntile = 4; }
  const long tok0 = (long)b * seqlen;
  const bf16* Pq = P + cqb + head * D; const bf16* Pk = P + ckb + head * D; const bf16* Pv = P + cvb + head * D;
  float m_reg = -1e30f, l_reg = 0; f32x16 o[4] = {}; bf16x8 qr[8];
  { const bf16* Qw = Pq + (tok0 + (long)(lq0 + r32) * dil + rq) * LDQ + hi * 8;
#pragma unroll
    for (int d0 = 0; d0 < 8; ++d0) qr[d0] = St::ld8(Qw + d0 * 16); }
  const int sr = tid >> 4, sc = (tid & 15) * 8, vst0 = v_st(sr, sc), vst1 = v_st(32 + sr, sc);
  const int vb0 = (int)(uintptr_t)V_lds + v_rd_base(lane);
  typename St::T vs0, vs1, ks0, ks1;
#define TILE_RK(tt) ((g < 2) ? res0 : res0 + ((tt) >> 1))
#define TILE_LK0(tt) ((g < 2) ? 64 * (t_lo + (tt)) : 64 * ((tt) & 1))
#define BLOAD(tt) do { const int rk_ = TILE_RK(tt), lk_ = TILE_LK0(tt); const long ta = (tok0 + (long)(lk_ + sr) * dil + rk_) * LDK + sc, tb = (tok0 + (long)(lk_ + 32 + sr) * dil + rk_) * LDK + sc; \
    vs0 = St::ld8(Pv + ta); vs1 = St::ld8(Pv + tb); ks0 = St::ld8(Pk + ta); ks1 = St::ld8(Pk + tb); } while (0)
  BLOAD(0);
  for (int tt = 0; tt < ntile; ++tt) {
    __syncthreads();
    { *(bf16x8*)((char*)V_lds + vst0) = vs0; *(bf16x8*)((char*)V_lds + vst1) = vs1; const int kc = sc * 2;
      *(bf16x8*)((char*)K_lds + KSWZ(sr, kc)) = ks0; *(bf16x8*)((char*)K_lds + KSWZ(32 + sr, kc)) = ks1; }
    __syncthreads();
    if (tt + 1 < ntile) BLOAD(tt + 1);
    const int rk = TILE_RK(tt), lk0 = TILE_LK0(tt);
    const bool need = (rk == rq) && (lk0 + 63 >= lq0 - 64) && (lk0 <= lq0 + 95);
    if (need) {
      f32x16 p0, p1; float mn, alpha; bf16x8 pa0, pa1, pa2, pa3;
      qkt(p0, p1, K_lds, qr, r32, hi);
      const int dd = lk0 - lq0 - r32 + 4 * hi;
#pragma unroll
      for (int r = 0; r < 16; ++r) { const int d0_ = dd + (r & 3) + 8 * (r >> 2), d1_ = d0_ + 32;
        if (d0_ < -64 || d0_ > 64) p0[r] = -INFINITY; if (d1_ < -64 || d1_ > 64) p1[r] = -INFINITY; }
      partialSM(p0, p1, m_reg, mn, alpha);
      if (__any(alpha < 1.f)) { if (hi == 0) al_l[r32] = alpha; asm volatile("s_waitcnt lgkmcnt(0)" ::: "memory");
#pragma unroll
        for (int d = 0; d < 4; ++d)
#pragma unroll
          for (int r = 0; r < 16; ++r) o[d][r] *= al_l[crow(r, hi)]; }
      finishSM(p0, p1, alpha, l_reg, pa0, pa1, pa2, pa3); SBAR();
      pv_d0(o, vb0, pa0, pa1, pa2, pa3);
    }
  }
#undef BLOAD
#undef TILE_RK
#undef TILE_LK0
  if (hi == 0) li_l[r32] = l_reg; asm volatile("s_waitcnt lgkmcnt(0)" ::: "memory");
  float rli[16];
#pragma unroll
  for (int r = 0; r < 16; ++r) rli[r] = __builtin_amdgcn_rcpf(li_l[crow(r, hi)]);
  bf16* Og = OG + (long)g * ntok * 512 + h * D;
#pragma unroll
  for (int r = 0; r < 16; ++r) { const long tok = tok0 + (long)(lq0 + crow(r, hi)) * dil + rq;
#pragma unroll
    for (int d0 = 0; d0 < 4; ++d0) Og[tok * 512 + d0 * 32 + r32] = f2bf_(o[d0][r] * rli[r]); }
  if (hi == 0) LSE[((long)g * ntok + tok0 + (long)(lq0 + r32) * dil + rq) * 4 + h] = m_reg * SCALE + __logf(l_reg);
  __syncthreads();
}
}

typedef unsigned short bf16_t;
constexpr int BATCH = 4, SEQ = 2048, DM = 2048, NTOK = BATCH * SEQ, NC = 11776;
constexpr int C_QA = 0, C_KA = 1024, C_VA = 1280, C_GA = 1536, C_QB = 2560, C_KB = 4096, C_VB = 5632, C_GB = 7168, C_ZA = 7680, C_ZB = 9728;
constexpr float EPS = 1e-6f;
constexpr size_t MiB = 1u << 20;
constexpr size_t WS_CTL = 0, WS_TAB = 1 * MiB, WS_WTIN = 2 * MiB, WS_WTAB = 48 * MiB, WS_WTO = 54 * MiB, WS_HB = 64 * MiB, WS_P = 96 * MiB, WS_Y = 280 * MiB, WS_OG = 304 * MiB, WS_LSE = 328 * MiB, WS_END = 330 * MiB;

#define LAS __attribute__((address_space(3)))
typedef float f32x4 __attribute__((ext_vector_type(4)));
typedef unsigned v4u __attribute__((ext_vector_type(4)));
constexpr int NWAVES = 8;
constexpr int LDS_BYTES = 147456;

__device__ __forceinline__ float bf2f(bf16_t h) { return __uint_as_float(((unsigned)h) << 16); }
__device__ __forceinline__ unsigned f2bf_u(float f) { unsigned u = __float_as_uint(f); return (u + 0x7fffu + ((u >> 16) & 1u)) >> 16; }
__device__ __forceinline__ bf16_t f2bf(float f) { return (bf16_t)f2bf_u(f); }
__device__ __forceinline__ unsigned pk2(float lo, float hi) { return f2bf_u(lo) | (f2bf_u(hi) << 16); }
__device__ __forceinline__ float wave_sum(float v) {
#pragma unroll
    for (int o = 1; o < 64; o <<= 1) v += __shfl_xor(v, o);
    return v;
}
__device__ __forceinline__ float silu(float v) { return v / (1.f + __expf(-v)); }

__device__ __forceinline__ int colmap(int kind, int p) {
    const int bj = p >> 7, wc = (p >> 5) & 3, n = (p >> 4) & 1, fq = (p >> 2) & 3, j = p & 3;
    const int gen = 128 * bj + 32 * wc + 8 * fq + 4 * n + j;
    if (kind == 0) return p;
    if (kind == 1) return gen;
    if (kind == 2) return 128 * bj + 64 * (wc >> 1) + 32 * n + 16 * (wc & 1) + 4 * fq + j;
    return wc == 0 ? p : gen;
}
__device__ __forceinline__ int kind_in(int pn) { (void)pn; return 1; }

__device__ __forceinline__ void transpose_item(const float* W, int N, bf16_t* WT, int ldt, int koff, int kindsel, LAS float* scr, int item, int lane) {
    const int nblk = N / 32, kb = item / nblk, nb = item % nblk, k0 = 64 * kb, n0 = 32 * nb;
    const int np = n0 + (lane & 31), pn = np >> 8;
    const int kind = kindsel < 0 ? kind_in(pn) : kindsel;
    const int srcc = (pn << 8) + colmap(kind, np & 255);
#pragma unroll 8
    for (int i = 0; i < 32; ++i) { const int kk = 2 * i + (lane >> 5); scr[kk * 33 + (lane & 31)] = W[(size_t)(k0 + kk) * N + srcc]; }
    asm volatile("s_waitcnt lgkmcnt(0)" ::: "memory");
    const int c = lane & 7;
#pragma unroll
    for (int j = 0; j < 4; ++j) { const int n = (lane >> 3) + 8 * j; const LAS float* s = scr + (8 * c) * 33 + n;
        v4u o; o.x = pk2(s[0 * 33], s[1 * 33]); o.y = pk2(s[2 * 33], s[3 * 33]); o.z = pk2(s[4 * 33], s[5 * 33]); o.w = pk2(s[6 * 33], s[7 * 33]);
        *(v4u*)(WT + (size_t)(n0 + n) * ldt + koff + k0 + 8 * c) = o; }
    asm volatile("s_waitcnt lgkmcnt(0)" ::: "memory");
}
__device__ __forceinline__ void rms_row_to_bf16(const float* xrow, const float* gain, bf16_t* orow, int lane) {
    const f32x4* xr = (const f32x4*)xrow + lane; const f32x4* gr = (const f32x4*)gain + lane;
    f32x4 v[8]; float s = 0.f;
#pragma unroll
    for (int j = 0; j < 8; ++j) { v[j] = xr[64 * j]; s += (v[j].x * v[j].x + v[j].y * v[j].y) + (v[j].z * v[j].z + v[j].w * v[j].w); }
    const float rs = rsqrtf(wave_sum(s) * (1.f / DM) + EPS);
    unsigned long long* o8 = (unsigned long long*)orow + lane;
#pragma unroll
    for (int j = 0; j < 8; ++j) { const f32x4 g = gr[64 * j]; const f32x4 y = v[j] * rs * g;
        o8[64 * j] = (unsigned long long)pk2(y.x, y.y) | ((unsigned long long)pk2(y.z, y.w) << 32); }
}

struct Args { const float* in[10]; float* out; unsigned char* ws; int ph_lo, ph_hi; };

__global__ void __launch_bounds__(NWAVES * 64, 2) mk_fwd(Args args) {
    extern __shared__ __attribute__((aligned(16))) unsigned char lds[];
    cg::grid_group grid = cg::this_grid();
    const int tid = threadIdx.x, lane = tid & 63, wave = __builtin_amdgcn_readfirstlane(tid >> 6);
    const int G = gridDim.x, bx = blockIdx.x;
    const int vcu = (G % 8 == 0) ? (bx % 8) * (G / 8) + bx / 8 : bx;
    unsigned char* ws = args.ws;
    const float* x = args.in[0]; const float* ng = args.in[1]; const float* w_in = args.in[2];
    bf16_t* WT_IN = (bf16_t*)(ws + WS_WTIN); bf16_t* HB = (bf16_t*)(ws + WS_HB); bf16_t* P = (bf16_t*)(ws + WS_P);
    float* COSA = (float*)(ws + WS_TAB); float* SINA = COSA + 2048; float* COSP = COSA + 4096; float* SINP = COSP + 32768;
    bf16_t* OG = (bf16_t*)(ws + WS_OG); float* LSE = (float*)(ws + WS_LSE); unsigned* CTL = (unsigned*)(ws + WS_CTL);
    bf16_t* WT_AB = (bf16_t*)(ws + WS_WTAB); bf16_t* WT_O = (bf16_t*)(ws + WS_WTO); bf16_t* Y = (bf16_t*)(ws + WS_Y); bf16_t* MG = HB; float* ROWSS = (float*)(ws + WS_CTL + 65536);
    const int lo = args.ph_lo, hi = args.ph_hi;
#define IN(k) (lo <= (k) && (k) < hi)
#define BOTH(k) (IN(k) && IN((k) + 1))
    if (IN(0)) {
        LAS float* scr = (LAS float*)((LAS unsigned char*)lds + wave * 16384);
        const int gw = vcu * NWAVES + wave, NGW = G * NWAVES;
        constexpr int I_IN = (DM / 64) * (NC / 32);
        constexpr int I_A = (1024 / 64) * (DM / 32), I_B = (512 / 64) * (DM / 32), I_O = (DM / 64) * (DM / 32);
        for (int it = gw; it < I_IN + I_A + I_B + I_O; it += NGW) {
            int r = it;
            if (r < I_IN) { transpose_item(w_in, NC, WT_IN, DM, 0, -1, scr, r, lane); continue; } r -= I_IN;
            if (r < I_A) { transpose_item(args.in[6], DM, WT_AB, 1536, 0, 1, scr, r, lane); continue; } r -= I_A;
            if (r < I_B) { transpose_item(args.in[7], DM, WT_AB, 1536, 1024, 1, scr, r, lane); continue; } r -= I_B;
            transpose_item(args.in[8], DM, WT_O, DM, 0, 0, scr, r, lane);
        }
        for (int i = bx * (NWAVES * 64) + tid; i < NTOK; i += G * NWAVES * 64) ROWSS[i] = 0.f;
        if (bx == 0 && tid == 0) CTL[0] = 0u;
        for (int i = bx * (NWAVES * 64) + tid; i < 2048 + 32768; i += G * NWAVES * 64) {
            if (i < 2048) { const int pos = i >> 5, fi = i & 31; const float a = (float)pos * (1.0f / powf(10000.0f, (float)fi / 32.0f)); COSA[i] = cosf(a); SINA[i] = sinf(a); }
            else { const int k = i - 2048, pos = k >> 4, fi = k & 15; const float a = (float)pos * (1.0f / powf(500000.0f, (float)fi / 16.0f)); COSP[k] = cosf(a); SINP[k] = sinf(a); }
        }
        for (int m = gw; m < NTOK; m += NGW) rms_row_to_bf16(x + (size_t)m * DM, ng, HB + (size_t)m * DM, lane);
        if (BOTH(0)) grid.sync();
    }
    if (IN(1)) {
        pg8::Gemm g{HB, WT_IN, NTOK, NC, DM}; pg8::StaticOrder S; S.init(NTOK, NC, G, bx);
        pg8::EpiRaw E{P, NC};
        pg8::gemm_phase<pg8::EpiRaw, pg8::StaticOrder, true, true>((LAS unsigned char*)lds, g, S, E);
        if (BOTH(1)) grid.sync();
    }
    if (IN(2)) {
        const int gw = vcu * NWAVES + wave, NGW = G * NWAVES; const float* qg = args.in[3]; const float* kg = args.in[4];
        {
            const int sub = lane >> 4, l16 = lane & 15;
            for (int it = gw; it < NTOK * 10 / 4; it += NGW) {
                const int item = it * 4 + sub, tok = item / 10, sl = item % 10, s = tok % SEQ;
                bf16_t* p = P + (size_t)tok * NC + (sl < 8 ? C_QA + sl * 128 : C_KA + (sl - 8) * 128) + l16 * 8;
                const float* gn = (sl < 8 ? qg : kg) + l16 * 8;
                const v4u raw = *(const v4u*)p; float v[8];
#pragma unroll
                for (int e = 0; e < 4; ++e) { v[2 * e] = __uint_as_float(raw[e] << 16); v[2 * e + 1] = __uint_as_float(raw[e] & 0xffff0000u); }
                float ss = 0.f;
#pragma unroll
                for (int e = 0; e < 8; ++e) ss += v[e] * v[e];
                ss += __shfl_xor(ss, 1); ss += __shfl_xor(ss, 2); ss += __shfl_xor(ss, 4); ss += __shfl_xor(ss, 8);
                const float rs = rsqrtf(ss * (1.f / 128.f) + EPS);
                const int pos = (l16 >> 3) ? (s & 63) : (s >> 6), i0 = 8 * (l16 & 3);
                float o[8];
#pragma unroll
                for (int e = 0; e < 8; ++e) { const float y = v[e] * rs * gn[e]; const float pr = __shfl_xor(y, 4);
                    const float c = COSA[pos * 32 + i0 + e], sn = SINA[pos * 32 + i0 + e];
                    o[e] = (l16 & 4) ? pr * sn + y * c : y * c - pr * sn; }
                v4u w; w.x = pk2(o[0], o[1]); w.y = pk2(o[2], o[3]); w.z = pk2(o[4], o[5]); w.w = pk2(o[6], o[7]);
                *(v4u*)p = w;
            }
        }
        {
            const int sub = lane >> 2, l4 = lane & 3;
            for (int it = gw; it < NTOK * 24 / 16; it += NGW) {
                const int item = it * 16 + sub, tok = item / 24, sl = item % 24, s = tok % SEQ;
                bf16_t* p = P + (size_t)tok * NC + (sl < 12 ? C_QB + sl * 128 : C_KB + (sl - 12) * 128) + l4 * 8;
                const v4u raw = *(const v4u*)p; float v[8];
#pragma unroll
                for (int e = 0; e < 4; ++e) { v[2 * e] = __uint_as_float(raw[e] << 16); v[2 * e + 1] = __uint_as_float(raw[e] & 0xffff0000u); }
                const int i0 = 8 * (l4 & 1);
                float o[8];
#pragma unroll
                for (int e = 0; e < 8; ++e) { const float y = v[e]; const float pr = __shfl_xor(y, 2);
                    const float c = COSP[s * 16 + i0 + e], sn = SINP[s * 16 + i0 + e];
                    o[e] = (l4 & 2) ? pr * sn + y * c : y * c - pr * sn; }
                v4u w; w.x = pk2(o[0], o[1]); w.y = pk2(o[2], o[3]); w.z = pk2(o[4], o[5]); w.w = pk2(o[6], o[7]);
                *(v4u*)p = w;
            }
        }
        if (BOTH(2)) grid.sync();
    }
    if (IN(3)) {
        for (int u = bx; u < 384; u += G) {
            const int blk = u & 7, h = (u >> 3) & 3, b = (u >> 5) & 3, g = u >> 7;
            att::attn_band_unit(P, OG, LSE, g, b, h, blk, C_QB, C_KB, C_VB, SEQ, NTOK, (char*)lds);
        }
        asm volatile("s_waitcnt vmcnt(0)" ::: "memory"); __syncthreads();
        if (tid == 0) { __builtin_amdgcn_fence(__ATOMIC_RELEASE, "agent"); asm volatile("s_waitcnt vmcnt(0)" ::: "memory"); __hip_atomic_fetch_add(CTL, 1u, __ATOMIC_RELAXED, __HIP_MEMORY_SCOPE_AGENT); }
        for (int u = bx; u < 256; u += G) {
            const int pair = u & 7, inner = u >> 3, b = pair >> 1, hkv = pair & 1, hq = hkv * 4 + (inner >> 3), qb = inner & 7;
            const size_t row0 = (size_t)b * SEQ + qb * 256;
            att::attn_dense_body(P + row0 * NC + C_QA + hq * 128, P + (size_t)b * SEQ * NC + C_KA + hkv * 128, P + (size_t)b * SEQ * NC + C_VA + hkv * 128,
                                 P + row0 * NC + C_GA + hq * 128, Y + row0 * 1536 + hq * 128, SEQ, (char*)lds);
        }
        if (tid == 0) { unsigned spins = 0; while (__hip_atomic_load(CTL, __ATOMIC_RELAXED, __HIP_MEMORY_SCOPE_AGENT) < (unsigned)G) { __builtin_amdgcn_s_sleep(4); if (++spins > (1u << 24)) break; }
            __builtin_amdgcn_fence(__ATOMIC_ACQUIRE, "agent"); asm volatile("s_waitcnt vmcnt(0)" ::: "memory"); }
        __syncthreads();
        for (int ci = bx * (NWAVES * 64) + tid; ci < NTOK * 64; ci += G * NWAVES * 64) {
            const int tok = ci >> 6, c8 = (ci & 63) * 8, h = c8 >> 7;
            const float l0 = LSE[((size_t)0 * NTOK + tok) * 4 + h], l1 = LSE[((size_t)1 * NTOK + tok) * 4 + h], l2 = LSE[((size_t)2 * NTOK + tok) * 4 + h];
            const float mx = fmaxf(l0, fmaxf(l1, l2)); float e0 = __expf(l0 - mx), e1 = __expf(l1 - mx), e2 = __expf(l2 - mx); const float inv = 1.f / (e0 + e1 + e2); e0 *= inv; e1 *= inv; e2 *= inv;
            const v4u a0 = *(const v4u*)(OG + ((size_t)0 * NTOK + tok) * 512 + c8), a1 = *(const v4u*)(OG + ((size_t)1 * NTOK + tok) * 512 + c8), a2 = *(const v4u*)(OG + ((size_t)2 * NTOK + tok) * 512 + c8);
            const v4u gz = *(const v4u*)(P + (size_t)tok * NC + C_GB + c8);
            v4u w;
#pragma unroll
            for (int e = 0; e < 4; ++e) {
                const float lo = e0 * __uint_as_float(a0[e] << 16) + e1 * __uint_as_float(a1[e] << 16) + e2 * __uint_as_float(a2[e] << 16);
                const float hh = e0 * __uint_as_float(a0[e] & 0xffff0000u) + e1 * __uint_as_float(a1[e] & 0xffff0000u) + e2 * __uint_as_float(a2[e] & 0xffff0000u);
                w[e] = pk2(lo * silu(__uint_as_float(gz[e] << 16)), hh * silu(__uint_as_float(gz[e] & 0xffff0000u))); }
            *(v4u*)(Y + (size_t)tok * 1536 + 1024 + c8) = w;
        }
        if (BOTH(3)) grid.sync();
    }
    if (IN(4)) {
        pg8::Gemm g{Y, WT_AB, NTOK, DM, 1536}; pg8::StaticOrder S; S.init(NTOK, DM, G, bx);
        pg8::EpiMerge E{P, NC, C_ZA, C_ZB, args.in[5], DM, MG, DM};
        pg8::gemm_phase<pg8::EpiMerge, pg8::StaticOrder, true, true>((LAS unsigned char*)lds, g, S, E);
        if (BOTH(4)) grid.sync();
    }
    if (IN(5)) {
        pg8::Gemm g{MG, WT_O, NTOK, DM, DM}; pg8::StaticOrder S; S.init(NTOK, DM, G, bx);
        pg8::EpiResid E{x, args.out, DM, ROWSS};
        pg8::gemm_phase<pg8::EpiResid, pg8::StaticOrder, true, true>((LAS unsigned char*)lds, g, S, E);
        if (BOTH(5)) grid.sync();
    }
    if (IN(6)) {
        const int gw = vcu * NWAVES + wave, NGW = G * NWAVES; const float* fg = args.in[9];
        for (int m = gw; m < NTOK; m += NGW) {
            const float rs = rsqrtf(ROWSS[m] * (1.f / DM) + EPS);
            f32x4* orow = (f32x4*)(args.out + (size_t)m * DM) + lane; const f32x4* gr = (const f32x4*)fg + lane;
#pragma unroll
            for (int j = 0; j < 8; ++j) orow[64 * j] = orow[64 * j] * rs * gr[64 * j];
        }
    }
#undef IN
#undef BOTH
}


extern "C" void kernel_launch(void* const* d_in, const int* in_sizes, int n_in, void* d_out, int out_size, void* d_ws, size_t ws_size, hipStream_t stream) {
    static int grid = 0;
    if (grid == 0) {
        if (n_in != 10 || in_sizes[0] != NTOK * DM || out_size != NTOK * DM || ws_size < WS_END) { fprintf(stderr, "kernel_launch: unexpected shapes / workspace (%zu)\n", ws_size); grid = -1; return; }
        int dev = 0, cus = 0, per_cu = 0;
        if (hipGetDevice(&dev) != hipSuccess || hipDeviceGetAttribute(&cus, hipDeviceAttributeMultiprocessorCount, dev) != hipSuccess) { grid = -1; return; }
        if (hipFuncSetAttribute((const void*)mk_fwd, hipFuncAttributeMaxDynamicSharedMemorySize, LDS_BYTES) != hipSuccess) { fprintf(stderr, "kernel_launch: hipFuncSetAttribute failed\n"); grid = -1; return; }
        if (hipOccupancyMaxActiveBlocksPerMultiprocessor(&per_cu, (const void*)mk_fwd, NWAVES * 64, LDS_BYTES) != hipSuccess || per_cu < 1) { fprintf(stderr, "kernel_launch: occupancy query says %d\n", per_cu); grid = -1; return; }
        grid = cus;
    }
    if (grid < 0) return;
    Args a{};
    for (int i = 0; i < 10; ++i) a.in[i] = (const float*)d_in[i];
    a.out = (float*)d_out; a.ws = (unsigned char*)d_ws; a.ph_lo = 0; a.ph_hi = 7;
    void* kargs[] = {&a};
    hipError_t e = hipLaunchCooperativeKernel((const void*)mk_fwd, dim3(grid), dim3(NWAVES * 64), kargs, LDS_BYTES, stream);
    if (e != hipSuccess) fprintf(stderr, "kernel_launch: cooperative launch failed: %s (grid %d)\n", hipGetErrorString(e), grid);
}
```

```cpp
#include <hip/hip_runtime.h>
#include <hip/hip_cooperative_groups.h>
#include <cstdio>
#include <cstdint>
#include <cmath>
namespace cg = cooperative_groups;
namespace pg8 {
#define PG8_LAS __attribute__((address_space(3)))
typedef unsigned short bf16_t;
typedef short bf16x8 __attribute__((ext_vector_type(8)));
typedef float f32x4 __attribute__((ext_vector_type(4)));
typedef unsigned u32x4 __attribute__((ext_vector_type(4)));
constexpr int BM = 256, BK = 64, HALF = 128, HTB = HALF * BK * 2  , STAGE_BYTES = 8 * HTB, NXCD = 8, WGM = 8;

__host__ __device__ __forceinline__ int lds_byte(int r, int c) { const int st = (r >> 4) * 2 + (c >> 5), rr = r & 15, cc = c & 31, ob = rr * 64 + cc * 2; return st * 1024 + (ob ^ (((ob >> 9) & 1) << 5)); }
__host__ __device__ __forceinline__ void stage_rc(int b, int& R, int& C) { const int st = b / 1024, sb = b % 1024, swz = sb ^ (((sb >> 9) & 1) << 5); R = (st >> 1) * 16 + swz / 64; C = (st & 1) * 32 + (swz % 64) / 2; }
__host__ __device__ __forceinline__ int perm32(int rho) { const int n = rho >> 4, i = rho & 15; return 8 * (i >> 2) + 4 * n + (i & 3); }

struct Unit { int pm, pn; };
struct Gemm { const bf16_t* A; const bf16_t* Bt; int M, N, K; };

struct StaticOrder {
    int nM, nN, nwg, G, c;
    __host__ __device__ void init(int M, int N, int G_, int c_) { nM = M / BM; nN = N / BM; nwg = nM * nN; G = G_; c = c_; }
    __host__ __device__ bool next(int i, Unit& u) const {
        const long L = (long)i * G + c; if (L >= nwg) return false;
        int wgid = (int)L; { const int q = nwg / NXCD, r = nwg % NXCD, xcd = wgid % NXCD, off = wgid / NXCD; wgid = (xcd < r ? xcd * (q + 1) : r * (q + 1) + (xcd - r) * q) + off; }
        const int nig = WGM * nN, gid = wgid / nig, fm = gid * WGM, gsz = (nM - fm) < WGM ? (nM - fm) : WGM;
        u.pm = fm + ((wgid % nig) % gsz); u.pn = (wgid % nig) / gsz; return true;
    }
    __device__ __forceinline__ void a_ready(const Unit&) const {}
    __device__ __forceinline__ void done(const Unit&) const {}
};

__device__ __forceinline__ unsigned cvt_pk_bf16(float lo, float hi) { unsigned r; asm volatile("v_cvt_pk_bf16_f32 %0, %1, %2" : "=v"(r) : "v"(lo), "v"(hi)); return r; }
typedef float f32x2 __attribute__((ext_vector_type(2)));

struct EpiRaw {
    static constexpr bool PERM = false, AFTER_DRAIN = false; static constexpr int HOOK_T = -1;
    bf16_t* O; int ldc;
    __device__ __forceinline__ void operator()(const f32x4 (&acc)[2][2][4][2], const Unit& u, int wr, int wc, int fr, int fq) const {
        const int row0 = u.pm * BM + wr * 64 + fr, col0 = u.pn * BM + wc * 32 + 8 * fq;
#pragma unroll
        for (int ai = 0; ai < 2; ++ai)
#pragma unroll
            for (int m = 0; m < 4; ++m) { bf16_t* rowp = O + (size_t)(row0 + ai * HALF + m * 16) * ldc + col0;
#pragma unroll
                for (int bj = 0; bj < 2; ++bj) { const f32x4 v0 = acc[ai][bj][m][0], v1 = acc[ai][bj][m][1];
                    u32x4 w; w.x = cvt_pk_bf16(v0[0], v0[1]); w.y = cvt_pk_bf16(v0[2], v0[3]); w.z = cvt_pk_bf16(v1[0], v1[1]); w.w = cvt_pk_bf16(v1[2], v1[3]);
                    *(u32x4*)(rowp + bj * HALF) = w; } }
    }
};

struct EpiMerge {
    static constexpr bool PERM = false, AFTER_DRAIN = false; static constexpr int HOOK_T = 16;
    const bf16_t* Pz; int ldp, cza, czb; const float* bias; int nb; bf16_t* O; int ldc;
    __device__ __forceinline__ void mid(f32x4 (&acc)[2][2][4][2], const Unit& u, int wr, int wc, int fr, int fq) const {
        int row0 = u.pm * BM + wr * 64 + fr; asm volatile("" : "+v"(row0));
#pragma unroll
        for (int bj = 0; bj < 2; ++bj) { const int col0 = u.pn * BM + bj * HALF + wc * 32 + 8 * fq;
            const f32x4 ba0 = *(const f32x4*)(bias + col0), ba1 = *(const f32x4*)(bias + col0 + 4), bb0 = *(const f32x4*)(bias + nb + col0), bb1 = *(const f32x4*)(bias + nb + col0 + 4);
#pragma unroll
            for (int ai = 0; ai < 2; ++ai)
#pragma unroll
                for (int m = 0; m < 4; ++m) { const size_t ro = (size_t)(row0 + ai * HALF + m * 16) * ldp + col0;
                    const u32x4 za = *(const u32x4*)(Pz + ro + cza), zb = *(const u32x4*)(Pz + ro + czb);
                    f32x4 r0, r1;
#pragma unroll
                    for (int e = 0; e < 4; ++e) { const unsigned a = za[e], b = zb[e];
                        const float a_lo = __uint_as_float(a << 16), a_hi = __uint_as_float(a & 0xffff0000u), b_lo = __uint_as_float(b << 16), b_hi = __uint_as_float(b & 0xffff0000u);
                        const float ba_lo = (e < 2 ? ba0 : ba1)[(2 * e) & 3], ba_hi = (e < 2 ? ba0 : ba1)[(2 * e + 1) & 3], bb_lo = (e < 2 ? bb0 : bb1)[(2 * e) & 3], bb_hi = (e < 2 ? bb0 : bb1)[(2 * e + 1) & 3];
                        const float q_lo = (1.f + __expf(-(b_lo + bb_lo))) / (1.f + __expf(-(a_lo + ba_lo))), q_hi = (1.f + __expf(-(b_hi + bb_hi))) / (1.f + __expf(-(a_hi + ba_hi)));
                        if (e < 2) { r0[2 * e] = q_lo; r0[2 * e + 1] = q_hi; } else { r1[2 * e - 4] = q_lo; r1[2 * e - 3] = q_hi; } }
                    acc[ai][bj][m][0] *= r0; acc[ai][bj][m][1] *= r1; } }
    }
    __device__ __forceinline__ void operator()(const f32x4 (&acc)[2][2][4][2], const Unit& u, int wr, int wc, int fr, int fq) const {
        const int row0 = u.pm * BM + wr * 64 + fr;
#pragma unroll
        for (int bj = 0; bj < 2; ++bj) { const int col0 = u.pn * BM + bj * HALF + wc * 32 + 8 * fq;
            const f32x4 bb0 = *(const f32x4*)(bias + nb + col0), bb1 = *(const f32x4*)(bias + nb + col0 + 4);
#pragma unroll
            for (int ai = 0; ai < 2; ++ai)
#pragma unroll
                for (int m = 0; m < 4; ++m) { const int row = row0 + ai * HALF + m * 16;
                    const u32x4 zb = *(const u32x4*)(Pz + (size_t)row * ldp + col0 + czb);
                    float s[8];
#pragma unroll
                    for (int e = 0; e < 4; ++e) { const unsigned b = zb[e]; const float b_lo = __uint_as_float(b << 16), b_hi = __uint_as_float(b & 0xffff0000u);
                        const float bb_lo = (e < 2 ? bb0 : bb1)[(2 * e) & 3], bb_hi = (e < 2 ? bb0 : bb1)[(2 * e + 1) & 3];
                        s[2 * e] = 1.f / (1.f + __expf(-(b_lo + bb_lo))); s[2 * e + 1] = 1.f / (1.f + __expf(-(b_hi + bb_hi))); }
                    const f32x4 v0 = acc[ai][bj][m][0], v1 = acc[ai][bj][m][1];
                    u32x4 w; w.x = cvt_pk_bf16(v0[0] * s[0], v0[1] * s[1]); w.y = cvt_pk_bf16(v0[2] * s[2], v0[3] * s[3]); w.z = cvt_pk_bf16(v1[0] * s[4], v1[1] * s[5]); w.w = cvt_pk_bf16(v1[2] * s[6], v1[3] * s[7]);
                    *(u32x4*)(O + (size_t)row * ldc + col0) = w; } }
    }
};
struct EpiResid {
    static constexpr bool PERM = false, AFTER_DRAIN = false; static constexpr int HOOK_T = -1;
    const float* base; float* out; int ldc; float* rowss;
    __device__ __forceinline__ void operator()(const f32x4 (&acc)[2][2][4][2], const Unit& u, int wr, int wc, int fr, int fq) const {
        const int row0 = u.pm * BM + wr * 64 + fr, col0 = u.pn * BM + wc * 32 + 4 * fq;
#pragma unroll
        for (int ai = 0; ai < 2; ++ai)
#pragma unroll
            for (int m = 0; m < 4; ++m) { const int row = row0 + ai * HALF + m * 16; const size_t off = (size_t)row * ldc + col0; float ss = 0.f;
#pragma unroll
                for (int bj = 0; bj < 2; ++bj)
#pragma unroll
                    for (int n = 0; n < 2; ++n) { const f32x4 o = *(const f32x4*)(base + off + bj * HALF + n * 16) + acc[ai][bj][m][n];
                        *(f32x4*)(out + off + bj * HALF + n * 16) = o; ss += (o[0] * o[0] + o[1] * o[1]) + (o[2] * o[2] + o[3] * o[3]); }
                ss += __shfl_xor(ss, 16); ss += __shfl_xor(ss, 32);
                if (fq == 0) atomicAdd(rowss + row, ss); }
    }
};

template <class Epi, class Sched, bool ALIGN_EPI = false, bool SP2 = false>
__device__ __forceinline__ void gemm_phase(PG8_LAS unsigned char* lds, const Gemm g, const Sched& S, const Epi& E) {
    const int tid = threadIdx.x, wid = __builtin_amdgcn_readfirstlane(tid >> 6), lane = tid & 63, wr = wid >> 2, wc = wid & 3, fr = lane & 15, fq = lane >> 4;
    const int K = g.K, nt = K / BK;
    unsigned voffA[2], voffB[2];
#pragma unroll
    for (int i = 0; i < 2; ++i) { int R, C; stage_rc(tid * 16 + i * 8192, R, C); const int Rb = Epi::PERM ? ((R & ~31) + perm32(R & 31)) : R;
        voffA[i] = (unsigned)(R * K + C) * 2u; voffB[i] = (unsigned)(Rb * K + C) * 2u; }
    const size_t kstep = (size_t)(BK * 2);
    const size_t hstep = (size_t)HALF * K * 2;
    const size_t tstep = 2 * hstep;
    const unsigned ldsw = (unsigned)wid * 1024u;
    const int aoff = lds_byte(wr * 64 + fr, fq * 8), boff = lds_byte(wc * 32 + fr, fq * 8);
#define PG8_SA(b, h) (((b) * 2 + (h)) * HTB)
#define PG8_SB(b, h) ((4 + (b) * 2 + (h)) * HTB)
#define PG8_STAGE(bufoff, gbase, voff) do { _Pragma("unroll") for (int _i = 0; _i < 2; ++_i) \
        __builtin_amdgcn_global_load_lds((const unsigned*)((const char*)(gbase) + (voff)[_i]), (PG8_LAS unsigned*)(lds + (bufoff) + ldsw + _i * 8192), 16, 0, 0); } while (0)
#define PG8_LDA(dst, b, h) do { _Pragma("unroll") for (int m = 0; m < 4; ++m) _Pragma("unroll") for (int k = 0; k < 2; ++k) dst[m][k] = *(const PG8_LAS bf16x8*)(lds + PG8_SA(b, h) + aoff + m * 2048 + k * 1024); } while (0)
#define PG8_LDB(dst, b, h) do { _Pragma("unroll") for (int n = 0; n < 2; ++n) _Pragma("unroll") for (int k = 0; k < 2; ++k) dst[n][k] = *(const PG8_LAS bf16x8*)(lds + PG8_SB(b, h) + boff + n * 2048 + k * 1024); } while (0)
#define PG8_MMA(ai, bj, At, Bt) do { __builtin_amdgcn_s_setprio(1); _Pragma("unroll") for (int m = 0; m < 4; ++m) _Pragma("unroll") for (int n = 0; n < 2; ++n) _Pragma("unroll") for (int k = 0; k < 2; ++k) \
        acc[ai][bj][m][n] = __builtin_amdgcn_mfma_f32_16x16x32_bf16(Bt[n][k], At[m][k], acc[ai][bj][m][n], 0, 0, 0); __builtin_amdgcn_s_setprio(0); } while (0)
#define PG8_WAIT_V(n) asm volatile("s_waitcnt vmcnt(" #n ")" ::: "memory")
#define PG8_WAIT_L(n) asm volatile("s_waitcnt lgkmcnt(" #n ")" ::: "memory")
#define PG8_BAR __builtin_amdgcn_s_barrier()
#define PG8_SCHED __builtin_amdgcn_sched_barrier(0)
    Unit cur, nxt; int ui = 0;
    if (!S.next(0, cur)) return;
    f32x4 acc[2][2][4][2];
#pragma unroll
    for (int a = 0; a < 2; ++a)
#pragma unroll
        for (int b = 0; b < 2; ++b)
#pragma unroll
            for (int m = 0; m < 4; ++m)
#pragma unroll
                for (int n = 0; n < 2; ++n) acc[a][b][m][n] = (f32x4){0.f, 0.f, 0.f, 0.f};
    bf16x8 At[4][2], B0[2][2], B1[2][2];
    const char* cA = (const char*)g.A + (size_t)cur.pm * tstep; const char* cB = (const char*)g.Bt + (size_t)cur.pn * tstep;
    S.a_ready(cur);
    if constexpr (SP2) {
        PG8_STAGE(PG8_SB(0, 0), cB, voffB); PG8_STAGE(PG8_SB(0, 1), cB + hstep, voffB); PG8_STAGE(PG8_SA(0, 0), cA, voffA); PG8_STAGE(PG8_SA(0, 1), cA + hstep, voffA);
        if (wr == 1) PG8_BAR;
        PG8_WAIT_V(2); PG8_BAR;
        PG8_STAGE(PG8_SB(1, 0), cB + kstep, voffB); PG8_STAGE(PG8_SA(1, 0), cA + kstep, voffA); PG8_STAGE(PG8_SB(1, 1), cB + hstep + kstep, voffB);
        PG8_WAIT_V(6); PG8_BAR;
    } else {
        PG8_STAGE(PG8_SB(0, 0), cB, voffB); PG8_STAGE(PG8_SA(0, 0), cA, voffA); PG8_STAGE(PG8_SB(0, 1), cB + hstep, voffB); PG8_STAGE(PG8_SA(0, 1), cA + hstep, voffA);
        if (wr == 1) PG8_BAR;
        PG8_WAIT_V(4); PG8_BAR;
        PG8_STAGE(PG8_SB(1, 0), cB + kstep, voffB); PG8_STAGE(PG8_SA(1, 0), cA + kstep, voffA); PG8_STAGE(PG8_SB(1, 1), cB + hstep + kstep, voffB);
        PG8_WAIT_V(6); PG8_BAR;
    }
    for (;;) {
        const bool has_next = S.next(ui + 1, nxt);
        const char* nA = has_next ? (const char*)g.A + (size_t)nxt.pm * tstep : cA; const char* nB = has_next ? (const char*)g.Bt + (size_t)nxt.pn * tstep : cB;
        for (int t = 0; t < nt; t += 2) {
            if constexpr (Epi::HOOK_T >= 0) { if (t == Epi::HOOK_T) E.mid(acc, cur, wr, wc, fr, fq); }
            const bool last = (t == nt - 2);
            const char* a1 = cA + (size_t)(t + 1) * kstep;
            const char* a2 = last ? nA : cA + (size_t)(t + 2) * kstep; const char* b2 = last ? nB : cB + (size_t)(t + 2) * kstep;
            const char* a3 = a2 + kstep; const char* b3 = b2 + kstep;
            if (last && has_next) S.a_ready(nxt);
            if constexpr (SP2) {
            PG8_LDB(B0, 0, 0); PG8_LDB(B1, 0, 1); PG8_SCHED; PG8_LDA(At, 0, 0); PG8_STAGE(PG8_SA(1, 1), a1 + hstep, voffA);
            PG8_WAIT_V(8); PG8_WAIT_L(0); PG8_BAR; PG8_MMA(0, 0, At, B0); PG8_MMA(0, 1, At, B1); PG8_BAR; PG8_SCHED;
            PG8_LDA(At, 0, 1); PG8_STAGE(PG8_SB(0, 0), b2, voffB); PG8_STAGE(PG8_SB(0, 1), b2 + hstep, voffB); PG8_STAGE(PG8_SA(0, 0), a2, voffA);
            PG8_WAIT_V(8); PG8_WAIT_L(0); PG8_BAR; PG8_MMA(1, 0, At, B0); PG8_MMA(1, 1, At, B1); PG8_BAR; PG8_SCHED;
            PG8_LDB(B0, 1, 0); PG8_LDB(B1, 1, 1); PG8_SCHED; PG8_LDA(At, 1, 0); PG8_STAGE(PG8_SA(0, 1), a2 + hstep, voffA);
            PG8_WAIT_V(8); PG8_WAIT_L(0); PG8_BAR; PG8_MMA(0, 0, At, B0); PG8_MMA(0, 1, At, B1); PG8_BAR; PG8_SCHED;
            PG8_LDA(At, 1, 1); PG8_STAGE(PG8_SB(1, 0), b3, voffB); PG8_STAGE(PG8_SB(1, 1), b3 + hstep, voffB); PG8_STAGE(PG8_SA(1, 0), a3, voffA);
            PG8_WAIT_V(8); PG8_WAIT_L(0); PG8_BAR; PG8_MMA(1, 0, At, B0); PG8_MMA(1, 1, At, B1); PG8_BAR; PG8_SCHED;
            } else {
            PG8_LDB(B0, 0, 0); PG8_SCHED; PG8_LDA(At, 0, 0); PG8_STAGE(PG8_SA(1, 1), a1 + hstep, voffA);
            PG8_WAIT_L(8); PG8_BAR; PG8_WAIT_L(0); PG8_MMA(0, 0, At, B0); PG8_BAR; PG8_SCHED;
            PG8_LDB(B1, 0, 1); PG8_STAGE(PG8_SB(0, 0), b2, voffB);
            PG8_BAR; PG8_WAIT_L(0); PG8_MMA(0, 1, At, B1); PG8_BAR;
            PG8_LDA(At, 0, 1); PG8_STAGE(PG8_SA(0, 0), a2, voffA);
            PG8_BAR; PG8_WAIT_L(0); PG8_MMA(1, 0, At, B0); PG8_BAR; PG8_SCHED;
            PG8_STAGE(PG8_SB(0, 1), b2 + hstep, voffB);
            PG8_WAIT_V(6); PG8_BAR; PG8_MMA(1, 1, At, B1); PG8_BAR;
            PG8_LDB(B0, 1, 0); PG8_SCHED; PG8_LDA(At, 1, 0); PG8_STAGE(PG8_SA(0, 1), a2 + hstep, voffA);
            PG8_WAIT_L(8); PG8_BAR; PG8_WAIT_L(0); PG8_MMA(0, 0, At, B0); PG8_BAR; PG8_SCHED;
            PG8_LDB(B1, 1, 1); PG8_STAGE(PG8_SB(1, 0), b3, voffB);
            PG8_BAR; PG8_WAIT_L(0); PG8_MMA(0, 1, At, B1); PG8_BAR;
            PG8_LDA(At, 1, 1); PG8_STAGE(PG8_SA(1, 0), a3, voffA);
            PG8_BAR; PG8_WAIT_L(0); PG8_MMA(1, 0, At, B0); PG8_BAR; PG8_SCHED;
            PG8_STAGE(PG8_SB(1, 1), b3 + hstep, voffB);
            PG8_WAIT_V(6); PG8_BAR; PG8_MMA(1, 1, At, B1); PG8_BAR;
            }
        }
        if constexpr (ALIGN_EPI) { if (wr == 0) PG8_BAR; }
        if constexpr (!Epi::AFTER_DRAIN) { E(acc, cur, wr, wc, fr, fq); S.done(cur); }
        if (!has_next) break;
#pragma unroll
        for (int a = 0; a < 2; ++a)
#pragma unroll
            for (int b = 0; b < 2; ++b)
#pragma unroll
                for (int m = 0; m < 4; ++m)
#pragma unroll
                    for (int n = 0; n < 2; ++n) acc[a][b][m][n] = (f32x4){0.f, 0.f, 0.f, 0.f};
        cur = nxt; cA = nA; cB = nB; ++ui;
        if constexpr (ALIGN_EPI) { if (wr == 1) PG8_BAR; }
    }
    PG8_WAIT_V(0);
    if constexpr (!ALIGN_EPI) { if (wr == 0) PG8_BAR; }
    PG8_BAR;
    if constexpr (Epi::AFTER_DRAIN) { E.fused(acc, cur, wr, wc, fr, fq, lds, wid, lane); S.done(cur); }
#undef PG8_SA
#undef PG8_SB
#undef PG8_STAGE
#undef PG8_LDA
#undef PG8_LDB
#undef PG8_MMA
#undef PG8_WAIT_V
#undef PG8_WAIT_L
#undef PG8_BAR
#undef PG8_SCHED
}
}

namespace att {
using bf16 = unsigned short;
constexpr int   D = 128, NW = 8, QBLK = 32, KVBLK = 64;
constexpr float SCALE = 0.088388347648318440f;
constexpr float THR = 8.f;
constexpr int SDEPTH = 2;
constexpr int LDQ = 11776, LDK = 11776;
constexpr int LDY = 1536;
constexpr size_t SHM_V = KVBLK * D * 2, SHM_K = KVBLK * D * 2, SHM_ATTN = 2 * SHM_V + 2 * SHM_K + NW * 64 * 4;
__device__ __forceinline__ float bf2f_(bf16 h) { return __uint_as_float(((unsigned)h) << 16); }
__device__ __forceinline__ bf16 f2bf_(float f) { unsigned u = __float_as_uint(f); return (bf16)((u + 0x7fffu + ((u >> 16) & 1u)) >> 16); }
using bf16x8 = __attribute__((ext_vector_type(8))) short;
using s16x4  = __attribute__((ext_vector_type(4))) short;
using f32x16 = __attribute__((ext_vector_type(16))) float;
using f32x8  = __attribute__((ext_vector_type(8))) float;
using u32x4  = __attribute__((ext_vector_type(4))) unsigned;
#define KSWZ(row, colB) ((row) * 256 + ((colB) ^ (((row) & 7) << 4)))
#define SBAR() __builtin_amdgcn_sched_barrier(0)
__device__ __forceinline__ int crow(int r, int hi) { return (r & 3) + 8 * (r >> 2) + 4 * hi; }
__device__ __forceinline__ unsigned cvtpk(float lo, float hi) {
  unsigned r; asm volatile("v_cvt_pk_bf16_f32 %0, %1, %2" : "=v"(r) : "v"(lo), "v"(hi)); return r;
}
template <typename TIn> struct Stage;
template <> struct Stage<bf16>  { using T = bf16x8;
  __device__ static __forceinline__ T ld8(const bf16* p) { return *reinterpret_cast<const bf16x8*>(p); }
  __device__ static __forceinline__ bf16x8 tobf(T x) { return x; } };
template <> struct Stage<float> { using T = f32x8;
  __device__ static __forceinline__ T ld8(const float* p) { return *reinterpret_cast<const f32x8*>(p); }
  __device__ static __forceinline__ bf16x8 tobf(T x) {
    u32x4 w = {cvtpk(x[0], x[1]), cvtpk(x[2], x[3]), cvtpk(x[4], x[5]), cvtpk(x[6], x[7])}; return *reinterpret_cast<bf16x8*>(&w); } };

__device__ __forceinline__ void partialSM(f32x16& p0, f32x16& p1, float& m_reg, float& mn, float& alpha) {
  constexpr float C = SCALE * 1.4426950408889634f;
  float pmax = p0[0]; for (int r = 1; r < 16; ++r) pmax = fmaxf(pmax, p0[r]); for (int r = 0; r < 16; ++r) pmax = fmaxf(pmax, p1[r]);
  { auto rr = __builtin_amdgcn_permlane32_swap(__float_as_uint(pmax), __float_as_uint(pmax), false, false);
    pmax = fmaxf(__uint_as_float(rr[0]), __uint_as_float(rr[1])); }
  if (__builtin_expect(__all(pmax - m_reg <= THR / SCALE), 1)) { mn = m_reg; alpha = 1.f; }
  else { mn = fmaxf(m_reg, pmax); alpha = __builtin_amdgcn_exp2f((m_reg - mn) * C); m_reg = mn; }
  float mnC = -mn * C;
  for (int r = 0; r < 16; ++r) p0[r] = fmaf(p0[r], C, mnC); for (int r = 0; r < 16; ++r) p1[r] = fmaf(p1[r], C, mnC);
  for (int r = 0; r < 16; ++r) p0[r] = __builtin_amdgcn_exp2f(p0[r]);
}
__device__ __forceinline__ void finishSM(f32x16& p0, f32x16& p1, float alpha, float& l_reg, bf16x8& pa0, bf16x8& pa1, bf16x8& pa2, bf16x8& pa3) {
  for (int r = 0; r < 16; ++r) p1[r] = __builtin_amdgcn_exp2f(p1[r]);
  float ps = 0; for (int r = 0; r < 16; ++r) ps += p0[r]; for (int r = 0; r < 16; ++r) ps += p1[r];
  { auto rr = __builtin_amdgcn_permlane32_swap(__float_as_uint(ps), __float_as_uint(ps), false, false);
    ps = __uint_as_float(rr[0]) + __uint_as_float(rr[1]); }
  l_reg = l_reg * alpha + ps;
#define PK4(P, BASE, OUT) do { unsigned a0 = cvtpk(P[BASE + 0], P[BASE + 1]), a1 = cvtpk(P[BASE + 2], P[BASE + 3]);   \
    unsigned b0 = cvtpk(P[BASE + 4], P[BASE + 5]), b1 = cvtpk(P[BASE + 6], P[BASE + 7]);                              \
    auto r0 = __builtin_amdgcn_permlane32_swap(a0, b0, false, false); auto r1 = __builtin_amdgcn_permlane32_swap(a1, b1, false, false); \
    u32x4 w = {r0[0], r1[0], r0[1], r1[1]}; OUT = *reinterpret_cast<bf16x8*>(&w); } while (0)
  PK4(p0, 0, pa0); PK4(p0, 8, pa1); PK4(p1, 0, pa2); PK4(p1, 8, pa3);
#undef PK4
}
__device__ __forceinline__ void qkt(f32x16& p0, f32x16& p1, const bf16* Ks, const bf16x8* qr, int r32, int hi) {
  p0 = f32x16{}; p1 = f32x16{};
  for (int d0 = 0; d0 < 8; ++d0) { int cb = (d0 * 16 + hi * 8) * 2;
    bf16x8 b0 = *reinterpret_cast<const bf16x8*>((const char*)Ks + KSWZ(r32, cb));
    bf16x8 b1 = *reinterpret_cast<const bf16x8*>((const char*)Ks + KSWZ(32 + r32, cb));
    p0 = __builtin_amdgcn_mfma_f32_32x32x16_bf16(b0, qr[d0], p0, 0, 0, 0);
    p1 = __builtin_amdgcn_mfma_f32_32x32x16_bf16(b1, qr[d0], p1, 0, 0, 0); }
}
__device__ __forceinline__ int v_st(int k, int c) { const int kk = (k & ~0xC) | ((k & 4) << 1) | ((k & 8) >> 1); return ((kk >> 3) * 4 + (c >> 5)) * 512 + ((kk & 7) * 32 + (c & 31)) * 2; }
__device__ __forceinline__ int v_rd_base(int lane) { return ((lane & 3) << 3) | (((lane >> 2) & 3) << 6) | (((lane >> 4) & 1) << 5) | (((lane >> 5) & 1) << 8); }
constexpr int v_rd_off(int d0, int ks, int half) { return d0 * 512 + ks * 4096 + half * 2048; }
template <int OFF> __device__ __forceinline__ s16x4 tr_read(int vb) {
  s16x4 r; asm volatile("ds_read_b64_tr_b16 %0, %1 offset:%2" : "=&v"(r) : "v"(vb), "i"(OFF) : "memory"); return r;
}
template <int D0> __device__ __forceinline__ void pv_one(f32x16& od, int vb, bf16x8 pa0, bf16x8 pa1, bf16x8 pa2, bf16x8 pa3) {
  const s16x4 l0 = tr_read<v_rd_off(D0, 0, 0)>(vb), h0 = tr_read<v_rd_off(D0, 0, 1)>(vb), l1 = tr_read<v_rd_off(D0, 1, 0)>(vb), h1 = tr_read<v_rd_off(D0, 1, 1)>(vb);
  const s16x4 l2 = tr_read<v_rd_off(D0, 2, 0)>(vb), h2 = tr_read<v_rd_off(D0, 2, 1)>(vb), l3 = tr_read<v_rd_off(D0, 3, 0)>(vb), h3 = tr_read<v_rd_off(D0, 3, 1)>(vb);
  asm volatile("s_waitcnt lgkmcnt(0)" ::: "memory"); SBAR();
#define PK(L, H) (bf16x8){L[0], L[1], L[2], L[3], H[0], H[1], H[2], H[3]}
  od = __builtin_amdgcn_mfma_f32_32x32x16_bf16(pa0, PK(l0, h0), od, 0, 0, 0);
  od = __builtin_amdgcn_mfma_f32_32x32x16_bf16(pa1, PK(l1, h1), od, 0, 0, 0);
  od = __builtin_amdgcn_mfma_f32_32x32x16_bf16(pa2, PK(l2, h2), od, 0, 0, 0);
  od = __builtin_amdgcn_mfma_f32_32x32x16_bf16(pa3, PK(l3, h3), od, 0, 0, 0);
#undef PK
}
__device__ __forceinline__ void pv_d0(f32x16* o, int vb, bf16x8 pa0, bf16x8 pa1, bf16x8 pa2, bf16x8 pa3) {
  pv_one<0>(o[0], vb, pa0, pa1, pa2, pa3); pv_one<1>(o[1], vb, pa0, pa1, pa2, pa3); pv_one<2>(o[2], vb, pa0, pa1, pa2, pa3); pv_one<3>(o[3], vb, pa0, pa1, pa2, pa3);
}

__device__ __forceinline__ void attn_dense_body(const bf16* __restrict__ Qb, const bf16* __restrict__ Kh, const bf16* __restrict__ Vh,
                                                const bf16* __restrict__ Gb, bf16* __restrict__ Yb, int seq, char* lds) {
  using TQ = bf16; using St = Stage<bf16>; using SQ = Stage<TQ>;
  const int tid = threadIdx.x, wid = tid >> 6, lane = tid & 63, r32 = lane & 31, hi = lane >> 5;
  bf16* V_lds = (bf16*)lds; bf16* K_lds = (bf16*)(lds + 2 * SHM_V);
  float* ws = (float*)(lds + 2 * SHM_V + 2 * SHM_K) + wid * 64; float* li_l = ws; float* al_l = ws + 32;
  float m_reg = -1e30f, l_reg = 0; f32x16 o[4] = {}; bf16x8 qr[8];
  const TQ* Qw = Qb + (long)(wid * QBLK + r32) * LDQ + hi * 8;
#pragma unroll
  for (int d0 = 0; d0 < 8; ++d0) qr[d0] = SQ::tobf(SQ::ld8(Qw + d0 * 16));
  const int sr = tid >> 4, sc = (tid & 15) * 8, vst0 = v_st(sr, sc), vst1 = v_st(32 + sr, sc);
  const unsigned toff = (unsigned)(sr * LDK + sc);
  const int vb0 = (int)(uintptr_t)V_lds + v_rd_base(lane);
  struct { typename St::T vs0, vs1, ks0, ks1; } sr_[SDEPTH];
#define SLOAD(i, k0) do { const bf16* vb_ = Vh + (long)(k0) * LDK; const bf16* kb_ = Kh + (long)(k0) * LDK; \
    sr_[i].vs0 = St::ld8(vb_ + toff); sr_[i].vs1 = St::ld8(vb_ + 32 * LDK + toff); \
    sr_[i].ks0 = St::ld8(kb_ + toff); sr_[i].ks1 = St::ld8(kb_ + 32 * LDK + toff); } while (0)
#define SWRITE(b, i) do { *(bf16x8*)((char*)V_lds + (b) * SHM_V + vst0) = St::tobf(sr_[i].vs0);          \
    *(bf16x8*)((char*)V_lds + (b) * SHM_V + vst1) = St::tobf(sr_[i].vs1); int kc = sc * 2;               \
    *(bf16x8*)((char*)K_lds + (b) * SHM_K + KSWZ(sr, kc)) = St::tobf(sr_[i].ks0);                       \
    *(bf16x8*)((char*)K_lds + (b) * SHM_K + KSWZ(32 + sr, kc)) = St::tobf(sr_[i].ks1); } while (0)
#define SWAIT() do { if constexpr (SDEPTH == 2) asm volatile("s_waitcnt vmcnt(4)" ::: "memory"); else asm volatile("s_waitcnt vmcnt(0)" ::: "memory"); } while (0)
#define RESC(a) do { if (__any((a) < 1.f)) { if (hi == 0) al_l[r32] = (a); asm volatile("s_waitcnt lgkmcnt(0)" ::: "memory"); \
    for (int d = 0; d < 4; ++d) for (int r = 0; r < 16; ++r) o[d][r] *= al_l[crow(r, hi)]; } } while (0)
  f32x16 pA0, pA1, pB0, pB1; float mnA, mnB, alA, alB; bf16x8 pa0, pa1, pa2, pa3; const int NT = seq / KVBLK;
  constexpr int SE = 0, SO = SDEPTH - 1;
  SLOAD(SE, 0); asm volatile("s_waitcnt vmcnt(0)" ::: "memory"); SWRITE(0, SE); __syncthreads();
  qkt(pA0, pA1, K_lds, qr, r32, hi); partialSM(pA0, pA1, m_reg, mnA, alA);
  SLOAD(SO, KVBLK); if constexpr (SDEPTH == 2) { if (2 < NT) SLOAD(SE, 2 * KVBLK); }
  SWAIT(); SWRITE(1, SO); __syncthreads();
  for (int j = 1; j + 1 < NT; j += 2) {
    SBAR(); qkt(pB0, pB1, (bf16*)((char*)K_lds + SHM_K), qr, r32, hi);
    finishSM(pA0, pA1, alA, l_reg, pa0, pa1, pa2, pa3); SBAR();
    SLOAD(SO, (j + SDEPTH) * KVBLK); SBAR();
    pv_d0(o, vb0, pa0, pa1, pa2, pa3); partialSM(pB0, pB1, m_reg, mnB, alB);
    __syncthreads(); SWAIT(); SWRITE(0, SE);
    RESC(alB); __syncthreads();
    SBAR(); qkt(pA0, pA1, K_lds, qr, r32, hi);
    finishSM(pB0, pB1, alB, l_reg, pa0, pa1, pa2, pa3); SBAR();
    if (SDEPTH == 1 || j + 3 < NT) SLOAD(SE, (j + 1 + SDEPTH) * KVBLK); SBAR();
    pv_d0(o, vb0 + (int)SHM_V, pa0, pa1, pa2, pa3); partialSM(pA0, pA1, m_reg, mnA, alA);
    __syncthreads(); SWAIT(); SWRITE(1, SO);
    RESC(alA); __syncthreads();
  }
  SBAR(); qkt(pB0, pB1, (bf16*)((char*)K_lds + SHM_K), qr, r32, hi);
  finishSM(pA0, pA1, alA, l_reg, pa0, pa1, pa2, pa3); SBAR();
  pv_d0(o, vb0, pa0, pa1, pa2, pa3); partialSM(pB0, pB1, m_reg, mnB, alB);
  __syncthreads(); RESC(alB);
  finishSM(pB0, pB1, alB, l_reg, pa0, pa1, pa2, pa3); SBAR();
  pv_d0(o, vb0 + (int)SHM_V, pa0, pa1, pa2, pa3);
  if (hi == 0) li_l[r32] = l_reg; asm volatile("s_waitcnt lgkmcnt(0)" ::: "memory");
  float rli[16];
#pragma unroll
  for (int r = 0; r < 16; ++r) rli[r] = __builtin_amdgcn_rcpf(li_l[crow(r, hi)]);
  int eoff = wid * QBLK; asm volatile("" : "+v"(eoff));
  const bf16* Gw = Gb + (long)eoff * LDQ; bf16* Yw = Yb + (long)eoff * LDY;
  int hie = hi; asm volatile("" : "+v"(hie));
#pragma unroll
  for (int r = 0; r < 16; ++r) { const int orow = crow(r, hie);
#pragma unroll
    for (int d0 = 0; d0 < 4; ++d0) { const float gv = bf2f_(Gw[orow * LDQ + d0 * 32 + r32]);
      Yw[orow * LDY + d0 * 32 + r32] = f2bf_(o[d0][r] * rli[r] * (gv / (1.f + __expf(-gv)))); }
    asm volatile("" ::: "memory"); }
  __syncthreads();
#undef SLOAD
#undef SWRITE
#undef SWAIT
#undef RESC
}

__device__ __forceinline__ void attn_band_unit(const bf16* __restrict__ P, bf16* __restrict__ OG, float* __restrict__ LSE, int g, int b, int h, int blk, int cqb, int ckb, int cvb, int seqlen, int ntok, char* lds) {
  using St = Stage<bf16>;
  const int tid = threadIdx.x, lane = tid & 63, r32 = lane & 31, hi = lane >> 5; const int wid = __builtin_amdgcn_readfirstlane(tid >> 6);
  bf16* V_lds = (bf16*)lds; bf16* K_lds = (bf16*)(lds + 2 * SHM_V);
  float* ws = (float*)(lds + 2 * SHM_V + 2 * SHM_K) + wid * 64; float* li_l = ws; float* al_l = ws + 32;
  const int dil = (g == 0) ? 1 : (g == 1 ? 4 : 16), head = g * 4 + h;
  int rq, lq0, ntile, t_lo, res0;
  if (g < 2) { const int kb = (g == 0) ? blk : (blk & 1), nt_all = seqlen / dil / 64; res0 = (g == 0) ? 0 : (blk >> 1);
    rq = res0; lq0 = 256 * kb + 32 * wid; t_lo = (4 * kb - 1 < 0) ? 0 : 4 * kb - 1; const int t_hi = (4 * kb + 5 > nt_all) ? nt_all : 4 * kb + 5; ntile = t_hi - t_lo; }
  else { res0 = 2 * blk; rq = res0 + (wid >> 2); lq0 = 32 * (wid & 3); t_lo = 0; ntile = 4; }
  const long tok0 = (long)b * seqlen;
  const bf16* Pq = P + cqb + head * D; const bf16* Pk = P + ckb + head * D; const bf16* Pv = P + cvb + head * D;
  float m_reg = -1e30f, l_reg = 0; f32x16 o[4] = {}; bf16x8 qr[8];
  { const bf16* Qw = Pq + (tok0 + (long)(lq0 + r32) * dil + rq) * LDQ + hi * 8;
#pragma unroll
    for (int d0 = 0; d0 < 8; ++d0) qr[d0] = St::ld8(Qw + d0 * 16); }
  const int sr = tid >> 4, sc = (tid & 15) * 8, vst0 = v_st(sr, sc), vst1 = v_st(32 + sr, sc);
  const int vb0 = (int)(uintptr_t)V_lds + v_rd_base(lane);
  typename St::T vs0, vs1, ks0, ks1;
#define TILE_RK(tt) ((g < 2) ? res0 : res0 + ((tt) >> 1))
#define TILE_LK0(tt) ((g < 2) ? 64 * (t_lo + (tt)) : 64 * ((tt) & 1))
#define BLOAD(tt) do { const int rk_ = TILE_RK(tt), lk_ = TILE_LK0(tt); const long ta = (tok0 + (long)(lk_ + sr) * dil + rk_) * LDK + sc, tb = (tok0 + (long)(lk_ + 32 + sr) * dil + rk_) * LDK + sc; \
    vs0 = St::ld8(Pv + ta); vs1 = St::ld8(Pv + tb); ks0 = St::ld8(Pk + ta); ks1 = St::ld8(Pk + tb); } while (0)
  BLOAD(0);
  for (int tt = 0; tt < ntile; ++tt) {
    __syncthreads();
    { *(bf16x8*)((char*)V_lds + vst0) = vs0; *(bf16x8*)((char*)V_lds + vst1) = vs1; const int kc = sc * 2;
      *(bf16x8*)((char*)K_lds + KSWZ(sr, kc)) = ks0; *(bf16x8*)((char*)K_lds + KSWZ(32 + sr, kc)) = ks1; }
    __syncthreads();
    if (tt + 1 < ntile) BLOAD(tt + 1);
    const int rk = TILE_RK(tt), lk0 = TILE_LK0(tt);
    const bool need = (rk == rq) && (lk0 + 63 >= lq0 - 64) && (lk0 <= lq0 + 95);
    if (need) {
      f32x16 p0, p1; float mn, alpha; bf16x8 pa0, pa1, pa2, pa3;
      qkt(p0, p1, K_lds, qr, r32, hi);
      const int dd = lk0 - lq0 - r32 + 4 * hi;
#pragma unroll
      for (int r = 0; r < 16; ++r) { const int d0_ = dd + (r & 3) + 8 * (r >> 2), d1_ = d0_ + 32;
        if (d0_ < -64 || d0_ > 64) p0[r] = -INFINITY; if (d1_ < -64 || d1_ > 64) p1[r] = -INFINITY; }
      partialSM(p0, p1, m_reg, mn, alpha);
      if (__any(alpha < 1.f)) { if (hi == 0) al_l[r32] = alpha; asm volatile("s_waitcnt lgkmcnt(0)" ::: "memory");
#pragma unroll
        for (int d = 0; d < 4; ++d)
#pragma unroll
          for (int r = 0; r < 16; ++r) o[d][r] *= al_l[crow(r, hi)]; }
      finishSM(p0, p1, alpha, l_reg, pa0, pa1, pa2, pa3); SBAR();
      pv_d0(o, vb0, pa0, pa1, pa2, pa3);
    }
  }
#undef BLOAD
#undef TILE_RK
#undef TILE_LK0
  if (hi == 0) li_l[r32] = l_reg; asm volatile("s_waitcnt lgkmcnt(0)" ::: "memory");
  float rli[16];
#pragma unroll
  for (int r = 0; r < 16; ++r) rli[r] = __builtin_amdgcn_rcpf(li_l[crow(r, hi)]);
  bf16* Og = OG + (long)g * ntok * 512 + h * D;
#pragma unroll
  for (int r = 0; r < 16; ++r) { const long tok = tok0 + (long)(lq0 + crow(r, hi)) * dil + rq;
#pragma unroll
    for (int d0 = 0; d0 < 4; ++d0) Og[tok * 512 + d0 * 32 + r32] = f2bf_(o[d0][r] * rli[r]); }
  if (hi == 0) LSE[((long)g * ntok + tok0 + (long)(lq0 + r32) * dil + rq) * 4 + h] = m_reg * SCALE + __logf(l_reg);
  __syncthreads();
}
}

typedef unsigned short bf16_t;
constexpr int BATCH = 4, SEQ = 2048, DM = 2048, NTOK = BATCH * SEQ, NC = 11776;
constexpr int C_QA = 0, C_KA = 1024, C_VA = 1280, C_GA = 1536, C_QB = 2560, C_KB = 4096, C_VB = 5632, C_GB = 7168, C_ZA = 7680, C_ZB = 9728;
constexpr float EPS = 1e-6f;
constexpr size_t MiB = 1u << 20;
constexpr size_t WS_CTL = 0, WS_TAB = 1 * MiB, WS_WTIN = 2 * MiB, WS_WTAB = 48 * MiB, WS_WTO = 54 * MiB, WS_HB = 64 * MiB, WS_P = 96 * MiB, WS_Y = 280 * MiB, WS_OG = 304 * MiB, WS_LSE = 328 * MiB, WS_END = 330 * MiB;

#define LAS __attribute__((address_space(3)))
typedef float f32x4 __attribute__((ext_vector_type(4)));
typedef unsigned v4u __attribute__((ext_vector_type(4)));
constexpr int NWAVES = 8;
constexpr int LDS_BYTES = 147456;

__device__ __forceinline__ float bf2f(bf16_t h) { return __uint_as_float(((unsigned)h) << 16); }
__device__ __forceinline__ unsigned f2bf_u(float f) { unsigned u = __float_as_uint(f); return (u + 0x7fffu + ((u >> 16) & 1u)) >> 16; }
__device__ __forceinline__ bf16_t f2bf(float f) { return (bf16_t)f2bf_u(f); }
__device__ __forceinline__ unsigned pk2(float lo, float hi) { return f2bf_u(lo) | (f2bf_u(hi) << 16); }
__device__ __forceinline__ float wave_sum(float v) {
#pragma unroll
    for (int o = 1; o < 64; o <<= 1) v += __shfl_xor(v, o);
    return v;
}
__device__ __forceinline__ float silu(float v) { return v / (1.f + __expf(-v)); }

__device__ __forceinline__ int colmap(int kind, int p) {
    const int bj = p >> 7, wc = (p >> 5) & 3, n = (p >> 4) & 1, fq = (p >> 2) & 3, j = p & 3;
    const int gen = 128 * bj + 32 * wc + 8 * fq + 4 * n + j;
    if (kind == 0) return p;
    if (kind == 1) return gen;
    if (kind == 2) return 128 * bj + 64 * (wc >> 1) + 32 * n + 16 * (wc & 1) + 4 * fq + j;
    return wc == 0 ? p : gen;
}
__device__ __forceinline__ int kind_in(int pn) { (void)pn; return 1; }

__device__ __forceinline__ void transpose_item(const float* W, int N, bf16_t* WT, int ldt, int koff, int kindsel, LAS float* scr, int item, int lane) {
    const int nblk = N / 32, kb = item / nblk, nb = item % nblk, k0 = 64 * kb, n0 = 32 * nb;
    const int np = n0 + (lane & 31), pn = np >> 8;
    const int kind = kindsel < 0 ? kind_in(pn) : kindsel;
    const int srcc = (pn << 8) + colmap(kind, np & 255);
#pragma unroll 8
    for (int i = 0; i < 32; ++i) { const int kk = 2 * i + (lane >> 5); scr[kk * 33 + (lane & 31)] = W[(size_t)(k0 + kk) * N + srcc]; }
    asm volatile("s_waitcnt lgkmcnt(0)" ::: "memory");
    const int c = lane & 7;
#pragma unroll
    for (int j = 0; j < 4; ++j) { const int n = (lane >> 3) + 8 * j; const LAS float* s = scr + (8 * c) * 33 + n;
        v4u o; o.x = pk2(s[0 * 33], s[1 * 33]); o.y = pk2(s[2 * 33], s[3 * 33]); o.z = pk2(s[4 * 33], s[5 * 33]); o.w = pk2(s[6 * 33], s[7 * 33]);
        *(v4u*)(WT + (size_t)(n0 + n) * ldt + koff + k0 + 8 * c) = o; }
    asm volatile("s_waitcnt lgkmcnt(0)" ::: "memory");
}
__device__ __forceinline__ void rms_row_to_bf16(const float* xrow, const float* gain, bf16_t* orow, int lane) {
    const f32x4* xr = (const f32x4*)xrow + lane; const f32x4* gr = (const f32x4*)gain + lane;
    f32x4 v[8]; float s = 0.f;
#pragma unroll
    for (int j = 0; j < 8; ++j) { v[j] = xr[64 * j]; s += (v[j].x * v[j].x + v[j].y * v[j].y) + (v[j].z * v[j].z + v[j].w * v[j].w); }
    const float rs = rsqrtf(wave_sum(s) * (1.f / DM) + EPS);
    unsigned long long* o8 = (unsigned long long*)orow + lane;
#pragma unroll
    for (int j = 0; j < 8; ++j) { const f32x4 g = gr[64 * j]; const f32x4 y = v[j] * rs * g;
        o8[64 * j] = (unsigned long long)pk2(y.x, y.y) | ((unsigned long long)pk2(y.z, y.w) << 32); }
}

#define XB_TMO      128
#define XB_XCNT(j)  (256  + 64 * (j))
#define XB_XSUB(j)  (1280 + 64 * (j))
#define XB_XGEN(j)  (2304 + 64 * (j))
#define XB_TOP      3328
#define XB_TOPGEN   3392
#define XCD_BAR_WORDS 3456
#define XB_SPIN_CAP (1u << 18)

__device__ __forceinline__ unsigned xb_ld(unsigned* p)              { return __hip_atomic_load(p, __ATOMIC_RELAXED, __HIP_MEMORY_SCOPE_AGENT); }
__device__ __forceinline__ unsigned xb_add(unsigned* p, unsigned v) { return __hip_atomic_fetch_add(p, v, __ATOMIC_RELAXED, __HIP_MEMORY_SCOPE_AGENT); }
__device__ __forceinline__ unsigned xb_xcc_id() { return (unsigned)__builtin_amdgcn_s_getreg((3 << 11) | 20) & 0xFu; }
#define XB_SPIN(cond, bar) do { unsigned _sp = 0; while (cond) { __builtin_amdgcn_s_sleep(1); \
    if ((++_sp & 255u) == 0u) { if (xb_ld(&(bar)[XB_TMO])) break; if (_sp > XB_SPIN_CAP) { atomicAdd(&(bar)[XB_TMO], 1u); break; } } } } while (0)

struct XcdBarrier {
    unsigned* bar; unsigned x;
    volatile LAS unsigned* st;
};

__device__ __forceinline__ XcdBarrier xcd_barrier_post(unsigned* bar, volatile LAS unsigned* st) {
    XcdBarrier b; b.bar = bar; b.x = xb_xcc_id(); b.st = st;
    if (threadIdx.x == 0) (void)xb_add(&bar[XB_XCNT(b.x)], 1u);
    return b;
}
__device__ __forceinline__ void xcd_barrier_complete(unsigned* bar, unsigned x, unsigned& nloc, unsigned& nx) {
    const unsigned G = gridDim.x * gridDim.y * gridDim.z;
    unsigned sum, cnt, mine, sp = 0u;
    for (;;) {
        sum = 0u; cnt = 0u; mine = 0u;
#pragma unroll
        for (unsigned j = 0; j < 16; ++j) { const unsigned c = xb_ld(&bar[XB_XCNT(j)]); sum += c; cnt += (c > 0u) ? 1u : 0u; mine = (j == x) ? c : mine; }
        if (sum == G) break;
        __builtin_amdgcn_s_sleep(1);
        if ((++sp & 255u) == 0u) { if (xb_ld(&bar[XB_TMO])) break; if (sp > XB_SPIN_CAP) { atomicAdd(&bar[XB_TMO], 1u); break; } }
    }
    nloc = mine > 0u ? mine : 1u; nx = cnt > 0u ? cnt : 1u;
}

__device__ __forceinline__ void xcd_barrier(const XcdBarrier& b) {
    asm volatile("s_waitcnt vmcnt(0)" ::: "memory");
    __syncthreads();
    if (threadIdx.x == 0) {
        unsigned* bar = b.bar;
        __builtin_amdgcn_s_waitcnt(0);
        unsigned nloc = b.st[0], nx = b.st[1];
        if (nloc == 0u) { xcd_barrier_complete(bar, b.x, nloc, nx); b.st[0] = nloc; b.st[1] = nx; }
        const unsigned old = xb_add(&bar[XB_XSUB(b.x)], 1u);
        const unsigned gen = old / nloc;
        if (old + 1u == (gen + 1u) * nloc) {
            __builtin_amdgcn_fence(__ATOMIC_RELEASE, "agent");
            asm volatile("s_waitcnt vmcnt(0)" ::: "memory");
            const unsigned og = xb_add(&bar[XB_TOP], 1u);
            const unsigned tg = og / nx;
            if (og + 1u == (tg + 1u) * nx) xb_add(&bar[XB_TOPGEN], 1u);
            else XB_SPIN(xb_ld(&bar[XB_TOPGEN]) == tg, bar);
            __builtin_amdgcn_fence(__ATOMIC_ACQUIRE, "agent");
            xb_add(&bar[XB_XGEN(b.x)], 1u);
            asm volatile("s_waitcnt vmcnt(0)" ::: "memory");
        } else {
            XB_SPIN(xb_ld(&bar[XB_XGEN(b.x)]) == gen, bar);
            __builtin_amdgcn_fence(__ATOMIC_ACQUIRE, "agent");
            asm volatile("s_waitcnt vmcnt(0)" ::: "memory");
        }
    }
    __syncthreads();
}

struct Args { const float* in[10]; float* out; unsigned char* ws; int ph_lo, ph_hi; };

__global__ void __launch_bounds__(NWAVES * 64, 2) mk_fwd(Args args) {
    extern __shared__ __attribute__((aligned(16))) unsigned char lds[];
    const int tid = threadIdx.x, lane = tid & 63, wave = __builtin_amdgcn_readfirstlane(tid >> 6);
    const int G = gridDim.x, bx = blockIdx.x;
    const int vcu = (G % 8 == 0) ? (bx % 8) * (G / 8) + bx / 8 : bx;
    unsigned char* ws = args.ws;
    const float* x = args.in[0]; const float* ng = args.in[1]; const float* w_in = args.in[2];
    bf16_t* WT_IN = (bf16_t*)(ws + WS_WTIN); bf16_t* HB = (bf16_t*)(ws + WS_HB); bf16_t* P = (bf16_t*)(ws + WS_P);
    float* COSA = (float*)(ws + WS_TAB); float* SINA = COSA + 2048; float* COSP = COSA + 4096; float* SINP = COSP + 32768;
    bf16_t* OG = (bf16_t*)(ws + WS_OG); float* LSE = (float*)(ws + WS_LSE); unsigned* CTL = (unsigned*)(ws + WS_CTL) + 4096;
    bf16_t* WT_AB = (bf16_t*)(ws + WS_WTAB); bf16_t* WT_O = (bf16_t*)(ws + WS_WTO); bf16_t* Y = (bf16_t*)(ws + WS_Y); bf16_t* MG = HB; float* ROWSS = (float*)(ws + WS_CTL + 65536);
    const int lo = args.ph_lo, hi = args.ph_hi;
    volatile LAS unsigned* MISC = (volatile LAS unsigned*)((LAS unsigned char*)lds + 131072 + 320);
    if (tid < 32) MISC[tid] = 0u;
    __syncthreads();
    XcdBarrier bar = xcd_barrier_post((unsigned*)(ws + WS_CTL), MISC + 8);
#define GRID_BAR() xcd_barrier(bar)
#define IN(k) (lo <= (k) && (k) < hi)
#define BOTH(k) (IN(k) && IN((k) + 1))
    if (IN(0)) {
        LAS float* scr = (LAS float*)((LAS unsigned char*)lds + wave * 16384);
        const int gw = vcu * NWAVES + wave, NGW = G * NWAVES;
        constexpr int I_IN = (DM / 64) * (NC / 32);
        constexpr int I_A = (1024 / 64) * (DM / 32), I_B = (512 / 64) * (DM / 32), I_O = (DM / 64) * (DM / 32);
        for (int it = gw; it < I_IN + I_A + I_B + I_O; it += NGW) {
            int r = it;
            if (r < I_IN) { transpose_item(w_in, NC, WT_IN, DM, 0, -1, scr, r, lane); continue; } r -= I_IN;
            if (r < I_A) { transpose_item(args.in[6], DM, WT_AB, 1536, 0, 1, scr, r, lane); continue; } r -= I_A;
            if (r < I_B) { transpose_item(args.in[7], DM, WT_AB, 1536, 1024, 1, scr, r, lane); continue; } r -= I_B;
            transpose_item(args.in[8], DM, WT_O, DM, 0, 0, scr, r, lane);
        }
        for (int i = bx * (NWAVES * 64) + tid; i < 2048 + 32768; i += G * NWAVES * 64) {
            if (i < 2048) { const int pos = i >> 5, fi = i & 31; const float a = (float)pos * (1.0f / powf(10000.0f, (float)fi / 32.0f)); COSA[i] = cosf(a); SINA[i] = sinf(a); }
            else { const int k = i - 2048, pos = k >> 4, fi = k & 15; const float a = (float)pos * (1.0f / powf(500000.0f, (float)fi / 16.0f)); COSP[k] = cosf(a); SINP[k] = sinf(a); }
        }
        for (int m = gw; m < NTOK; m += NGW) rms_row_to_bf16(x + (size_t)m * DM, ng, HB + (size_t)m * DM, lane);
        if (BOTH(0)) GRID_BAR();
    }
    if (IN(1)) {
        pg8::Gemm g{HB, WT_IN, NTOK, NC, DM}; pg8::StaticOrder S; S.init(NTOK, NC, G, bx);
        pg8::EpiRaw E{P, NC};
        pg8::gemm_phase<pg8::EpiRaw, pg8::StaticOrder, true, true>((LAS unsigned char*)lds, g, S, E);
        if (BOTH(1)) GRID_BAR();
    }
    if (IN(2)) {
        const int gw = vcu * NWAVES + wave, NGW = G * NWAVES; const float* qg = args.in[3]; const float* kg = args.in[4];
        {
            const int sub = lane >> 4, l16 = lane & 15;
            for (int it = gw; it < NTOK * 10 / 4; it += NGW) {
                const int item = it * 4 + sub, tok = item / 10, sl = item % 10, s = tok % SEQ;
                bf16_t* p = P + (size_t)tok * NC + (sl < 8 ? C_QA + sl * 128 : C_KA + (sl - 8) * 128) + l16 * 8;
                const float* gn = (sl < 8 ? qg : kg) + l16 * 8;
                const v4u raw = *(const v4u*)p; float v[8];
#pragma unroll
                for (int e = 0; e < 4; ++e) { v[2 * e] = __uint_as_float(raw[e] << 16); v[2 * e + 1] = __uint_as_float(raw[e] & 0xffff0000u); }
                float ss = 0.f;
#pragma unroll
                for (int e = 0; e < 8; ++e) ss += v[e] * v[e];
                ss += __shfl_xor(ss, 1); ss += __shfl_xor(ss, 2); ss += __shfl_xor(ss, 4); ss += __shfl_xor(ss, 8);
                const float rs = rsqrtf(ss * (1.f / 128.f) + EPS);
                const int pos = (l16 >> 3) ? (s & 63) : (s >> 6), i0 = 8 * (l16 & 3);
                float o[8];
#pragma unroll
                for (int e = 0; e < 8; ++e) { const float y = v[e] * rs * gn[e]; const float pr = __shfl_xor(y, 4);
                    const float c = COSA[pos * 32 + i0 + e], sn = SINA[pos * 32 + i0 + e];
                    o[e] = (l16 & 4) ? pr * sn + y * c : y * c - pr * sn; }
                v4u w; w.x = pk2(o[0], o[1]); w.y = pk2(o[2], o[3]); w.z = pk2(o[4], o[5]); w.w = pk2(o[6], o[7]);
                *(v4u*)p = w;
            }
        }
        {
            const int sub = lane >> 2, l4 = lane & 3;
            for (int it = gw; it < NTOK * 24 / 16; it += NGW) {
                const int item = it * 16 + sub, tok = item / 24, sl = item % 24, s = tok % SEQ;
                bf16_t* p = P + (size_t)tok * NC + (sl < 12 ? C_QB + sl * 128 : C_KB + (sl - 12) * 128) + l4 * 8;
                const v4u raw = *(const v4u*)p; float v[8];
#pragma unroll
                for (int e = 0; e < 4; ++e) { v[2 * e] = __uint_as_float(raw[e] << 16); v[2 * e + 1] = __uint_as_float(raw[e] & 0xffff0000u); }
                const int i0 = 8 * (l4 & 1);
                float o[8];
#pragma unroll
                for (int e = 0; e < 8; ++e) { const float y = v[e]; const float pr = __shfl_xor(y, 2);
                    const float c = COSP[s * 16 + i0 + e], sn = SINP[s * 16 + i0 + e];
                    o[e] = (l4 & 2) ? pr * sn + y * c : y * c - pr * sn; }
                v4u w; w.x = pk2(o[0], o[1]); w.y = pk2(o[2], o[3]); w.z = pk2(o[4], o[5]); w.w = pk2(o[6], o[7]);
                *(v4u*)p = w;
            }
        }
        if (BOTH(2)) GRID_BAR();
    }
    if (IN(3)) {
        for (int u = bx; u < 384; u += G) {
            const int blk = u & 7, h = (u >> 3) & 3, b = (u >> 5) & 3, g = u >> 7;
            att::attn_band_unit(P, OG, LSE, g, b, h, blk, C_QB, C_KB, C_VB, SEQ, NTOK, (char*)lds);
        }
        asm volatile("s_waitcnt vmcnt(0)" ::: "memory"); __syncthreads();
        if (tid == 0) { __builtin_amdgcn_fence(__ATOMIC_RELEASE, "agent"); asm volatile("s_waitcnt vmcnt(0)" ::: "memory"); __hip_atomic_fetch_add(CTL, 1u, __ATOMIC_RELAXED, __HIP_MEMORY_SCOPE_AGENT); }
        for (int u = bx; u < 256; u += G) {
            const int pair = u & 7, inner = u >> 3, b = pair >> 1, hkv = pair & 1, hq = hkv * 4 + (inner >> 3), qb = inner & 7;
            const size_t row0 = (size_t)b * SEQ + qb * 256;
            att::attn_dense_body(P + row0 * NC + C_QA + hq * 128, P + (size_t)b * SEQ * NC + C_KA + hkv * 128, P + (size_t)b * SEQ * NC + C_VA + hkv * 128,
                                 P + row0 * NC + C_GA + hq * 128, Y + row0 * 1536 + hq * 128, SEQ, (char*)lds);
        }
        if (tid == 0) { unsigned spins = 0; while (__hip_atomic_load(CTL, __ATOMIC_RELAXED, __HIP_MEMORY_SCOPE_AGENT) < (unsigned)G) { __builtin_amdgcn_s_sleep(4); if (++spins > (1u << 24)) break; }
            __builtin_amdgcn_fence(__ATOMIC_ACQUIRE, "agent"); asm volatile("s_waitcnt vmcnt(0)" ::: "memory"); }
        __syncthreads();
        for (int ci = bx * (NWAVES * 64) + tid; ci < NTOK * 64; ci += G * NWAVES * 64) {
            const int tok = ci >> 6, c8 = (ci & 63) * 8, h = c8 >> 7;
            const float l0 = LSE[((size_t)0 * NTOK + tok) * 4 + h], l1 = LSE[((size_t)1 * NTOK + tok) * 4 + h], l2 = LSE[((size_t)2 * NTOK + tok) * 4 + h];
            const float mx = fmaxf(l0, fmaxf(l1, l2)); float e0 = __expf(l0 - mx), e1 = __expf(l1 - mx), e2 = __expf(l2 - mx); const float inv = 1.f / (e0 + e1 + e2); e0 *= inv; e1 *= inv; e2 *= inv;
            const v4u a0 = *(const v4u*)(OG + ((size_t)0 * NTOK + tok) * 512 + c8), a1 = *(const v4u*)(OG + ((size_t)1 * NTOK + tok) * 512 + c8), a2 = *(const v4u*)(OG + ((size_t)2 * NTOK + tok) * 512 + c8);
            const v4u gz = *(const v4u*)(P + (size_t)tok * NC + C_GB + c8);
            v4u w;
#pragma unroll
            for (int e = 0; e < 4; ++e) {
                const float lo = e0 * __uint_as_float(a0[e] << 16) + e1 * __uint_as_float(a1[e] << 16) + e2 * __uint_as_float(a2[e] << 16);
                const float hh = e0 * __uint_as_float(a0[e] & 0xffff0000u) + e1 * __uint_as_float(a1[e] & 0xffff0000u) + e2 * __uint_as_float(a2[e] & 0xffff0000u);
                w[e] = pk2(lo * silu(__uint_as_float(gz[e] << 16)), hh * silu(__uint_as_float(gz[e] & 0xffff0000u))); }
            *(v4u*)(Y + (size_t)tok * 1536 + 1024 + c8) = w;
        }
        if (BOTH(3)) GRID_BAR();
    }
    if (IN(4)) {
        pg8::Gemm g{Y, WT_AB, NTOK, DM, 1536}; pg8::StaticOrder S; S.init(NTOK, DM, G, bx);
        pg8::EpiMerge E{P, NC, C_ZA, C_ZB, args.in[5], DM, MG, DM};
        pg8::gemm_phase<pg8::EpiMerge, pg8::StaticOrder, true, true>((LAS unsigned char*)lds, g, S, E);
        if (BOTH(4)) GRID_BAR();
    }
    if (IN(5)) {
        pg8::Gemm g{MG, WT_O, NTOK, DM, DM}; pg8::StaticOrder S; S.init(NTOK, DM, G, bx);
        pg8::EpiResid E{x, args.out, DM, ROWSS};
        pg8::gemm_phase<pg8::EpiResid, pg8::StaticOrder, true, true>((LAS unsigned char*)lds, g, S, E);
        if (BOTH(5)) GRID_BAR();
    }
    if (IN(6)) {
        const int gw = vcu * NWAVES + wave, NGW = G * NWAVES; const float* fg = args.in[9];
        for (int m = gw; m < NTOK; m += NGW) {
            const float rs = rsqrtf(ROWSS[m] * (1.f / DM) + EPS);
            f32x4* orow = (f32x4*)(args.out + (size_t)m * DM) + lane; const f32x4* gr = (const f32x4*)fg + lane;
#pragma unroll
            for (int j = 0; j < 8; ++j) orow[64 * j] = orow[64 * j] * rs * gr[64 * j];
        }
    }
#undef IN
#undef BOTH
}


extern "C" void kernel_launch(void* const* d_in, const int* in_sizes, int n_in, void* d_out, int out_size, void* d_ws, size_t ws_size, hipStream_t stream) {
    static int grid = 0;
    if (grid == 0) {
        if (n_in != 10 || in_sizes[0] != NTOK * DM || out_size != NTOK * DM || ws_size < WS_END) { fprintf(stderr, "kernel_launch: unexpected shapes / workspace (%zu)\n", ws_size); grid = -1; return; }
        int dev = 0, cus = 0, per_cu = 0;
        if (hipGetDevice(&dev) != hipSuccess || hipDeviceGetAttribute(&cus, hipDeviceAttributeMultiprocessorCount, dev) != hipSuccess) { grid = -1; return; }
        if (hipFuncSetAttribute((const void*)mk_fwd, hipFuncAttributeMaxDynamicSharedMemorySize, LDS_BYTES) != hipSuccess) { fprintf(stderr, "kernel_launch: hipFuncSetAttribute failed\n"); grid = -1; return; }
        if (hipOccupancyMaxActiveBlocksPerMultiprocessor(&per_cu, (const void*)mk_fwd, NWAVES * 64, LDS_BYTES) != hipSuccess || per_cu < 1) { fprintf(stderr, "kernel_launch: occupancy query says %d\n", per_cu); grid = -1; return; }
        grid = cus;
    }
    if (grid < 0) return;
    if (hipMemsetAsync((char*)d_ws + WS_CTL, 0, 131072, stream) != hipSuccess) { fprintf(stderr, "kernel_launch: memset failed\n"); return; }
    Args a{};
    for (int i = 0; i < 10; ++i) a.in[i] = (const float*)d_in[i];
    a.out = (float*)d_out; a.ws = (unsigned char*)d_ws; a.ph_lo = 0; a.ph_hi = 7;
    void* kargs[] = {&a};
    hipError_t e = hipLaunchCooperativeKernel((const void*)mk_fwd, dim3(grid), dim3(NWAVES * 64), kargs, LDS_BYTES, stream);
    if (e != hipSuccess) fprintf(stderr, "kernel_launch: cooperative launch failed: %s (grid %d)\n", hipGetErrorString(e), grid);
}
```

```cpp
#include <hip/hip_runtime.h>
#include <hip/hip_cooperative_groups.h>
#include <cstdio>
#include <cstdint>
#include <cmath>
namespace cg = cooperative_groups;
namespace pg8 {
#define PG8_LAS __attribute__((address_space(3)))
typedef unsigned short bf16_t;
typedef short bf16x8 __attribute__((ext_vector_type(8)));
typedef float f32x4 __attribute__((ext_vector_type(4)));
typedef unsigned u32x4 __attribute__((ext_vector_type(4)));
constexpr int BM = 256, BK = 64, HALF = 128, HTB = HALF * BK * 2  , STAGE_BYTES = 8 * HTB, NXCD = 8, WGM = 8;

__host__ __device__ __forceinline__ int lds_byte(int r, int c) { const int st = (r >> 4) * 2 + (c >> 5), rr = r & 15, cc = c & 31, ob = rr * 64 + cc * 2; return st * 1024 + (ob ^ (((ob >> 9) & 1) << 5)); }
__host__ __device__ __forceinline__ void stage_rc(int b, int& R, int& C) { const int st = b / 1024, sb = b % 1024, swz = sb ^ (((sb >> 9) & 1) << 5); R = (st >> 1) * 16 + swz / 64; C = (st & 1) * 32 + (swz % 64) / 2; }
__host__ __device__ __forceinline__ int perm32(int rho) { const int n = rho >> 4, i = rho & 15; return 8 * (i >> 2) + 4 * n + (i & 3); }

struct Unit { int pm, pn; };
struct Gemm { const bf16_t* A; const bf16_t* Bt; int M, N, K; };

struct StaticOrder {
    int nM, nN, nwg, G, c;
    __host__ __device__ void init(int M, int N, int G_, int c_) { nM = M / BM; nN = N / BM; nwg = nM * nN; G = G_; c = c_; }
    __host__ __device__ bool next(int i, Unit& u) const {
        const long L = (long)i * G + c; if (L >= nwg) return false;
        int wgid = (int)L; { const int q = nwg / NXCD, r = nwg % NXCD, xcd = wgid % NXCD, off = wgid / NXCD; wgid = (xcd < r ? xcd * (q + 1) : r * (q + 1) + (xcd - r) * q) + off; }
        const int nig = WGM * nN, gid = wgid / nig, fm = gid * WGM, gsz = (nM - fm) < WGM ? (nM - fm) : WGM;
        u.pm = fm + ((wgid % nig) % gsz); u.pn = (wgid % nig) / gsz; return true;
    }
    __device__ __forceinline__ void a_ready(const Unit&) const {}
    __device__ __forceinline__ void done(const Unit&) const {}
};

__device__ __forceinline__ unsigned cvt_pk_bf16(float lo, float hi) { unsigned r; asm volatile("v_cvt_pk_bf16_f32 %0, %1, %2" : "=v"(r) : "v"(lo), "v"(hi)); return r; }
typedef float f32x2 __attribute__((ext_vector_type(2)));

struct EpiRaw {
    static constexpr bool PERM = false, AFTER_DRAIN = false; static constexpr int HOOK_T = -1;
    bf16_t* O; int ldc;
    __device__ __forceinline__ void operator()(const f32x4 (&acc)[2][2][4][2], const Unit& u, int wr, int wc, int fr, int fq) const {
        const int row0 = u.pm * BM + wr * 64 + fr, col0 = u.pn * BM + wc * 32 + 8 * fq;
#pragma unroll
        for (int ai = 0; ai < 2; ++ai)
#pragma unroll
            for (int m = 0; m < 4; ++m) { bf16_t* rowp = O + (size_t)(row0 + ai * HALF + m * 16) * ldc + col0;
#pragma unroll
                for (int bj = 0; bj < 2; ++bj) { const f32x4 v0 = acc[ai][bj][m][0], v1 = acc[ai][bj][m][1];
                    u32x4 w; w.x = cvt_pk_bf16(v0[0], v0[1]); w.y = cvt_pk_bf16(v0[2], v0[3]); w.z = cvt_pk_bf16(v1[0], v1[1]); w.w = cvt_pk_bf16(v1[2], v1[3]);
                    *(u32x4*)(rowp + bj * HALF) = w; } }
    }
};

struct EpiMerge {
    static constexpr bool PERM = false, AFTER_DRAIN = false; static constexpr int HOOK_T = 16;
    const bf16_t* Pz; int ldp, cza, czb; const float* bias; int nb; bf16_t* O; int ldc;
    __device__ __forceinline__ void mid(f32x4 (&acc)[2][2][4][2], const Unit& u, int wr, int wc, int fr, int fq) const {
        int row0 = u.pm * BM + wr * 64 + fr; asm volatile("" : "+v"(row0));
#pragma unroll
        for (int bj = 0; bj < 2; ++bj) { const int col0 = u.pn * BM + bj * HALF + wc * 32 + 8 * fq;
            const f32x4 ba0 = *(const f32x4*)(bias + col0), ba1 = *(const f32x4*)(bias + col0 + 4), bb0 = *(const f32x4*)(bias + nb + col0), bb1 = *(const f32x4*)(bias + nb + col0 + 4);
#pragma unroll
            for (int ai = 0; ai < 2; ++ai)
#pragma unroll
                for (int m = 0; m < 4; ++m) { const size_t ro = (size_t)(row0 + ai * HALF + m * 16) * ldp + col0;
                    const u32x4 za = *(const u32x4*)(Pz + ro + cza), zb = *(const u32x4*)(Pz + ro + czb);
                    f32x4 r0, r1;
#pragma unroll
                    for (int e = 0; e < 4; ++e) { const unsigned a = za[e], b = zb[e];
                        const float a_lo = __uint_as_float(a << 16), a_hi = __uint_as_float(a & 0xffff0000u), b_lo = __uint_as_float(b << 16), b_hi = __uint_as_float(b & 0xffff0000u);
                        const float ba_lo = (e < 2 ? ba0 : ba1)[(2 * e) & 3], ba_hi = (e < 2 ? ba0 : ba1)[(2 * e + 1) & 3], bb_lo = (e < 2 ? bb0 : bb1)[(2 * e) & 3], bb_hi = (e < 2 ? bb0 : bb1)[(2 * e + 1) & 3];
                        const float q_lo = (1.f + __expf(-(b_lo + bb_lo))) / (1.f + __expf(-(a_lo + ba_lo))), q_hi = (1.f + __expf(-(b_hi + bb_hi))) / (1.f + __expf(-(a_hi + ba_hi)));
                        if (e < 2) { r0[2 * e] = q_lo; r0[2 * e + 1] = q_hi; } else { r1[2 * e - 4] = q_lo; r1[2 * e - 3] = q_hi; } }
                    acc[ai][bj][m][0] *= r0; acc[ai][bj][m][1] *= r1; } }
    }
    __device__ __forceinline__ void operator()(const f32x4 (&acc)[2][2][4][2], const Unit& u, int wr, int wc, int fr, int fq) const {
        const int row0 = u.pm * BM + wr * 64 + fr;
#pragma unroll
        for (int bj = 0; bj < 2; ++bj) { const int col0 = u.pn * BM + bj * HALF + wc * 32 + 8 * fq;
            const f32x4 bb0 = *(const f32x4*)(bias + nb + col0), bb1 = *(const f32x4*)(bias + nb + col0 + 4);
#pragma unroll
            for (int ai = 0; ai < 2; ++ai)
#pragma unroll
                for (int m = 0; m < 4; ++m) { const int row = row0 + ai * HALF + m * 16;
                    const u32x4 zb = *(const u32x4*)(Pz + (size_t)row * ldp + col0 + czb);
                    float s[8];
#pragma unroll
                    for (int e = 0; e < 4; ++e) { const unsigned b = zb[e]; const float b_lo = __uint_as_float(b << 16), b_hi = __uint_as_float(b & 0xffff0000u);
                        const float bb_lo = (e < 2 ? bb0 : bb1)[(2 * e) & 3], bb_hi = (e < 2 ? bb0 : bb1)[(2 * e + 1) & 3];
                        s[2 * e] = 1.f / (1.f + __expf(-(b_lo + bb_lo))); s[2 * e + 1] = 1.f / (1.f + __expf(-(b_hi + bb_hi))); }
                    const f32x4 v0 = acc[ai][bj][m][0], v1 = acc[ai][bj][m][1];
                    u32x4 w; w.x = cvt_pk_bf16(v0[0] * s[0], v0[1] * s[1]); w.y = cvt_pk_bf16(v0[2] * s[2], v0[3] * s[3]); w.z = cvt_pk_bf16(v1[0] * s[4], v1[1] * s[5]); w.w = cvt_pk_bf16(v1[2] * s[6], v1[3] * s[7]);
                    *(u32x4*)(O + (size_t)row * ldc + col0) = w; } }
    }
};
struct EpiResid {
    static constexpr bool PERM = false, AFTER_DRAIN = false; static constexpr int HOOK_T = -1;
    const float* base; float* out; int ldc; float* rowss;
    __device__ __forceinline__ void operator()(const f32x4 (&acc)[2][2][4][2], const Unit& u, int wr, int wc, int fr, int fq) const {
        const int row0 = u.pm * BM + wr * 64 + fr, col0 = u.pn * BM + wc * 32 + 4 * fq;
#pragma unroll
        for (int ai = 0; ai < 2; ++ai)
#pragma unroll
            for (int m = 0; m < 4; ++m) { const int row = row0 + ai * HALF + m * 16; const size_t off = (size_t)row * ldc + col0; float ss = 0.f;
#pragma unroll
                for (int bj = 0; bj < 2; ++bj)
#pragma unroll
                    for (int n = 0; n < 2; ++n) { const f32x4 o = *(const f32x4*)(base + off + bj * HALF + n * 16) + acc[ai][bj][m][n];
                        *(f32x4*)(out + off + bj * HALF + n * 16) = o; ss += (o[0] * o[0] + o[1] * o[1]) + (o[2] * o[2] + o[3] * o[3]); }
                ss += __shfl_xor(ss, 16); ss += __shfl_xor(ss, 32);
                if (fq == 0) atomicAdd(rowss + row, ss); }
    }
};


struct EpiIn {
    static constexpr bool PERM = false, AFTER_DRAIN = false; static constexpr int HOOK_T = -1;
    bf16_t* O; int ldc; const float* cosa; const float* sina; const float* cosp; const float* sinp; const float* qg; const float* kg; const float* bias; bf16_t* SA; bf16_t* SB; PG8_LAS float* red; float eps;
    __device__ __forceinline__ static unsigned long long pk4(const f32x4 v) { return (unsigned long long)cvt_pk_bf16(v[0], v[1]) | ((unsigned long long)cvt_pk_bf16(v[2], v[3]) << 32); }
    __device__ __forceinline__ void operator()(const f32x4 (&acc)[2][2][4][2], const Unit& u, int wr, int wc, int fr, int fq) const {
        const int pn = u.pn; const int row0 = u.pm * BM + wr * 64 + fr;
        if (pn < 5) {
#pragma unroll
            for (int ai = 0; ai < 2; ++ai)
#pragma unroll
                for (int m = 0; m < 4; ++m)
#pragma unroll
                    for (int bj = 0; bj < 2; ++bj) { const f32x4 v0 = acc[ai][bj][m][0], v1 = acc[ai][bj][m][1];
                        float ss = (v0[0] * v0[0] + v0[1] * v0[1]) + (v0[2] * v0[2] + v0[3] * v0[3]) + (v1[0] * v1[0] + v1[1] * v1[1]) + (v1[2] * v1[2] + v1[3] * v1[3]);
                        ss += __shfl_xor(ss, 16); ss += __shfl_xor(ss, 32);
                        if (fq == 0) red[(ai * HALF + wr * 64 + m * 16 + fr) * 8 + bj * 4 + wc] = ss; }
            asm volatile("s_waitcnt lgkmcnt(0)" ::: "memory"); __builtin_amdgcn_s_barrier(); asm volatile("" ::: "memory");
            const int half = wc >> 1, i0 = 16 * (wc & 1) + 4 * fq;
            const float* g = (pn < 4) ? qg : kg;
            const f32x4 g0 = *(const f32x4*)(g + 64 * half + i0), g1 = *(const f32x4*)(g + 64 * half + 32 + i0);
#pragma unroll
            for (int ai = 0; ai < 2; ++ai)
#pragma unroll
                for (int m = 0; m < 4; ++m) { const int row = row0 + ai * HALF + m * 16, sq = row & 2047, pos = half ? (sq & 63) : (sq >> 6);
                    const f32x4 c = *(const f32x4*)(cosa + pos * 32 + i0), sn = *(const f32x4*)(sina + pos * 32 + i0);
#pragma unroll
                    for (int bj = 0; bj < 2; ++bj) { const f32x4 pr = *(const PG8_LAS f32x4*)(red + (ai * HALF + wr * 64 + m * 16 + fr) * 8 + bj * 4);
                        const float rs = rsqrtf(((pr[0] + pr[1]) + (pr[2] + pr[3])) * (1.f / 128.f) + eps);
                        const f32x4 y0 = acc[ai][bj][m][0] * rs * g0, y1 = acc[ai][bj][m][1] * rs * g1;
                        const f32x4 lo = y0 * c - y1 * sn, hi = y0 * sn + y1 * c;
                        bf16_t* p = O + (size_t)row * ldc + pn * BM + bj * HALF + 64 * half + i0;
                        *(unsigned long long*)p = pk4(lo); *(unsigned long long*)(p + 32) = pk4(hi); } }
        } else if (pn >= 10 && pn < 22 && wc == 0) {
            const int i0 = 4 * fq;
#pragma unroll
            for (int ai = 0; ai < 2; ++ai)
#pragma unroll
                for (int m = 0; m < 4; ++m) { const int row = row0 + ai * HALF + m * 16, sq = row & 2047;
                    const f32x4 c = *(const f32x4*)(cosp + sq * 16 + i0), sn = *(const f32x4*)(sinp + sq * 16 + i0);
#pragma unroll
                    for (int bj = 0; bj < 2; ++bj) { const f32x4 y0 = acc[ai][bj][m][0], y1 = acc[ai][bj][m][1];
                        const f32x4 lo = y0 * c - y1 * sn, hi = y0 * sn + y1 * c;
                        bf16_t* p = O + (size_t)row * ldc + pn * BM + bj * HALF + i0;
                        *(unsigned long long*)p = pk4(lo); *(unsigned long long*)(p + 16) = pk4(hi); } }
        } else if (pn >= 30) {
            const int which = pn >= 38 ? 1 : 0, pnz = pn - (which ? 38 : 30);
            const float* bs = bias + which * 2048 + pnz * BM + wc * 32 + 8 * fq;
            bf16_t* dst = (which ? SB : SA) + ((((size_t)(u.pm * 8 + pnz) * 8 + (wr * 4 + wc)) * 16) * 64 + (fq * 16 + fr)) * 8;
#pragma unroll
            for (int bj = 0; bj < 2; ++bj) { const f32x4 b0 = *(const f32x4*)(bs + bj * HALF), b1 = *(const f32x4*)(bs + bj * HALF + 4);
#pragma unroll
                for (int ai = 0; ai < 2; ++ai)
#pragma unroll
                    for (int m = 0; m < 4; ++m) { const f32x4 v0 = acc[ai][bj][m][0] + b0, v1 = acc[ai][bj][m][1] + b1; float sg[8];
#pragma unroll
                        for (int e = 0; e < 4; ++e) { sg[e] = 1.f / (1.f + __expf(-v0[e])); sg[4 + e] = 1.f / (1.f + __expf(-v1[e])); }
                        u32x4 w; w.x = cvt_pk_bf16(sg[0], sg[1]); w.y = cvt_pk_bf16(sg[2], sg[3]); w.z = cvt_pk_bf16(sg[4], sg[5]); w.w = cvt_pk_bf16(sg[6], sg[7]);
                        *(u32x4*)(dst + (ai * 8 + bj * 4 + m) * 512) = w; } }
        } else {
            const bool act = (pn >= 6 && pn < 10) || pn == 28 || pn == 29;
            const int col0 = pn * BM + wc * 32 + 8 * fq;
#pragma unroll
            for (int ai = 0; ai < 2; ++ai)
#pragma unroll
                for (int m = 0; m < 4; ++m) { bf16_t* rowp = O + (size_t)(row0 + ai * HALF + m * 16) * ldc + col0;
#pragma unroll
                    for (int bj = 0; bj < 2; ++bj) { f32x4 v0 = acc[ai][bj][m][0], v1 = acc[ai][bj][m][1];
                        if (act) {
#pragma unroll
                            for (int e = 0; e < 4; ++e) { v0[e] = v0[e] / (1.f + __expf(-v0[e])); v1[e] = v1[e] / (1.f + __expf(-v1[e])); } }
                        u32x4 w; w.x = cvt_pk_bf16(v0[0], v0[1]); w.y = cvt_pk_bf16(v0[2], v0[3]); w.z = cvt_pk_bf16(v1[0], v1[1]); w.w = cvt_pk_bf16(v1[2], v1[3]);
                        *(u32x4*)(rowp + bj * HALF) = w; } }
        }
    }
};
struct EpiMerge2 {
    static constexpr bool PERM = false, AFTER_DRAIN = false; static constexpr int HOOK_T = 16;
    const bf16_t* SA; const bf16_t* SB; bf16_t* O; int ldc;
    __device__ __forceinline__ void mid(f32x4 (&acc)[2][2][4][2], const Unit& u, int wr, int wc, int fr, int fq) const {
        int lane = fq * 16 + fr; asm volatile("" : "+v"(lane));
        const size_t base = ((((size_t)(u.pm * 8 + u.pn) * 8 + (wr * 4 + wc)) * 16) * 64 + lane) * 8;
#pragma unroll
        for (int f = 0; f < 16; ++f) { const int ai = f >> 3, bj = (f >> 2) & 1, m = f & 3;
            const u32x4 a = *(const u32x4*)(SA + base + f * 512), b = *(const u32x4*)(SB + base + f * 512);
            f32x4 r0, r1;
#pragma unroll
            for (int e = 0; e < 4; ++e) { const float q_lo = __uint_as_float(a[e] << 16) * __builtin_amdgcn_rcpf(__uint_as_float(b[e] << 16)), q_hi = __uint_as_float(a[e] & 0xffff0000u) * __builtin_amdgcn_rcpf(__uint_as_float(b[e] & 0xffff0000u));
                if (e < 2) { r0[2 * e] = q_lo; r0[2 * e + 1] = q_hi; } else { r1[2 * e - 4] = q_lo; r1[2 * e - 3] = q_hi; } }
            acc[ai][bj][m][0] *= r0; acc[ai][bj][m][1] *= r1; }
    }
    __device__ __forceinline__ void operator()(const f32x4 (&acc)[2][2][4][2], const Unit& u, int wr, int wc, int fr, int fq) const {
        const int lane = fq * 16 + fr, row0 = u.pm * BM + wr * 64 + fr, col0 = u.pn * BM + wc * 32 + 8 * fq;
        const size_t base = ((((size_t)(u.pm * 8 + u.pn) * 8 + (wr * 4 + wc)) * 16) * 64 + lane) * 8;
#pragma unroll
        for (int f = 0; f < 16; ++f) { const int ai = f >> 3, bj = (f >> 2) & 1, m = f & 3;
            const u32x4 b = *(const u32x4*)(SB + base + f * 512);
            const f32x4 v0 = acc[ai][bj][m][0], v1 = acc[ai][bj][m][1];
            u32x4 w; w.x = cvt_pk_bf16(v0[0] * __uint_as_float(b[0] << 16), v0[1] * __uint_as_float(b[0] & 0xffff0000u)); w.y = cvt_pk_bf16(v0[2] * __uint_as_float(b[1] << 16), v0[3] * __uint_as_float(b[1] & 0xffff0000u));
            w.z = cvt_pk_bf16(v1[0] * __uint_as_float(b[2] << 16), v1[1] * __uint_as_float(b[2] & 0xffff0000u)); w.w = cvt_pk_bf16(v1[2] * __uint_as_float(b[3] << 16), v1[3] * __uint_as_float(b[3] & 0xffff0000u));
            *(u32x4*)(O + (size_t)(row0 + ai * HALF + m * 16) * ldc + col0 + bj * HALF) = w; }
    }
};
struct EpiResidNorm {
    static constexpr bool PERM = false, AFTER_DRAIN = true; static constexpr int HOOK_T = -1;
    const float* base; float* out; int ldc; const float* gain; float* xb; unsigned* cnt; int ntn; float eps;
    __device__ __forceinline__ void fused(f32x4 (&acc)[2][2][4][2], const Unit& u, int wr, int wc, int fr, int fq, PG8_LAS unsigned char* lds, int wid, int lane) const {
        PG8_LAS float* Pp = (PG8_LAS float*)lds;
        PG8_LAS float* Sr = (PG8_LAS float*)(lds + 4096);
        const int row0 = u.pm * BM + wr * 64 + fr, col0 = u.pn * BM + wc * 32 + 4 * fq;
#pragma unroll
        for (int ai = 0; ai < 2; ++ai)
#pragma unroll
            for (int m = 0; m < 4; ++m) { const size_t off = (size_t)(row0 + ai * HALF + m * 16) * ldc + col0; float ss = 0.f;
#pragma unroll
                for (int bj = 0; bj < 2; ++bj)
#pragma unroll
                    for (int n = 0; n < 2; ++n) { const f32x4 o = *(const f32x4*)(base + off + bj * HALF + n * 16) + acc[ai][bj][m][n]; acc[ai][bj][m][n] = o;
                        ss += (o[0] * o[0] + o[1] * o[1]) + (o[2] * o[2] + o[3] * o[3]); }
                ss += __shfl_xor(ss, 16); ss += __shfl_xor(ss, 32);
                if (fq == 0) Pp[(ai * HALF + wr * 64 + m * 16 + fr) * 4 + wc] = ss;
                if (m & 1) asm volatile("" ::: "memory"); }
        asm volatile("s_waitcnt lgkmcnt(0)" ::: "memory"); __builtin_amdgcn_s_barrier(); asm volatile("" ::: "memory");
        const int tid = wid * 64 + lane;
        if (tid < 256) { const f32x4 p = *(const PG8_LAS f32x4*)(Pp + tid * 4);
            __hip_atomic_store(xb + (size_t)(u.pm * BM + tid) * 8 + u.pn, (p[0] + p[1]) + (p[2] + p[3]), __ATOMIC_RELAXED, __HIP_MEMORY_SCOPE_AGENT); }
        asm volatile("s_waitcnt vmcnt(0)" ::: "memory"); __builtin_amdgcn_s_barrier(); asm volatile("" ::: "memory");
        if (tid == 0) __hip_atomic_fetch_add(cnt + 64 * u.pm, 1u, __ATOMIC_RELAXED, __HIP_MEMORY_SCOPE_AGENT);
        if (wid == 0) { unsigned spins = 0;
            while ((unsigned)__builtin_amdgcn_readfirstlane(__hip_atomic_load(cnt + 64 * u.pm, __ATOMIC_RELAXED, __HIP_MEMORY_SCOPE_AGENT)) < (unsigned)ntn) { __builtin_amdgcn_s_sleep(2); if (++spins > (1u << 22)) break; }
            __builtin_amdgcn_fence(__ATOMIC_ACQUIRE, "agent"); }
        asm volatile("s_waitcnt vmcnt(0) lgkmcnt(0)" ::: "memory"); __builtin_amdgcn_s_barrier(); asm volatile("" ::: "memory");
        if (tid < 256) { const float* slot = xb + (size_t)(u.pm * BM + tid) * 8; float tot = 0.f;
#pragma unroll
            for (int t = 0; t < 8; ++t) tot += __hip_atomic_load(slot + t, __ATOMIC_RELAXED, __HIP_MEMORY_SCOPE_AGENT);
            Sr[tid] = rsqrtf(tot * (1.0f / 2048.0f) + eps); }
        asm volatile("s_waitcnt lgkmcnt(0)" ::: "memory"); __builtin_amdgcn_s_barrier(); asm volatile("" ::: "memory");
#pragma unroll
        for (int bj = 0; bj < 2; ++bj)
#pragma unroll
            for (int n = 0; n < 2; ++n) { const f32x4 g = *(const f32x4*)(gain + col0 + bj * HALF + n * 16);
#pragma unroll
                for (int ai = 0; ai < 2; ++ai)
#pragma unroll
                    for (int m = 0; m < 4; ++m) { const int rl = ai * HALF + wr * 64 + m * 16 + fr; const float rs = Sr[rl];
                        *(f32x4*)(out + (size_t)(u.pm * BM + rl) * ldc + col0 + bj * HALF + n * 16) = acc[ai][bj][m][n] * rs * g; } }
    }
};

template <class Epi, class Sched, bool ALIGN_EPI = false, bool SP2 = false>
__device__ __forceinline__ void gemm_phase(PG8_LAS unsigned char* lds, const Gemm g, const Sched& S, const Epi& E) {
    const int tid = threadIdx.x, wid = __builtin_amdgcn_readfirstlane(tid >> 6), lane = tid & 63, wr = wid >> 2, wc = wid & 3, fr = lane & 15, fq = lane >> 4;
    const int K = g.K, nt = K / BK;
    unsigned voffA[2], voffB[2];
#pragma unroll
    for (int i = 0; i < 2; ++i) { int R, C; stage_rc(tid * 16 + i * 8192, R, C); const int Rb = Epi::PERM ? ((R & ~31) + perm32(R & 31)) : R;
        voffA[i] = (unsigned)(R * K + C) * 2u; voffB[i] = (unsigned)(Rb * K + C) * 2u; }
    const size_t kstep = (size_t)(BK * 2);
    const size_t hstep = (size_t)HALF * K * 2;
    const size_t tstep = 2 * hstep;
    const unsigned ldsw = (unsigned)wid * 1024u;
    const int aoff = lds_byte(wr * 64 + fr, fq * 8), boff = lds_byte(wc * 32 + fr, fq * 8);
#define PG8_SA(b, h) (((b) * 2 + (h)) * HTB)
#define PG8_SB(b, h) ((4 + (b) * 2 + (h)) * HTB)
#define PG8_STAGE(bufoff, gbase, voff) do { _Pragma("unroll") for (int _i = 0; _i < 2; ++_i) \
        __builtin_amdgcn_global_load_lds((const unsigned*)((const char*)(gbase) + (voff)[_i]), (PG8_LAS unsigned*)(lds + (bufoff) + ldsw + _i * 8192), 16, 0, 0); } while (0)
#define PG8_LDA(dst, b, h) do { _Pragma("unroll") for (int m = 0; m < 4; ++m) _Pragma("unroll") for (int k = 0; k < 2; ++k) dst[m][k] = *(const PG8_LAS bf16x8*)(lds + PG8_SA(b, h) + aoff + m * 2048 + k * 1024); } while (0)
#define PG8_LDB(dst, b, h) do { _Pragma("unroll") for (int n = 0; n < 2; ++n) _Pragma("unroll") for (int k = 0; k < 2; ++k) dst[n][k] = *(const PG8_LAS bf16x8*)(lds + PG8_SB(b, h) + boff + n * 2048 + k * 1024); } while (0)
#define PG8_MMA(ai, bj, At, Bt) do { __builtin_amdgcn_s_setprio(1); _Pragma("unroll") for (int m = 0; m < 4; ++m) _Pragma("unroll") for (int n = 0; n < 2; ++n) _Pragma("unroll") for (int k = 0; k < 2; ++k) \
        acc[ai][bj][m][n] = __builtin_amdgcn_mfma_f32_16x16x32_bf16(Bt[n][k], At[m][k], acc[ai][bj][m][n], 0, 0, 0); __builtin_amdgcn_s_setprio(0); } while (0)
#define PG8_WAIT_V(n) asm volatile("s_waitcnt vmcnt(" #n ")" ::: "memory")
#define PG8_WAIT_L(n) asm volatile("s_waitcnt lgkmcnt(" #n ")" ::: "memory")
#define PG8_BAR __builtin_amdgcn_s_barrier()
#define PG8_SCHED __builtin_amdgcn_sched_barrier(0)
    Unit cur, nxt; int ui = 0;
    if (!S.next(0, cur)) return;
    f32x4 acc[2][2][4][2];
#pragma unroll
    for (int a = 0; a < 2; ++a)
#pragma unroll
        for (int b = 0; b < 2; ++b)
#pragma unroll
            for (int m = 0; m < 4; ++m)
#pragma unroll
                for (int n = 0; n < 2; ++n) acc[a][b][m][n] = (f32x4){0.f, 0.f, 0.f, 0.f};
    bf16x8 At[4][2], B0[2][2], B1[2][2];
    const char* cA = (const char*)g.A + (size_t)cur.pm * tstep; const char* cB = (const char*)g.Bt + (size_t)cur.pn * tstep;
    S.a_ready(cur);
    if constexpr (SP2) {
        PG8_STAGE(PG8_SB(0, 0), cB, voffB); PG8_STAGE(PG8_SB(0, 1), cB + hstep, voffB); PG8_STAGE(PG8_SA(0, 0), cA, voffA); PG8_STAGE(PG8_SA(0, 1), cA + hstep, voffA);
        if (wr == 1) PG8_BAR;
        PG8_WAIT_V(2); PG8_BAR;
        PG8_STAGE(PG8_SB(1, 0), cB + kstep, voffB); PG8_STAGE(PG8_SA(1, 0), cA + kstep, voffA); PG8_STAGE(PG8_SB(1, 1), cB + hstep + kstep, voffB);
        PG8_WAIT_V(6); PG8_BAR;
    } else {
        PG8_STAGE(PG8_SB(0, 0), cB, voffB); PG8_STAGE(PG8_SA(0, 0), cA, voffA); PG8_STAGE(PG8_SB(0, 1), cB + hstep, voffB); PG8_STAGE(PG8_SA(0, 1), cA + hstep, voffA);
        if (wr == 1) PG8_BAR;
        PG8_WAIT_V(4); PG8_BAR;
        PG8_STAGE(PG8_SB(1, 0), cB + kstep, voffB); PG8_STAGE(PG8_SA(1, 0), cA + kstep, voffA); PG8_STAGE(PG8_SB(1, 1), cB + hstep + kstep, voffB);
        PG8_WAIT_V(6); PG8_BAR;
    }
    for (;;) {
        const bool has_next = S.next(ui + 1, nxt);
        const char* nA = has_next ? (const char*)g.A + (size_t)nxt.pm * tstep : cA; const char* nB = has_next ? (const char*)g.Bt + (size_t)nxt.pn * tstep : cB;
        for (int t = 0; t < nt; t += 2) {
            if constexpr (Epi::HOOK_T >= 0) { if (t == Epi::HOOK_T) E.mid(acc, cur, wr, wc, fr, fq); }
            const bool last = (t == nt - 2);
            const char* a1 = cA + (size_t)(t + 1) * kstep;
            const char* a2 = last ? nA : cA + (size_t)(t + 2) * kstep; const char* b2 = last ? nB : cB + (size_t)(t + 2) * kstep;
            const char* a3 = a2 + kstep; const char* b3 = b2 + kstep;
            if (last && has_next) S.a_ready(nxt);
            if constexpr (SP2) {
            PG8_LDB(B0, 0, 0); PG8_LDB(B1, 0, 1); PG8_SCHED; PG8_LDA(At, 0, 0); PG8_STAGE(PG8_SA(1, 1), a1 + hstep, voffA);
            PG8_WAIT_V(8); PG8_WAIT_L(0); PG8_BAR; PG8_MMA(0, 0, At, B0); PG8_MMA(0, 1, At, B1); PG8_BAR; PG8_SCHED;
            PG8_LDA(At, 0, 1); PG8_STAGE(PG8_SB(0, 0), b2, voffB); PG8_STAGE(PG8_SB(0, 1), b2 + hstep, voffB); PG8_STAGE(PG8_SA(0, 0), a2, voffA);
            PG8_WAIT_V(8); PG8_WAIT_L(0); PG8_BAR; PG8_MMA(1, 0, At, B0); PG8_MMA(1, 1, At, B1); PG8_BAR; PG8_SCHED;
            PG8_LDB(B0, 1, 0); PG8_LDB(B1, 1, 1); PG8_SCHED; PG8_LDA(At, 1, 0); PG8_STAGE(PG8_SA(0, 1), a2 + hstep, voffA);
            PG8_WAIT_V(8); PG8_WAIT_L(0); PG8_BAR; PG8_MMA(0, 0, At, B0); PG8_MMA(0, 1, At, B1); PG8_BAR; PG8_SCHED;
            PG8_LDA(At, 1, 1); PG8_STAGE(PG8_SB(1, 0), b3, voffB); PG8_STAGE(PG8_SB(1, 1), b3 + hstep, voffB); PG8_STAGE(PG8_SA(1, 0), a3, voffA);
            PG8_WAIT_V(8); PG8_WAIT_L(0); PG8_BAR; PG8_MMA(1, 0, At, B0); PG8_MMA(1, 1, At, B1); PG8_BAR; PG8_SCHED;
            } else {
            PG8_LDB(B0, 0, 0); PG8_SCHED; PG8_LDA(At, 0, 0); PG8_STAGE(PG8_SA(1, 1), a1 + hstep, voffA);
            PG8_WAIT_L(8); PG8_BAR; PG8_WAIT_L(0); PG8_MMA(0, 0, At, B0); PG8_BAR; PG8_SCHED;
            PG8_LDB(B1, 0, 1); PG8_STAGE(PG8_SB(0, 0), b2, voffB);
            PG8_BAR; PG8_WAIT_L(0); PG8_MMA(0, 1, At, B1); PG8_BAR;
            PG8_LDA(At, 0, 1); PG8_STAGE(PG8_SA(0, 0), a2, voffA);
            PG8_BAR; PG8_WAIT_L(0); PG8_MMA(1, 0, At, B0); PG8_BAR; PG8_SCHED;
            PG8_STAGE(PG8_SB(0, 1), b2 + hstep, voffB);
            PG8_WAIT_V(6); PG8_BAR; PG8_MMA(1, 1, At, B1); PG8_BAR;
            PG8_LDB(B0, 1, 0); PG8_SCHED; PG8_LDA(At, 1, 0); PG8_STAGE(PG8_SA(0, 1), a2 + hstep, voffA);
            PG8_WAIT_L(8); PG8_BAR; PG8_WAIT_L(0); PG8_MMA(0, 0, At, B0); PG8_BAR; PG8_SCHED;
            PG8_LDB(B1, 1, 1); PG8_STAGE(PG8_SB(1, 0), b3, voffB);
            PG8_BAR; PG8_WAIT_L(0); PG8_MMA(0, 1, At, B1); PG8_BAR;
            PG8_LDA(At, 1, 1); PG8_STAGE(PG8_SA(1, 0), a3, voffA);
            PG8_BAR; PG8_WAIT_L(0); PG8_MMA(1, 0, At, B0); PG8_BAR; PG8_SCHED;
            PG8_STAGE(PG8_SB(1, 1), b3 + hstep, voffB);
            PG8_WAIT_V(6); PG8_BAR; PG8_MMA(1, 1, At, B1); PG8_BAR;
            }
        }
        if constexpr (ALIGN_EPI) { if (wr == 0) PG8_BAR; }
        if constexpr (!Epi::AFTER_DRAIN) { E(acc, cur, wr, wc, fr, fq); S.done(cur); }
        if (!has_next) break;
#pragma unroll
        for (int a = 0; a < 2; ++a)
#pragma unroll
            for (int b = 0; b < 2; ++b)
#pragma unroll
                for (int m = 0; m < 4; ++m)
#pragma unroll
                    for (int n = 0; n < 2; ++n) acc[a][b][m][n] = (f32x4){0.f, 0.f, 0.f, 0.f};
        cur = nxt; cA = nA; cB = nB; ++ui;
        if constexpr (ALIGN_EPI) { if (wr == 1) PG8_BAR; }
    }
    PG8_WAIT_V(0);
    if constexpr (!ALIGN_EPI) { if (wr == 0) PG8_BAR; }
    PG8_BAR;
    if constexpr (Epi::AFTER_DRAIN) { E.fused(acc, cur, wr, wc, fr, fq, lds, wid, lane); S.done(cur); }
#undef PG8_SA
#undef PG8_SB
#undef PG8_STAGE
#undef PG8_LDA
#undef PG8_LDB
#undef PG8_MMA
#undef PG8_WAIT_V
#undef PG8_WAIT_L
#undef PG8_BAR
#undef PG8_SCHED
}
}

namespace att {
using bf16 = unsigned short;
constexpr int   D = 128, NW = 8, QBLK = 32, KVBLK = 64;
constexpr float SCALE = 0.088388347648318440f;
constexpr float THR = 8.f;
constexpr int SDEPTH = 2;
constexpr int LDQ = 7680, LDK = 7680;
constexpr int LDY = 1536;
constexpr size_t SHM_V = KVBLK * D * 2, SHM_K = KVBLK * D * 2, SHM_ATTN = 2 * SHM_V + 2 * SHM_K + NW * 64 * 4;
__device__ __forceinline__ float bf2f_(bf16 h) { return __uint_as_float(((unsigned)h) << 16); }
__device__ __forceinline__ bf16 f2bf_(float f) { unsigned u = __float_as_uint(f); return (bf16)((u + 0x7fffu + ((u >> 16) & 1u)) >> 16); }
using bf16x8 = __attribute__((ext_vector_type(8))) short;
using s16x4  = __attribute__((ext_vector_type(4))) short;
using f32x16 = __attribute__((ext_vector_type(16))) float;
using f32x8  = __attribute__((ext_vector_type(8))) float;
using u32x4  = __attribute__((ext_vector_type(4))) unsigned;
#define KSWZ(row, colB) ((row) * 256 + ((colB) ^ (((row) & 7) << 4)))
#define SBAR() __builtin_amdgcn_sched_barrier(0)
__device__ __forceinline__ int crow(int r, int hi) { return (r & 3) + 8 * (r >> 2) + 4 * hi; }
__device__ __forceinline__ unsigned cvtpk(float lo, float hi) {
  unsigned r; asm volatile("v_cvt_pk_bf16_f32 %0, %1, %2" : "=v"(r) : "v"(lo), "v"(hi)); return r;
}
template <typename TIn> struct Stage;
template <> struct Stage<bf16>  { using T = bf16x8;
  __device__ static __forceinline__ T ld8(const bf16* p) { return *reinterpret_cast<const bf16x8*>(p); }
  __device__ static __forceinline__ bf16x8 tobf(T x) { return x; } };
template <> struct Stage<float> { using T = f32x8;
  __device__ static __forceinline__ T ld8(const float* p) { return *reinterpret_cast<const f32x8*>(p); }
  __device__ static __forceinline__ bf16x8 tobf(T x) {
    u32x4 w = {cvtpk(x[0], x[1]), cvtpk(x[2], x[3]), cvtpk(x[4], x[5]), cvtpk(x[6], x[7])}; return *reinterpret_cast<bf16x8*>(&w); } };

__device__ __forceinline__ void partialSM(f32x16& p0, f32x16& p1, float& m_reg, float& mn, float& alpha) {
  constexpr float C = SCALE * 1.4426950408889634f;
  float pmax = p0[0]; for (int r = 1; r < 16; ++r) pmax = fmaxf(pmax, p0[r]); for (int r = 0; r < 16; ++r) pmax = fmaxf(pmax, p1[r]);
  { auto rr = __builtin_amdgcn_permlane32_swap(__float_as_uint(pmax), __float_as_uint(pmax), false, false);
    pmax = fmaxf(__uint_as_float(rr[0]), __uint_as_float(rr[1])); }
  if (__builtin_expect(__all(pmax - m_reg <= THR / SCALE), 1)) { mn = m_reg; alpha = 1.f; }
  else { mn = fmaxf(m_reg, pmax); alpha = __builtin_amdgcn_exp2f((m_reg - mn) * C); m_reg = mn; }
  float mnC = -mn * C;
  for (int r = 0; r < 16; ++r) p0[r] = fmaf(p0[r], C, mnC); for (int r = 0; r < 16; ++r) p1[r] = fmaf(p1[r], C, mnC);
  for (int r = 0; r < 16; ++r) p0[r] = __builtin_amdgcn_exp2f(p0[r]);
}
__device__ __forceinline__ void finishSM(f32x16& p0, f32x16& p1, float alpha, float& l_reg, bf16x8& pa0, bf16x8& pa1, bf16x8& pa2, bf16x8& pa3) {
  for (int r = 0; r < 16; ++r) p1[r] = __builtin_amdgcn_exp2f(p1[r]);
  float ps = 0; for (int r = 0; r < 16; ++r) ps += p0[r]; for (int r = 0; r < 16; ++r) ps += p1[r];
  { auto rr = __builtin_amdgcn_permlane32_swap(__float_as_uint(ps), __float_as_uint(ps), false, false);
    ps = __uint_as_float(rr[0]) + __uint_as_float(rr[1]); }
  l_reg = l_reg * alpha + ps;
#define PK4(P, BASE, OUT) do { unsigned a0 = cvtpk(P[BASE + 0], P[BASE + 1]), a1 = cvtpk(P[BASE + 2], P[BASE + 3]);   \
    unsigned b0 = cvtpk(P[BASE + 4], P[BASE + 5]), b1 = cvtpk(P[BASE + 6], P[BASE + 7]);                              \
    auto r0 = __builtin_amdgcn_permlane32_swap(a0, b0, false, false); auto r1 = __builtin_amdgcn_permlane32_swap(a1, b1, false, false); \
    u32x4 w = {r0[0], r1[0], r0[1], r1[1]}; OUT = *reinterpret_cast<bf16x8*>(&w); } while (0)
  PK4(p0, 0, pa0); PK4(p0, 8, pa1); PK4(p1, 0, pa2); PK4(p1, 8, pa3);
#undef PK4
}
__device__ __forceinline__ void qkt(f32x16& p0, f32x16& p1, const bf16* Ks, const bf16x8* qr, int r32, int hi) {
  p0 = f32x16{}; p1 = f32x16{};
  for (int d0 = 0; d0 < 8; ++d0) { int cb = (d0 * 16 + hi * 8) * 2;
    bf16x8 b0 = *reinterpret_cast<const bf16x8*>((const char*)Ks + KSWZ(r32, cb));
    bf16x8 b1 = *reinterpret_cast<const bf16x8*>((const char*)Ks + KSWZ(32 + r32, cb));
    p0 = __builtin_amdgcn_mfma_f32_32x32x16_bf16(b0, qr[d0], p0, 0, 0, 0);
    p1 = __builtin_amdgcn_mfma_f32_32x32x16_bf16(b1, qr[d0], p1, 0, 0, 0); }
}
__device__ __forceinline__ int v_st(int k, int c) { const int kk = (k & ~0xC) | ((k & 4) << 1) | ((k & 8) >> 1); return ((kk >> 3) * 4 + (c >> 5)) * 512 + ((kk & 7) * 32 + (c & 31)) * 2; }
__device__ __forceinline__ int v_rd_base(int lane) { return ((lane & 3) << 3) | (((lane >> 2) & 3) << 6) | (((lane >> 4) & 1) << 5) | (((lane >> 5) & 1) << 8); }
constexpr int v_rd_off(int d0, int ks, int half) { return d0 * 512 + ks * 4096 + half * 2048; }
template <int OFF> __device__ __forceinline__ s16x4 tr_read(int vb) {
  s16x4 r; asm volatile("ds_read_b64_tr_b16 %0, %1 offset:%2" : "=&v"(r) : "v"(vb), "i"(OFF) : "memory"); return r;
}
template <int D0> __device__ __forceinline__ void pv_one(f32x16& od, int vb, bf16x8 pa0, bf16x8 pa1, bf16x8 pa2, bf16x8 pa3) {
  const s16x4 l0 = tr_read<v_rd_off(D0, 0, 0)>(vb), h0 = tr_read<v_rd_off(D0, 0, 1)>(vb), l1 = tr_read<v_rd_off(D0, 1, 0)>(vb), h1 = tr_read<v_rd_off(D0, 1, 1)>(vb);
  const s16x4 l2 = tr_read<v_rd_off(D0, 2, 0)>(vb), h2 = tr_read<v_rd_off(D0, 2, 1)>(vb), l3 = tr_read<v_rd_off(D0, 3, 0)>(vb), h3 = tr_read<v_rd_off(D0, 3, 1)>(vb);
  asm volatile("s_waitcnt lgkmcnt(0)" ::: "memory"); SBAR();
#define PK(L, H) (bf16x8){L[0], L[1], L[2], L[3], H[0], H[1], H[2], H[3]}
  od = __builtin_amdgcn_mfma_f32_32x32x16_bf16(pa0, PK(l0, h0), od, 0, 0, 0);
  od = __builtin_amdgcn_mfma_f32_32x32x16_bf16(pa1, PK(l1, h1), od, 0, 0, 0);
  od = __builtin_amdgcn_mfma_f32_32x32x16_bf16(pa2, PK(l2, h2), od, 0, 0, 0);
  od = __builtin_amdgcn_mfma_f32_32x32x16_bf16(pa3, PK(l3, h3), od, 0, 0, 0);
#undef PK
}
__device__ __forceinline__ void pv_d0(f32x16* o, int vb, bf16x8 pa0, bf16x8 pa1, bf16x8 pa2, bf16x8 pa3) {
  pv_one<0>(o[0], vb, pa0, pa1, pa2, pa3); pv_one<1>(o[1], vb, pa0, pa1, pa2, pa3); pv_one<2>(o[2], vb, pa0, pa1, pa2, pa3); pv_one<3>(o[3], vb, pa0, pa1, pa2, pa3);
}

__device__ __forceinline__ void attn_dense_body(const bf16* __restrict__ Qb, const bf16* __restrict__ Kh, const bf16* __restrict__ Vh,
                                                const bf16* __restrict__ Gb, bf16* __restrict__ Yb, int seq, char* lds) {
  using TQ = bf16; using St = Stage<bf16>; using SQ = Stage<TQ>;
  const int tid = threadIdx.x, wid = tid >> 6, lane = tid & 63, r32 = lane & 31, hi = lane >> 5;
  bf16* V_lds = (bf16*)lds; bf16* K_lds = (bf16*)(lds + 2 * SHM_V);
  float* ws = (float*)(lds + 2 * SHM_V + 2 * SHM_K) + wid * 64; float* li_l = ws; float* al_l = ws + 32;
  float m_reg = -1e30f, l_reg = 0; f32x16 o[4] = {}; bf16x8 qr[8];
  const TQ* Qw = Qb + (long)(wid * QBLK + r32) * LDQ + hi * 8;
#pragma unroll
  for (int d0 = 0; d0 < 8; ++d0) qr[d0] = SQ::tobf(SQ::ld8(Qw + d0 * 16));
  const int sr = tid >> 4, sc = (tid & 15) * 8, vst0 = v_st(sr, sc), vst1 = v_st(32 + sr, sc);
  const unsigned toff = (unsigned)(sr * LDK + sc);
  const int vb0 = (int)(uintptr_t)V_lds + v_rd_base(lane);
  struct { typename St::T vs0, vs1, ks0, ks1; } sr_[SDEPTH];
#define SLOAD(i, k0) do { const bf16* vb_ = Vh + (long)(k0) * LDK; const bf16* kb_ = Kh + (long)(k0) * LDK; \
    sr_[i].vs0 = St::ld8(vb_ + toff); sr_[i].vs1 = St::ld8(vb_ + 32 * LDK + toff); \
    sr_[i].ks0 = St::ld8(kb_ + toff); sr_[i].ks1 = St::ld8(kb_ + 32 * LDK + toff); } while (0)
#define SWRITE(b, i) do { *(bf16x8*)((char*)V_lds + (b) * SHM_V + vst0) = St::tobf(sr_[i].vs0);          \
    *(bf16x8*)((char*)V_lds + (b) * SHM_V + vst1) = St::tobf(sr_[i].vs1); int kc = sc * 2;               \
    *(bf16x8*)((char*)K_lds + (b) * SHM_K + KSWZ(sr, kc)) = St::tobf(sr_[i].ks0);                       \
    *(bf16x8*)((char*)K_lds + (b) * SHM_K + KSWZ(32 + sr, kc)) = St::tobf(sr_[i].ks1); } while (0)
#define SWAIT() do { if constexpr (SDEPTH == 2) asm volatile("s_waitcnt vmcnt(4)" ::: "memory"); else asm volatile("s_waitcnt vmcnt(0)" ::: "memory"); } while (0)
#define RESC(a) do { if (__any((a) < 1.f)) { if (hi == 0) al_l[r32] = (a); asm volatile("s_waitcnt lgkmcnt(0)" ::: "memory"); \
    for (int d = 0; d < 4; ++d) for (int r = 0; r < 16; ++r) o[d][r] *= al_l[crow(r, hi)]; } } while (0)
  f32x16 pA0, pA1, pB0, pB1; float mnA, mnB, alA, alB; bf16x8 pa0, pa1, pa2, pa3; const int NT = seq / KVBLK;
  constexpr int SE = 0, SO = SDEPTH - 1;
  SLOAD(SE, 0); asm volatile("s_waitcnt vmcnt(0)" ::: "memory"); SWRITE(0, SE); __syncthreads();
  qkt(pA0, pA1, K_lds, qr, r32, hi); partialSM(pA0, pA1, m_reg, mnA, alA);
  SLOAD(SO, KVBLK); if constexpr (SDEPTH == 2) { if (2 < NT) SLOAD(SE, 2 * KVBLK); }
  SWAIT(); SWRITE(1, SO); __syncthreads();
  for (int j = 1; j + 1 < NT; j += 2) {
    SBAR(); qkt(pB0, pB1, (bf16*)((char*)K_lds + SHM_K), qr, r32, hi);
    finishSM(pA0, pA1, alA, l_reg, pa0, pa1, pa2, pa3); SBAR();
    SLOAD(SO, (j + SDEPTH) * KVBLK); SBAR();
    pv_d0(o, vb0, pa0, pa1, pa2, pa3); partialSM(pB0, pB1, m_reg, mnB, alB);
    __syncthreads(); SWAIT(); SWRITE(0, SE);
    RESC(alB); __syncthreads();
    SBAR(); qkt(pA0, pA1, K_lds, qr, r32, hi);
    finishSM(pB0, pB1, alB, l_reg, pa0, pa1, pa2, pa3); SBAR();
    if (SDEPTH == 1 || j + 3 < NT) SLOAD(SE, (j + 1 + SDEPTH) * KVBLK); SBAR();
    pv_d0(o, vb0 + (int)SHM_V, pa0, pa1, pa2, pa3); partialSM(pA0, pA1, m_reg, mnA, alA);
    __syncthreads(); SWAIT(); SWRITE(1, SO);
    RESC(alA); __syncthreads();
  }
  SBAR(); qkt(pB0, pB1, (bf16*)((char*)K_lds + SHM_K), qr, r32, hi);
  finishSM(pA0, pA1, alA, l_reg, pa0, pa1, pa2, pa3); SBAR();
  pv_d0(o, vb0, pa0, pa1, pa2, pa3); partialSM(pB0, pB1, m_reg, mnB, alB);
  __syncthreads(); RESC(alB);
  finishSM(pB0, pB1, alB, l_reg, pa0, pa1, pa2, pa3); SBAR();
  pv_d0(o, vb0 + (int)SHM_V, pa0, pa1, pa2, pa3);
  if (hi == 0) li_l[r32] = l_reg; asm volatile("s_waitcnt lgkmcnt(0)" ::: "memory");
  float rli[16];
#pragma unroll
  for (int r = 0; r < 16; ++r) rli[r] = __builtin_amdgcn_rcpf(li_l[crow(r, hi)]);
  int eoff = wid * QBLK; asm volatile("" : "+v"(eoff));
  const bf16* Gw = Gb + (long)eoff * LDQ; bf16* Yw = Yb + (long)eoff * LDY;
  int hie = hi; asm volatile("" : "+v"(hie));
#pragma unroll
  for (int r = 0; r < 16; ++r) { const int orow = crow(r, hie);
#pragma unroll
    for (int d0 = 0; d0 < 4; ++d0) { const float gv = bf2f_(Gw[orow * LDQ + d0 * 32 + r32]);
      Yw[orow * LDY + d0 * 32 + r32] = f2bf_(o[d0][r] * rli[r] * gv); }
    asm volatile("" ::: "memory"); }
  __syncthreads();
#undef SLOAD
#undef SWRITE
#undef SWAIT
#undef RESC
}

__device__ __forceinline__ void attn_band_unit(const bf16* __restrict__ P, bf16* __restrict__ OG, float* __restrict__ LSE, int g, int b, int h, int blk, int cqb, int ckb, int cvb, int seqlen, int ntok, char* lds) {
  using St = Stage<bf16>;
  const int tid = threadIdx.x, lane = tid & 63, r32 = lane & 31, hi = lane >> 5; const int wid = __builtin_amdgcn_readfirstlane(tid >> 6);
  bf16* V_lds = (bf16*)lds; bf16* K_lds = (bf16*)(lds + 2 * SHM_V);
  float* ws = (float*)(lds + 2 * SHM_V + 2 * SHM_K) + wid * 64; float* li_l = ws; float* al_l = ws + 32;
  const int dil = (g == 0) ? 1 : (g == 1 ? 4 : 16), head = g * 4 + h;
  int rq, lq0, ntile, t_lo, res0;
  if (g < 2) { const int kb = (g == 0) ? blk : (blk & 1), nt_all = seqlen / dil / 64; res0 = (g == 0) ? 0 : (blk >> 1);
    rq = res0; lq0 = 256 * kb + 32 * wid; t_lo = (4 * kb - 1 < 0) ? 0 : 4 * kb - 1; const int t_hi = (4 * kb + 5 > nt_all) ? nt_all : 4 * kb + 5; ntile = t_hi - t_lo; }
  else { res0 = 2 * blk; rq = res0 + (wid >> 2); lq0 = 32 * (wid & 3); t_lo = 0; ntile = 4; }
  const long tok0 = (long)b * seqlen;
  const bf16* Pq = P + cqb + head * D; const bf16* Pk = P + ckb + head * D; const bf16* Pv = P + cvb + head * D;
  float m_reg = -1e30f, l_reg = 0; f32x16 o[4] = {}; bf16x8 qr[8];
  { const bf16* Qw = Pq + (tok0 + (long)(lq0 + r32) * dil + rq) * LDQ + hi * 8;
#pragma unroll
    for (int d0 = 0; d0 < 8; ++d0) qr[d0] = St::ld8(Qw + d0 * 16); }
  const int sr = tid >> 4, sc = (tid & 15) * 8, vst0 = v_st(sr, sc), vst1 = v_st(32 + sr, sc);
  const int vb0 = (int)(uintptr_t)V_lds + v_rd_base(lane);
  typename St::T vs0, vs1, ks0, ks1;
#define TILE_RK(tt) ((g < 2) ? res0 : res0 + ((tt) >> 1))
#define TILE_LK0(tt) ((g < 2) ? 64 * (t_lo + (tt)) : 64 * ((tt) & 1))
#define BLOAD(tt) do { const int rk_ = TILE_RK(tt), lk_ = TILE_LK0(tt); const long ta = (tok0 + (long)(lk_ + sr) * dil + rk_) * LDK + sc, tb = (tok0 + (long)(lk_ + 32 + sr) * dil + rk_) * LDK + sc; \
    vs0 = St::ld8(Pv + ta); vs1 = St::ld8(Pv + tb); ks0 = St::ld8(Pk + ta); ks1 = St::ld8(Pk + tb); } while (0)
  BLOAD(0);
  for (int tt = 0; tt < ntile; ++tt) {
    __syncthreads();
    { *(bf16x8*)((char*)V_lds + vst0) = vs0; *(bf16x8*)((char*)V_lds + vst1) = vs1; const int kc = sc * 2;
      *(bf16x8*)((char*)K_lds + KSWZ(sr, kc)) = ks0; *(bf16x8*)((char*)K_lds + KSWZ(32 + sr, kc)) = ks1; }
    __syncthreads();
    if (tt + 1 < ntile) BLOAD(tt + 1);
    const int rk = TILE_RK(tt), lk0 = TILE_LK0(tt);
    const bool need = (rk == rq) && (lk0 + 63 >= lq0 - 64) && (lk0 <= lq0 + 95);
    if (need) {
      f32x16 p0, p1; float mn, alpha; bf16x8 pa0, pa1, pa2, pa3;
      qkt(p0, p1, K_lds, qr, r32, hi);
      const int dd = lk0 - lq0 - r32 + 4 * hi;
#pragma unroll
      for (int r = 0; r < 16; ++r) { const int d0_ = dd + (r & 3) + 8 * (r >> 2), d1_ = d0_ + 32;
        if (d0_ < -64 || d0_ > 64) p0[r] = -INFINITY; if (d1_ < -64 || d1_ > 64) p1[r] = -INFINITY; }
      partialSM(p0, p1, m_reg, mn, alpha);
      if (__any(alpha < 1.f)) { if (hi == 0) al_l[r32] = alpha; asm volatile("s_waitcnt lgkmcnt(0)" ::: "memory");
#pragma unroll
        for (int d = 0; d < 4; ++d)
#pragma unroll
          for (int r = 0; r < 16; ++r) o[d][r] *= al_l[crow(r, hi)]; }
      finishSM(p0, p1, alpha, l_reg, pa0, pa1, pa2, pa3); SBAR();
      pv_d0(o, vb0, pa0, pa1, pa2, pa3);
    }
  }
#undef BLOAD
#undef TILE_RK
#undef TILE_LK0
  if (hi == 0) li_l[r32] = l_reg; asm volatile("s_waitcnt lgkmcnt(0)" ::: "memory");
  float rli[16];
#pragma unroll
  for (int r = 0; r < 16; ++r) rli[r] = __builtin_amdgcn_rcpf(li_l[crow(r, hi)]);
  bf16* Og = OG + (long)g * ntok * 512 + h * D;
#pragma unroll
  for (int r = 0; r < 16; ++r) { const long tok = tok0 + (long)(lq0 + crow(r, hi)) * dil + rq;
#pragma unroll
    for (int d0 = 0; d0 < 4; ++d0) Og[tok * 512 + d0 * 32 + r32] = f2bf_(o[d0][r] * rli[r]); }
  if (hi == 0) LSE[((long)g * ntok + tok0 + (long)(lq0 + r32) * dil + rq) * 4 + h] = m_reg * SCALE + __logf(l_reg);
  __syncthreads();
}
}

typedef unsigned short bf16_t;
constexpr int BATCH = 4, SEQ = 2048, DM = 2048, NTOK = BATCH * SEQ, NC = 11776;
constexpr int C_QA = 0, C_KA = 1024, C_VA = 1280, C_GA = 1536, C_QB = 2560, C_KB = 4096, C_VB = 5632, C_GB = 7168, C_ZA = 7680, C_ZB = 9728;
constexpr float EPS = 1e-6f;
constexpr size_t MiB = 1u << 20;
constexpr int PITCH = 7680;
constexpr size_t WS_CTL = 0, WS_TAB = 1 * MiB, WS_XB = 1 * MiB + 512 * 1024, WS_WTIN = 2 * MiB, WS_WTAB = 48 * MiB, WS_WTO = 54 * MiB, WS_HB = 64 * MiB, WS_P = 96 * MiB, WS_Y = 216 * MiB, WS_OG = 240 * MiB, WS_LSE = 264 * MiB,
                 WS_SA = 266 * MiB, WS_SB = 298 * MiB, WS_END = 330 * MiB;

#define LAS __attribute__((address_space(3)))
typedef float f32x4 __attribute__((ext_vector_type(4)));
typedef unsigned v4u __attribute__((ext_vector_type(4)));
constexpr int NWAVES = 8;
constexpr int LDS_BYTES = 147456;

__device__ __forceinline__ float bf2f(bf16_t h) { return __uint_as_float(((unsigned)h) << 16); }
__device__ __forceinline__ unsigned f2bf_u(float f) { unsigned u = __float_as_uint(f); return (u + 0x7fffu + ((u >> 16) & 1u)) >> 16; }
__device__ __forceinline__ bf16_t f2bf(float f) { return (bf16_t)f2bf_u(f); }
__device__ __forceinline__ unsigned pk2(float lo, float hi) { return f2bf_u(lo) | (f2bf_u(hi) << 16); }
__device__ __forceinline__ float wave_sum(float v) {
#pragma unroll
    for (int o = 1; o < 64; o <<= 1) v += __shfl_xor(v, o);
    return v;
}
__device__ __forceinline__ float silu(float v) { return v / (1.f + __expf(-v)); }

__device__ __forceinline__ int colmap(int kind, int p) {
    const int bj = p >> 7, wc = (p >> 5) & 3, n = (p >> 4) & 1, fq = (p >> 2) & 3, j = p & 3;
    const int gen = 128 * bj + 32 * wc + 8 * fq + 4 * n + j;
    if (kind == 0) return p;
    if (kind == 1) return gen;
    if (kind == 2) return 128 * bj + 64 * (wc >> 1) + 32 * n + 16 * (wc & 1) + 4 * fq + j;
    return wc == 0 ? p : gen;
}
__device__ __forceinline__ int kind_in(int pn) { return pn < 5 ? 2 : ((pn >= 10 && pn < 22) ? 3 : 1); }

__device__ __forceinline__ void transpose_item(const float* W, int N, bf16_t* WT, int ldt, int koff, int kindsel, LAS float* scr, int item, int lane) {
    const int nblk = N / 32, kb = item / nblk, nb = item % nblk, k0 = 64 * kb, n0 = 32 * nb;
    const int np = n0 + (lane & 31), pn = np >> 8;
    const int kind = kindsel < 0 ? kind_in(pn) : kindsel;
    const int srcc = (pn << 8) + colmap(kind, np & 255);
#pragma unroll 8
    for (int i = 0; i < 32; ++i) { const int kk = 2 * i + (lane >> 5); scr[kk * 33 + (lane & 31)] = W[(size_t)(k0 + kk) * N + srcc]; }
    asm volatile("s_waitcnt lgkmcnt(0)" ::: "memory");
    const int c = lane & 7;
#pragma unroll
    for (int j = 0; j < 4; ++j) { const int n = (lane >> 3) + 8 * j; const LAS float* s = scr + (8 * c) * 33 + n;
        v4u o; o.x = pk2(s[0 * 33], s[1 * 33]); o.y = pk2(s[2 * 33], s[3 * 33]); o.z = pk2(s[4 * 33], s[5 * 33]); o.w = pk2(s[6 * 33], s[7 * 33]);
        *(v4u*)(WT + (size_t)(n0 + n) * ldt + koff + k0 + 8 * c) = o; }
    asm volatile("s_waitcnt lgkmcnt(0)" ::: "memory");
}
__device__ __forceinline__ void rms_row_to_bf16(const float* xrow, const float* gain, bf16_t* orow, int lane) {
    const f32x4* xr = (const f32x4*)xrow + lane; const f32x4* gr = (const f32x4*)gain + lane;
    f32x4 v[8]; float s = 0.f;
#pragma unroll
    for (int j = 0; j < 8; ++j) { v[j] = xr[64 * j]; s += (v[j].x * v[j].x + v[j].y * v[j].y) + (v[j].z * v[j].z + v[j].w * v[j].w); }
    const float rs = rsqrtf(wave_sum(s) * (1.f / DM) + EPS);
    unsigned long long* o8 = (unsigned long long*)orow + lane;
#pragma unroll
    for (int j = 0; j < 8; ++j) { const f32x4 g = gr[64 * j]; const f32x4 y = v[j] * rs * g;
        o8[64 * j] = (unsigned long long)pk2(y.x, y.y) | ((unsigned long long)pk2(y.z, y.w) << 32); }
}

#define XB_TMO      128
#define XB_XCNT(j)  (256  + 64 * (j))
#define XB_XSUB(j)  (1280 + 64 * (j))
#define XB_XGEN(j)  (2304 + 64 * (j))
#define XB_TOP      3328
#define XB_TOPGEN   3392
#define XCD_BAR_WORDS 3456
#define XB_SPIN_CAP (1u << 18)

__device__ __forceinline__ unsigned xb_ld(unsigned* p)              { return __hip_atomic_load(p, __ATOMIC_RELAXED, __HIP_MEMORY_SCOPE_AGENT); }
__device__ __forceinline__ unsigned xb_add(unsigned* p, unsigned v) { return __hip_atomic_fetch_add(p, v, __ATOMIC_RELAXED, __HIP_MEMORY_SCOPE_AGENT); }
__device__ __forceinline__ unsigned xb_xcc_id() { return (unsigned)__builtin_amdgcn_s_getreg((3 << 11) | 20) & 0xFu; }
#define XB_SPIN(cond, bar) do { unsigned _sp = 0; while (cond) { __builtin_amdgcn_s_sleep(1); \
    if ((++_sp & 255u) == 0u) { if (xb_ld(&(bar)[XB_TMO])) break; if (_sp > XB_SPIN_CAP) { atomicAdd(&(bar)[XB_TMO], 1u); break; } } } } while (0)

struct XcdBarrier {
    unsigned* bar; unsigned x;
    volatile LAS unsigned* st;
};

__device__ __forceinline__ XcdBarrier xcd_barrier_post(unsigned* bar, volatile LAS unsigned* st) {
    XcdBarrier b; b.bar = bar; b.x = xb_xcc_id(); b.st = st;
    if (threadIdx.x == 0) (void)xb_add(&bar[XB_XCNT(b.x)], 1u);
    return b;
}
__device__ __forceinline__ void xcd_barrier_complete(unsigned* bar, unsigned x, unsigned& nloc, unsigned& nx) {
    const unsigned G = gridDim.x * gridDim.y * gridDim.z;
    unsigned sum, cnt, mine, sp = 0u;
    for (;;) {
        sum = 0u; cnt = 0u; mine = 0u;
#pragma unroll
        for (unsigned j = 0; j < 16; ++j) { const unsigned c = xb_ld(&bar[XB_XCNT(j)]); sum += c; cnt += (c > 0u) ? 1u : 0u; mine = (j == x) ? c : mine; }
        if (sum == G) break;
        __builtin_amdgcn_s_sleep(1);
        if ((++sp & 255u) == 0u) { if (xb_ld(&bar[XB_TMO])) break; if (sp > XB_SPIN_CAP) { atomicAdd(&bar[XB_TMO], 1u); break; } }
    }
    nloc = mine > 0u ? mine : 1u; nx = cnt > 0u ? cnt : 1u;
}

__device__ __forceinline__ void xcd_barrier(const XcdBarrier& b) {
    asm volatile("s_waitcnt vmcnt(0)" ::: "memory");
    __syncthreads();
    if (threadIdx.x == 0) {
        unsigned* bar = b.bar;
        __builtin_amdgcn_s_waitcnt(0);
        unsigned nloc = b.st[0], nx = b.st[1];
        if (nloc == 0u) { xcd_barrier_complete(bar, b.x, nloc, nx); b.st[0] = nloc; b.st[1] = nx; }
        const unsigned old = xb_add(&bar[XB_XSUB(b.x)], 1u);
        const unsigned gen = old / nloc;
        if (old + 1u == (gen + 1u) * nloc) {
            __builtin_amdgcn_fence(__ATOMIC_RELEASE, "agent");
            asm volatile("s_waitcnt vmcnt(0)" ::: "memory");
            const unsigned og = xb_add(&bar[XB_TOP], 1u);
            const unsigned tg = og / nx;
            if (og + 1u == (tg + 1u) * nx) xb_add(&bar[XB_TOPGEN], 1u);
            else XB_SPIN(xb_ld(&bar[XB_TOPGEN]) == tg, bar);
            __builtin_amdgcn_fence(__ATOMIC_ACQUIRE, "agent");
            xb_add(&bar[XB_XGEN(b.x)], 1u);
            asm volatile("s_waitcnt vmcnt(0)" ::: "memory");
        } else {
            XB_SPIN(xb_ld(&bar[XB_XGEN(b.x)]) == gen, bar);
            __builtin_amdgcn_fence(__ATOMIC_ACQUIRE, "agent");
            asm volatile("s_waitcnt vmcnt(0)" ::: "memory");
        }
    }
    __syncthreads();
}

struct Args { const float* in[10]; float* out; unsigned char* ws; int ph_lo, ph_hi; };

__global__ void __launch_bounds__(NWAVES * 64, 2) mk_fwd(Args args) {
    extern __shared__ __attribute__((aligned(16))) unsigned char lds[];
    const int tid = threadIdx.x, lane = tid & 63, wave = __builtin_amdgcn_readfirstlane(tid >> 6);
    const int G = gridDim.x, bx = blockIdx.x;
    const int vcu = (G % 8 == 0) ? (bx % 8) * (G / 8) + bx / 8 : bx;
    unsigned char* ws = args.ws;
    const float* x = args.in[0]; const float* ng = args.in[1]; const float* w_in = args.in[2];
    bf16_t* WT_IN = (bf16_t*)(ws + WS_WTIN); bf16_t* HB = (bf16_t*)(ws + WS_HB); bf16_t* P = (bf16_t*)(ws + WS_P);
    float* COSA = (float*)(ws + WS_TAB); float* SINA = COSA + 2048; float* COSP = COSA + 4096; float* SINP = COSP + 32768;
    bf16_t* OG = (bf16_t*)(ws + WS_OG); float* LSE = (float*)(ws + WS_LSE); unsigned* CTL = (unsigned*)(ws + WS_CTL) + 4096;
    bf16_t* WT_AB = (bf16_t*)(ws + WS_WTAB); bf16_t* WT_O = (bf16_t*)(ws + WS_WTO); bf16_t* Y = (bf16_t*)(ws + WS_Y); bf16_t* MG = HB; bf16_t* SA = (bf16_t*)(ws + WS_SA); bf16_t* SB = (bf16_t*)(ws + WS_SB); float* XB = (float*)(ws + WS_XB); unsigned* PCNT = (unsigned*)(ws + WS_CTL) + 8192;
    const int lo = args.ph_lo, hi = args.ph_hi;
    volatile LAS unsigned* MISC = (volatile LAS unsigned*)((LAS unsigned char*)lds + 131072 + 320);
    if (tid < 32) MISC[tid] = 0u;
    __syncthreads();
    XcdBarrier bar = xcd_barrier_post((unsigned*)(ws + WS_CTL), MISC + 8);
#define GRID_BAR() xcd_barrier(bar)
#define IN(k) (lo <= (k) && (k) < hi)
#define BOTH(k) (IN(k) && IN((k) + 1))
    if (IN(0)) {
        LAS float* scr = (LAS float*)((LAS unsigned char*)lds + wave * 16384);
        const int gw = vcu * NWAVES + wave, NGW = G * NWAVES;
        constexpr int I_IN = (DM / 64) * (NC / 32);
        constexpr int I_A = (1024 / 64) * (DM / 32), I_B = (512 / 64) * (DM / 32), I_O = (DM / 64) * (DM / 32);
        for (int it = gw; it < I_IN + I_A + I_B + I_O; it += NGW) {
            int r = it;
            if (r < I_IN) { transpose_item(w_in, NC, WT_IN, DM, 0, -1, scr, r, lane); continue; } r -= I_IN;
            if (r < I_A) { transpose_item(args.in[6], DM, WT_AB, 1536, 0, 1, scr, r, lane); continue; } r -= I_A;
            if (r < I_B) { transpose_item(args.in[7], DM, WT_AB, 1536, 1024, 1, scr, r, lane); continue; } r -= I_B;
            transpose_item(args.in[8], DM, WT_O, DM, 0, 0, scr, r, lane);
        }
        for (int i = bx * (NWAVES * 64) + tid; i < 2048 + 32768; i += G * NWAVES * 64) {
            if (i < 2048) { const int pos = i >> 5, fi = i & 31; const float a = (float)pos * (1.0f / powf(10000.0f, (float)fi / 32.0f)); COSA[i] = cosf(a); SINA[i] = sinf(a); }
            else { const int k = i - 2048, pos = k >> 4, fi = k & 15; const float a = (float)pos * (1.0f / powf(500000.0f, (float)fi / 16.0f)); COSP[k] = cosf(a); SINP[k] = sinf(a); }
        }
        for (int m = gw; m < NTOK; m += NGW) rms_row_to_bf16(x + (size_t)m * DM, ng, HB + (size_t)m * DM, lane);
        if (BOTH(0)) GRID_BAR();
    }
    if (IN(1)) {
        pg8::Gemm g{HB, WT_IN, NTOK, NC, DM}; pg8::StaticOrder S; S.init(NTOK, NC, G, bx);
        pg8::EpiIn E{P, PITCH, COSA, SINA, COSP, SINP, args.in[3], args.in[4], args.in[5], SA, SB, (LAS float*)((LAS unsigned char*)lds + 131072 + 1024), EPS};
        pg8::gemm_phase<pg8::EpiIn, pg8::StaticOrder, true, true>((LAS unsigned char*)lds, g, S, E);
        if (BOTH(1)) GRID_BAR();
    }
    if (IN(2)) {
        for (int u = bx; u < 384; u += G) {
            const int blk = u & 7, h = (u >> 3) & 3, b = (u >> 5) & 3, g = u >> 7;
            att::attn_band_unit(P, OG, LSE, g, b, h, blk, C_QB, C_KB, C_VB, SEQ, NTOK, (char*)lds);
        }
        asm volatile("s_waitcnt vmcnt(0)" ::: "memory"); __syncthreads();
        if (tid == 0) { __builtin_amdgcn_fence(__ATOMIC_RELEASE, "agent"); asm volatile("s_waitcnt vmcnt(0)" ::: "memory"); __hip_atomic_fetch_add(CTL, 1u, __ATOMIC_RELAXED, __HIP_MEMORY_SCOPE_AGENT); }
        for (int u = bx; u < 256; u += G) {
            const int pair = u & 7, inner = u >> 3, b = pair >> 1, hkv = pair & 1, hq = hkv * 4 + (inner >> 3), qb = inner & 7;
            const size_t row0 = (size_t)b * SEQ + qb * 256;
            att::attn_dense_body(P + row0 * PITCH + C_QA + hq * 128, P + (size_t)b * SEQ * PITCH + C_KA + hkv * 128, P + (size_t)b * SEQ * PITCH + C_VA + hkv * 128,
                                 P + row0 * PITCH + C_GA + hq * 128, Y + row0 * 1536 + hq * 128, SEQ, (char*)lds);
        }
        if (tid == 0) { unsigned spins = 0; while (__hip_atomic_load(CTL, __ATOMIC_RELAXED, __HIP_MEMORY_SCOPE_AGENT) < (unsigned)G) { __builtin_amdgcn_s_sleep(4); if (++spins > (1u << 24)) break; }
            __builtin_amdgcn_fence(__ATOMIC_ACQUIRE, "agent"); asm volatile("s_waitcnt vmcnt(0)" ::: "memory"); }
        __syncthreads();
        for (int ci = bx * (NWAVES * 64) + tid; ci < NTOK * 64; ci += G * NWAVES * 64) {
            const int tok = ci >> 6, c8 = (ci & 63) * 8, h = c8 >> 7;
            const float l0 = LSE[((size_t)0 * NTOK + tok) * 4 + h], l1 = LSE[((size_t)1 * NTOK + tok) * 4 + h], l2 = LSE[((size_t)2 * NTOK + tok) * 4 + h];
            const float mx = fmaxf(l0, fmaxf(l1, l2)); float e0 = __expf(l0 - mx), e1 = __expf(l1 - mx), e2 = __expf(l2 - mx); const float inv = 1.f / (e0 + e1 + e2); e0 *= inv; e1 *= inv; e2 *= inv;
            const v4u a0 = *(const v4u*)(OG + ((size_t)0 * NTOK + tok) * 512 + c8), a1 = *(const v4u*)(OG + ((size_t)1 * NTOK + tok) * 512 + c8), a2 = *(const v4u*)(OG + ((size_t)2 * NTOK + tok) * 512 + c8);
            const v4u gz = *(const v4u*)(P + (size_t)tok * PITCH + C_GB + c8);
            v4u w;
#pragma unroll
            for (int e = 0; e < 4; ++e) {
                const float lo = e0 * __uint_as_float(a0[e] << 16) + e1 * __uint_as_float(a1[e] << 16) + e2 * __uint_as_float(a2[e] << 16);
                const float hh = e0 * __uint_as_float(a0[e] & 0xffff0000u) + e1 * __uint_as_float(a1[e] & 0xffff0000u) + e2 * __uint_as_float(a2[e] & 0xffff0000u);
                w[e] = pk2(lo * __uint_as_float(gz[e] << 16), hh * __uint_as_float(gz[e] & 0xffff0000u)); }
            *(v4u*)(Y + (size_t)tok * 1536 + 1024 + c8) = w;
        }
        if (BOTH(2)) GRID_BAR();
    }
    if (IN(3)) {
        pg8::Gemm g{Y, WT_AB, NTOK, DM, 1536}; pg8::StaticOrder S; S.init(NTOK, DM, G, bx);
        pg8::EpiMerge2 E{SA, SB, MG, DM};
        pg8::gemm_phase<pg8::EpiMerge2, pg8::StaticOrder, true, true>((LAS unsigned char*)lds, g, S, E);
        if (BOTH(3)) GRID_BAR();
    }
    if (IN(4)) {
        pg8::Gemm g{MG, WT_O, NTOK, DM, DM}; pg8::StaticOrder S; S.init(NTOK, DM, G, bx);
        pg8::EpiResidNorm E{x, args.out, DM, args.in[9], XB, PCNT, 8, EPS};
        if (G == 256) pg8::gemm_phase<pg8::EpiResidNorm, pg8::StaticOrder, false, true>((LAS unsigned char*)lds, g, S, E);
    }
#undef IN
#undef BOTH
}


extern "C" void kernel_launch(void* const* d_in, const int* in_sizes, int n_in, void* d_out, int out_size, void* d_ws, size_t ws_size, hipStream_t stream) {
    static int grid = 0;
    if (grid == 0) {
        if (n_in != 10 || in_sizes[0] != NTOK * DM || out_size != NTOK * DM || ws_size < WS_END) { fprintf(stderr, "kernel_launch: unexpected shapes / workspace (%zu)\n", ws_size); grid = -1; return; }
        int dev = 0, cus = 0, per_cu = 0;
        if (hipGetDevice(&dev) != hipSuccess || hipDeviceGetAttribute(&cus, hipDeviceAttributeMultiprocessorCount, dev) != hipSuccess) { grid = -1; return; }
        if (hipFuncSetAttribute((const void*)mk_fwd, hipFuncAttributeMaxDynamicSharedMemorySize, LDS_BYTES) != hipSuccess) { fprintf(stderr, "kernel_launch: hipFuncSetAttribute failed\n"); grid = -1; return; }
        if (hipOccupancyMaxActiveBlocksPerMultiprocessor(&per_cu, (const void*)mk_fwd, NWAVES * 64, LDS_BYTES) != hipSuccess || per_cu < 1) { fprintf(stderr, "kernel_launch: occupancy query says %d\n", per_cu); grid = -1; return; }
        grid = cus;
    }
    if (grid < 0) return;
    if (hipMemsetAsync((char*)d_ws + WS_CTL, 0, 131072, stream) != hipSuccess) { fprintf(stderr, "kernel_launch: memset failed\n"); return; }
    Args a{};
    for (int i = 0; i < 10; ++i) a.in[i] = (const float*)d_in[i];
    a.out = (float*)d_out; a.ws = (unsigned char*)d_ws; a.ph_lo = 0; a.ph_hi = 5;
    void* kargs[] = {&a};
    hipError_t e = hipLaunchCooperativeKernel((const void*)mk_fwd, dim3(grid), dim3(NWAVES * 64), kargs, LDS_BYTES, stream);
    if (e != hipSuccess) fprintf(stderr, "kernel_launch: cooperative launch failed: %s (grid %d)\n", hipGetErrorString(e), grid);
}
```

```cpp
#include <hip/hip_runtime.h>
#include <hip/hip_cooperative_groups.h>
#include <cstdio>
#include <cstdint>
#include <cmath>
namespace cg = cooperative_groups;
__device__ __forceinline__ int fresh_lane() { int l; asm volatile("v_mbcnt_lo_u32_b32 %0, -1, 0\n\tv_mbcnt_hi_u32_b32 %0, -1, %0" : "=v"(l)); return l; }
namespace pg8 {
#define PG8_LAS __attribute__((address_space(3)))
typedef unsigned short bf16_t;
typedef short bf16x8 __attribute__((ext_vector_type(8)));
typedef float f32x4 __attribute__((ext_vector_type(4)));
typedef unsigned u32x4 __attribute__((ext_vector_type(4)));
typedef int v4i_t __attribute__((ext_vector_type(4)));
constexpr int BM = 256, BK = 64, HALF = 128, HTB = HALF * BK * 2  , STAGE_BYTES = 8 * HTB, NXCD = 8, WGM = 8;

__host__ __device__ __forceinline__ int lds_byte(int r, int c) { const int st = (r >> 4) * 2 + (c >> 5), rr = r & 15, cc = c & 31, ob = rr * 64 + cc * 2; return st * 1024 + (ob ^ (((ob >> 9) & 1) << 5)); }
__host__ __device__ __forceinline__ void stage_rc(int b, int& R, int& C) { const int st = b / 1024, sb = b % 1024, swz = sb ^ (((sb >> 9) & 1) << 5); R = (st >> 1) * 16 + swz / 64; C = (st & 1) * 32 + (swz % 64) / 2; }
__host__ __device__ __forceinline__ int perm32(int rho) { const int n = rho >> 4, i = rho & 15; return 8 * (i >> 2) + 4 * n + (i & 3); }

struct Unit { int pm, pn; };
struct Gemm { const bf16_t* A; const bf16_t* Bt; int M, N, K; };

struct StaticOrder {
    int nM, nN, nwg, G, c;
    __host__ __device__ void init(int M, int N, int G_, int c_) { nM = M / BM; nN = N / BM; nwg = nM * nN; G = G_; c = c_; }
    __host__ __device__ bool next(int i, Unit& u) const {
        const long L = (long)i * G + c; if (L >= nwg) return false;
        int wgid = (int)L; { const int q = nwg / NXCD, r = nwg % NXCD, xcd = wgid % NXCD, off = wgid / NXCD; wgid = (xcd < r ? xcd * (q + 1) : r * (q + 1) + (xcd - r) * q) + off; }
        const int nig = WGM * nN, gid = wgid / nig, fm = gid * WGM, gsz = (nM - fm) < WGM ? (nM - fm) : WGM;
        u.pm = fm + ((wgid % nig) % gsz); u.pn = (wgid % nig) / gsz; return true;
    }
    __device__ __forceinline__ void a_ready(const Unit&) const {}
    __device__ __forceinline__ void done(const Unit&) const {}
};

__device__ __forceinline__ unsigned cvt_pk_bf16(float lo, float hi) { unsigned r; asm volatile("v_cvt_pk_bf16_f32 %0, %1, %2" : "=v"(r) : "v"(lo), "v"(hi)); return r; }
typedef float f32x2 __attribute__((ext_vector_type(2)));

struct EpiRaw {
    static constexpr bool PERM = false, AFTER_DRAIN = false, FP8 = false; static constexpr int HOOK_T = -1;
    bf16_t* O; int ldc;
    __device__ __forceinline__ void operator()(const f32x4 (&acc)[2][2][4][2], const Unit& u, int wr, int wc, int fr, int fq) const {
        const int row0 = u.pm * BM + wr * 64 + fr, col0 = u.pn * BM + wc * 32 + 8 * fq;
#pragma unroll
        for (int ai = 0; ai < 2; ++ai)
#pragma unroll
            for (int m = 0; m < 4; ++m) { bf16_t* rowp = O + (size_t)(row0 + ai * HALF + m * 16) * ldc + col0;
#pragma unroll
                for (int bj = 0; bj < 2; ++bj) { const f32x4 v0 = acc[ai][bj][m][0], v1 = acc[ai][bj][m][1];
                    u32x4 w; w.x = cvt_pk_bf16(v0[0], v0[1]); w.y = cvt_pk_bf16(v0[2], v0[3]); w.z = cvt_pk_bf16(v1[0], v1[1]); w.w = cvt_pk_bf16(v1[2], v1[3]);
                    *(u32x4*)(rowp + bj * HALF) = w; } }
    }
};

struct EpiMerge {
    static constexpr bool PERM = false, AFTER_DRAIN = false, FP8 = false; static constexpr int HOOK_T = 16;
    const bf16_t* Pz; int ldp, cza, czb; const float* bias; int nb; bf16_t* O; int ldc;
    __device__ __forceinline__ void mid(f32x4 (&acc)[2][2][4][2], const Unit& u, int wr, int wc, int fr, int fq) const {
        int row0 = u.pm * BM + wr * 64 + fr; asm volatile("" : "+v"(row0));
#pragma unroll
        for (int bj = 0; bj < 2; ++bj) { const int col0 = u.pn * BM + bj * HALF + wc * 32 + 8 * fq;
            const f32x4 ba0 = *(const f32x4*)(bias + col0), ba1 = *(const f32x4*)(bias + col0 + 4), bb0 = *(const f32x4*)(bias + nb + col0), bb1 = *(const f32x4*)(bias + nb + col0 + 4);
#pragma unroll
            for (int ai = 0; ai < 2; ++ai)
#pragma unroll
                for (int m = 0; m < 4; ++m) { const size_t ro = (size_t)(row0 + ai * HALF + m * 16) * ldp + col0;
                    const u32x4 za = *(const u32x4*)(Pz + ro + cza), zb = *(const u32x4*)(Pz + ro + czb);
                    f32x4 r0, r1;
#pragma unroll
                    for (int e = 0; e < 4; ++e) { const unsigned a = za[e], b = zb[e];
                        const float a_lo = __uint_as_float(a << 16), a_hi = __uint_as_float(a & 0xffff0000u), b_lo = __uint_as_float(b << 16), b_hi = __uint_as_float(b & 0xffff0000u);
                        const float ba_lo = (e < 2 ? ba0 : ba1)[(2 * e) & 3], ba_hi = (e < 2 ? ba0 : ba1)[(2 * e + 1) & 3], bb_lo = (e < 2 ? bb0 : bb1)[(2 * e) & 3], bb_hi = (e < 2 ? bb0 : bb1)[(2 * e + 1) & 3];
                        const float q_lo = (1.f + __expf(-(b_lo + bb_lo))) / (1.f + __expf(-(a_lo + ba_lo))), q_hi = (1.f + __expf(-(b_hi + bb_hi))) / (1.f + __expf(-(a_hi + ba_hi)));
                        if (e < 2) { r0[2 * e] = q_lo; r0[2 * e + 1] = q_hi; } else { r1[2 * e - 4] = q_lo; r1[2 * e - 3] = q_hi; } }
                    acc[ai][bj][m][0] *= r0; acc[ai][bj][m][1] *= r1; } }
    }
    __device__ __forceinline__ void operator()(const f32x4 (&acc)[2][2][4][2], const Unit& u, int wr, int wc, int fr, int fq) const {
        const int row0 = u.pm * BM + wr * 64 + fr;
#pragma unroll
        for (int bj = 0; bj < 2; ++bj) { const int col0 = u.pn * BM + bj * HALF + wc * 32 + 8 * fq;
            const f32x4 bb0 = *(const f32x4*)(bias + nb + col0), bb1 = *(const f32x4*)(bias + nb + col0 + 4);
#pragma unroll
            for (int ai = 0; ai < 2; ++ai)
#pragma unroll
                for (int m = 0; m < 4; ++m) { const int row = row0 + ai * HALF + m * 16;
                    const u32x4 zb = *(const u32x4*)(Pz + (size_t)row * ldp + col0 + czb);
                    float s[8];
#pragma unroll
                    for (int e = 0; e < 4; ++e) { const unsigned b = zb[e]; const float b_lo = __uint_as_float(b << 16), b_hi = __uint_as_float(b & 0xffff0000u);
                        const float bb_lo = (e < 2 ? bb0 : bb1)[(2 * e) & 3], bb_hi = (e < 2 ? bb0 : bb1)[(2 * e + 1) & 3];
                        s[2 * e] = 1.f / (1.f + __expf(-(b_lo + bb_lo))); s[2 * e + 1] = 1.f / (1.f + __expf(-(b_hi + bb_hi))); }
                    const f32x4 v0 = acc[ai][bj][m][0], v1 = acc[ai][bj][m][1];
                    u32x4 w; w.x = cvt_pk_bf16(v0[0] * s[0], v0[1] * s[1]); w.y = cvt_pk_bf16(v0[2] * s[2], v0[3] * s[3]); w.z = cvt_pk_bf16(v1[0] * s[4], v1[1] * s[5]); w.w = cvt_pk_bf16(v1[2] * s[6], v1[3] * s[7]);
                    *(u32x4*)(O + (size_t)row * ldc + col0) = w; } }
    }
};
struct EpiResid {
    static constexpr bool PERM = false, AFTER_DRAIN = false, FP8 = false; static constexpr int HOOK_T = -1;
    const float* base; float* out; int ldc; float* rowss;
    __device__ __forceinline__ void operator()(const f32x4 (&acc)[2][2][4][2], const Unit& u, int wr, int wc, int fr, int fq) const {
        const int row0 = u.pm * BM + wr * 64 + fr, col0 = u.pn * BM + wc * 32 + 4 * fq;
#pragma unroll
        for (int ai = 0; ai < 2; ++ai)
#pragma unroll
            for (int m = 0; m < 4; ++m) { const int row = row0 + ai * HALF + m * 16; const size_t off = (size_t)row * ldc + col0; float ss = 0.f;
#pragma unroll
                for (int bj = 0; bj < 2; ++bj)
#pragma unroll
                    for (int n = 0; n < 2; ++n) { const f32x4 o = *(const f32x4*)(base + off + bj * HALF + n * 16) + acc[ai][bj][m][n];
                        *(f32x4*)(out + off + bj * HALF + n * 16) = o; ss += (o[0] * o[0] + o[1] * o[1]) + (o[2] * o[2] + o[3] * o[3]); }
                ss += __shfl_xor(ss, 16); ss += __shfl_xor(ss, 32);
                if (fq == 0) atomicAdd(rowss + row, ss); }
    }
};


struct EpiIn {
    static constexpr bool PERM = false, AFTER_DRAIN = false, FP8 = false; static constexpr int HOOK_T = -1;
    bf16_t* O; int ldc; const float* cosa; const float* sina; const float* cosp; const float* sinp; const float* qg; const float* kg; const float* bias; bf16_t* SA; bf16_t* SB; PG8_LAS float* red; float eps;
    __device__ __forceinline__ static unsigned long long pk4(const f32x4 v) { return (unsigned long long)cvt_pk_bf16(v[0], v[1]) | ((unsigned long long)cvt_pk_bf16(v[2], v[3]) << 32); }
    __device__ __forceinline__ void operator()(const f32x4 (&acc)[2][2][4][2], const Unit& u, int wr, int wc, int fr_, int fq_) const {
        (void)fr_; (void)fq_; const int ln_ = fresh_lane(), fr = ln_ & 15, fq = ln_ >> 4;
        const int pn = u.pn; const int row0 = u.pm * BM + wr * 64 + fr;
        if (pn < 5) {
#pragma unroll
            for (int ai = 0; ai < 2; ++ai)
#pragma unroll
                for (int m = 0; m < 4; ++m)
#pragma unroll
                    for (int bj = 0; bj < 2; ++bj) { const f32x4 v0 = acc[ai][bj][m][0], v1 = acc[ai][bj][m][1];
                        float ss = (v0[0] * v0[0] + v0[1] * v0[1]) + (v0[2] * v0[2] + v0[3] * v0[3]) + (v1[0] * v1[0] + v1[1] * v1[1]) + (v1[2] * v1[2] + v1[3] * v1[3]);
                        ss += __shfl_xor(ss, 16); ss += __shfl_xor(ss, 32);
                        if (fq == 0) red[(ai * HALF + wr * 64 + m * 16 + fr) * 8 + bj * 4 + wc] = ss; }
            asm volatile("s_waitcnt lgkmcnt(0)" ::: "memory"); __builtin_amdgcn_s_barrier(); asm volatile("" ::: "memory");
            const int half = wc >> 1, i0 = 16 * (wc & 1) + 4 * fq;
            const float* g = (pn < 4) ? qg : kg;
            const f32x4 g0 = *(const f32x4*)(g + 64 * half + i0), g1 = *(const f32x4*)(g + 64 * half + 32 + i0);
#pragma unroll
            for (int ai = 0; ai < 2; ++ai)
#pragma unroll
                for (int m = 0; m < 4; ++m) { const int row = row0 + ai * HALF + m * 16, sq = row & 2047, pos = half ? (sq & 63) : (sq >> 6);
                    const f32x4 c = *(const f32x4*)(cosa + pos * 32 + i0), sn = *(const f32x4*)(sina + pos * 32 + i0);
#pragma unroll
                    for (int bj = 0; bj < 2; ++bj) { const f32x4 pr = *(const PG8_LAS f32x4*)(red + (ai * HALF + wr * 64 + m * 16 + fr) * 8 + bj * 4);
                        const float rs = rsqrtf(((pr[0] + pr[1]) + (pr[2] + pr[3])) * (1.f / 128.f) + eps);
                        const f32x4 y0 = acc[ai][bj][m][0] * rs * g0, y1 = acc[ai][bj][m][1] * rs * g1;
                        const f32x4 lo = y0 * c - y1 * sn, hi = y0 * sn + y1 * c;
                        bf16_t* p = O + (size_t)row * ldc + pn * BM + bj * HALF + 64 * half + i0;
                        *(unsigned long long*)p = pk4(lo); *(unsigned long long*)(p + 32) = pk4(hi); } }
        } else if (pn >= 10 && pn < 22 && wc == 0) {
            const int i0 = 4 * fq;
#pragma unroll
            for (int ai = 0; ai < 2; ++ai)
#pragma unroll
                for (int m = 0; m < 4; ++m) { const int row = row0 + ai * HALF + m * 16, sq = row & 2047;
                    const f32x4 c = *(const f32x4*)(cosp + sq * 16 + i0), sn = *(const f32x4*)(sinp + sq * 16 + i0);
#pragma unroll
                    for (int bj = 0; bj < 2; ++bj) { const f32x4 y0 = acc[ai][bj][m][0], y1 = acc[ai][bj][m][1];
                        const f32x4 lo = y0 * c - y1 * sn, hi = y0 * sn + y1 * c;
                        bf16_t* p = O + (size_t)row * ldc + pn * BM + bj * HALF + i0;
                        *(unsigned long long*)p = pk4(lo); *(unsigned long long*)(p + 16) = pk4(hi); } }
        } else if (pn >= 30) {
            const int which = pn >= 38 ? 1 : 0, pnz = pn - (which ? 38 : 30);
            const float* bs = bias + which * 2048 + pnz * BM + wc * 32 + 8 * fq;
            bf16_t* dst = (which ? SB : SA) + ((((size_t)(u.pm * 8 + pnz) * 8 + (wr * 4 + wc)) * 16) * 64 + (fq * 16 + fr)) * 8;
#pragma unroll
            for (int bj = 0; bj < 2; ++bj) { const f32x4 b0 = *(const f32x4*)(bs + bj * HALF), b1 = *(const f32x4*)(bs + bj * HALF + 4);
#pragma unroll
                for (int ai = 0; ai < 2; ++ai)
#pragma unroll
                    for (int m = 0; m < 4; ++m) { const f32x4 v0 = acc[ai][bj][m][0] + b0, v1 = acc[ai][bj][m][1] + b1; float sg[8];
#pragma unroll
                        for (int e = 0; e < 4; ++e) { sg[e] = 1.f / (1.f + __expf(-v0[e])); sg[4 + e] = 1.f / (1.f + __expf(-v1[e])); }
                        u32x4 w; w.x = cvt_pk_bf16(sg[0], sg[1]); w.y = cvt_pk_bf16(sg[2], sg[3]); w.z = cvt_pk_bf16(sg[4], sg[5]); w.w = cvt_pk_bf16(sg[6], sg[7]);
                        __builtin_nontemporal_store(w, (u32x4*)(dst + (ai * 8 + bj * 4 + m) * 512)); } }
        } else {
            const bool act = (pn >= 6 && pn < 10) || pn == 28 || pn == 29;
            const int col0 = pn * BM + wc * 32 + 8 * fq;
#pragma unroll
            for (int ai = 0; ai < 2; ++ai)
#pragma unroll
                for (int m = 0; m < 4; ++m) { bf16_t* rowp = O + (size_t)(row0 + ai * HALF + m * 16) * ldc + col0;
#pragma unroll
                    for (int bj = 0; bj < 2; ++bj) { f32x4 v0 = acc[ai][bj][m][0], v1 = acc[ai][bj][m][1];
                        if (act) {
#pragma unroll
                            for (int e = 0; e < 4; ++e) { v0[e] = v0[e] / (1.f + __expf(-v0[e])); v1[e] = v1[e] / (1.f + __expf(-v1[e])); } }
                        u32x4 w; w.x = cvt_pk_bf16(v0[0], v0[1]); w.y = cvt_pk_bf16(v0[2], v0[3]); w.z = cvt_pk_bf16(v1[0], v1[1]); w.w = cvt_pk_bf16(v1[2], v1[3]);
                        *(u32x4*)(rowp + bj * HALF) = w; } }
        }
    }
};
struct EpiGate {
    static constexpr bool PERM = false, AFTER_DRAIN = false, FP8 = true; static constexpr int HOOK_T = -1;
    const float* bias; bf16_t* SA; bf16_t* SB; float descale;
    __device__ __forceinline__ void operator()(const f32x4 (&acc)[2][2][4][2], const Unit& u, int wr, int wc, int fr_, int fq_) const {
        (void)fr_; (void)fq_; const int ln_ = fresh_lane(), fr = ln_ & 15, fq = ln_ >> 4;
        const int which = u.pn >= 8 ? 1 : 0, pnz = u.pn & 7;
        const float* bs = bias + which * 2048 + pnz * BM + wc * 32 + 8 * fq;
        bf16_t* dst = (which ? SB : SA) + ((((size_t)(u.pm * 8 + pnz) * 8 + (wr * 4 + wc)) * 16) * 64 + (fq * 16 + fr)) * 8;
#pragma unroll
        for (int bj = 0; bj < 2; ++bj) { const f32x4 b0 = *(const f32x4*)(bs + bj * HALF), b1 = *(const f32x4*)(bs + bj * HALF + 4);
#pragma unroll
            for (int ai = 0; ai < 2; ++ai)
#pragma unroll
                for (int m = 0; m < 4; ++m) { const f32x4 v0 = acc[ai][bj][m][0] * descale + b0, v1 = acc[ai][bj][m][1] * descale + b1; float sg[8];
#pragma unroll
                    for (int e = 0; e < 4; ++e) { sg[e] = 1.f / (1.f + __expf(-v0[e])); sg[4 + e] = 1.f / (1.f + __expf(-v1[e])); }
                    u32x4 w; w.x = cvt_pk_bf16(sg[0], sg[1]); w.y = cvt_pk_bf16(sg[2], sg[3]); w.z = cvt_pk_bf16(sg[4], sg[5]); w.w = cvt_pk_bf16(sg[6], sg[7]);
                    __builtin_nontemporal_store(w, (u32x4*)(dst + (ai * 8 + bj * 4 + m) * 512)); } }
    }
};
struct EpiMerge2 {
    static constexpr bool PERM = false, AFTER_DRAIN = false, FP8 = false; static constexpr int HOOK_T = 16;
    const bf16_t* SA; const bf16_t* SB; bf16_t* O; int ldc;
    __device__ __forceinline__ void mid(f32x4 (&acc)[2][2][4][2], const Unit& u, int wr, int wc, int fr, int fq) const {
        int lane = fq * 16 + fr; asm volatile("" : "+v"(lane));
        const size_t base = ((((size_t)(u.pm * 8 + u.pn) * 8 + (wr * 4 + wc)) * 16) * 64 + lane) * 8;
#pragma unroll
        for (int f = 0; f < 16; ++f) { const int ai = f >> 3, bj = (f >> 2) & 1, m = f & 3;
            const u32x4 a = __builtin_nontemporal_load((const u32x4*)(SA + base + f * 512)), b = *(const u32x4*)(SB + base + f * 512);
            f32x4 r0, r1;
#pragma unroll
            for (int e = 0; e < 4; ++e) { const float q_lo = __uint_as_float(a[e] << 16) * __builtin_amdgcn_rcpf(__uint_as_float(b[e] << 16)), q_hi = __uint_as_float(a[e] & 0xffff0000u) * __builtin_amdgcn_rcpf(__uint_as_float(b[e] & 0xffff0000u));
                if (e < 2) { r0[2 * e] = q_lo; r0[2 * e + 1] = q_hi; } else { r1[2 * e - 4] = q_lo; r1[2 * e - 3] = q_hi; } }
            acc[ai][bj][m][0] *= r0; acc[ai][bj][m][1] *= r1; }
    }
    __device__ __forceinline__ void operator()(const f32x4 (&acc)[2][2][4][2], const Unit& u, int wr, int wc, int fr_, int fq_) const {
        (void)fr_; (void)fq_; const int ln_ = fresh_lane(), fr = ln_ & 15, fq = ln_ >> 4;
        const int lane = fq * 16 + fr, row0 = u.pm * BM + wr * 64 + fr, col0 = u.pn * BM + wc * 32 + 8 * fq;
        const size_t base = ((((size_t)(u.pm * 8 + u.pn) * 8 + (wr * 4 + wc)) * 16) * 64 + lane) * 8;
#pragma unroll
        for (int f = 0; f < 16; ++f) { const int ai = f >> 3, bj = (f >> 2) & 1, m = f & 3;
            const u32x4 b = __builtin_nontemporal_load((const u32x4*)(SB + base + f * 512));
            const f32x4 v0 = acc[ai][bj][m][0], v1 = acc[ai][bj][m][1];
            u32x4 w; w.x = cvt_pk_bf16(v0[0] * __uint_as_float(b[0] << 16), v0[1] * __uint_as_float(b[0] & 0xffff0000u)); w.y = cvt_pk_bf16(v0[2] * __uint_as_float(b[1] << 16), v0[3] * __uint_as_float(b[1] & 0xffff0000u));
            w.z = cvt_pk_bf16(v1[0] * __uint_as_float(b[2] << 16), v1[1] * __uint_as_float(b[2] & 0xffff0000u)); w.w = cvt_pk_bf16(v1[2] * __uint_as_float(b[3] << 16), v1[3] * __uint_as_float(b[3] & 0xffff0000u));
            *(u32x4*)(O + (size_t)(row0 + ai * HALF + m * 16) * ldc + col0 + bj * HALF) = w; }
    }
};
struct EpiResidNorm {
    static constexpr bool PERM = false, AFTER_DRAIN = true, FP8 = false; static constexpr int HOOK_T = -1;
    const float* base; float* out; int ldc; const float* gain; float* xb; unsigned* cnt; int ntn; float eps;
    __device__ __forceinline__ void fused(f32x4 (&acc)[2][2][4][2], const Unit& u, int wr, int wc, int fr_, int fq_, PG8_LAS unsigned char* lds, int wid, int lane) const {
        (void)fr_; (void)fq_; const int ln_ = fresh_lane(), fr = ln_ & 15, fq = ln_ >> 4;
        PG8_LAS float* Pp = (PG8_LAS float*)lds;
        PG8_LAS float* Sr = (PG8_LAS float*)(lds + 4096);
        const int row0 = u.pm * BM + wr * 64 + fr, col0 = u.pn * BM + wc * 32 + 4 * fq;
#pragma unroll
        for (int ai = 0; ai < 2; ++ai)
#pragma unroll
            for (int m = 0; m < 4; ++m) { const size_t off = (size_t)(row0 + ai * HALF + m * 16) * ldc + col0; float ss = 0.f;
#pragma unroll
                for (int bj = 0; bj < 2; ++bj)
#pragma unroll
                    for (int n = 0; n < 2; ++n) { const f32x4 o = __builtin_nontemporal_load((const f32x4*)(base + off + bj * HALF + n * 16)) + acc[ai][bj][m][n]; acc[ai][bj][m][n] = o;
                        ss += (o[0] * o[0] + o[1] * o[1]) + (o[2] * o[2] + o[3] * o[3]); }
                ss += __shfl_xor(ss, 16); ss += __shfl_xor(ss, 32);
                if (fq == 0) Pp[(ai * HALF + wr * 64 + m * 16 + fr) * 4 + wc] = ss;
                if (m & 1) asm volatile("" ::: "memory"); }
        asm volatile("s_waitcnt lgkmcnt(0)" ::: "memory"); __builtin_amdgcn_s_barrier(); asm volatile("" ::: "memory");
        const int tid = wid * 64 + lane;
        if (tid < 256) { const f32x4 p = *(const PG8_LAS f32x4*)(Pp + tid * 4);
            __hip_atomic_store(xb + (size_t)(u.pm * BM + tid) * 8 + u.pn, (p[0] + p[1]) + (p[2] + p[3]), __ATOMIC_RELAXED, __HIP_MEMORY_SCOPE_AGENT); }
        asm volatile("s_waitcnt vmcnt(0)" ::: "memory"); __builtin_amdgcn_s_barrier(); asm volatile("" ::: "memory");
        if (tid == 0) __hip_atomic_fetch_add(cnt + 64 * u.pm, 1u, __ATOMIC_RELAXED, __HIP_MEMORY_SCOPE_AGENT);
        if (wid == 0) { unsigned spins = 0;
            while ((unsigned)__builtin_amdgcn_readfirstlane(__hip_atomic_load(cnt + 64 * u.pm, __ATOMIC_RELAXED, __HIP_MEMORY_SCOPE_AGENT)) < (unsigned)ntn) { __builtin_amdgcn_s_sleep(2); if (++spins > (1u << 22)) break; }
            __builtin_amdgcn_fence(__ATOMIC_ACQUIRE, "agent"); }
        asm volatile("s_waitcnt vmcnt(0) lgkmcnt(0)" ::: "memory"); __builtin_amdgcn_s_barrier(); asm volatile("" ::: "memory");
        if (tid < 256) { const float* slot = xb + (size_t)(u.pm * BM + tid) * 8; float tot = 0.f;
#pragma unroll
            for (int t = 0; t < 8; ++t) tot += __hip_atomic_load(slot + t, __ATOMIC_RELAXED, __HIP_MEMORY_SCOPE_AGENT);
            Sr[tid] = rsqrtf(tot * (1.0f / 2048.0f) + eps); }
        asm volatile("s_waitcnt lgkmcnt(0)" ::: "memory"); __builtin_amdgcn_s_barrier(); asm volatile("" ::: "memory");
#pragma unroll
        for (int bj = 0; bj < 2; ++bj)
#pragma unroll
            for (int n = 0; n < 2; ++n) { const f32x4 g = *(const f32x4*)(gain + col0 + bj * HALF + n * 16);
#pragma unroll
                for (int ai = 0; ai < 2; ++ai)
#pragma unroll
                    for (int m = 0; m < 4; ++m) { const int rl = ai * HALF + wr * 64 + m * 16 + fr; const float rs = Sr[rl];
                        __builtin_nontemporal_store(acc[ai][bj][m][n] * rs * g, (f32x4*)(out + (size_t)(u.pm * BM + rl) * ldc + col0 + bj * HALF + n * 16)); } }
    }
};

template <class Epi, class Sched, bool ALIGN_EPI = false, bool SP2 = false>
__device__ __forceinline__ void gemm_phase(PG8_LAS unsigned char* lds, const Gemm g, const Sched& S, const Epi& E, const int wave_) {
    const int wid = wave_, lane = fresh_lane(), tid = wid * 64 + lane, wr = wid >> 2, wc = wid & 3, fr = lane & 15, fq = lane >> 4;
    const int K = g.K, nt = K / BK;
    unsigned voffA[2], voffB[2];
#pragma unroll
    for (int i = 0; i < 2; ++i) { int R, C; stage_rc(tid * 16 + i * 8192, R, C); const int Rb = Epi::PERM ? ((R & ~31) + perm32(R & 31)) : R;
        voffA[i] = (unsigned)(R * K + C) * 2u; voffB[i] = (unsigned)(Rb * K + C) * 2u; }
    const unsigned kstep = (unsigned)(BK * 2);
    const unsigned hstep = (unsigned)HALF * (unsigned)K * 2u;
    const unsigned tstep = 2u * hstep;
    const __amdgpu_buffer_rsrc_t rs_voffA = __builtin_amdgcn_make_buffer_rsrc((void*)g.A, 0, (int)((unsigned)g.M * (unsigned)K * 2u), 0x00020000);
    const __amdgpu_buffer_rsrc_t rs_voffB = __builtin_amdgcn_make_buffer_rsrc((void*)g.Bt, 0, (int)((unsigned)g.N * (unsigned)K * 2u), 0x00020000);
    const unsigned ldsw = (unsigned)wid * 1024u;
    const int aoff = lds_byte(wr * 64 + fr, fq * 8), boff = lds_byte(wc * 32 + fr, fq * 8);
#define PG8_SA(b, h) (((b) * 2 + (h)) * HTB)
#define PG8_SB(b, h) ((4 + (b) * 2 + (h)) * HTB)
#define PG8_STAGE(bufoff, goff, voff) do { _Pragma("unroll") for (int _i = 0; _i < 2; ++_i) \
        __builtin_amdgcn_raw_ptr_buffer_load_lds(rs_##voff, (PG8_LAS void*)(lds + (bufoff) + ldsw + _i * 8192), 16, (int)(voff)[_i], (int)(goff), 0, 0); } while (0)
#define PG8_LDA(dst, b, h) do { _Pragma("unroll") for (int m = 0; m < 4; ++m) _Pragma("unroll") for (int k = 0; k < 2; ++k) dst[m][k] = *(const PG8_LAS bf16x8*)(lds + PG8_SA(b, h) + aoff + m * 2048 + k * 1024); } while (0)
#define PG8_LDB(dst, b, h) do { _Pragma("unroll") for (int n = 0; n < 2; ++n) _Pragma("unroll") for (int k = 0; k < 2; ++k) dst[n][k] = *(const PG8_LAS bf16x8*)(lds + PG8_SB(b, h) + boff + n * 2048 + k * 1024); } while (0)
#define PG8_CAT(x, y) __builtin_shufflevector(__builtin_bit_cast(v4i_t, x), __builtin_bit_cast(v4i_t, y), 0, 1, 2, 3, 4, 5, 6, 7)
#define PG8_MMA(ai, bj, At, Bt) do { __builtin_amdgcn_s_setprio(1); _Pragma("unroll") for (int m = 0; m < 4; ++m) _Pragma("unroll") for (int n = 0; n < 2; ++n) { \
        if constexpr (Epi::FP8) acc[ai][bj][m][n] = __builtin_amdgcn_mfma_scale_f32_16x16x128_f8f6f4(PG8_CAT(Bt[n][0], Bt[n][1]), PG8_CAT(At[m][0], At[m][1]), acc[ai][bj][m][n], 0, 0, 0, 0x7f7f7f7f, 0, 0x7f7f7f7f); \
        else { _Pragma("unroll") for (int k = 0; k < 2; ++k) acc[ai][bj][m][n] = __builtin_amdgcn_mfma_f32_16x16x32_bf16(Bt[n][k], At[m][k], acc[ai][bj][m][n], 0, 0, 0); } } \
        __builtin_amdgcn_s_setprio(0); } while (0)
#define PG8_WAIT_V(n) asm volatile("s_waitcnt vmcnt(" #n ")" ::: "memory")
#define PG8_WAIT_L(n) asm volatile("s_waitcnt lgkmcnt(" #n ")" ::: "memory")
#define PG8_BAR __builtin_amdgcn_s_barrier()
#define PG8_SCHED __builtin_amdgcn_sched_barrier(0)
    Unit cur, nxt; int ui = 0;
    if (!S.next(0, cur)) return;
    f32x4 acc[2][2][4][2];
#pragma unroll
    for (int a = 0; a < 2; ++a)
#pragma unroll
        for (int b = 0; b < 2; ++b)
#pragma unroll
            for (int m = 0; m < 4; ++m)
#pragma unroll
                for (int n = 0; n < 2; ++n) acc[a][b][m][n] = (f32x4){0.f, 0.f, 0.f, 0.f};
    bf16x8 At[4][2], B0[2][2], B1[2][2];
    unsigned cA = (unsigned)cur.pm * tstep, cB = (unsigned)cur.pn * tstep;
    S.a_ready(cur);
    if constexpr (SP2) {
        PG8_STAGE(PG8_SB(0, 0), cB, voffB); PG8_STAGE(PG8_SB(0, 1), cB + hstep, voffB); PG8_STAGE(PG8_SA(0, 0), cA, voffA); PG8_STAGE(PG8_SA(0, 1), cA + hstep, voffA);
        if (wr == 1) PG8_BAR;
        PG8_WAIT_V(2); PG8_BAR;
        PG8_STAGE(PG8_SB(1, 0), cB + kstep, voffB); PG8_STAGE(PG8_SA(1, 0), cA + kstep, voffA); PG8_STAGE(PG8_SB(1, 1), cB + hstep + kstep, voffB);
        PG8_WAIT_V(6); PG8_BAR;
    } else {
        PG8_STAGE(PG8_SB(0, 0), cB, voffB); PG8_STAGE(PG8_SA(0, 0), cA, voffA); PG8_STAGE(PG8_SB(0, 1), cB + hstep, voffB); PG8_STAGE(PG8_SA(0, 1), cA + hstep, voffA);
        if (wr == 1) PG8_BAR;
        PG8_WAIT_V(4); PG8_BAR;
        PG8_STAGE(PG8_SB(1, 0), cB + kstep, voffB); PG8_STAGE(PG8_SA(1, 0), cA + kstep, voffA); PG8_STAGE(PG8_SB(1, 1), cB + hstep + kstep, voffB);
        PG8_WAIT_V(6); PG8_BAR;
    }
    for (;;) {
        const bool has_next = S.next(ui + 1, nxt);
        const unsigned nA = has_next ? (unsigned)nxt.pm * tstep : cA, nB = has_next ? (unsigned)nxt.pn * tstep : cB;
        for (int t = 0; t < nt; t += 2) {
            if constexpr (Epi::HOOK_T >= 0) { if (t == Epi::HOOK_T) E.mid(acc, cur, wr, wc, fr, fq); }
            const bool last = (t == nt - 2);
            const unsigned a1 = cA + (unsigned)(t + 1) * kstep;
            const unsigned a2 = last ? nA : cA + (unsigned)(t + 2) * kstep, b2 = last ? nB : cB + (unsigned)(t + 2) * kstep;
            const unsigned a3 = a2 + kstep, b3 = b2 + kstep;
            if (last && has_next) S.a_ready(nxt);
            if constexpr (SP2) {
            PG8_LDB(B0, 0, 0); PG8_LDB(B1, 0, 1); PG8_SCHED; PG8_LDA(At, 0, 0); PG8_STAGE(PG8_SA(1, 1), a1 + hstep, voffA);
            PG8_WAIT_V(8); PG8_WAIT_L(0); PG8_BAR; PG8_MMA(0, 0, At, B0); PG8_MMA(0, 1, At, B1); PG8_BAR; PG8_SCHED;
            PG8_LDA(At, 0, 1); PG8_STAGE(PG8_SB(0, 0), b2, voffB); PG8_STAGE(PG8_SB(0, 1), b2 + hstep, voffB); PG8_STAGE(PG8_SA(0, 0), a2, voffA);
            PG8_WAIT_V(8); PG8_WAIT_L(0); PG8_BAR; PG8_MMA(1, 0, At, B0); PG8_MMA(1, 1, At, B1); PG8_BAR; PG8_SCHED;
            PG8_LDB(B0, 1, 0); PG8_LDB(B1, 1, 1); PG8_SCHED; PG8_LDA(At, 1, 0); PG8_STAGE(PG8_SA(0, 1), a2 + hstep, voffA);
            PG8_WAIT_V(8); PG8_WAIT_L(0); PG8_BAR; PG8_MMA(0, 0, At, B0); PG8_MMA(0, 1, At, B1); PG8_BAR; PG8_SCHED;
            PG8_LDA(At, 1, 1); PG8_STAGE(PG8_SB(1, 0), b3, voffB); PG8_STAGE(PG8_SB(1, 1), b3 + hstep, voffB); PG8_STAGE(PG8_SA(1, 0), a3, voffA);
            PG8_WAIT_V(8); PG8_WAIT_L(0); PG8_BAR; PG8_MMA(1, 0, At, B0); PG8_MMA(1, 1, At, B1); PG8_BAR; PG8_SCHED;
            } else {
            PG8_LDB(B0, 0, 0); PG8_SCHED; PG8_LDA(At, 0, 0); PG8_STAGE(PG8_SA(1, 1), a1 + hstep, voffA);
            PG8_WAIT_L(8); PG8_BAR; PG8_WAIT_L(0); PG8_MMA(0, 0, At, B0); PG8_BAR; PG8_SCHED;
            PG8_LDB(B1, 0, 1); PG8_STAGE(PG8_SB(0, 0), b2, voffB);
            PG8_BAR; PG8_WAIT_L(0); PG8_MMA(0, 1, At, B1); PG8_BAR;
            PG8_LDA(At, 0, 1); PG8_STAGE(PG8_SA(0, 0), a2, voffA);
            PG8_BAR; PG8_WAIT_L(0); PG8_MMA(1, 0, At, B0); PG8_BAR; PG8_SCHED;
            PG8_STAGE(PG8_SB(0, 1), b2 + hstep, voffB);
            PG8_WAIT_V(6); PG8_BAR; PG8_MMA(1, 1, At, B1); PG8_BAR;
            PG8_LDB(B0, 1, 0); PG8_SCHED; PG8_LDA(At, 1, 0); PG8_STAGE(PG8_SA(0, 1), a2 + hstep, voffA);
            PG8_WAIT_L(8); PG8_BAR; PG8_WAIT_L(0); PG8_MMA(0, 0, At, B0); PG8_BAR; PG8_SCHED;
            PG8_LDB(B1, 1, 1); PG8_STAGE(PG8_SB(1, 0), b3, voffB);
            PG8_BAR; PG8_WAIT_L(0); PG8_MMA(0, 1, At, B1); PG8_BAR;
            PG8_LDA(At, 1, 1); PG8_STAGE(PG8_SA(1, 0), a3, voffA);
            PG8_BAR; PG8_WAIT_L(0); PG8_MMA(1, 0, At, B0); PG8_BAR; PG8_SCHED;
            PG8_STAGE(PG8_SB(1, 1), b3 + hstep, voffB);
            PG8_WAIT_V(6); PG8_BAR; PG8_MMA(1, 1, At, B1); PG8_BAR;
            }
        }
        if constexpr (ALIGN_EPI) { if (wr == 0) PG8_BAR; }
        if constexpr (!Epi::AFTER_DRAIN) { E(acc, cur, wr, wc, fr, fq); S.done(cur); }
        if (!has_next) break;
#pragma unroll
        for (int a = 0; a < 2; ++a)
#pragma unroll
            for (int b = 0; b < 2; ++b)
#pragma unroll
                for (int m = 0; m < 4; ++m)
#pragma unroll
                    for (int n = 0; n < 2; ++n) acc[a][b][m][n] = (f32x4){0.f, 0.f, 0.f, 0.f};
        cur = nxt; cA = nA; cB = nB; ++ui;
        if constexpr (ALIGN_EPI) { if (wr == 1) PG8_BAR; }
    }
    PG8_WAIT_V(0);
    if constexpr (!ALIGN_EPI) { if (wr == 0) PG8_BAR; }
    PG8_BAR;
    if constexpr (Epi::AFTER_DRAIN) { E.fused(acc, cur, wr, wc, fr, fq, lds, wid, lane); S.done(cur); }
#undef PG8_SA
#undef PG8_SB
#undef PG8_STAGE
#undef PG8_LDA
#undef PG8_LDB
#undef PG8_MMA
#undef PG8_CAT
#undef PG8_WAIT_V
#undef PG8_WAIT_L
#undef PG8_BAR
#undef PG8_SCHED
}
}

namespace att {
using bf16 = unsigned short;
constexpr int   D = 128, NW = 8, QBLK = 32, KVBLK = 64;
constexpr float SCALE = 0.088388347648318440f;
constexpr float THR = 8.f;
constexpr int SDEPTH = 2;
constexpr int LDQ = 7680, LDK = 7680;
constexpr int LDY = 1536;
constexpr size_t SHM_V = KVBLK * D * 2, SHM_K = KVBLK * D * 2, SHM_ATTN = 2 * SHM_V + 2 * SHM_K + NW * 64 * 4;
__device__ __forceinline__ float bf2f_(bf16 h) { return __uint_as_float(((unsigned)h) << 16); }
__device__ __forceinline__ bf16 f2bf_(float f) { unsigned u = __float_as_uint(f); return (bf16)((u + 0x7fffu + ((u >> 16) & 1u)) >> 16); }
using bf16x8 = __attribute__((ext_vector_type(8))) short;
using s16x4  = __attribute__((ext_vector_type(4))) short;
using f32x16 = __attribute__((ext_vector_type(16))) float;
using f32x8  = __attribute__((ext_vector_type(8))) float;
using u32x4  = __attribute__((ext_vector_type(4))) unsigned;
using f32x4_ = __attribute__((ext_vector_type(4))) float;
#define KSWZ(row, colB) ((row) * 256 + ((colB) ^ (((row) & 7) << 4)))
#define SBAR() __builtin_amdgcn_sched_barrier(0)
__device__ __forceinline__ int crow(int r, int hi) { return (r & 3) + 8 * (r >> 2) + 4 * hi; }
__device__ __forceinline__ unsigned cvtpk(float lo, float hi) {
  unsigned r; asm volatile("v_cvt_pk_bf16_f32 %0, %1, %2" : "=v"(r) : "v"(lo), "v"(hi)); return r;
}
template <typename TIn> struct Stage;
template <> struct Stage<bf16>  { using T = bf16x8;
  __device__ static __forceinline__ T ld8(const bf16* p) { return *reinterpret_cast<const bf16x8*>(p); }
  __device__ static __forceinline__ bf16x8 tobf(T x) { return x; } };
template <> struct Stage<float> { using T = f32x8;
  __device__ static __forceinline__ T ld8(const float* p) { return *reinterpret_cast<const f32x8*>(p); }
  __device__ static __forceinline__ bf16x8 tobf(T x) {
    u32x4 w = {cvtpk(x[0], x[1]), cvtpk(x[2], x[3]), cvtpk(x[4], x[5]), cvtpk(x[6], x[7])}; return *reinterpret_cast<bf16x8*>(&w); } };

__device__ __forceinline__ void partialSM(f32x16& p0, f32x16& p1, float& m_reg, float& mn, float& alpha) {
  constexpr float C = SCALE * 1.4426950408889634f;
  float pmax = p0[0]; for (int r = 1; r < 16; ++r) pmax = fmaxf(pmax, p0[r]); for (int r = 0; r < 16; ++r) pmax = fmaxf(pmax, p1[r]);
  { auto rr = __builtin_amdgcn_permlane32_swap(__float_as_uint(pmax), __float_as_uint(pmax), false, false);
    pmax = fmaxf(__uint_as_float(rr[0]), __uint_as_float(rr[1])); }
  if (__builtin_expect(__all(pmax - m_reg <= THR / SCALE), 1)) { mn = m_reg; alpha = 1.f; }
  else { mn = fmaxf(m_reg, pmax); alpha = __builtin_amdgcn_exp2f((m_reg - mn) * C); m_reg = mn; }
  float mnC = -mn * C;
  for (int r = 0; r < 16; ++r) p0[r] = fmaf(p0[r], C, mnC); for (int r = 0; r < 16; ++r) p1[r] = fmaf(p1[r], C, mnC);
  for (int r = 0; r < 16; ++r) p0[r] = __builtin_amdgcn_exp2f(p0[r]);
}
__device__ __forceinline__ void finishSM(f32x16& p0, f32x16& p1, float alpha, float& l_reg, bf16x8& pa0, bf16x8& pa1, bf16x8& pa2, bf16x8& pa3) {
  for (int r = 0; r < 16; ++r) p1[r] = __builtin_amdgcn_exp2f(p1[r]);
  float ps = 0; for (int r = 0; r < 16; ++r) ps += p0[r]; for (int r = 0; r < 16; ++r) ps += p1[r];
  { auto rr = __builtin_amdgcn_permlane32_swap(__float_as_uint(ps), __float_as_uint(ps), false, false);
    ps = __uint_as_float(rr[0]) + __uint_as_float(rr[1]); }
  l_reg = l_reg * alpha + ps;
#define PK4(P, BASE, OUT) do { unsigned a0 = cvtpk(P[BASE + 0], P[BASE + 1]), a1 = cvtpk(P[BASE + 2], P[BASE + 3]);   \
    unsigned b0 = cvtpk(P[BASE + 4], P[BASE + 5]), b1 = cvtpk(P[BASE + 6], P[BASE + 7]);                              \
    auto r0 = __builtin_amdgcn_permlane32_swap(a0, b0, false, false); auto r1 = __builtin_amdgcn_permlane32_swap(a1, b1, false, false); \
    u32x4 w = {r0[0], r1[0], r0[1], r1[1]}; OUT = *reinterpret_cast<bf16x8*>(&w); } while (0)
  PK4(p0, 0, pa0); PK4(p0, 8, pa1); PK4(p1, 0, pa2); PK4(p1, 8, pa3);
#undef PK4
}
__device__ __forceinline__ void qkt(f32x16& p0, f32x16& p1, const bf16* Ks, const bf16x8* qr, int r32, int hi) {
  p0 = f32x16{}; p1 = f32x16{};
  for (int d0 = 0; d0 < 8; ++d0) { int cb = (d0 * 16 + hi * 8) * 2;
    bf16x8 b0 = *reinterpret_cast<const bf16x8*>((const char*)Ks + KSWZ(r32, cb));
    bf16x8 b1 = *reinterpret_cast<const bf16x8*>((const char*)Ks + KSWZ(32 + r32, cb));
    p0 = __builtin_amdgcn_mfma_f32_32x32x16_bf16(b0, qr[d0], p0, 0, 0, 0);
    p1 = __builtin_amdgcn_mfma_f32_32x32x16_bf16(b1, qr[d0], p1, 0, 0, 0); }
}
__device__ __forceinline__ int v_st(int k, int c) { const int kk = (k & ~0xC) | ((k & 4) << 1) | ((k & 8) >> 1); return ((kk >> 3) * 4 + (c >> 5)) * 512 + ((kk & 7) * 32 + (c & 31)) * 2; }
__device__ __forceinline__ int v_rd_base(int lane) { return ((lane & 3) << 3) | (((lane >> 2) & 3) << 6) | (((lane >> 4) & 1) << 5) | (((lane >> 5) & 1) << 8); }
constexpr int v_rd_off(int d0, int ks, int half) { return d0 * 512 + ks * 4096 + half * 2048; }
template <int OFF> __device__ __forceinline__ s16x4 tr_read(int vb) {
  s16x4 r; asm volatile("ds_read_b64_tr_b16 %0, %1 offset:%2" : "=&v"(r) : "v"(vb), "i"(OFF) : "memory"); return r;
}
template <int D0> __device__ __forceinline__ void pv_one(f32x16& od, int vb, bf16x8 pa0, bf16x8 pa1, bf16x8 pa2, bf16x8 pa3) {
  const s16x4 l0 = tr_read<v_rd_off(D0, 0, 0)>(vb), h0 = tr_read<v_rd_off(D0, 0, 1)>(vb), l1 = tr_read<v_rd_off(D0, 1, 0)>(vb), h1 = tr_read<v_rd_off(D0, 1, 1)>(vb);
  const s16x4 l2 = tr_read<v_rd_off(D0, 2, 0)>(vb), h2 = tr_read<v_rd_off(D0, 2, 1)>(vb), l3 = tr_read<v_rd_off(D0, 3, 0)>(vb), h3 = tr_read<v_rd_off(D0, 3, 1)>(vb);
  asm volatile("s_waitcnt lgkmcnt(0)" ::: "memory"); SBAR();
#define PK(L, H) (bf16x8){L[0], L[1], L[2], L[3], H[0], H[1], H[2], H[3]}
  od = __builtin_amdgcn_mfma_f32_32x32x16_bf16(pa0, PK(l0, h0), od, 0, 0, 0);
  od = __builtin_amdgcn_mfma_f32_32x32x16_bf16(pa1, PK(l1, h1), od, 0, 0, 0);
  od = __builtin_amdgcn_mfma_f32_32x32x16_bf16(pa2, PK(l2, h2), od, 0, 0, 0);
  od = __builtin_amdgcn_mfma_f32_32x32x16_bf16(pa3, PK(l3, h3), od, 0, 0, 0);
#undef PK
}
__device__ __forceinline__ void pv_d0(f32x16* o, int vb, bf16x8 pa0, bf16x8 pa1, bf16x8 pa2, bf16x8 pa3) {
  pv_one<0>(o[0], vb, pa0, pa1, pa2, pa3); pv_one<1>(o[1], vb, pa0, pa1, pa2, pa3); pv_one<2>(o[2], vb, pa0, pa1, pa2, pa3); pv_one<3>(o[3], vb, pa0, pa1, pa2, pa3);
}

__device__ __forceinline__ void attn_dense_body(const bf16* __restrict__ Qb, const bf16* __restrict__ Kh, const bf16* __restrict__ Vh,
                                                const bf16* __restrict__ Gb, bf16* __restrict__ Yb, int seq, char* lds, const int wave_) {
  using TQ = bf16; using St = Stage<bf16>; using SQ = Stage<TQ>;
  const int wid = wave_, lane = fresh_lane(), tid = wid * 64 + lane, r32 = lane & 31, hi = lane >> 5;
  bf16* V_lds = (bf16*)lds; bf16* K_lds = (bf16*)(lds + 2 * SHM_V);
  float* ws = (float*)(lds + 2 * SHM_V + 2 * SHM_K) + wid * 64; float* li_l = ws; float* al_l = ws + 32;
  float m_reg = -1e30f, l_reg = 0; f32x16 o[4] = {}; bf16x8 qr[8];
  const TQ* Qw = Qb + (long)(wid * QBLK + r32) * LDQ + hi * 8;
#pragma unroll
  for (int d0 = 0; d0 < 8; ++d0) qr[d0] = SQ::tobf(SQ::ld8(Qw + d0 * 16));
  const int sr = tid >> 4, sc = (tid & 15) * 8, vst0 = v_st(sr, sc), vst1 = v_st(32 + sr, sc);
  const unsigned toff = (unsigned)(sr * LDK + sc);
  const int vb0 = (int)(uintptr_t)V_lds + v_rd_base(lane);
  struct { typename St::T vs0, vs1, ks0, ks1; } sr_[SDEPTH];
#define SLOAD(i, k0) do { const bf16* vb_ = Vh + (long)(k0) * LDK; const bf16* kb_ = Kh + (long)(k0) * LDK; \
    sr_[i].vs0 = St::ld8(vb_ + toff); sr_[i].vs1 = St::ld8(vb_ + 32 * LDK + toff); \
    sr_[i].ks0 = St::ld8(kb_ + toff); sr_[i].ks1 = St::ld8(kb_ + 32 * LDK + toff); } while (0)
#define SWRITE(b, i) do { *(bf16x8*)((char*)V_lds + (b) * SHM_V + vst0) = St::tobf(sr_[i].vs0);          \
    *(bf16x8*)((char*)V_lds + (b) * SHM_V + vst1) = St::tobf(sr_[i].vs1); int kc = sc * 2;               \
    *(bf16x8*)((char*)K_lds + (b) * SHM_K + KSWZ(sr, kc)) = St::tobf(sr_[i].ks0);                       \
    *(bf16x8*)((char*)K_lds + (b) * SHM_K + KSWZ(32 + sr, kc)) = St::tobf(sr_[i].ks1); } while (0)
#define SWAIT() do { if constexpr (SDEPTH == 2) asm volatile("s_waitcnt vmcnt(4)" ::: "memory"); else asm volatile("s_waitcnt vmcnt(0)" ::: "memory"); } while (0)
#define RESC(a) do { if (__any((a) < 1.f)) { if (hi == 0) al_l[r32] = (a); asm volatile("s_waitcnt lgkmcnt(0)" ::: "memory"); \
    for (int d = 0; d < 4; ++d) for (int r = 0; r < 16; ++r) o[d][r] *= al_l[crow(r, hi)]; } } while (0)
  f32x16 pA0, pA1, pB0, pB1; float mnA, mnB, alA, alB; bf16x8 pa0, pa1, pa2, pa3; const int NT = seq / KVBLK;
  constexpr int SE = 0, SO = SDEPTH - 1;
  SLOAD(SE, 0); asm volatile("s_waitcnt vmcnt(0)" ::: "memory"); SWRITE(0, SE); __syncthreads();
  qkt(pA0, pA1, K_lds, qr, r32, hi); partialSM(pA0, pA1, m_reg, mnA, alA);
  SLOAD(SO, KVBLK); if constexpr (SDEPTH == 2) { if (2 < NT) SLOAD(SE, 2 * KVBLK); }
  SWAIT(); SWRITE(1, SO); __syncthreads();
  for (int j = 1; j + 1 < NT; j += 2) {
    SBAR(); qkt(pB0, pB1, (bf16*)((char*)K_lds + SHM_K), qr, r32, hi);
    finishSM(pA0, pA1, alA, l_reg, pa0, pa1, pa2, pa3); SBAR();
    SLOAD(SO, (j + SDEPTH) * KVBLK); SBAR();
    pv_d0(o, vb0, pa0, pa1, pa2, pa3); partialSM(pB0, pB1, m_reg, mnB, alB);
    __syncthreads(); SWAIT(); SWRITE(0, SE);
    RESC(alB); __syncthreads();
    SBAR(); qkt(pA0, pA1, K_lds, qr, r32, hi);
    finishSM(pB0, pB1, alB, l_reg, pa0, pa1, pa2, pa3); SBAR();
    if (SDEPTH == 1 || j + 3 < NT) SLOAD(SE, (j + 1 + SDEPTH) * KVBLK); SBAR();
    pv_d0(o, vb0 + (int)SHM_V, pa0, pa1, pa2, pa3); partialSM(pA0, pA1, m_reg, mnA, alA);
    __syncthreads(); SWAIT(); SWRITE(1, SO);
    RESC(alA); __syncthreads();
  }
  SBAR(); qkt(pB0, pB1, (bf16*)((char*)K_lds + SHM_K), qr, r32, hi);
  finishSM(pA0, pA1, alA, l_reg, pa0, pa1, pa2, pa3); SBAR();
  pv_d0(o, vb0, pa0, pa1, pa2, pa3); partialSM(pB0, pB1, m_reg, mnB, alB);
  __syncthreads(); RESC(alB);
  finishSM(pB0, pB1, alB, l_reg, pa0, pa1, pa2, pa3); SBAR();
  pv_d0(o, vb0 + (int)SHM_V, pa0, pa1, pa2, pa3);
  if (hi == 0) li_l[r32] = l_reg; asm volatile("s_waitcnt lgkmcnt(0)" ::: "memory");
  float rli[16];
#pragma unroll
  for (int r = 0; r < 16; ++r) rli[r] = __builtin_amdgcn_rcpf(li_l[crow(r, hi)]);
  __syncthreads();
  { float* stg = (float*)(lds + wid * 16384);
#pragma unroll
    for (int r = 0; r < 16; ++r) { const int orow = crow(r, hi);
#pragma unroll
      for (int d0 = 0; d0 < 4; ++d0) stg[orow * 128 + d0 * 32 + r32] = o[d0][r] * rli[r]; }
    asm volatile("s_waitcnt lgkmcnt(0)" ::: "memory");
    const int ch = lane & 15, rb = lane >> 4;
    const bf16* Gw = Gb + (long)(wid * QBLK + rb) * LDQ + ch * 8; bf16* Yw = Yb + (long)(wid * QBLK + rb) * LDY + ch * 8;
    u32x4 gq[8];
#pragma unroll
    for (int i = 0; i < 8; ++i) gq[i] = *(const u32x4*)(Gw + (long)(4 * i) * LDQ);
#pragma unroll
    for (int i = 0; i < 8; ++i) { const float* sp = stg + (4 * i + rb) * 128 + ch * 8;
      const f32x4_ a = *(const f32x4_*)sp, b = *(const f32x4_*)(sp + 4); u32x4 w;
      w[0] = cvtpk(a[0] * __uint_as_float(gq[i][0] << 16), a[1] * __uint_as_float(gq[i][0] & 0xffff0000u));
      w[1] = cvtpk(a[2] * __uint_as_float(gq[i][1] << 16), a[3] * __uint_as_float(gq[i][1] & 0xffff0000u));
      w[2] = cvtpk(b[0] * __uint_as_float(gq[i][2] << 16), b[1] * __uint_as_float(gq[i][2] & 0xffff0000u));
      w[3] = cvtpk(b[2] * __uint_as_float(gq[i][3] << 16), b[3] * __uint_as_float(gq[i][3] & 0xffff0000u));
      *(u32x4*)(Yw + (long)(4 * i) * LDY) = w; } }
  __syncthreads();
#undef SLOAD
#undef SWRITE
#undef SWAIT
#undef RESC
}

__device__ __forceinline__ void attn_band_unit(const bf16* __restrict__ P, bf16* __restrict__ OG, float* __restrict__ LSE, int g, int b, int h, int blk, int cqb, int ckb, int cvb, int seqlen, int ntok, char* lds, const int wave_) {
  using St = Stage<bf16>;
  const int wid = wave_, lane = fresh_lane(), tid = wid * 64 + lane, r32 = lane & 31, hi = lane >> 5;
  bf16* V_lds = (bf16*)lds; bf16* K_lds = (bf16*)(lds + 2 * SHM_V);
  float* ws = (float*)(lds + 2 * SHM_V + 2 * SHM_K) + wid * 64; float* li_l = ws; float* al_l = ws + 32;
  const int dil = (g == 0) ? 1 : (g == 1 ? 4 : 16), head = g * 4 + h;
  int rq, lq0, ntile, t_lo, res0;
  if (g < 2) { const int kb = (g == 0) ? blk : (blk & 1), nt_all = seqlen / dil / 64; res0 = (g == 0) ? 0 : (blk >> 1);
    rq = res0; lq0 = 256 * kb + 32 * wid; t_lo = (4 * kb - 1 < 0) ? 0 : 4 * kb - 1; const int t_hi = (4 * kb + 5 > nt_all) ? nt_all : 4 * kb + 5; ntile = t_hi - t_lo; }
  else { res0 = 2 * blk; rq = res0 + (wid >> 2); lq0 = 32 * (wid & 3); t_lo = 0; ntile = 4; }
  const long tok0 = (long)b * seqlen;
  const bf16* Pq = P + cqb + head * D; const bf16* Pk = P + ckb + head * D; const bf16* Pv = P + cvb + head * D;
  float m_reg = -1e30f, l_reg = 0; f32x16 o[4] = {}; bf16x8 qr[8];
  { const bf16* Qw = Pq + (tok0 + (long)(lq0 + r32) * dil + rq) * LDQ + hi * 8;
#pragma unroll
    for (int d0 = 0; d0 < 8; ++d0) qr[d0] = St::ld8(Qw + d0 * 16); }
  const int sr = tid >> 4, sc = (tid & 15) * 8, vst0 = v_st(sr, sc), vst1 = v_st(32 + sr, sc);
  const int vb0 = (int)(uintptr_t)V_lds + v_rd_base(lane);
  typename St::T vs0, vs1, ks0, ks1, vt0, vt1, kt0, kt1;
#define TILE_RK(tt) ((g < 2) ? res0 : res0 + ((tt) >> 1))
#define TILE_LK0(tt) ((g < 2) ? 64 * (t_lo + (tt)) : 64 * ((tt) & 1))
#define BLOAD(tt, V0, V1, K0, K1) do { const int rk_ = TILE_RK(tt), lk_ = TILE_LK0(tt); const long ta = (tok0 + (long)(lk_ + sr) * dil + rk_) * LDK + sc, tb = (tok0 + (long)(lk_ + 32 + sr) * dil + rk_) * LDK + sc; \
    V0 = St::ld8(Pv + ta); V1 = St::ld8(Pv + tb); K0 = St::ld8(Pk + ta); K1 = St::ld8(Pk + tb); } while (0)
#define BWRITE(V0, V1, K0, K1) do { *(bf16x8*)((char*)V_lds + vst0) = V0; *(bf16x8*)((char*)V_lds + vst1) = V1; const int kc = sc * 2; \
    *(bf16x8*)((char*)K_lds + KSWZ(sr, kc)) = K0; *(bf16x8*)((char*)K_lds + KSWZ(32 + sr, kc)) = K1; } while (0)
#define BCOMPUTE(tt) do { const int rk = TILE_RK(tt), lk0 = TILE_LK0(tt); \
    const bool need = (rk == rq) && (lk0 + 63 >= lq0 - 64) && (lk0 <= lq0 + 95); \
    if (need) { \
      f32x16 p0, p1; float mn, alpha; bf16x8 pa0, pa1, pa2, pa3; \
      qkt(p0, p1, K_lds, qr, r32, hi); \
      const int dd = lk0 - lq0 - r32 + 4 * hi;                      \
      _Pragma("unroll") for (int r = 0; r < 16; ++r) { const int d0_ = dd + (r & 3) + 8 * (r >> 2), d1_ = d0_ + 32; \
        if (d0_ < -64 || d0_ > 64) p0[r] = -INFINITY; if (d1_ < -64 || d1_ > 64) p1[r] = -INFINITY; } \
      partialSM(p0, p1, m_reg, mn, alpha); \
      if (__any(alpha < 1.f)) { if (hi == 0) al_l[r32] = alpha; asm volatile("s_waitcnt lgkmcnt(0)" ::: "memory"); \
        _Pragma("unroll") for (int d = 0; d < 4; ++d) _Pragma("unroll") for (int r = 0; r < 16; ++r) o[d][r] *= al_l[crow(r, hi)]; } \
      finishSM(p0, p1, alpha, l_reg, pa0, pa1, pa2, pa3); SBAR(); \
      pv_d0(o, vb0, pa0, pa1, pa2, pa3); \
    } } while (0)
  BLOAD(0, vs0, vs1, ks0, ks1); if (ntile > 1) BLOAD(1, vt0, vt1, kt0, kt1);
  for (int tt = 0; tt < ntile; tt += 2) {
    __syncthreads();
    BWRITE(vs0, vs1, ks0, ks1);
    __syncthreads();
    if (tt + 2 < ntile) BLOAD(tt + 2, vs0, vs1, ks0, ks1);
    BCOMPUTE(tt);
    if (tt + 1 < ntile) {
      __syncthreads();
      BWRITE(vt0, vt1, kt0, kt1);
      __syncthreads();
      if (tt + 3 < ntile) BLOAD(tt + 3, vt0, vt1, kt0, kt1);
      BCOMPUTE(tt + 1);
    }
  }
#undef BWRITE
#undef BCOMPUTE
#undef BLOAD
#undef TILE_RK
#undef TILE_LK0
  if (hi == 0) li_l[r32] = l_reg; asm volatile("s_waitcnt lgkmcnt(0)" ::: "memory");
  float rli[16];
#pragma unroll
  for (int r = 0; r < 16; ++r) rli[r] = __builtin_amdgcn_rcpf(li_l[crow(r, hi)]);
  __syncthreads();
  { float* stg = (float*)(lds + wid * 16384);
#pragma unroll
    for (int r = 0; r < 16; ++r) { const int orow = crow(r, hi);
#pragma unroll
      for (int d0 = 0; d0 < 4; ++d0) stg[orow * 128 + d0 * 32 + r32] = o[d0][r] * rli[r]; }
    asm volatile("s_waitcnt lgkmcnt(0)" ::: "memory");
    const int ch = lane & 15, rb = lane >> 4;
    bf16* Og = OG + (long)g * ntok * 512 + h * D + ch * 8;
#pragma unroll
    for (int i = 0; i < 8; ++i) { const int row = 4 * i + rb; const float* sp = stg + row * 128 + ch * 8;
      const f32x4_ a = *(const f32x4_*)sp, b = *(const f32x4_*)(sp + 4); u32x4 w;
      w[0] = cvtpk(a[0], a[1]); w[1] = cvtpk(a[2], a[3]); w[2] = cvtpk(b[0], b[1]); w[3] = cvtpk(b[2], b[3]);
      *(u32x4*)(Og + (tok0 + (long)(lq0 + row) * dil + rq) * 512) = w; } }
  if (hi == 0) LSE[((long)g * ntok + tok0 + (long)(lq0 + r32) * dil + rq) * 4 + h] = m_reg * SCALE + __logf(l_reg);
  __syncthreads();
}
}

typedef unsigned short bf16_t;
constexpr int BATCH = 4, SEQ = 2048, DM = 2048, NTOK = BATCH * SEQ, NC = 11776;
constexpr int C_QA = 0, C_KA = 1024, C_VA = 1280, C_GA = 1536, C_QB = 2560, C_KB = 4096, C_VB = 5632, C_GB = 7168, C_ZA = 7680, C_ZB = 9728;
constexpr float EPS = 1e-6f;
constexpr float H8_SCALE = 4.0f, W8_SCALE = 64.0f;
constexpr size_t MiB = 1u << 20;
constexpr int PITCH = 7680;
constexpr size_t WS_CTL = 0, WS_TAB = 1 * MiB, WS_XB = 1 * MiB + 512 * 1024, WS_WTIN = 2 * MiB, WS_WTAB = 48 * MiB, WS_WTO = 54 * MiB, WS_HB = 64 * MiB, WS_P = 96 * MiB, WS_Y = 216 * MiB, WS_OG = 240 * MiB, WS_LSE = 264 * MiB,
                 WS_SA = 266 * MiB, WS_SB = 298 * MiB, WS_H8 = 330 * MiB, WS_WTZ8 = 346 * MiB, WS_END = 354 * MiB;

#define LAS __attribute__((address_space(3)))
typedef float f32x4 __attribute__((ext_vector_type(4)));
typedef unsigned v4u __attribute__((ext_vector_type(4)));
constexpr int NWAVES = 8;
constexpr int LDS_BYTES = 147456;

__device__ __forceinline__ float bf2f(bf16_t h) { return __uint_as_float(((unsigned)h) << 16); }
__device__ __forceinline__ unsigned f2bf_u(float f) { unsigned u = __float_as_uint(f); return (u + 0x7fffu + ((u >> 16) & 1u)) >> 16; }
__device__ __forceinline__ bf16_t f2bf(float f) { return (bf16_t)f2bf_u(f); }
__device__ __forceinline__ unsigned pk2(float lo, float hi) { return f2bf_u(lo) | (f2bf_u(hi) << 16); }
__device__ __forceinline__ float wave_sum(float v) {
#pragma unroll
    for (int o = 1; o < 64; o <<= 1) v += __shfl_xor(v, o);
    return v;
}
__device__ __forceinline__ float silu(float v) { return v / (1.f + __expf(-v)); }

__device__ __forceinline__ int colmap(int kind, int p) {
    const int bj = p >> 7, wc = (p >> 5) & 3, n = (p >> 4) & 1, fq = (p >> 2) & 3, j = p & 3;
    const int gen = 128 * bj + 32 * wc + 8 * fq + 4 * n + j;
    if (kind == 0) return p;
    if (kind == 1) return gen;
    if (kind == 2) return 128 * bj + 64 * (wc >> 1) + 32 * n + 16 * (wc & 1) + 4 * fq + j;
    return wc == 0 ? p : gen;
}
__device__ __forceinline__ int kind_in(int pn) { return pn < 5 ? 2 : ((pn >= 10 && pn < 22) ? 3 : 1); }

struct TrSrc { const float* W; int N; bf16_t* WT; int ldt, koff, kindsel; unsigned char* wt8; int n8; };
__device__ __forceinline__ void tr_load(const TrSrc& t, int item, int lane, f32x4 (&v)[8]) {
    const int nblk = t.N / 32, kb = item / nblk, nb = item % nblk, k0 = 64 * kb, n0 = 32 * nb;
    const int np = n0 + 4 * (lane & 7), pn = np >> 8;
    const int kind = t.kindsel < 0 ? kind_in(pn) : t.kindsel;
    const float* src = t.W + (size_t)(k0 + (lane >> 3)) * t.N + (pn << 8) + colmap(kind, np & 255);
#pragma unroll
    for (int i = 0; i < 8; ++i) v[i] = __builtin_nontemporal_load((const f32x4*)(src + (size_t)(8 * i) * t.N));
}
__device__ __forceinline__ void tr_store(const TrSrc& t, int item, int lane, const f32x4 (&v)[8], LAS float* scr) {
    const int nblk = t.N / 32, kb = item / nblk, nb = item % nblk, k0 = 64 * kb, n0 = 32 * nb;
    { LAS float* d = scr + (lane >> 3) * 33 + 4 * (lane & 7);
#pragma unroll
      for (int i = 0; i < 8; ++i) { d[i * 264 + 0] = v[i][0]; d[i * 264 + 1] = v[i][1]; d[i * 264 + 2] = v[i][2]; d[i * 264 + 3] = v[i][3]; } }
    asm volatile("s_waitcnt lgkmcnt(0)" ::: "memory");
    const int c = lane & 7;
    if (t.wt8 != nullptr && n0 >= t.n8) {
#pragma unroll
        for (int j = 0; j < 4; ++j) { const int n = (lane >> 3) + 8 * j; const LAS float* sp = scr + (8 * c) * 33 + n;
            int lo = 0, hi = 0;
            lo = __builtin_amdgcn_cvt_pk_fp8_f32(sp[0 * 33] * W8_SCALE, sp[1 * 33] * W8_SCALE, lo, false); lo = __builtin_amdgcn_cvt_pk_fp8_f32(sp[2 * 33] * W8_SCALE, sp[3 * 33] * W8_SCALE, lo, true);
            hi = __builtin_amdgcn_cvt_pk_fp8_f32(sp[4 * 33] * W8_SCALE, sp[5 * 33] * W8_SCALE, hi, false); hi = __builtin_amdgcn_cvt_pk_fp8_f32(sp[6 * 33] * W8_SCALE, sp[7 * 33] * W8_SCALE, hi, true);
            *(unsigned long long*)(t.wt8 + (size_t)(n0 - t.n8 + n) * t.ldt + k0 + 8 * c) = (unsigned long long)(unsigned)lo | ((unsigned long long)(unsigned)hi << 32); }
    } else {
#pragma unroll
    for (int j = 0; j < 4; ++j) { const int n = (lane >> 3) + 8 * j; const LAS float* sp = scr + (8 * c) * 33 + n;
        v4u o; o.x = pk2(sp[0 * 33], sp[1 * 33]); o.y = pk2(sp[2 * 33], sp[3 * 33]); o.z = pk2(sp[4 * 33], sp[5 * 33]); o.w = pk2(sp[6 * 33], sp[7 * 33]);
        *(v4u*)(t.WT + (size_t)(n0 + n) * t.ldt + t.koff + k0 + 8 * c) = o; }
    }
    asm volatile("s_waitcnt lgkmcnt(0)" ::: "memory");
}
__device__ __forceinline__ void tr_matrix(const TrSrc& t, int nitems, int gw, int NGW, int lane, LAS float* scr) {
    f32x4 a[8], b[8];
    int it = gw;
    if (it < nitems) tr_load(t, it, lane, a);
    for (; it < nitems; it += 2 * NGW) {
        const bool hb = it + NGW < nitems;
        if (hb) tr_load(t, it + NGW, lane, b);
        tr_store(t, it, lane, a, scr);
        if (hb) { if (it + 2 * NGW < nitems) tr_load(t, it + 2 * NGW, lane, a); tr_store(t, it + NGW, lane, b, scr); }
    }
}
__device__ __forceinline__ void rms_row_load(const float* xrow, int lane, f32x4 (&v)[8]) {
    const f32x4* xr = (const f32x4*)xrow + lane;
#pragma unroll
    for (int j = 0; j < 8; ++j) v[j] = __builtin_nontemporal_load(xr + 64 * j);
}
__device__ __forceinline__ void rms_row_store(const f32x4 (&v)[8], const float* gain, bf16_t* orow, unsigned char* orow8, int lane) {
    const f32x4* gr = (const f32x4*)gain + lane; float s = 0.f;
#pragma unroll
    for (int j = 0; j < 8; ++j) s += (v[j].x * v[j].x + v[j].y * v[j].y) + (v[j].z * v[j].z + v[j].w * v[j].w);
    const float rs = rsqrtf(wave_sum(s) * (1.f / DM) + EPS);
    unsigned long long* o8 = (unsigned long long*)orow + lane;
    unsigned* q8 = (unsigned*)orow8 + lane;
#pragma unroll
    for (int j = 0; j < 8; ++j) { const f32x4 g = gr[64 * j]; const f32x4 y = v[j] * rs * g;
        o8[64 * j] = (unsigned long long)pk2(y.x, y.y) | ((unsigned long long)pk2(y.z, y.w) << 32);
        int w = 0; w = __builtin_amdgcn_cvt_pk_fp8_f32(y.x * H8_SCALE, y.y * H8_SCALE, w, false); w = __builtin_amdgcn_cvt_pk_fp8_f32(y.z * H8_SCALE, y.w * H8_SCALE, w, true);
        q8[64 * j] = (unsigned)w; }
}
__device__ __forceinline__ void rms_rows(const float* x, const float* gain, bf16_t* H, unsigned char* H8, int m0, int step, int nrows, int lane) {
    f32x4 a[8], b[8];
    int m = m0;
    if (m < nrows) rms_row_load(x + (size_t)m * DM, lane, a);
    for (; m < nrows; m += 2 * step) {
        const bool hb = m + step < nrows;
        if (hb) rms_row_load(x + (size_t)(m + step) * DM, lane, b);
        rms_row_store(a, gain, H + (size_t)m * DM, H8 + (size_t)m * DM, lane);
        if (hb) { if (m + 2 * step < nrows) rms_row_load(x + (size_t)(m + 2 * step) * DM, lane, a); rms_row_store(b, gain, H + (size_t)(m + step) * DM, H8 + (size_t)(m + step) * DM, lane); }
    }
}

#define XB_TMO      128
#define XB_XCNT(j)  (256  + 64 * (j))
#define XB_XSUB(j)  (1280 + 64 * (j))
#define XB_XGEN(j)  (2304 + 64 * (j))
#define XB_TOP      3328
#define XB_TOPGEN   3392
#define XCD_BAR_WORDS 3456
#define XB_SPIN_CAP (1u << 18)

__device__ __forceinline__ unsigned xb_ld(unsigned* p)              { return __hip_atomic_load(p, __ATOMIC_RELAXED, __HIP_MEMORY_SCOPE_AGENT); }
__device__ __forceinline__ unsigned xb_add(unsigned* p, unsigned v) { return __hip_atomic_fetch_add(p, v, __ATOMIC_RELAXED, __HIP_MEMORY_SCOPE_AGENT); }
__device__ __forceinline__ unsigned xb_xcc_id() { return (unsigned)__builtin_amdgcn_s_getreg((3 << 11) | 20) & 0xFu; }
#define XB_SPIN(cond, bar) do { unsigned _sp = 0; while (cond) { __builtin_amdgcn_s_sleep(1); \
    if ((++_sp & 255u) == 0u) { if (xb_ld(&(bar)[XB_TMO])) break; if (_sp > XB_SPIN_CAP) { atomicAdd(&(bar)[XB_TMO], 1u); break; } } } } while (0)

struct XcdBarrier {
    unsigned* bar; unsigned x;
    volatile LAS unsigned* st;
};

__device__ __forceinline__ XcdBarrier xcd_barrier_post(unsigned* bar, volatile LAS unsigned* st) {
    XcdBarrier b; b.bar = bar; b.x = xb_xcc_id(); b.st = st;
    if (threadIdx.x == 0) (void)xb_add(&bar[XB_XCNT(b.x)], 1u);
    return b;
}
__device__ __forceinline__ void xcd_barrier_complete(unsigned* bar, unsigned x, unsigned& nloc, unsigned& nx) {
    const unsigned G = gridDim.x * gridDim.y * gridDim.z;
    unsigned sum, cnt, mine, sp = 0u;
    for (;;) {
        sum = 0u; cnt = 0u; mine = 0u;
#pragma unroll
        for (unsigned j = 0; j < 16; ++j) { const unsigned c = xb_ld(&bar[XB_XCNT(j)]); sum += c; cnt += (c > 0u) ? 1u : 0u; mine = (j == x) ? c : mine; }
        if (sum == G) break;
        __builtin_amdgcn_s_sleep(1);
        if ((++sp & 255u) == 0u) { if (xb_ld(&bar[XB_TMO])) break; if (sp > XB_SPIN_CAP) { atomicAdd(&bar[XB_TMO], 1u); break; } }
    }
    nloc = mine > 0u ? mine : 1u; nx = cnt > 0u ? cnt : 1u;
}

__device__ __forceinline__ void xcd_barrier(const XcdBarrier& b, const int wave_) {
    asm volatile("s_waitcnt vmcnt(0)" ::: "memory");
    __syncthreads();
    if (wave_ == 0 && fresh_lane() == 0) {
        unsigned* bar = b.bar;
        __builtin_amdgcn_s_waitcnt(0);
        unsigned nloc = b.st[0], nx = b.st[1];
        if (nloc == 0u) { xcd_barrier_complete(bar, b.x, nloc, nx); b.st[0] = nloc; b.st[1] = nx; }
        const unsigned old = xb_add(&bar[XB_XSUB(b.x)], 1u);
        const unsigned gen = old / nloc;
        if (old + 1u == (gen + 1u) * nloc) {
            __builtin_amdgcn_fence(__ATOMIC_RELEASE, "agent");
            asm volatile("s_waitcnt vmcnt(0)" ::: "memory");
            const unsigned og = xb_add(&bar[XB_TOP], 1u);
            const unsigned tg = og / nx;
            if (og + 1u == (tg + 1u) * nx) xb_add(&bar[XB_TOPGEN], 1u);
            else XB_SPIN(xb_ld(&bar[XB_TOPGEN]) == tg, bar);
            __builtin_amdgcn_fence(__ATOMIC_ACQUIRE, "agent");
            xb_add(&bar[XB_XGEN(b.x)], 1u);
            asm volatile("s_waitcnt vmcnt(0)" ::: "memory");
        } else {
            XB_SPIN(xb_ld(&bar[XB_XGEN(b.x)]) == gen, bar);
            __builtin_amdgcn_fence(__ATOMIC_ACQUIRE, "agent");
            asm volatile("s_waitcnt vmcnt(0)" ::: "memory");
        }
    }
    __syncthreads();
}

struct Args { const float* in[10]; float* out; unsigned char* ws; int ph_lo, ph_hi; };

__global__ void __launch_bounds__(NWAVES * 64, 2) mk_fwd(Args args) {
    extern __shared__ __attribute__((aligned(16))) unsigned char lds[];
    const int wave = __builtin_amdgcn_readfirstlane((int)threadIdx.x >> 6);
#define TID_LANE const int lane = fresh_lane(); const int tid = wave * 64 + lane; (void)tid; (void)lane;
    const int G = gridDim.x, bx = blockIdx.x;
    const int vcu = (G % 8 == 0) ? (bx % 8) * (G / 8) + bx / 8 : bx;
    unsigned char* ws = args.ws;
    const float* x = args.in[0]; const float* ng = args.in[1]; const float* w_in = args.in[2];
    bf16_t* WT_IN = (bf16_t*)(ws + WS_WTIN); bf16_t* HB = (bf16_t*)(ws + WS_HB); bf16_t* P = (bf16_t*)(ws + WS_P);
    float* COSA = (float*)(ws + WS_TAB); float* SINA = COSA + 2048; float* COSP = COSA + 4096; float* SINP = COSP + 32768;
    bf16_t* OG = (bf16_t*)(ws + WS_OG); float* LSE = (float*)(ws + WS_LSE); unsigned* CTL = (unsigned*)(ws + WS_CTL) + 4096;
    bf16_t* WT_AB = (bf16_t*)(ws + WS_WTAB); bf16_t* WT_O = (bf16_t*)(ws + WS_WTO); bf16_t* Y = (bf16_t*)(ws + WS_Y); bf16_t* MG = HB; unsigned char* H8 = ws + WS_H8; unsigned char* WTZ8 = ws + WS_WTZ8; bf16_t* SA = (bf16_t*)(ws + WS_SA); bf16_t* SB = (bf16_t*)(ws + WS_SB); float* XB = (float*)(ws + WS_XB); unsigned* PCNT = (unsigned*)(ws + WS_CTL) + 8192;
    const int lo = args.ph_lo, hi = args.ph_hi;
    volatile LAS unsigned* MISC = (volatile LAS unsigned*)((LAS unsigned char*)lds + 131072 + 320);
    if (threadIdx.x < 32) MISC[threadIdx.x] = 0u;
    __syncthreads();
    XcdBarrier bar = xcd_barrier_post((unsigned*)(ws + WS_CTL), MISC + 8);
#define GRID_BAR() xcd_barrier(bar, wave)
#define IN(k) (lo <= (k) && (k) < hi)
#define BOTH(k) (IN(k) && IN((k) + 1))
    if (IN(0)) { TID_LANE
        LAS float* scr = (LAS float*)((LAS unsigned char*)lds + wave * 16384);
        const int gw = vcu * NWAVES + wave, NGW = G * NWAVES;
        constexpr int I_IN = (DM / 64) * (NC / 32);
        { const TrSrc t{w_in, NC, WT_IN, DM, 0, -1, WTZ8, 7680}; tr_matrix(t, I_IN, gw, NGW, lane, scr); }
        for (int i = bx * (NWAVES * 64) + tid; i < 2048 + 32768; i += G * NWAVES * 64) {
            if (i < 2048) { const int pos = i >> 5, fi = i & 31; const float a = (float)pos * (1.0f / powf(10000.0f, (float)fi / 32.0f)); COSA[i] = cosf(a); SINA[i] = sinf(a); }
            else { const int k = i - 2048, pos = k >> 4, fi = k & 15; const float a = (float)pos * (1.0f / powf(500000.0f, (float)fi / 16.0f)); COSP[k] = cosf(a); SINP[k] = sinf(a); }
        }
        rms_rows(x, ng, HB, H8, gw, NGW, NTOK, lane);
        if (BOTH(0)) GRID_BAR();
    }
    if (IN(1)) { TID_LANE
        pg8::Gemm g{HB, WT_IN, NTOK, PITCH, DM}; pg8::StaticOrder S; S.init(NTOK, PITCH, G, bx);
        pg8::EpiIn E{P, PITCH, COSA, SINA, COSP, SINP, args.in[3], args.in[4], args.in[5], SA, SB, (LAS float*)((LAS unsigned char*)lds + 131072 + 1024), EPS};
        pg8::gemm_phase<pg8::EpiIn, pg8::StaticOrder, true, true>((LAS unsigned char*)lds, g, S, E, wave);
        {
            pg8::Gemm g8{(const bf16_t*)H8, (const bf16_t*)WTZ8, NTOK, 4096, DM / 2}; pg8::StaticOrder S8; S8.init(NTOK, 4096, G, bx);
            pg8::EpiGate E8{args.in[5], SA, SB, 1.0f / (H8_SCALE * W8_SCALE)};
            pg8::gemm_phase<pg8::EpiGate, pg8::StaticOrder, true, true>((LAS unsigned char*)lds, g8, S8, E8, wave);
        }
        {
            const int nwg = (NTOK / 256) * (PITCH / 256), nfull = nwg % G;
            const int first = nfull == 0 ? 0 : nfull, nidle = G - first;
            if (bx >= first) {
                LAS float* scr = (LAS float*)((LAS unsigned char*)lds + wave * 16384);
                const int gw2 = (bx - first) * NWAVES + wave, NGW2 = nidle * NWAVES;
                constexpr int I_A = (1024 / 64) * (DM / 32), I_B = (512 / 64) * (DM / 32), I_O = (DM / 64) * (DM / 32);
                { const TrSrc t{args.in[6], DM, WT_AB, 1536, 0, 1, nullptr, 0}; tr_matrix(t, I_A, gw2, NGW2, lane, scr); }
                { const TrSrc t{args.in[7], DM, WT_AB, 1536, 1024, 1, nullptr, 0}; tr_matrix(t, I_B, gw2, NGW2, lane, scr); }
                { const TrSrc t{args.in[8], DM, WT_O, DM, 0, 0, nullptr, 0}; tr_matrix(t, I_O, gw2, NGW2, lane, scr); }
            }
        }
        if (BOTH(1)) GRID_BAR();
    }
    if (IN(2)) { TID_LANE
        for (int u = bx; u < 384; u += G) {
            const int blk = u & 7, h = (u >> 3) & 3, b = (u >> 5) & 3, g = u >> 7;
            att::attn_band_unit(P, OG, LSE, g, b, h, blk, C_QB, C_KB, C_VB, SEQ, NTOK, (char*)lds, wave);
        }
        asm volatile("s_waitcnt vmcnt(0)" ::: "memory"); __syncthreads();
        if (tid == 0) { __builtin_amdgcn_fence(__ATOMIC_RELEASE, "agent"); asm volatile("s_waitcnt vmcnt(0)" ::: "memory"); __hip_atomic_fetch_add(CTL, 1u, __ATOMIC_RELAXED, __HIP_MEMORY_SCOPE_AGENT); }
        for (int u = bx; u < 256; u += G) {
            const int pair = u & 7, inner = u >> 3, b = pair >> 1, hkv = pair & 1, hq = hkv * 4 + (inner >> 3), qb = inner & 7;
            const size_t row0 = (size_t)b * SEQ + qb * 256;
            att::attn_dense_body(P + row0 * PITCH + C_QA + hq * 128, P + (size_t)b * SEQ * PITCH + C_KA + hkv * 128, P + (size_t)b * SEQ * PITCH + C_VA + hkv * 128,
                                 P + row0 * PITCH + C_GA + hq * 128, Y + row0 * 1536 + hq * 128, SEQ, (char*)lds, wave);
        }
        const int mfirst = (384 - G > 0 && 384 - G < G) ? 384 - G : 0, nmerge = G - mfirst;
        if (bx >= mfirst) {
            if (tid == 0) { unsigned spins = 0; while (__hip_atomic_load(CTL, __ATOMIC_RELAXED, __HIP_MEMORY_SCOPE_AGENT) < (unsigned)G) { __builtin_amdgcn_s_sleep(4); if (++spins > (1u << 24)) break; }
                __builtin_amdgcn_fence(__ATOMIC_ACQUIRE, "agent"); asm volatile("s_waitcnt vmcnt(0)" ::: "memory"); }
            __syncthreads();
            for (int c0 = (bx - mfirst) * (NWAVES * 64) + tid; c0 < NTOK * 64; c0 += 2 * nmerge * NWAVES * 64) {
                v4u a0[2], a1[2], a2[2], gz[2]; float e0[2], e1[2], e2[2]; int tok[2], c8[2]; bool ok[2];
#pragma unroll
                for (int q = 0; q < 2; ++q) { const int ci = c0 + q * nmerge * NWAVES * 64; ok[q] = ci < NTOK * 64; const int cj = ok[q] ? ci : c0; tok[q] = cj >> 6; c8[q] = (cj & 63) * 8; const int h = c8[q] >> 7;
                    e0[q] = LSE[((size_t)0 * NTOK + tok[q]) * 4 + h]; e1[q] = LSE[((size_t)1 * NTOK + tok[q]) * 4 + h]; e2[q] = LSE[((size_t)2 * NTOK + tok[q]) * 4 + h];
                    a0[q] = *(const v4u*)(OG + ((size_t)0 * NTOK + tok[q]) * 512 + c8[q]); a1[q] = *(const v4u*)(OG + ((size_t)1 * NTOK + tok[q]) * 512 + c8[q]); a2[q] = *(const v4u*)(OG + ((size_t)2 * NTOK + tok[q]) * 512 + c8[q]);
                    gz[q] = *(const v4u*)(P + (size_t)tok[q] * PITCH + C_GB + c8[q]); }
#pragma unroll
                for (int q = 0; q < 2; ++q) { const float mx = fmaxf(e0[q], fmaxf(e1[q], e2[q])); float w0 = __expf(e0[q] - mx), w1 = __expf(e1[q] - mx), w2 = __expf(e2[q] - mx); const float inv = 1.f / (w0 + w1 + w2); w0 *= inv; w1 *= inv; w2 *= inv;
                    v4u w;
#pragma unroll
                    for (int e = 0; e < 4; ++e) {
                        const float lo = w0 * __uint_as_float(a0[q][e] << 16) + w1 * __uint_as_float(a1[q][e] << 16) + w2 * __uint_as_float(a2[q][e] << 16);
                        const float hh = w0 * __uint_as_float(a0[q][e] & 0xffff0000u) + w1 * __uint_as_float(a1[q][e] & 0xffff0000u) + w2 * __uint_as_float(a2[q][e] & 0xffff0000u);
                        w[e] = pk2(lo * __uint_as_float(gz[q][e] << 16), hh * __uint_as_float(gz[q][e] & 0xffff0000u)); }
                    if (ok[q]) *(v4u*)(Y + (size_t)tok[q] * 1536 + 1024 + c8[q]) = w; }
            }
        }
        if (BOTH(2)) GRID_BAR();
    }
    if (IN(3)) {
        pg8::Gemm g{Y, WT_AB, NTOK, DM, 1536}; pg8::StaticOrder S; S.init(NTOK, DM, G, bx);
        pg8::EpiMerge2 E{SA, SB, MG, DM};
        pg8::gemm_phase<pg8::EpiMerge2, pg8::StaticOrder, true, true>((LAS unsigned char*)lds, g, S, E, wave);
        if (BOTH(3)) GRID_BAR();
    }
    if (IN(4)) {
        pg8::Gemm g{MG, WT_O, NTOK, DM, DM}; pg8::StaticOrder S; S.init(NTOK, DM, G, bx);
        pg8::EpiResidNorm E{x, args.out, DM, args.in[9], XB, PCNT, 8, EPS};
        if (G == 256) pg8::gemm_phase<pg8::EpiResidNorm, pg8::StaticOrder, false, true>((LAS unsigned char*)lds, g, S, E, wave);
    }
#undef IN
#undef BOTH
}


extern "C" void kernel_launch(void* const* d_in, const int* in_sizes, int n_in, void* d_out, int out_size, void* d_ws, size_t ws_size, hipStream_t stream) {
    static int grid = 0;
    if (grid == 0) {
        if (n_in != 10 || in_sizes[0] != NTOK * DM || out_size != NTOK * DM || ws_size < WS_END) { fprintf(stderr, "kernel_launch: unexpected shapes / workspace (%zu)\n", ws_size); grid = -1; return; }
        int dev = 0, cus = 0, per_cu = 0;
        if (hipGetDevice(&dev) != hipSuccess || hipDeviceGetAttribute(&cus, hipDeviceAttributeMultiprocessorCount, dev) != hipSuccess) { grid = -1; return; }
        if (hipFuncSetAttribute((const void*)mk_fwd, hipFuncAttributeMaxDynamicSharedMemorySize, LDS_BYTES) != hipSuccess) { fprintf(stderr, "kernel_launch: hipFuncSetAttribute failed\n"); grid = -1; return; }
        if (hipOccupancyMaxActiveBlocksPerMultiprocessor(&per_cu, (const void*)mk_fwd, NWAVES * 64, LDS_BYTES) != hipSuccess || per_cu < 1) { fprintf(stderr, "kernel_launch: occupancy query says %d\n", per_cu); grid = -1; return; }
        grid = cus;
    }
    if (grid < 0) return;
    if (hipMemsetAsync((char*)d_ws + WS_CTL, 0, 131072, stream) != hipSuccess) { fprintf(stderr, "kernel_launch: memset failed\n"); return; }
    Args a{};
    for (int i = 0; i < 10; ++i) a.in[i] = (const float*)d_in[i];
    a.out = (float*)d_out; a.ws = (unsigned char*)d_ws; a.ph_lo = 0; a.ph_hi = 5;
    void* kargs[] = {&a};
    hipError_t e = hipLaunchCooperativeKernel((const void*)mk_fwd, dim3(grid), dim3(NWAVES * 64), kargs, LDS_BYTES, stream);
    if (e != hipSuccess) fprintf(stderr, "kernel_launch: cooperative launch failed: %s (grid %d)\n", hipGetErrorString(e), grid);
}
```

```cpp
#include <hip/hip_runtime.h>
#include <hip/hip_cooperative_groups.h>
#include <cstdio>
#include <cstdint>
#include <cmath>
namespace cg = cooperative_groups;
__device__ __forceinline__ int fresh_lane() { int l; asm volatile("v_mbcnt_lo_u32_b32 %0, -1, 0\n\tv_mbcnt_hi_u32_b32 %0, -1, %0" : "=v"(l)); return l; }
namespace pg8 {
#define PG8_LAS __attribute__((address_space(3)))
typedef unsigned short bf16_t;
typedef short bf16x8 __attribute__((ext_vector_type(8)));
typedef float f32x4 __attribute__((ext_vector_type(4)));
typedef unsigned u32x4 __attribute__((ext_vector_type(4)));
typedef int v4i_t __attribute__((ext_vector_type(4)));
constexpr int BM = 256, BK = 64, HALF = 128, HTB = HALF * BK * 2  , STAGE_BYTES = 8 * HTB, NXCD = 8, WGM = 8;

__host__ __device__ __forceinline__ int lds_byte(int r, int c) { const int st = (r >> 4) * 2 + (c >> 5), rr = r & 15, cc = c & 31, ob = rr * 64 + cc * 2; return st * 1024 + (ob ^ (((ob >> 9) & 1) << 5)); }
__host__ __device__ __forceinline__ void stage_rc(int b, int& R, int& C) { const int st = b / 1024, sb = b % 1024, swz = sb ^ (((sb >> 9) & 1) << 5); R = (st >> 1) * 16 + swz / 64; C = (st & 1) * 32 + (swz % 64) / 2; }
__host__ __device__ __forceinline__ int perm32(int rho) { const int n = rho >> 4, i = rho & 15; return 8 * (i >> 2) + 4 * n + (i & 3); }

struct Unit { int pm, pn; };
struct Gemm { const bf16_t* A; const bf16_t* Bt; int M, N, K; };

struct StaticOrder {
    int nM, nN, nwg, G, c;
    __host__ __device__ void init(int M, int N, int G_, int c_) { nM = M / BM; nN = N / BM; nwg = nM * nN; G = G_; c = c_; }
    __host__ __device__ bool next(int i, Unit& u) const { const long L = (long)i * G + c; if (L >= nwg) return false; unit_of((int)L, u); return true; }
    __host__ __device__ bool unit_of(int L, Unit& u) const {
        int wgid = L; { const int q = nwg / NXCD, r = nwg % NXCD, xcd = wgid % NXCD, off = wgid / NXCD; wgid = (xcd < r ? xcd * (q + 1) : r * (q + 1) + (xcd - r) * q) + off; }
        const int nig = WGM * nN, gid = wgid / nig, fm = gid * WGM, gsz = (nM - fm) < WGM ? (nM - fm) : WGM;
        u.pm = fm + ((wgid % nig) % gsz); u.pn = (wgid % nig) / gsz; return true;
    }
    __device__ __forceinline__ void a_ready(const Unit&) const {}
    __device__ __forceinline__ void done(const Unit&) const {}
};


__device__ __forceinline__ unsigned cvt_pk_bf16(float lo, float hi) { unsigned r; asm volatile("v_cvt_pk_bf16_f32 %0, %1, %2" : "=v"(r) : "v"(lo), "v"(hi)); return r; }
typedef float f32x2 __attribute__((ext_vector_type(2)));

struct EpiRaw {
    static constexpr bool PERM = false, AFTER_DRAIN = false, FP8 = false; static constexpr int HOOK_T = -1;
    bf16_t* O; int ldc;
    __device__ __forceinline__ void operator()(const f32x4 (&acc)[2][2][4][2], const Unit& u, int wr, int wc, int fr, int fq) const {
        const int row0 = u.pm * BM + wr * 64 + fr, col0 = u.pn * BM + wc * 32 + 8 * fq;
#pragma unroll
        for (int ai = 0; ai < 2; ++ai)
#pragma unroll
            for (int m = 0; m < 4; ++m) { bf16_t* rowp = O + (size_t)(row0 + ai * HALF + m * 16) * ldc + col0;
#pragma unroll
                for (int bj = 0; bj < 2; ++bj) { const f32x4 v0 = acc[ai][bj][m][0], v1 = acc[ai][bj][m][1];
                    u32x4 w; w.x = cvt_pk_bf16(v0[0], v0[1]); w.y = cvt_pk_bf16(v0[2], v0[3]); w.z = cvt_pk_bf16(v1[0], v1[1]); w.w = cvt_pk_bf16(v1[2], v1[3]);
                    *(u32x4*)(rowp + bj * HALF) = w; } }
    }
};

struct EpiMerge {
    static constexpr bool PERM = false, AFTER_DRAIN = false, FP8 = false; static constexpr int HOOK_T = 16;
    const bf16_t* Pz; int ldp, cza, czb; const float* bias; int nb; bf16_t* O; int ldc;
    __device__ __forceinline__ void mid(f32x4 (&acc)[2][2][4][2], const Unit& u, int wr, int wc, int fr, int fq) const {
        int row0 = u.pm * BM + wr * 64 + fr; asm volatile("" : "+v"(row0));
#pragma unroll
        for (int bj = 0; bj < 2; ++bj) { const int col0 = u.pn * BM + bj * HALF + wc * 32 + 8 * fq;
            const f32x4 ba0 = *(const f32x4*)(bias + col0), ba1 = *(const f32x4*)(bias + col0 + 4), bb0 = *(const f32x4*)(bias + nb + col0), bb1 = *(const f32x4*)(bias + nb + col0 + 4);
#pragma unroll
            for (int ai = 0; ai < 2; ++ai)
#pragma unroll
                for (int m = 0; m < 4; ++m) { const size_t ro = (size_t)(row0 + ai * HALF + m * 16) * ldp + col0;
                    const u32x4 za = *(const u32x4*)(Pz + ro + cza), zb = *(const u32x4*)(Pz + ro + czb);
                    f32x4 r0, r1;
#pragma unroll
                    for (int e = 0; e < 4; ++e) { const unsigned a = za[e], b = zb[e];
                        const float a_lo = __uint_as_float(a << 16), a_hi = __uint_as_float(a & 0xffff0000u), b_lo = __uint_as_float(b << 16), b_hi = __uint_as_float(b & 0xffff0000u);
                        const float ba_lo = (e < 2 ? ba0 : ba1)[(2 * e) & 3], ba_hi = (e < 2 ? ba0 : ba1)[(2 * e + 1) & 3], bb_lo = (e < 2 ? bb0 : bb1)[(2 * e) & 3], bb_hi = (e < 2 ? bb0 : bb1)[(2 * e + 1) & 3];
                        const float q_lo = (1.f + __expf(-(b_lo + bb_lo))) / (1.f + __expf(-(a_lo + ba_lo))), q_hi = (1.f + __expf(-(b_hi + bb_hi))) / (1.f + __expf(-(a_hi + ba_hi)));
                        if (e < 2) { r0[2 * e] = q_lo; r0[2 * e + 1] = q_hi; } else { r1[2 * e - 4] = q_lo; r1[2 * e - 3] = q_hi; } }
                    acc[ai][bj][m][0] *= r0; acc[ai][bj][m][1] *= r1; } }
    }
    __device__ __forceinline__ void operator()(const f32x4 (&acc)[2][2][4][2], const Unit& u, int wr, int wc, int fr, int fq) const {
        const int row0 = u.pm * BM + wr * 64 + fr;
#pragma unroll
        for (int bj = 0; bj < 2; ++bj) { const int col0 = u.pn * BM + bj * HALF + wc * 32 + 8 * fq;
            const f32x4 bb0 = *(const f32x4*)(bias + nb + col0), bb1 = *(const f32x4*)(bias + nb + col0 + 4);
#pragma unroll
            for (int ai = 0; ai < 2; ++ai)
#pragma unroll
                for (int m = 0; m < 4; ++m) { const int row = row0 + ai * HALF + m * 16;
                    const u32x4 zb = *(const u32x4*)(Pz + (size_t)row * ldp + col0 + czb);
                    float s[8];
#pragma unroll
                    for (int e = 0; e < 4; ++e) { const unsigned b = zb[e]; const float b_lo = __uint_as_float(b << 16), b_hi = __uint_as_float(b & 0xffff0000u);
                        const float bb_lo = (e < 2 ? bb0 : bb1)[(2 * e) & 3], bb_hi = (e < 2 ? bb0 : bb1)[(2 * e + 1) & 3];
                        s[2 * e] = 1.f / (1.f + __expf(-(b_lo + bb_lo))); s[2 * e + 1] = 1.f / (1.f + __expf(-(b_hi + bb_hi))); }
                    const f32x4 v0 = acc[ai][bj][m][0], v1 = acc[ai][bj][m][1];
                    u32x4 w; w.x = cvt_pk_bf16(v0[0] * s[0], v0[1] * s[1]); w.y = cvt_pk_bf16(v0[2] * s[2], v0[3] * s[3]); w.z = cvt_pk_bf16(v1[0] * s[4], v1[1] * s[5]); w.w = cvt_pk_bf16(v1[2] * s[6], v1[3] * s[7]);
                    *(u32x4*)(O + (size_t)row * ldc + col0) = w; } }
    }
};
struct EpiResid {
    static constexpr bool PERM = false, AFTER_DRAIN = false, FP8 = false; static constexpr int HOOK_T = -1;
    const float* base; float* out; int ldc; float* rowss;
    __device__ __forceinline__ void operator()(const f32x4 (&acc)[2][2][4][2], const Unit& u, int wr, int wc, int fr, int fq) const {
        const int row0 = u.pm * BM + wr * 64 + fr, col0 = u.pn * BM + wc * 32 + 4 * fq;
#pragma unroll
        for (int ai = 0; ai < 2; ++ai)
#pragma unroll
            for (int m = 0; m < 4; ++m) { const int row = row0 + ai * HALF + m * 16; const size_t off = (size_t)row * ldc + col0; float ss = 0.f;
#pragma unroll
                for (int bj = 0; bj < 2; ++bj)
#pragma unroll
                    for (int n = 0; n < 2; ++n) { const f32x4 o = *(const f32x4*)(base + off + bj * HALF + n * 16) + acc[ai][bj][m][n];
                        *(f32x4*)(out + off + bj * HALF + n * 16) = o; ss += (o[0] * o[0] + o[1] * o[1]) + (o[2] * o[2] + o[3] * o[3]); }
                ss += __shfl_xor(ss, 16); ss += __shfl_xor(ss, 32);
                if (fq == 0) atomicAdd(rowss + row, ss); }
    }
};


template <bool F8> struct EpiIn {
    static constexpr bool PERM = false, AFTER_DRAIN = false, FP8 = F8; static constexpr int HOOK_T = -1;
    bf16_t* O; int ldc; const float* cosa; const float* sina; const float* cosp; const float* sinp; const float* qg; const float* kg; const float* bias; bf16_t* SA; bf16_t* SB; PG8_LAS float* red; float eps; float sc;
    __device__ __forceinline__ static unsigned long long pk4(const f32x4 v) { return (unsigned long long)cvt_pk_bf16(v[0], v[1]) | ((unsigned long long)cvt_pk_bf16(v[2], v[3]) << 32); }
    __device__ __forceinline__ void operator()(const f32x4 (&acc)[2][2][4][2], const Unit& u, int wr, int wc, int fr_, int fq_) const {
        (void)fr_; (void)fq_; const int ln_ = fresh_lane(), fr = ln_ & 15, fq = ln_ >> 4;
        const int pn = F8 ? (u.pn < 14 ? u.pn : u.pn + 16) : u.pn + 14; const int row0 = u.pm * BM + wr * 64 + fr;
        if (pn < 5) {
#pragma unroll
            for (int ai = 0; ai < 2; ++ai)
#pragma unroll
                for (int m = 0; m < 4; ++m)
#pragma unroll
                    for (int bj = 0; bj < 2; ++bj) { const f32x4 v0 = (acc[ai][bj][m][0] * sc), v1 = (acc[ai][bj][m][1] * sc);
                        float ss = (v0[0] * v0[0] + v0[1] * v0[1]) + (v0[2] * v0[2] + v0[3] * v0[3]) + (v1[0] * v1[0] + v1[1] * v1[1]) + (v1[2] * v1[2] + v1[3] * v1[3]);
                        ss += __shfl_xor(ss, 16); ss += __shfl_xor(ss, 32);
                        if (fq == 0) red[(ai * HALF + wr * 64 + m * 16 + fr) * 8 + bj * 4 + wc] = ss; }
            asm volatile("s_waitcnt lgkmcnt(0)" ::: "memory"); __builtin_amdgcn_s_barrier(); asm volatile("" ::: "memory");
            const int half = wc >> 1, i0 = 16 * (wc & 1) + 4 * fq;
            const float* g = (pn < 4) ? qg : kg;
            const f32x4 g0 = *(const f32x4*)(g + 64 * half + i0), g1 = *(const f32x4*)(g + 64 * half + 32 + i0);
#pragma unroll
            for (int ai = 0; ai < 2; ++ai)
#pragma unroll
                for (int m = 0; m < 4; ++m) { const int row = row0 + ai * HALF + m * 16, sq = row & 2047, pos = half ? (sq & 63) : (sq >> 6);
                    const f32x4 c = *(const f32x4*)(cosa + pos * 32 + i0), sn = *(const f32x4*)(sina + pos * 32 + i0);
#pragma unroll
                    for (int bj = 0; bj < 2; ++bj) { const f32x4 pr = *(const PG8_LAS f32x4*)(red + (ai * HALF + wr * 64 + m * 16 + fr) * 8 + bj * 4);
                        const float rs = rsqrtf(((pr[0] + pr[1]) + (pr[2] + pr[3])) * (1.f / 128.f) + eps);
                        const f32x4 y0 = (acc[ai][bj][m][0] * sc) * rs * g0, y1 = (acc[ai][bj][m][1] * sc) * rs * g1;
                        const f32x4 lo = y0 * c - y1 * sn, hi = y0 * sn + y1 * c;
                        bf16_t* p = O + (size_t)row * ldc + pn * BM + bj * HALF + 64 * half + i0;
                        *(unsigned long long*)p = pk4(lo); *(unsigned long long*)(p + 32) = pk4(hi); } }
        } else if (pn >= 10 && pn < 22 && wc == 0) {
            const int i0 = 4 * fq;
#pragma unroll
            for (int ai = 0; ai < 2; ++ai)
#pragma unroll
                for (int m = 0; m < 4; ++m) { const int row = row0 + ai * HALF + m * 16, sq = row & 2047;
                    const f32x4 c = *(const f32x4*)(cosp + sq * 16 + i0), sn = *(const f32x4*)(sinp + sq * 16 + i0);
#pragma unroll
                    for (int bj = 0; bj < 2; ++bj) { const f32x4 y0 = (acc[ai][bj][m][0] * sc), y1 = (acc[ai][bj][m][1] * sc);
                        const f32x4 lo = y0 * c - y1 * sn, hi = y0 * sn + y1 * c;
                        bf16_t* p = O + (size_t)row * ldc + pn * BM + bj * HALF + i0;
                        *(unsigned long long*)p = pk4(lo); *(unsigned long long*)(p + 16) = pk4(hi); } }
        } else if (pn >= 30) {
            const int which = pn >= 38 ? 1 : 0, pnz = pn - (which ? 38 : 30);
            const float* bs = bias + which * 2048 + pnz * BM + wc * 32 + 8 * fq;
            bf16_t* dst = (which ? SB : SA) + ((((size_t)(u.pm * 8 + pnz) * 8 + (wr * 4 + wc)) * 16) * 64 + (fq * 16 + fr)) * 8;
#pragma unroll
            for (int bj = 0; bj < 2; ++bj) { const f32x4 b0 = *(const f32x4*)(bs + bj * HALF), b1 = *(const f32x4*)(bs + bj * HALF + 4);
#pragma unroll
                for (int ai = 0; ai < 2; ++ai)
#pragma unroll
                    for (int m = 0; m < 4; ++m) { const f32x4 v0 = (acc[ai][bj][m][0] * sc) + b0, v1 = (acc[ai][bj][m][1] * sc) + b1; float sg[8];
#pragma unroll
                        for (int e = 0; e < 4; ++e) { sg[e] = 1.f / (1.f + __expf(-v0[e])); sg[4 + e] = 1.f / (1.f + __expf(-v1[e])); }
                        u32x4 w; w.x = cvt_pk_bf16(sg[0], sg[1]); w.y = cvt_pk_bf16(sg[2], sg[3]); w.z = cvt_pk_bf16(sg[4], sg[5]); w.w = cvt_pk_bf16(sg[6], sg[7]);
                        __builtin_nontemporal_store(w, (u32x4*)(dst + (ai * 8 + bj * 4 + m) * 512)); } }
        } else {
            const bool act = (pn >= 6 && pn < 10) || pn == 28 || pn == 29;
            const int col0 = pn * BM + wc * 32 + 8 * fq;
#pragma unroll
            for (int ai = 0; ai < 2; ++ai)
#pragma unroll
                for (int m = 0; m < 4; ++m) { bf16_t* rowp = O + (size_t)(row0 + ai * HALF + m * 16) * ldc + col0;
#pragma unroll
                    for (int bj = 0; bj < 2; ++bj) { f32x4 v0 = (acc[ai][bj][m][0] * sc), v1 = (acc[ai][bj][m][1] * sc);
                        if (act) {
#pragma unroll
                            for (int e = 0; e < 4; ++e) { v0[e] = v0[e] / (1.f + __expf(-v0[e])); v1[e] = v1[e] / (1.f + __expf(-v1[e])); } }
                        u32x4 w; w.x = cvt_pk_bf16(v0[0], v0[1]); w.y = cvt_pk_bf16(v0[2], v0[3]); w.z = cvt_pk_bf16(v1[0], v1[1]); w.w = cvt_pk_bf16(v1[2], v1[3]);
                        *(u32x4*)(rowp + bj * HALF) = w; } }
        }
    }
};
struct EpiMerge2 {
    static constexpr bool PERM = false, AFTER_DRAIN = false, FP8 = false; static constexpr int HOOK_T = 16;
    const bf16_t* SA; const bf16_t* SB; bf16_t* O; int ldc;
    __device__ __forceinline__ void mid(f32x4 (&acc)[2][2][4][2], const Unit& u, int wr, int wc, int fr, int fq) const {
        int lane = fq * 16 + fr; asm volatile("" : "+v"(lane));
        const size_t base = ((((size_t)(u.pm * 8 + u.pn) * 8 + (wr * 4 + wc)) * 16) * 64 + lane) * 8;
#pragma unroll
        for (int f = 0; f < 16; ++f) { const int ai = f >> 3, bj = (f >> 2) & 1, m = f & 3;
            const u32x4 a = __builtin_nontemporal_load((const u32x4*)(SA + base + f * 512)), b = *(const u32x4*)(SB + base + f * 512);
            f32x4 r0, r1;
#pragma unroll
            for (int e = 0; e < 4; ++e) { const float q_lo = __uint_as_float(a[e] << 16) * __builtin_amdgcn_rcpf(__uint_as_float(b[e] << 16)), q_hi = __uint_as_float(a[e] & 0xffff0000u) * __builtin_amdgcn_rcpf(__uint_as_float(b[e] & 0xffff0000u));
                if (e < 2) { r0[2 * e] = q_lo; r0[2 * e + 1] = q_hi; } else { r1[2 * e - 4] = q_lo; r1[2 * e - 3] = q_hi; } }
            acc[ai][bj][m][0] *= r0; acc[ai][bj][m][1] *= r1; }
    }
    __device__ __forceinline__ void operator()(const f32x4 (&acc)[2][2][4][2], const Unit& u, int wr, int wc, int fr_, int fq_) const {
        (void)fr_; (void)fq_; const int ln_ = fresh_lane(), fr = ln_ & 15, fq = ln_ >> 4;
        const int lane = fq * 16 + fr, row0 = u.pm * BM + wr * 64 + fr, col0 = u.pn * BM + wc * 32 + 8 * fq;
        const size_t base = ((((size_t)(u.pm * 8 + u.pn) * 8 + (wr * 4 + wc)) * 16) * 64 + lane) * 8;
#pragma unroll
        for (int f = 0; f < 16; ++f) { const int ai = f >> 3, bj = (f >> 2) & 1, m = f & 3;
            const u32x4 b = __builtin_nontemporal_load((const u32x4*)(SB + base + f * 512));
            const f32x4 v0 = acc[ai][bj][m][0], v1 = acc[ai][bj][m][1];
            u32x4 w; w.x = cvt_pk_bf16(v0[0] * __uint_as_float(b[0] << 16), v0[1] * __uint_as_float(b[0] & 0xffff0000u)); w.y = cvt_pk_bf16(v0[2] * __uint_as_float(b[1] << 16), v0[3] * __uint_as_float(b[1] & 0xffff0000u));
            w.z = cvt_pk_bf16(v1[0] * __uint_as_float(b[2] << 16), v1[1] * __uint_as_float(b[2] & 0xffff0000u)); w.w = cvt_pk_bf16(v1[2] * __uint_as_float(b[3] << 16), v1[3] * __uint_as_float(b[3] & 0xffff0000u));
            *(u32x4*)(O + (size_t)(row0 + ai * HALF + m * 16) * ldc + col0 + bj * HALF) = w; }
    }
};
struct EpiResidNorm {
    static constexpr bool PERM = false, AFTER_DRAIN = true, FP8 = false; static constexpr int HOOK_T = -1;
    const float* base; float* out; int ldc; const float* gain; float* xb; unsigned* cnt; int ntn; float eps;
    __device__ __forceinline__ void fused(f32x4 (&acc)[2][2][4][2], const Unit& u, int wr, int wc, int fr_, int fq_, PG8_LAS unsigned char* lds, int wid, int lane) const {
        (void)fr_; (void)fq_; const int ln_ = fresh_lane(), fr = ln_ & 15, fq = ln_ >> 4;
        PG8_LAS float* Pp = (PG8_LAS float*)lds;
        PG8_LAS float* Sr = (PG8_LAS float*)(lds + 4096);
        const int row0 = u.pm * BM + wr * 64 + fr, col0 = u.pn * BM + wc * 32 + 4 * fq;
#pragma unroll
        for (int ai = 0; ai < 2; ++ai)
#pragma unroll
            for (int m = 0; m < 4; ++m) { const size_t off = (size_t)(row0 + ai * HALF + m * 16) * ldc + col0; float ss = 0.f;
#pragma unroll
                for (int bj = 0; bj < 2; ++bj)
#pragma unroll
                    for (int n = 0; n < 2; ++n) { const f32x4 o = __builtin_nontemporal_load((const f32x4*)(base + off + bj * HALF + n * 16)) + acc[ai][bj][m][n]; acc[ai][bj][m][n] = o;
                        ss += (o[0] * o[0] + o[1] * o[1]) + (o[2] * o[2] + o[3] * o[3]); }
                ss += __shfl_xor(ss, 16); ss += __shfl_xor(ss, 32);
                if (fq == 0) Pp[(ai * HALF + wr * 64 + m * 16 + fr) * 4 + wc] = ss;
                if (m & 1) asm volatile("" ::: "memory"); }
        asm volatile("s_waitcnt lgkmcnt(0)" ::: "memory"); __builtin_amdgcn_s_barrier(); asm volatile("" ::: "memory");
        const int tid = wid * 64 + lane;
        if (tid < 256) { const f32x4 p = *(const PG8_LAS f32x4*)(Pp + tid * 4);
            __hip_atomic_store(xb + (size_t)(u.pm * BM + tid) * 8 + u.pn, (p[0] + p[1]) + (p[2] + p[3]), __ATOMIC_RELAXED, __HIP_MEMORY_SCOPE_AGENT); }
        asm volatile("s_waitcnt vmcnt(0)" ::: "memory"); __builtin_amdgcn_s_barrier(); asm volatile("" ::: "memory");
        if (tid == 0) __hip_atomic_fetch_add(cnt + 64 * u.pm, 1u, __ATOMIC_RELAXED, __HIP_MEMORY_SCOPE_AGENT);
        if (wid == 0) { unsigned spins = 0;
            while ((unsigned)__builtin_amdgcn_readfirstlane(__hip_atomic_load(cnt + 64 * u.pm, __ATOMIC_RELAXED, __HIP_MEMORY_SCOPE_AGENT)) < (unsigned)ntn) { __builtin_amdgcn_s_sleep(2); if (++spins > (1u << 22)) break; }
            __builtin_amdgcn_fence(__ATOMIC_ACQUIRE, "agent"); }
        asm volatile("s_waitcnt vmcnt(0) lgkmcnt(0)" ::: "memory"); __builtin_amdgcn_s_barrier(); asm volatile("" ::: "memory");
        if (tid < 256) { const float* slot = xb + (size_t)(u.pm * BM + tid) * 8; float tot = 0.f;
#pragma unroll
            for (int t = 0; t < 8; ++t) tot += __hip_atomic_load(slot + t, __ATOMIC_RELAXED, __HIP_MEMORY_SCOPE_AGENT);
            Sr[tid] = rsqrtf(tot * (1.0f / 2048.0f) + eps); }
        asm volatile("s_waitcnt lgkmcnt(0)" ::: "memory"); __builtin_amdgcn_s_barrier(); asm volatile("" ::: "memory");
#pragma unroll
        for (int bj = 0; bj < 2; ++bj)
#pragma unroll
            for (int n = 0; n < 2; ++n) { const f32x4 g = *(const f32x4*)(gain + col0 + bj * HALF + n * 16);
#pragma unroll
                for (int ai = 0; ai < 2; ++ai)
#pragma unroll
                    for (int m = 0; m < 4; ++m) { const int rl = ai * HALF + wr * 64 + m * 16 + fr; const float rs = Sr[rl];
                        __builtin_nontemporal_store(acc[ai][bj][m][n] * rs * g, (f32x4*)(out + (size_t)(u.pm * BM + rl) * ldc + col0 + bj * HALF + n * 16)); } }
    }
};

template <class Epi, class Sched, bool ALIGN_EPI = false, bool SP2 = false>
__device__ __forceinline__ void gemm_phase(PG8_LAS unsigned char* lds, const Gemm g, const Sched& S, const Epi& E, const int wave_) {
    const int wid = wave_, lane = fresh_lane(), tid = wid * 64 + lane, wr = wid >> 2, wc = wid & 3, fr = lane & 15, fq = lane >> 4;
    const int K = g.K, nt = K / BK;
    unsigned voffA[2], voffB[2];
#pragma unroll
    for (int i = 0; i < 2; ++i) { int R, C; stage_rc(tid * 16 + i * 8192, R, C); const int Rb = Epi::PERM ? ((R & ~31) + perm32(R & 31)) : R;
        voffA[i] = (unsigned)(R * K + C) * 2u; voffB[i] = (unsigned)(Rb * K + C) * 2u; }
    const unsigned kstep = (unsigned)(BK * 2);
    const unsigned hstep = (unsigned)HALF * (unsigned)K * 2u;
    const unsigned tstep = 2u * hstep;
    const __amdgpu_buffer_rsrc_t rs_voffA = __builtin_amdgcn_make_buffer_rsrc((void*)g.A, 0, (int)((unsigned)g.M * (unsigned)K * 2u), 0x00020000);
    const __amdgpu_buffer_rsrc_t rs_voffB = __builtin_amdgcn_make_buffer_rsrc((void*)g.Bt, 0, (int)((unsigned)g.N * (unsigned)K * 2u), 0x00020000);
    const unsigned ldsw = (unsigned)wid * 1024u;
    const int aoff = lds_byte(wr * 64 + fr, fq * 8), boff = lds_byte(wc * 32 + fr, fq * 8);
#define PG8_SA(b, h) (((b) * 2 + (h)) * HTB)
#define PG8_SB(b, h) ((4 + (b) * 2 + (h)) * HTB)
#define PG8_STAGE(bufoff, goff, voff) do { _Pragma("unroll") for (int _i = 0; _i < 2; ++_i) \
        __builtin_amdgcn_raw_ptr_buffer_load_lds(rs_##voff, (PG8_LAS void*)(lds + (bufoff) + ldsw + _i * 8192), 16, (int)(voff)[_i], (int)(goff), 0, 0); } while (0)
#define PG8_LDA(dst, b, h) do { _Pragma("unroll") for (int m = 0; m < 4; ++m) _Pragma("unroll") for (int k = 0; k < 2; ++k) dst[m][k] = *(const PG8_LAS bf16x8*)(lds + PG8_SA(b, h) + aoff + m * 2048 + k * 1024); } while (0)
#define PG8_LDB(dst, b, h) do { _Pragma("unroll") for (int n = 0; n < 2; ++n) _Pragma("unroll") for (int k = 0; k < 2; ++k) dst[n][k] = *(const PG8_LAS bf16x8*)(lds + PG8_SB(b, h) + boff + n * 2048 + k * 1024); } while (0)
#define PG8_CAT(x, y) __builtin_shufflevector(__builtin_bit_cast(v4i_t, x), __builtin_bit_cast(v4i_t, y), 0, 1, 2, 3, 4, 5, 6, 7)
#define PG8_MMA(ai, bj, At, Bt) do { __builtin_amdgcn_s_setprio(1); _Pragma("unroll") for (int m = 0; m < 4; ++m) _Pragma("unroll") for (int n = 0; n < 2; ++n) { \
        if constexpr (Epi::FP8) acc[ai][bj][m][n] = __builtin_amdgcn_mfma_scale_f32_16x16x128_f8f6f4(PG8_CAT(Bt[n][0], Bt[n][1]), PG8_CAT(At[m][0], At[m][1]), acc[ai][bj][m][n], 0, 0, 0, 0x7f7f7f7f, 0, 0x7f7f7f7f); \
        else { _Pragma("unroll") for (int k = 0; k < 2; ++k) acc[ai][bj][m][n] = __builtin_amdgcn_mfma_f32_16x16x32_bf16(Bt[n][k], At[m][k], acc[ai][bj][m][n], 0, 0, 0); } } \
        __builtin_amdgcn_s_setprio(0); } while (0)
#define PG8_WAIT_V(n) asm volatile("s_waitcnt vmcnt(" #n ")" ::: "memory")
#define PG8_WAIT_L(n) asm volatile("s_waitcnt lgkmcnt(" #n ")" ::: "memory")
#define PG8_BAR __builtin_amdgcn_s_barrier()
#define PG8_SCHED __builtin_amdgcn_sched_barrier(0)
    Unit cur, nxt; int ui = 0;
    if (!S.next(0, cur)) return;
    f32x4 acc[2][2][4][2];
#pragma unroll
    for (int a = 0; a < 2; ++a)
#pragma unroll
        for (int b = 0; b < 2; ++b)
#pragma unroll
            for (int m = 0; m < 4; ++m)
#pragma unroll
                for (int n = 0; n < 2; ++n) acc[a][b][m][n] = (f32x4){0.f, 0.f, 0.f, 0.f};
    bf16x8 At[4][2], B0[2][2], B1[2][2];
    unsigned cA = (unsigned)cur.pm * tstep, cB = (unsigned)cur.pn * tstep;
    S.a_ready(cur);
    if constexpr (SP2) {
        PG8_STAGE(PG8_SB(0, 0), cB, voffB); PG8_STAGE(PG8_SB(0, 1), cB + hstep, voffB); PG8_STAGE(PG8_SA(0, 0), cA, voffA); PG8_STAGE(PG8_SA(0, 1), cA + hstep, voffA);
        if (wr == 1) PG8_BAR;
        PG8_WAIT_V(2); PG8_BAR;
        PG8_STAGE(PG8_SB(1, 0), cB + kstep, voffB); PG8_STAGE(PG8_SA(1, 0), cA + kstep, voffA); PG8_STAGE(PG8_SB(1, 1), cB + hstep + kstep, voffB);
        PG8_WAIT_V(6); PG8_BAR;
    } else {
        PG8_STAGE(PG8_SB(0, 0), cB, voffB); PG8_STAGE(PG8_SA(0, 0), cA, voffA); PG8_STAGE(PG8_SB(0, 1), cB + hstep, voffB); PG8_STAGE(PG8_SA(0, 1), cA + hstep, voffA);
        if (wr == 1) PG8_BAR;
        PG8_WAIT_V(4); PG8_BAR;
        PG8_STAGE(PG8_SB(1, 0), cB + kstep, voffB); PG8_STAGE(PG8_SA(1, 0), cA + kstep, voffA); PG8_STAGE(PG8_SB(1, 1), cB + hstep + kstep, voffB);
        PG8_WAIT_V(6); PG8_BAR;
    }
    for (;;) {
        const bool has_next = S.next(ui + 1, nxt);
        const unsigned nA = has_next ? (unsigned)nxt.pm * tstep : cA, nB = has_next ? (unsigned)nxt.pn * tstep : cB;
        for (int t = 0; t < nt; t += 2) {
            if constexpr (Epi::HOOK_T >= 0) { if (t == Epi::HOOK_T) E.mid(acc, cur, wr, wc, fr, fq); }
            const bool last = (t == nt - 2);
            const unsigned a1 = cA + (unsigned)(t + 1) * kstep;
            const unsigned a2 = last ? nA : cA + (unsigned)(t + 2) * kstep, b2 = last ? nB : cB + (unsigned)(t + 2) * kstep;
            const unsigned a3 = a2 + kstep, b3 = b2 + kstep;
            if (last && has_next) S.a_ready(nxt);
            if constexpr (SP2) {
            PG8_LDB(B0, 0, 0); PG8_LDB(B1, 0, 1); PG8_SCHED; PG8_LDA(At, 0, 0); PG8_STAGE(PG8_SA(1, 1), a1 + hstep, voffA);
            PG8_WAIT_V(8); PG8_WAIT_L(0); PG8_BAR; PG8_MMA(0, 0, At, B0); PG8_MMA(0, 1, At, B1); PG8_BAR; PG8_SCHED;
            PG8_LDA(At, 0, 1); PG8_STAGE(PG8_SB(0, 0), b2, voffB); PG8_STAGE(PG8_SB(0, 1), b2 + hstep, voffB); PG8_STAGE(PG8_SA(0, 0), a2, voffA);
            PG8_WAIT_V(8); PG8_WAIT_L(0); PG8_BAR; PG8_MMA(1, 0, At, B0); PG8_MMA(1, 1, At, B1); PG8_BAR; PG8_SCHED;
            PG8_LDB(B0, 1, 0); PG8_LDB(B1, 1, 1); PG8_SCHED; PG8_LDA(At, 1, 0); PG8_STAGE(PG8_SA(0, 1), a2 + hstep, voffA);
            PG8_WAIT_V(8); PG8_WAIT_L(0); PG8_BAR; PG8_MMA(0, 0, At, B0); PG8_MMA(0, 1, At, B1); PG8_BAR; PG8_SCHED;
            PG8_LDA(At, 1, 1); PG8_STAGE(PG8_SB(1, 0), b3, voffB); PG8_STAGE(PG8_SB(1, 1), b3 + hstep, voffB); PG8_STAGE(PG8_SA(1, 0), a3, voffA);
            PG8_WAIT_V(8); PG8_WAIT_L(0); PG8_BAR; PG8_MMA(1, 0, At, B0); PG8_MMA(1, 1, At, B1); PG8_BAR; PG8_SCHED;
            } else {
            PG8_LDB(B0, 0, 0); PG8_SCHED; PG8_LDA(At, 0, 0); PG8_STAGE(PG8_SA(1, 1), a1 + hstep, voffA);
            PG8_WAIT_L(8); PG8_BAR; PG8_WAIT_L(0); PG8_MMA(0, 0, At, B0); PG8_BAR; PG8_SCHED;
            PG8_LDB(B1, 0, 1); PG8_STAGE(PG8_SB(0, 0), b2, voffB);
            PG8_BAR; PG8_WAIT_L(0); PG8_MMA(0, 1, At, B1); PG8_BAR;
            PG8_LDA(At, 0, 1); PG8_STAGE(PG8_SA(0, 0), a2, voffA);
            PG8_BAR; PG8_WAIT_L(0); PG8_MMA(1, 0, At, B0); PG8_BAR; PG8_SCHED;
            PG8_STAGE(PG8_SB(0, 1), b2 + hstep, voffB);
            PG8_WAIT_V(6); PG8_BAR; PG8_MMA(1, 1, At, B1); PG8_BAR;
            PG8_LDB(B0, 1, 0); PG8_SCHED; PG8_LDA(At, 1, 0); PG8_STAGE(PG8_SA(0, 1), a2 + hstep, voffA);
            PG8_WAIT_L(8); PG8_BAR; PG8_WAIT_L(0); PG8_MMA(0, 0, At, B0); PG8_BAR; PG8_SCHED;
            PG8_LDB(B1, 1, 1); PG8_STAGE(PG8_SB(1, 0), b3, voffB);
            PG8_BAR; PG8_WAIT_L(0); PG8_MMA(0, 1, At, B1); PG8_BAR;
            PG8_LDA(At, 1, 1); PG8_STAGE(PG8_SA(1, 0), a3, voffA);
            PG8_BAR; PG8_WAIT_L(0); PG8_MMA(1, 0, At, B0); PG8_BAR; PG8_SCHED;
            PG8_STAGE(PG8_SB(1, 1), b3 + hstep, voffB);
            PG8_WAIT_V(6); PG8_BAR; PG8_MMA(1, 1, At, B1); PG8_BAR;
            }
        }
        if constexpr (ALIGN_EPI) { if (wr == 0) PG8_BAR; }
        if constexpr (!Epi::AFTER_DRAIN) { E(acc, cur, wr, wc, fr, fq); S.done(cur); }
        if (!has_next) break;
#pragma unroll
        for (int a = 0; a < 2; ++a)
#pragma unroll
            for (int b = 0; b < 2; ++b)
#pragma unroll
                for (int m = 0; m < 4; ++m)
#pragma unroll
                    for (int n = 0; n < 2; ++n) acc[a][b][m][n] = (f32x4){0.f, 0.f, 0.f, 0.f};
        cur = nxt; cA = nA; cB = nB; ++ui;
        if constexpr (ALIGN_EPI) { if (wr == 1) PG8_BAR; }
    }
    PG8_WAIT_V(0);
    if constexpr (!ALIGN_EPI) { if (wr == 0) PG8_BAR; }
    PG8_BAR;
    if constexpr (Epi::AFTER_DRAIN) { E.fused(acc, cur, wr, wc, fr, fq, lds, wid, lane); S.done(cur); }
#undef PG8_SA
#undef PG8_SB
#undef PG8_STAGE
#undef PG8_LDA
#undef PG8_LDB
#undef PG8_MMA
#undef PG8_CAT
#undef PG8_WAIT_V
#undef PG8_WAIT_L
#undef PG8_BAR
#undef PG8_SCHED
}
}

namespace att {
using bf16 = unsigned short;
constexpr int   D = 128, NW = 8, QBLK = 32, KVBLK = 64;
constexpr float SCALE = 0.088388347648318440f;
constexpr float THR = 8.f;
constexpr int SDEPTH = 2;
constexpr int LDQ = 7680, LDK = 7680;
constexpr int LDY = 1536;
constexpr size_t SHM_V = KVBLK * D * 2, SHM_K = KVBLK * D * 2, SHM_ATTN = 2 * SHM_V + 2 * SHM_K + NW * 64 * 4;
__device__ __forceinline__ float bf2f_(bf16 h) { return __uint_as_float(((unsigned)h) << 16); }
__device__ __forceinline__ bf16 f2bf_(float f) { unsigned u = __float_as_uint(f); return (bf16)((u + 0x7fffu + ((u >> 16) & 1u)) >> 16); }
using bf16x8 = __attribute__((ext_vector_type(8))) short;
using s16x4  = __attribute__((ext_vector_type(4))) short;
using f32x16 = __attribute__((ext_vector_type(16))) float;
using f32x8  = __attribute__((ext_vector_type(8))) float;
using u32x4  = __attribute__((ext_vector_type(4))) unsigned;
using f32x4_ = __attribute__((ext_vector_type(4))) float;
#define KSWZ(row, colB) ((row) * 256 + ((colB) ^ (((row) & 7) << 4)))
#define SBAR() __builtin_amdgcn_sched_barrier(0)
__device__ __forceinline__ int crow(int r, int hi) { return (r & 3) + 8 * (r >> 2) + 4 * hi; }
__device__ __forceinline__ unsigned cvtpk(float lo, float hi) {
  unsigned r; asm volatile("v_cvt_pk_bf16_f32 %0, %1, %2" : "=v"(r) : "v"(lo), "v"(hi)); return r;
}
template <typename TIn> struct Stage;
template <> struct Stage<bf16>  { using T = bf16x8;
  __device__ static __forceinline__ T ld8(const bf16* p) { return *reinterpret_cast<const bf16x8*>(p); }
  __device__ static __forceinline__ bf16x8 tobf(T x) { return x; } };
template <> struct Stage<float> { using T = f32x8;
  __device__ static __forceinline__ T ld8(const float* p) { return *reinterpret_cast<const f32x8*>(p); }
  __device__ static __forceinline__ bf16x8 tobf(T x) {
    u32x4 w = {cvtpk(x[0], x[1]), cvtpk(x[2], x[3]), cvtpk(x[4], x[5]), cvtpk(x[6], x[7])}; return *reinterpret_cast<bf16x8*>(&w); } };

__device__ __forceinline__ void partialSM(f32x16& p0, f32x16& p1, float& m_reg, float& mn, float& alpha) {
  constexpr float C = SCALE * 1.4426950408889634f;
  float pmax = p0[0]; for (int r = 1; r < 16; ++r) pmax = fmaxf(pmax, p0[r]); for (int r = 0; r < 16; ++r) pmax = fmaxf(pmax, p1[r]);
  { auto rr = __builtin_amdgcn_permlane32_swap(__float_as_uint(pmax), __float_as_uint(pmax), false, false);
    pmax = fmaxf(__uint_as_float(rr[0]), __uint_as_float(rr[1])); }
  if (__builtin_expect(__all(pmax - m_reg <= THR / SCALE), 1)) { mn = m_reg; alpha = 1.f; }
  else { mn = fmaxf(m_reg, pmax); alpha = __builtin_amdgcn_exp2f((m_reg - mn) * C); m_reg = mn; }
  float mnC = -mn * C;
  for (int r = 0; r < 16; ++r) p0[r] = fmaf(p0[r], C, mnC); for (int r = 0; r < 16; ++r) p1[r] = fmaf(p1[r], C, mnC);
  for (int r = 0; r < 16; ++r) p0[r] = __builtin_amdgcn_exp2f(p0[r]);
}
__device__ __forceinline__ void finishSM(f32x16& p0, f32x16& p1, float alpha, float& l_reg, bf16x8& pa0, bf16x8& pa1, bf16x8& pa2, bf16x8& pa3) {
  for (int r = 0; r < 16; ++r) p1[r] = __builtin_amdgcn_exp2f(p1[r]);
  float ps = 0; for (int r = 0; r < 16; ++r) ps += p0[r]; for (int r = 0; r < 16; ++r) ps += p1[r];
  { auto rr = __builtin_amdgcn_permlane32_swap(__float_as_uint(ps), __float_as_uint(ps), false, false);
    ps = __uint_as_float(rr[0]) + __uint_as_float(rr[1]); }
  l_reg = l_reg * alpha + ps;
#define PK4(P, BASE, OUT) do { unsigned a0 = cvtpk(P[BASE + 0], P[BASE + 1]), a1 = cvtpk(P[BASE + 2], P[BASE + 3]);   \
    unsigned b0 = cvtpk(P[BASE + 4], P[BASE + 5]), b1 = cvtpk(P[BASE + 6], P[BASE + 7]);                              \
    auto r0 = __builtin_amdgcn_permlane32_swap(a0, b0, false, false); auto r1 = __builtin_amdgcn_permlane32_swap(a1, b1, false, false); \
    u32x4 w = {r0[0], r1[0], r0[1], r1[1]}; OUT = *reinterpret_cast<bf16x8*>(&w); } while (0)
  PK4(p0, 0, pa0); PK4(p0, 8, pa1); PK4(p1, 0, pa2); PK4(p1, 8, pa3);
#undef PK4
}
__device__ __forceinline__ void qkt(f32x16& p0, f32x16& p1, const bf16* Ks, const bf16x8* qr, int r32, int hi) {
  p0 = f32x16{}; p1 = f32x16{};
  for (int d0 = 0; d0 < 8; ++d0) { int cb = (d0 * 16 + hi * 8) * 2;
    bf16x8 b0 = *reinterpret_cast<const bf16x8*>((const char*)Ks + KSWZ(r32, cb));
    bf16x8 b1 = *reinterpret_cast<const bf16x8*>((const char*)Ks + KSWZ(32 + r32, cb));
    p0 = __builtin_amdgcn_mfma_f32_32x32x16_bf16(b0, qr[d0], p0, 0, 0, 0);
    p1 = __builtin_amdgcn_mfma_f32_32x32x16_bf16(b1, qr[d0], p1, 0, 0, 0); }
}
__device__ __forceinline__ int v_st(int k, int c) { const int kk = (k & ~0xC) | ((k & 4) << 1) | ((k & 8) >> 1); return ((kk >> 3) * 4 + (c >> 5)) * 512 + ((kk & 7) * 32 + (c & 31)) * 2; }
__device__ __forceinline__ int v_rd_base(int lane) { return ((lane & 3) << 3) | (((lane >> 2) & 3) << 6) | (((lane >> 4) & 1) << 5) | (((lane >> 5) & 1) << 8); }
constexpr int v_rd_off(int d0, int ks, int half) { return d0 * 512 + ks * 4096 + half * 2048; }
template <int OFF> __device__ __forceinline__ s16x4 tr_read(int vb) {
  s16x4 r; asm volatile("ds_read_b64_tr_b16 %0, %1 offset:%2" : "=&v"(r) : "v"(vb), "i"(OFF) : "memory"); return r;
}
template <int D0> __device__ __forceinline__ void pv_one(f32x16& od, int vb, bf16x8 pa0, bf16x8 pa1, bf16x8 pa2, bf16x8 pa3) {
  const s16x4 l0 = tr_read<v_rd_off(D0, 0, 0)>(vb), h0 = tr_read<v_rd_off(D0, 0, 1)>(vb), l1 = tr_read<v_rd_off(D0, 1, 0)>(vb), h1 = tr_read<v_rd_off(D0, 1, 1)>(vb);
  const s16x4 l2 = tr_read<v_rd_off(D0, 2, 0)>(vb), h2 = tr_read<v_rd_off(D0, 2, 1)>(vb), l3 = tr_read<v_rd_off(D0, 3, 0)>(vb), h3 = tr_read<v_rd_off(D0, 3, 1)>(vb);
  asm volatile("s_waitcnt lgkmcnt(0)" ::: "memory"); SBAR();
#define PK(L, H) (bf16x8){L[0], L[1], L[2], L[3], H[0], H[1], H[2], H[3]}
  od = __builtin_amdgcn_mfma_f32_32x32x16_bf16(pa0, PK(l0, h0), od, 0, 0, 0);
  od = __builtin_amdgcn_mfma_f32_32x32x16_bf16(pa1, PK(l1, h1), od, 0, 0, 0);
  od = __builtin_amdgcn_mfma_f32_32x32x16_bf16(pa2, PK(l2, h2), od, 0, 0, 0);
  od = __builtin_amdgcn_mfma_f32_32x32x16_bf16(pa3, PK(l3, h3), od, 0, 0, 0);
#undef PK
}
__device__ __forceinline__ void pv_d0(f32x16* o, int vb, bf16x8 pa0, bf16x8 pa1, bf16x8 pa2, bf16x8 pa3) {
  pv_one<0>(o[0], vb, pa0, pa1, pa2, pa3); pv_one<1>(o[1], vb, pa0, pa1, pa2, pa3); pv_one<2>(o[2], vb, pa0, pa1, pa2, pa3); pv_one<3>(o[3], vb, pa0, pa1, pa2, pa3);
}

__device__ __forceinline__ void attn_dense_body(const bf16* __restrict__ Qb, const bf16* __restrict__ Kh, const bf16* __restrict__ Vh,
                                                const bf16* __restrict__ Gb, bf16* __restrict__ Yb, int seq, char* lds, const int wave_) {
  using TQ = bf16; using St = Stage<bf16>; using SQ = Stage<TQ>;
  const int wid = wave_, lane = fresh_lane(), tid = wid * 64 + lane, r32 = lane & 31, hi = lane >> 5;
  bf16* V_lds = (bf16*)lds; bf16* K_lds = (bf16*)(lds + 2 * SHM_V);
  float* ws = (float*)(lds + 2 * SHM_V + 2 * SHM_K) + wid * 64; float* li_l = ws; float* al_l = ws + 32;
  float m_reg = -1e30f, l_reg = 0; f32x16 o[4] = {}; bf16x8 qr[8];
  const TQ* Qw = Qb + (long)(wid * QBLK + r32) * LDQ + hi * 8;
#pragma unroll
  for (int d0 = 0; d0 < 8; ++d0) qr[d0] = SQ::tobf(SQ::ld8(Qw + d0 * 16));
  const int sr = tid >> 4, sc = (tid & 15) * 8, vst0 = v_st(sr, sc), vst1 = v_st(32 + sr, sc);
  const unsigned toff = (unsigned)(sr * LDK + sc);
  const int vb0 = (int)(uintptr_t)V_lds + v_rd_base(lane);
  struct { typename St::T vs0, vs1, ks0, ks1; } sr_[SDEPTH];
#define SLOAD(i, k0) do { const bf16* vb_ = Vh + (long)(k0) * LDK; const bf16* kb_ = Kh + (long)(k0) * LDK; \
    sr_[i].vs0 = St::ld8(vb_ + toff); sr_[i].vs1 = St::ld8(vb_ + 32 * LDK + toff); \
    sr_[i].ks0 = St::ld8(kb_ + toff); sr_[i].ks1 = St::ld8(kb_ + 32 * LDK + toff); } while (0)
#define SWRITE(b, i) do { *(bf16x8*)((char*)V_lds + (b) * SHM_V + vst0) = St::tobf(sr_[i].vs0);          \
    *(bf16x8*)((char*)V_lds + (b) * SHM_V + vst1) = St::tobf(sr_[i].vs1); int kc = sc * 2;               \
    *(bf16x8*)((char*)K_lds + (b) * SHM_K + KSWZ(sr, kc)) = St::tobf(sr_[i].ks0);                       \
    *(bf16x8*)((char*)K_lds + (b) * SHM_K + KSWZ(32 + sr, kc)) = St::tobf(sr_[i].ks1); } while (0)
#define SWAIT() do { if constexpr (SDEPTH == 2) asm volatile("s_waitcnt vmcnt(4)" ::: "memory"); else asm volatile("s_waitcnt vmcnt(0)" ::: "memory"); } while (0)
#define RESC(a) do { if (__any((a) < 1.f)) { if (hi == 0) al_l[r32] = (a); asm volatile("s_waitcnt lgkmcnt(0)" ::: "memory"); \
    for (int d = 0; d < 4; ++d) for (int r = 0; r < 16; ++r) o[d][r] *= al_l[crow(r, hi)]; } } while (0)
  f32x16 pA0, pA1, pB0, pB1; float mnA, mnB, alA, alB; bf16x8 pa0, pa1, pa2, pa3; const int NT = seq / KVBLK;
  constexpr int SE = 0, SO = SDEPTH - 1;
  SLOAD(SE, 0); asm volatile("s_waitcnt vmcnt(0)" ::: "memory"); SWRITE(0, SE); __syncthreads();
  qkt(pA0, pA1, K_lds, qr, r32, hi); partialSM(pA0, pA1, m_reg, mnA, alA);
  SLOAD(SO, KVBLK); if constexpr (SDEPTH == 2) { if (2 < NT) SLOAD(SE, 2 * KVBLK); }
  SWAIT(); SWRITE(1, SO); __syncthreads();
  for (int j = 1; j + 1 < NT; j += 2) {
    SBAR(); qkt(pB0, pB1, (bf16*)((char*)K_lds + SHM_K), qr, r32, hi);
    finishSM(pA0, pA1, alA, l_reg, pa0, pa1, pa2, pa3); SBAR();
    SLOAD(SO, (j + SDEPTH) * KVBLK); SBAR();
    pv_d0(o, vb0, pa0, pa1, pa2, pa3); partialSM(pB0, pB1, m_reg, mnB, alB);
    __syncthreads(); SWAIT(); SWRITE(0, SE);
    RESC(alB); __syncthreads();
    SBAR(); qkt(pA0, pA1, K_lds, qr, r32, hi);
    finishSM(pB0, pB1, alB, l_reg, pa0, pa1, pa2, pa3); SBAR();
    if (SDEPTH == 1 || j + 3 < NT) SLOAD(SE, (j + 1 + SDEPTH) * KVBLK); SBAR();
    pv_d0(o, vb0 + (int)SHM_V, pa0, pa1, pa2, pa3); partialSM(pA0, pA1, m_reg, mnA, alA);
    __syncthreads(); SWAIT(); SWRITE(1, SO);
    RESC(alA); __syncthreads();
  }
  SBAR(); qkt(pB0, pB1, (bf16*)((char*)K_lds + SHM_K), qr, r32, hi);
  finishSM(pA0, pA1, alA, l_reg, pa0, pa1, pa2, pa3); SBAR();
  pv_d0(o, vb0, pa0, pa1, pa2, pa3); partialSM(pB0, pB1, m_reg, mnB, alB);
  __syncthreads(); RESC(alB);
  finishSM(pB0, pB1, alB, l_reg, pa0, pa1, pa2, pa3); SBAR();
  pv_d0(o, vb0 + (int)SHM_V, pa0, pa1, pa2, pa3);
  if (hi == 0) li_l[r32] = l_reg; asm volatile("s_waitcnt lgkmcnt(0)" ::: "memory");
  float rli[16];
#pragma unroll
  for (int r = 0; r < 16; ++r) rli[r] = __builtin_amdgcn_rcpf(li_l[crow(r, hi)]);
  __syncthreads();
  { float* stg = (float*)(lds + wid * 16384);
#pragma unroll
    for (int r = 0; r < 16; ++r) { const int orow = crow(r, hi);
#pragma unroll
      for (int d0 = 0; d0 < 4; ++d0) stg[orow * 128 + d0 * 32 + r32] = o[d0][r] * rli[r]; }
    asm volatile("s_waitcnt lgkmcnt(0)" ::: "memory");
    const int ch = lane & 15, rb = lane >> 4;
    const bf16* Gw = Gb + (long)(wid * QBLK + rb) * LDQ + ch * 8; bf16* Yw = Yb + (long)(wid * QBLK + rb) * LDY + ch * 8;
    u32x4 gq[8];
#pragma unroll
    for (int i = 0; i < 8; ++i) gq[i] = *(const u32x4*)(Gw + (long)(4 * i) * LDQ);
#pragma unroll
    for (int i = 0; i < 8; ++i) { const float* sp = stg + (4 * i + rb) * 128 + ch * 8;
      const f32x4_ a = *(const f32x4_*)sp, b = *(const f32x4_*)(sp + 4); u32x4 w;
      w[0] = cvtpk(a[0] * __uint_as_float(gq[i][0] << 16), a[1] * __uint_as_float(gq[i][0] & 0xffff0000u));
      w[1] = cvtpk(a[2] * __uint_as_float(gq[i][1] << 16), a[3] * __uint_as_float(gq[i][1] & 0xffff0000u));
      w[2] = cvtpk(b[0] * __uint_as_float(gq[i][2] << 16), b[1] * __uint_as_float(gq[i][2] & 0xffff0000u));
      w[3] = cvtpk(b[2] * __uint_as_float(gq[i][3] << 16), b[3] * __uint_as_float(gq[i][3] & 0xffff0000u));
      *(u32x4*)(Yw + (long)(4 * i) * LDY) = w; } }
  __syncthreads();
#undef SLOAD
#undef SWRITE
#undef SWAIT
#undef RESC
}

__device__ __forceinline__ void attn_band_unit(const bf16* __restrict__ P, bf16* __restrict__ OG, float* __restrict__ LSE, int g, int b, int h, int blk, int cqb, int ckb, int cvb, int seqlen, int ntok, char* lds, const int wave_) {
  using St = Stage<bf16>;
  const int wid = wave_, lane = fresh_lane(), tid = wid * 64 + lane, r32 = lane & 31, hi = lane >> 5;
  bf16* V_lds = (bf16*)lds; bf16* K_lds = (bf16*)(lds + 2 * SHM_V);
  float* ws = (float*)(lds + 2 * SHM_V + 2 * SHM_K) + wid * 64; float* li_l = ws; float* al_l = ws + 32;
  const int dil = (g == 0) ? 1 : (g == 1 ? 4 : 16), head = g * 4 + h;
  int rq, lq0, ntile, t_lo, res0;
  if (g < 2) { const int kb = (g == 0) ? blk : (blk & 1), nt_all = seqlen / dil / 64; res0 = (g == 0) ? 0 : (blk >> 1);
    rq = res0; lq0 = 256 * kb + 32 * wid; t_lo = (4 * kb - 1 < 0) ? 0 : 4 * kb - 1; const int t_hi = (4 * kb + 5 > nt_all) ? nt_all : 4 * kb + 5; ntile = t_hi - t_lo; }
  else { res0 = 2 * blk; rq = res0 + (wid >> 2); lq0 = 32 * (wid & 3); t_lo = 0; ntile = 4; }
  const long tok0 = (long)b * seqlen;
  const bf16* Pq = P + cqb + head * D; const bf16* Pk = P + ckb + head * D; const bf16* Pv = P + cvb + head * D;
  float m_reg = -1e30f, l_reg = 0; f32x16 o[4] = {}; bf16x8 qr[8];
  { const bf16* Qw = Pq + (tok0 + (long)(lq0 + r32) * dil + rq) * LDQ + hi * 8;
#pragma unroll
    for (int d0 = 0; d0 < 8; ++d0) qr[d0] = St::ld8(Qw + d0 * 16); }
  const int sr = tid >> 4, sc = (tid & 15) * 8, vst0 = v_st(sr, sc), vst1 = v_st(32 + sr, sc);
  const int vb0 = (int)(uintptr_t)V_lds + v_rd_base(lane);
  typename St::T vs0, vs1, ks0, ks1, vt0, vt1, kt0, kt1;
#define TILE_RK(tt) ((g < 2) ? res0 : res0 + ((tt) >> 1))
#define TILE_LK0(tt) ((g < 2) ? 64 * (t_lo + (tt)) : 64 * ((tt) & 1))
#define BLOAD(tt, V0, V1, K0, K1) do { const int rk_ = TILE_RK(tt), lk_ = TILE_LK0(tt); const long ta = (tok0 + (long)(lk_ + sr) * dil + rk_) * LDK + sc, tb = (tok0 + (long)(lk_ + 32 + sr) * dil + rk_) * LDK + sc; \
    V0 = St::ld8(Pv + ta); V1 = St::ld8(Pv + tb); K0 = St::ld8(Pk + ta); K1 = St::ld8(Pk + tb); } while (0)
#define BWRITE(V0, V1, K0, K1) do { *(bf16x8*)((char*)V_lds + vst0) = V0; *(bf16x8*)((char*)V_lds + vst1) = V1; const int kc = sc * 2; \
    *(bf16x8*)((char*)K_lds + KSWZ(sr, kc)) = K0; *(bf16x8*)((char*)K_lds + KSWZ(32 + sr, kc)) = K1; } while (0)
#define BCOMPUTE(tt) do { const int rk = TILE_RK(tt), lk0 = TILE_LK0(tt); \
    const bool need = (rk == rq) && (lk0 + 63 >= lq0 - 64) && (lk0 <= lq0 + 95); \
    if (need) { \
      f32x16 p0, p1; float mn, alpha; bf16x8 pa0, pa1, pa2, pa3; \
      qkt(p0, p1, K_lds, qr, r32, hi); \
      const int dd = lk0 - lq0 - r32 + 4 * hi;                      \
      _Pragma("unroll") for (int r = 0; r < 16; ++r) { const int d0_ = dd + (r & 3) + 8 * (r >> 2), d1_ = d0_ + 32; \
        if (d0_ < -64 || d0_ > 64) p0[r] = -INFINITY; if (d1_ < -64 || d1_ > 64) p1[r] = -INFINITY; } \
      partialSM(p0, p1, m_reg, mn, alpha); \
      if (__any(alpha < 1.f)) { if (hi == 0) al_l[r32] = alpha; asm volatile("s_waitcnt lgkmcnt(0)" ::: "memory"); \
        _Pragma("unroll") for (int d = 0; d < 4; ++d) _Pragma("unroll") for (int r = 0; r < 16; ++r) o[d][r] *= al_l[crow(r, hi)]; } \
      finishSM(p0, p1, alpha, l_reg, pa0, pa1, pa2, pa3); SBAR(); \
      pv_d0(o, vb0, pa0, pa1, pa2, pa3); \
    } } while (0)
  BLOAD(0, vs0, vs1, ks0, ks1); if (ntile > 1) BLOAD(1, vt0, vt1, kt0, kt1);
  for (int tt = 0; tt < ntile; tt += 2) {
    __syncthreads();
    BWRITE(vs0, vs1, ks0, ks1);
    __syncthreads();
    if (tt + 2 < ntile) BLOAD(tt + 2, vs0, vs1, ks0, ks1);
    BCOMPUTE(tt);
    if (tt + 1 < ntile) {
      __syncthreads();
      BWRITE(vt0, vt1, kt0, kt1);
      __syncthreads();
      if (tt + 3 < ntile) BLOAD(tt + 3, vt0, vt1, kt0, kt1);
      BCOMPUTE(tt + 1);
    }
  }
#undef BWRITE
#undef BCOMPUTE
#undef BLOAD
#undef TILE_RK
#undef TILE_LK0
  if (hi == 0) li_l[r32] = l_reg; asm volatile("s_waitcnt lgkmcnt(0)" ::: "memory");
  float rli[16];
#pragma unroll
  for (int r = 0; r < 16; ++r) rli[r] = __builtin_amdgcn_rcpf(li_l[crow(r, hi)]);
  __syncthreads();
  { float* stg = (float*)(lds + wid * 16384);
#pragma unroll
    for (int r = 0; r < 16; ++r) { const int orow = crow(r, hi);
#pragma unroll
      for (int d0 = 0; d0 < 4; ++d0) stg[orow * 128 + d0 * 32 + r32] = o[d0][r] * rli[r]; }
    asm volatile("s_waitcnt lgkmcnt(0)" ::: "memory");
    const int ch = lane & 15, rb = lane >> 4;
    bf16* Og = OG + (long)g * ntok * 512 + h * D + ch * 8;
#pragma unroll
    for (int i = 0; i < 8; ++i) { const int row = 4 * i + rb; const float* sp = stg + row * 128 + ch * 8;
      const f32x4_ a = *(const f32x4_*)sp, b = *(const f32x4_*)(sp + 4); u32x4 w;
      w[0] = cvtpk(a[0], a[1]); w[1] = cvtpk(a[2], a[3]); w[2] = cvtpk(b[0], b[1]); w[3] = cvtpk(b[2], b[3]);
      *(u32x4*)(Og + (tok0 + (long)(lq0 + row) * dil + rq) * 512) = w; } }
  if (hi == 0) LSE[((long)g * ntok + tok0 + (long)(lq0 + r32) * dil + rq) * 4 + h] = m_reg * SCALE + __logf(l_reg);
  __syncthreads();
}
}

typedef unsigned short bf16_t;
constexpr int BATCH = 4, SEQ = 2048, DM = 2048, NTOK = BATCH * SEQ, NC = 11776;
constexpr int C_QA = 0, C_KA = 1024, C_VA = 1280, C_GA = 1536, C_QB = 2560, C_KB = 4096, C_VB = 5632, C_GB = 7168, C_ZA = 7680, C_ZB = 9728;
constexpr float EPS = 1e-6f;
constexpr float H8_SCALE = 4.0f, W8_SCALE = 64.0f;
constexpr size_t MiB = 1u << 20;
constexpr int PITCH = 7680;
constexpr size_t WS_CTL = 0, WS_TAB = 1 * MiB, WS_XB = 1 * MiB + 512 * 1024, WS_WTIN = 2 * MiB, WS_WTAB = 48 * MiB, WS_WTO = 54 * MiB, WS_HB = 64 * MiB, WS_P = 96 * MiB, WS_Y = 216 * MiB, WS_OG = 240 * MiB, WS_LSE = 264 * MiB,
                 WS_SA = 266 * MiB, WS_SB = 298 * MiB, WS_H8 = 330 * MiB, WS_WTZ8 = 346 * MiB, WS_END = 361 * MiB;

#define LAS __attribute__((address_space(3)))
typedef float f32x4 __attribute__((ext_vector_type(4)));
typedef unsigned v4u __attribute__((ext_vector_type(4)));
constexpr int NWAVES = 8;
constexpr int LDS_BYTES = 147456;

__device__ __forceinline__ float bf2f(bf16_t h) { return __uint_as_float(((unsigned)h) << 16); }
__device__ __forceinline__ unsigned f2bf_u(float f) { unsigned u = __float_as_uint(f); return (u + 0x7fffu + ((u >> 16) & 1u)) >> 16; }
__device__ __forceinline__ bf16_t f2bf(float f) { return (bf16_t)f2bf_u(f); }
__device__ __forceinline__ unsigned pk2(float lo, float hi) { return f2bf_u(lo) | (f2bf_u(hi) << 16); }
__device__ __forceinline__ float wave_sum(float v) {
#pragma unroll
    for (int o = 1; o < 64; o <<= 1) v += __shfl_xor(v, o);
    return v;
}
__device__ __forceinline__ float silu(float v) { return v / (1.f + __expf(-v)); }

__device__ __forceinline__ int colmap(int kind, int p) {
    const int bj = p >> 7, wc = (p >> 5) & 3, n = (p >> 4) & 1, fq = (p >> 2) & 3, j = p & 3;
    const int gen = 128 * bj + 32 * wc + 8 * fq + 4 * n + j;
    if (kind == 0) return p;
    if (kind == 1) return gen;
    if (kind == 2) return 128 * bj + 64 * (wc >> 1) + 32 * n + 16 * (wc & 1) + 4 * fq + j;
    return wc == 0 ? p : gen;
}
__device__ __forceinline__ int kind_in(int pn) { return pn < 5 ? 2 : ((pn >= 10 && pn < 22) ? 3 : 1); }

struct TrSrc { const float* W; int N; bf16_t* WT; int ldt, koff, kindsel; unsigned char* wt8; int n8; };
__device__ __forceinline__ void tr_load(const TrSrc& t, int item, int lane, f32x4 (&v)[8]) {
    const int nblk = t.N / 32, kb = item / nblk, nb = item % nblk, k0 = 64 * kb, n0 = 32 * nb;
    const int np = n0 + 4 * (lane & 7), pn = np >> 8;
    const int kind = t.kindsel < 0 ? kind_in(pn) : t.kindsel;
    const float* src = t.W + (size_t)(k0 + (lane >> 3)) * t.N + (pn << 8) + colmap(kind, np & 255);
#pragma unroll
    for (int i = 0; i < 8; ++i) v[i] = __builtin_nontemporal_load((const f32x4*)(src + (size_t)(8 * i) * t.N));
}
__device__ __forceinline__ void tr_store(const TrSrc& t, int item, int lane, const f32x4 (&v)[8], LAS float* scr) {
    const int nblk = t.N / 32, kb = item / nblk, nb = item % nblk, k0 = 64 * kb, n0 = 32 * nb;
    { LAS float* d = scr + (lane >> 3) * 33 + 4 * (lane & 7);
#pragma unroll
      for (int i = 0; i < 8; ++i) { d[i * 264 + 0] = v[i][0]; d[i * 264 + 1] = v[i][1]; d[i * 264 + 2] = v[i][2]; d[i * 264 + 3] = v[i][3]; } }
    asm volatile("s_waitcnt lgkmcnt(0)" ::: "memory");
    const int c = lane & 7;
    const int pn_ = n0 >> 8; const bool is8 = t.wt8 != nullptr && (n0 >= t.n8 || pn_ < 14);
    const int n8row = n0 >= t.n8 ? n0 - t.n8 + 14 * 256 : n0;
    if (is8) {
#pragma unroll
        for (int j = 0; j < 4; ++j) { const int n = (lane >> 3) + 8 * j; const LAS float* sp = scr + (8 * c) * 33 + n;
            int lo = 0, hi = 0;
            lo = __builtin_amdgcn_cvt_pk_fp8_f32(sp[0 * 33] * W8_SCALE, sp[1 * 33] * W8_SCALE, lo, false); lo = __builtin_amdgcn_cvt_pk_fp8_f32(sp[2 * 33] * W8_SCALE, sp[3 * 33] * W8_SCALE, lo, true);
            hi = __builtin_amdgcn_cvt_pk_fp8_f32(sp[4 * 33] * W8_SCALE, sp[5 * 33] * W8_SCALE, hi, false); hi = __builtin_amdgcn_cvt_pk_fp8_f32(sp[6 * 33] * W8_SCALE, sp[7 * 33] * W8_SCALE, hi, true);
            *(unsigned long long*)(t.wt8 + (size_t)(n8row + n) * t.ldt + k0 + 8 * c) = (unsigned long long)(unsigned)lo | ((unsigned long long)(unsigned)hi << 32); }
    } else {
#pragma unroll
    for (int j = 0; j < 4; ++j) { const int n = (lane >> 3) + 8 * j; const LAS float* sp = scr + (8 * c) * 33 + n;
        v4u o; o.x = pk2(sp[0 * 33], sp[1 * 33]); o.y = pk2(sp[2 * 33], sp[3 * 33]); o.z = pk2(sp[4 * 33], sp[5 * 33]); o.w = pk2(sp[6 * 33], sp[7 * 33]);
        *(v4u*)(t.WT + (size_t)(n0 + n) * t.ldt + t.koff + k0 + 8 * c) = o; }
    }
    asm volatile("s_waitcnt lgkmcnt(0)" ::: "memory");
}
__device__ __forceinline__ void tr_matrix(const TrSrc& t, int nitems, int gw, int NGW, int lane, LAS float* scr) {
    f32x4 a[8], b[8];
    int it = gw;
    if (it < nitems) tr_load(t, it, lane, a);
    for (; it < nitems; it += 2 * NGW) {
        const bool hb = it + NGW < nitems;
        if (hb) tr_load(t, it + NGW, lane, b);
        tr_store(t, it, lane, a, scr);
        if (hb) { if (it + 2 * NGW < nitems) tr_load(t, it + 2 * NGW, lane, a); tr_store(t, it + NGW, lane, b, scr); }
    }
}
__device__ __forceinline__ void rms_row_load(const float* xrow, int lane, f32x4 (&v)[8]) {
    const f32x4* xr = (const f32x4*)xrow + lane;
#pragma unroll
    for (int j = 0; j < 8; ++j) v[j] = __builtin_nontemporal_load(xr + 64 * j);
}
__device__ __forceinline__ void rms_row_store(const f32x4 (&v)[8], const float* gain, bf16_t* orow, unsigned char* orow8, int lane) {
    const f32x4* gr = (const f32x4*)gain + lane; float s = 0.f;
#pragma unroll
    for (int j = 0; j < 8; ++j) s += (v[j].x * v[j].x + v[j].y * v[j].y) + (v[j].z * v[j].z + v[j].w * v[j].w);
    const float rs = rsqrtf(wave_sum(s) * (1.f / DM) + EPS);
    unsigned long long* o8 = (unsigned long long*)orow + lane;
    unsigned* q8 = (unsigned*)orow8 + lane;
#pragma unroll
    for (int j = 0; j < 8; ++j) { const f32x4 g = gr[64 * j]; const f32x4 y = v[j] * rs * g;
        o8[64 * j] = (unsigned long long)pk2(y.x, y.y) | ((unsigned long long)pk2(y.z, y.w) << 32);
        int w = 0; w = __builtin_amdgcn_cvt_pk_fp8_f32(y.x * H8_SCALE, y.y * H8_SCALE, w, false); w = __builtin_amdgcn_cvt_pk_fp8_f32(y.z * H8_SCALE, y.w * H8_SCALE, w, true);
        q8[64 * j] = (unsigned)w; }
}
__device__ __forceinline__ void rms_rows(const float* x, const float* gain, bf16_t* H, unsigned char* H8, int m0, int step, int nrows, int lane) {
    f32x4 a[8], b[8];
    int m = m0;
    if (m < nrows) rms_row_load(x + (size_t)m * DM, lane, a);
    for (; m < nrows; m += 2 * step) {
        const bool hb = m + step < nrows;
        if (hb) rms_row_load(x + (size_t)(m + step) * DM, lane, b);
        rms_row_store(a, gain, H + (size_t)m * DM, H8 + (size_t)m * DM, lane);
        if (hb) { if (m + 2 * step < nrows) rms_row_load(x + (size_t)(m + 2 * step) * DM, lane, a); rms_row_store(b, gain, H + (size_t)(m + step) * DM, H8 + (size_t)(m + step) * DM, lane); }
    }
}

#define XB_TMO      128
#define XB_XCNT(j)  (256  + 64 * (j))
#define XB_XSUB(j)  (1280 + 64 * (j))
#define XB_XGEN(j)  (2304 + 64 * (j))
#define XB_TOP      3328
#define XB_TOPGEN   3392
#define XCD_BAR_WORDS 3456
#define XB_SPIN_CAP (1u << 18)

__device__ __forceinline__ unsigned xb_ld(unsigned* p)              { return __hip_atomic_load(p, __ATOMIC_RELAXED, __HIP_MEMORY_SCOPE_AGENT); }
__device__ __forceinline__ unsigned xb_add(unsigned* p, unsigned v) { return __hip_atomic_fetch_add(p, v, __ATOMIC_RELAXED, __HIP_MEMORY_SCOPE_AGENT); }
__device__ __forceinline__ unsigned xb_xcc_id() { return (unsigned)__builtin_amdgcn_s_getreg((3 << 11) | 20) & 0xFu; }
#define XB_SPIN(cond, bar) do { unsigned _sp = 0; while (cond) { __builtin_amdgcn_s_sleep(1); \
    if ((++_sp & 255u) == 0u) { if (xb_ld(&(bar)[XB_TMO])) break; if (_sp > XB_SPIN_CAP) { atomicAdd(&(bar)[XB_TMO], 1u); break; } } } } while (0)

struct XcdBarrier {
    unsigned* bar; unsigned x;
    volatile LAS unsigned* st;
};

__device__ __forceinline__ XcdBarrier xcd_barrier_post(unsigned* bar, volatile LAS unsigned* st) {
    XcdBarrier b; b.bar = bar; b.x = xb_xcc_id(); b.st = st;
    if (threadIdx.x == 0) (void)xb_add(&bar[XB_XCNT(b.x)], 1u);
    return b;
}
__device__ __forceinline__ void xcd_barrier_complete(unsigned* bar, unsigned x, unsigned& nloc, unsigned& nx) {
    const unsigned G = gridDim.x * gridDim.y * gridDim.z;
    unsigned sum, cnt, mine, sp = 0u;
    for (;;) {
        sum = 0u; cnt = 0u; mine = 0u;
#pragma unroll
        for (unsigned j = 0; j < 16; ++j) { const unsigned c = xb_ld(&bar[XB_XCNT(j)]); sum += c; cnt += (c > 0u) ? 1u : 0u; mine = (j == x) ? c : mine; }
        if (sum == G) break;
        __builtin_amdgcn_s_sleep(1);
        if ((++sp & 255u) == 0u) { if (xb_ld(&bar[XB_TMO])) break; if (sp > XB_SPIN_CAP) { atomicAdd(&bar[XB_TMO], 1u); break; } }
    }
    nloc = mine > 0u ? mine : 1u; nx = cnt > 0u ? cnt : 1u;
}

__device__ __forceinline__ void xcd_barrier(const XcdBarrier& b, const int wave_) {
    asm volatile("s_waitcnt vmcnt(0)" ::: "memory");
    __syncthreads();
    if (wave_ == 0 && fresh_lane() == 0) {
        unsigned* bar = b.bar;
        __builtin_amdgcn_s_waitcnt(0);
        unsigned nloc = b.st[0], nx = b.st[1];
        if (nloc == 0u) { xcd_barrier_complete(bar, b.x, nloc, nx); b.st[0] = nloc; b.st[1] = nx; }
        const unsigned old = xb_add(&bar[XB_XSUB(b.x)], 1u);
        const unsigned gen = old / nloc;
        if (old + 1u == (gen + 1u) * nloc) {
            __builtin_amdgcn_fence(__ATOMIC_RELEASE, "agent");
            asm volatile("s_waitcnt vmcnt(0)" ::: "memory");
            const unsigned og = xb_add(&bar[XB_TOP], 1u);
            const unsigned tg = og / nx;
            if (og + 1u == (tg + 1u) * nx) xb_add(&bar[XB_TOPGEN], 1u);
            else XB_SPIN(xb_ld(&bar[XB_TOPGEN]) == tg, bar);
            __builtin_amdgcn_fence(__ATOMIC_ACQUIRE, "agent");
            xb_add(&bar[XB_XGEN(b.x)], 1u);
            asm volatile("s_waitcnt vmcnt(0)" ::: "memory");
        } else {
            XB_SPIN(xb_ld(&bar[XB_XGEN(b.x)]) == gen, bar);
            __builtin_amdgcn_fence(__ATOMIC_ACQUIRE, "agent");
            asm volatile("s_waitcnt vmcnt(0)" ::: "memory");
        }
    }
    __syncthreads();
}

struct Args { const float* in[10]; float* out; unsigned char* ws; int ph_lo, ph_hi; };

__global__ void __launch_bounds__(NWAVES * 64, 2) mk_fwd(Args args) {
    extern __shared__ __attribute__((aligned(16))) unsigned char lds[];
    const int wave = __builtin_amdgcn_readfirstlane((int)threadIdx.x >> 6);
#define TID_LANE const int lane = fresh_lane(); const int tid = wave * 64 + lane; (void)tid; (void)lane;
    const int G = gridDim.x, bx = blockIdx.x;
    const int vcu = (G % 8 == 0) ? (bx % 8) * (G / 8) + bx / 8 : bx;
    unsigned char* ws = args.ws;
    const float* x = args.in[0]; const float* ng = args.in[1]; const float* w_in = args.in[2];
    bf16_t* WT_IN = (bf16_t*)(ws + WS_WTIN); bf16_t* HB = (bf16_t*)(ws + WS_HB); bf16_t* P = (bf16_t*)(ws + WS_P);
    float* COSA = (float*)(ws + WS_TAB); float* SINA = COSA + 2048; float* COSP = COSA + 4096; float* SINP = COSP + 32768;
    bf16_t* OG = (bf16_t*)(ws + WS_OG); float* LSE = (float*)(ws + WS_LSE); unsigned* CTL = (unsigned*)(ws + WS_CTL) + 4096;
    bf16_t* WT_AB = (bf16_t*)(ws + WS_WTAB); bf16_t* WT_O = (bf16_t*)(ws + WS_WTO); bf16_t* Y = (bf16_t*)(ws + WS_Y); bf16_t* MG = HB; unsigned char* H8 = ws + WS_H8; unsigned char* WTZ8 = ws + WS_WTZ8; bf16_t* SA = (bf16_t*)(ws + WS_SA); bf16_t* SB = (bf16_t*)(ws + WS_SB); float* XB = (float*)(ws + WS_XB); unsigned* PCNT = (unsigned*)(ws + WS_CTL) + 8192;
    const int lo = args.ph_lo, hi = args.ph_hi;
    volatile LAS unsigned* MISC = (volatile LAS unsigned*)((LAS unsigned char*)lds + 131072 + 320);
    if (threadIdx.x < 32) MISC[threadIdx.x] = 0u;
    __syncthreads();
    XcdBarrier bar = xcd_barrier_post((unsigned*)(ws + WS_CTL), MISC + 8);
#define GRID_BAR() xcd_barrier(bar, wave)
#define IN(k) (lo <= (k) && (k) < hi)
#define BOTH(k) (IN(k) && IN((k) + 1))
    if (IN(0)) { TID_LANE
        LAS float* scr = (LAS float*)((LAS unsigned char*)lds + wave * 16384);
        const int gw = vcu * NWAVES + wave, NGW = G * NWAVES;
        constexpr int I_IN = (DM / 64) * (NC / 32);
        { const TrSrc t{w_in, NC, WT_IN, DM, 0, -1, WTZ8, 7680}; tr_matrix(t, I_IN, gw, NGW, lane, scr); }
        for (int i = bx * (NWAVES * 64) + tid; i < 2048 + 32768; i += G * NWAVES * 64) {
            if (i < 2048) { const int pos = i >> 5, fi = i & 31; const float a = (float)pos * (1.0f / powf(10000.0f, (float)fi / 32.0f)); COSA[i] = cosf(a); SINA[i] = sinf(a); }
            else { const int k = i - 2048, pos = k >> 4, fi = k & 15; const float a = (float)pos * (1.0f / powf(500000.0f, (float)fi / 16.0f)); COSP[k] = cosf(a); SINP[k] = sinf(a); }
        }
        rms_rows(x, ng, HB, H8, gw, NGW, NTOK, lane);
        if (BOTH(0)) GRID_BAR();
    }
    if (IN(1)) { TID_LANE
        const float dsc = 1.0f / (H8_SCALE * W8_SCALE);
        {
            pg8::Gemm g{HB, WT_IN + (size_t)14 * 256 * DM, NTOK, 16 * 256, DM}; pg8::StaticOrder S; S.init(NTOK, 16 * 256, G, bx);
            pg8::EpiIn<false> E{P, PITCH, COSA, SINA, COSP, SINP, args.in[3], args.in[4], args.in[5], SA, SB, (LAS float*)((LAS unsigned char*)lds + 131072 + 1024), EPS, 1.0f};
            pg8::gemm_phase<pg8::EpiIn<false>, pg8::StaticOrder, true, true>((LAS unsigned char*)lds, g, S, E, wave);
        }
        {
            pg8::Gemm g8{(const bf16_t*)H8, (const bf16_t*)WTZ8, NTOK, 30 * 256, DM / 2}; pg8::StaticOrder S8; S8.init(NTOK, 30 * 256, G, bx);
            pg8::EpiIn<true> E8{P, PITCH, COSA, SINA, COSP, SINP, args.in[3], args.in[4], args.in[5], SA, SB, (LAS float*)((LAS unsigned char*)lds + 131072 + 1024), EPS, dsc};
            pg8::gemm_phase<pg8::EpiIn<true>, pg8::StaticOrder, true, true>((LAS unsigned char*)lds, g8, S8, E8, wave);
        }
        const int nheavy = ((NTOK / 256) * 30) % G;
        {
            const int first = nheavy > 0 ? nheavy : 0, nidle = G - first;
            if (bx >= first) {
                LAS float* scr = (LAS float*)((LAS unsigned char*)lds + wave * 16384);
                const int gw2 = (bx - first) * NWAVES + wave, NGW2 = nidle * NWAVES;
                constexpr int I_A = (1024 / 64) * (DM / 32), I_B = (512 / 64) * (DM / 32), I_O = (DM / 64) * (DM / 32);
                { const TrSrc t{args.in[6], DM, WT_AB, 1536, 0, 1, nullptr, 0}; tr_matrix(t, I_A, gw2, NGW2, lane, scr); }
                { const TrSrc t{args.in[7], DM, WT_AB, 1536, 1024, 1, nullptr, 0}; tr_matrix(t, I_B, gw2, NGW2, lane, scr); }
                { const TrSrc t{args.in[8], DM, WT_O, DM, 0, 0, nullptr, 0}; tr_matrix(t, I_O, gw2, NGW2, lane, scr); }
            }
        }
        if (BOTH(1)) GRID_BAR();
    }
    if (IN(2)) { TID_LANE
        for (int u = bx; u < 384; u += G) {
            const int blk = u & 7, h = (u >> 3) & 3, b = (u >> 5) & 3, g = u >> 7;
            att::attn_band_unit(P, OG, LSE, g, b, h, blk, C_QB, C_KB, C_VB, SEQ, NTOK, (char*)lds, wave);
        }
        asm volatile("s_waitcnt vmcnt(0)" ::: "memory"); __syncthreads();
        if (tid == 0) { __builtin_amdgcn_fence(__ATOMIC_RELEASE, "agent"); asm volatile("s_waitcnt vmcnt(0)" ::: "memory"); __hip_atomic_fetch_add(CTL, 1u, __ATOMIC_RELAXED, __HIP_MEMORY_SCOPE_AGENT); }
        for (int u = bx; u < 256; u += G) {
            const int pair = u & 7, inner = u >> 3, b = pair >> 1, hkv = pair & 1, hq = hkv * 4 + (inner >> 3), qb = inner & 7;
            const size_t row0 = (size_t)b * SEQ + qb * 256;
            att::attn_dense_body(P + row0 * PITCH + C_QA + hq * 128, P + (size_t)b * SEQ * PITCH + C_KA + hkv * 128, P + (size_t)b * SEQ * PITCH + C_VA + hkv * 128,
                                 P + row0 * PITCH + C_GA + hq * 128, Y + row0 * 1536 + hq * 128, SEQ, (char*)lds, wave);
        }
        const int mfirst = (384 - G > 0 && 384 - G < G) ? 384 - G : 0, nmerge = G - mfirst;
        if (bx >= mfirst) {
            if (tid == 0) { unsigned spins = 0; while (__hip_atomic_load(CTL, __ATOMIC_RELAXED, __HIP_MEMORY_SCOPE_AGENT) < (unsigned)G) { __builtin_amdgcn_s_sleep(4); if (++spins > (1u << 24)) break; }
                __builtin_amdgcn_fence(__ATOMIC_ACQUIRE, "agent"); asm volatile("s_waitcnt vmcnt(0)" ::: "memory"); }
            __syncthreads();
            for (int c0 = (bx - mfirst) * (NWAVES * 64) + tid; c0 < NTOK * 64; c0 += 2 * nmerge * NWAVES * 64) {
                v4u a0[2], a1[2], a2[2], gz[2]; float e0[2], e1[2], e2[2]; int tok[2], c8[2]; bool ok[2];
#pragma unroll
                for (int q = 0; q < 2; ++q) { const int ci = c0 + q * nmerge * NWAVES * 64; ok[q] = ci < NTOK * 64; const int cj = ok[q] ? ci : c0; tok[q] = cj >> 6; c8[q] = (cj & 63) * 8; const int h = c8[q] >> 7;
                    e0[q] = LSE[((size_t)0 * NTOK + tok[q]) * 4 + h]; e1[q] = LSE[((size_t)1 * NTOK + tok[q]) * 4 + h]; e2[q] = LSE[((size_t)2 * NTOK + tok[q]) * 4 + h];
                    a0[q] = *(const v4u*)(OG + ((size_t)0 * NTOK + tok[q]) * 512 + c8[q]); a1[q] = *(const v4u*)(OG + ((size_t)1 * NTOK + tok[q]) * 512 + c8[q]); a2[q] = *(const v4u*)(OG + ((size_t)2 * NTOK + tok[q]) * 512 + c8[q]);
                    gz[q] = *(const v4u*)(P + (size_t)tok[q] * PITCH + C_GB + c8[q]); }
#pragma unroll
                for (int q = 0; q < 2; ++q) { const float mx = fmaxf(e0[q], fmaxf(e1[q], e2[q])); float w0 = __expf(e0[q] - mx), w1 = __expf(e1[q] - mx), w2 = __expf(e2[q] - mx); const float inv = 1.f / (w0 + w1 + w2); w0 *= inv; w1 *= inv; w2 *= inv;
                    v4u w;
#pragma unroll
                    for (int e = 0; e < 4; ++e) {
                        const float lo = w0 * __uint_as_float(a0[q][e] << 16) + w1 * __uint_as_float(a1[q][e] << 16) + w2 * __uint_as_float(a2[q][e] << 16);
                        const float hh = w0 * __uint_as_float(a0[q][e] & 0xffff0000u) + w1 * __uint_as_float(a1[q][e] & 0xffff0000u) + w2 * __uint_as_float(a2[q][e] & 0xffff0000u);
                        w[e] = pk2(lo * __uint_as_float(gz[q][e] << 16), hh * __uint_as_float(gz[q][e] & 0xffff0000u)); }
                    if (ok[q]) *(v4u*)(Y + (size_t)tok[q] * 1536 + 1024 + c8[q]) = w; }
            }
        }
        if (BOTH(2)) GRID_BAR();
    }
    if (IN(3)) {
        pg8::Gemm g{Y, WT_AB, NTOK, DM, 1536}; pg8::StaticOrder S; S.init(NTOK, DM, G, bx);
        pg8::EpiMerge2 E{SA, SB, MG, DM};
        pg8::gemm_phase<pg8::EpiMerge2, pg8::StaticOrder, true, true>((LAS unsigned char*)lds, g, S, E, wave);
        if (BOTH(3)) GRID_BAR();
    }
    if (IN(4)) {
        pg8::Gemm g{MG, WT_O, NTOK, DM, DM}; pg8::StaticOrder S; S.init(NTOK, DM, G, bx);
        pg8::EpiResidNorm E{x, args.out, DM, args.in[9], XB, PCNT, 8, EPS};
        if (G == 256) pg8::gemm_phase<pg8::EpiResidNorm, pg8::StaticOrder, false, true>((LAS unsigned char*)lds, g, S, E, wave);
    }
#undef IN
#undef BOTH
}


extern "C" void kernel_launch(void* const* d_in, const int* in_sizes, int n_in, void* d_out, int out_size, void* d_ws, size_t ws_size, hipStream_t stream) {
    static int grid = 0;
    if (grid == 0) {
        if (n_in != 10 || in_sizes[0] != NTOK * DM || out_size != NTOK * DM || ws_size < WS_END) { fprintf(stderr, "kernel_launch: unexpected shapes / workspace (%zu)\n", ws_size); grid = -1; return; }
        int dev = 0, cus = 0, per_cu = 0;
        if (hipGetDevice(&dev) != hipSuccess || hipDeviceGetAttribute(&cus, hipDeviceAttributeMultiprocessorCount, dev) != hipSuccess) { grid = -1; return; }
        if (hipFuncSetAttribute((const void*)mk_fwd, hipFuncAttributeMaxDynamicSharedMemorySize, LDS_BYTES) != hipSuccess) { fprintf(stderr, "kernel_launch: hipFuncSetAttribute failed\n"); grid = -1; return; }
        if (hipOccupancyMaxActiveBlocksPerMultiprocessor(&per_cu, (const void*)mk_fwd, NWAVES * 64, LDS_BYTES) != hipSuccess || per_cu < 1) { fprintf(stderr, "kernel_launch: occupancy query says %d\n", per_cu); grid = -1; return; }
        grid = cus;
    }
    if (grid < 0) return;
    if (hipMemsetAsync((char*)d_ws + WS_CTL, 0, 131072, stream) != hipSuccess) { fprintf(stderr, "kernel_launch: memset failed\n"); return; }
    Args a{};
    for (int i = 0; i < 10; ++i) a.in[i] = (const float*)d_in[i];
    a.out = (float*)d_out; a.ws = (unsigned char*)d_ws; a.ph_lo = 0; a.ph_hi = 5;
    void* kargs[] = {&a};
    hipError_t e = hipLaunchCooperativeKernel((const void*)mk_fwd, dim3(grid), dim3(NWAVES * 64), kargs, LDS_BYTES, stream);
    if (e != hipSuccess) fprintf(stderr, "kernel_launch: cooperative launch failed: %s (grid %d)\n", hipGetErrorString(e), grid);
}
```

```cpp
#include <hip/hip_runtime.h>
#include <hip/hip_cooperative_groups.h>
#include <cstdio>
#include <cstdint>
#include <cmath>
namespace cg = cooperative_groups;
__device__ __forceinline__ int fresh_lane() { int l; asm volatile("v_mbcnt_lo_u32_b32 %0, -1, 0\n\tv_mbcnt_hi_u32_b32 %0, -1, %0" : "=v"(l)); return l; }
namespace pg8 {
#define PG8_LAS __attribute__((address_space(3)))
typedef unsigned short bf16_t;
typedef short bf16x8 __attribute__((ext_vector_type(8)));
typedef float f32x4 __attribute__((ext_vector_type(4)));
typedef unsigned u32x4 __attribute__((ext_vector_type(4)));
typedef int v4i_t __attribute__((ext_vector_type(4)));
constexpr int BM = 256, BK = 64, HALF = 128, HTB = HALF * BK * 2  , STAGE_BYTES = 8 * HTB, NXCD = 8, WGM = 8;

__host__ __device__ __forceinline__ int lds_byte(int r, int c) { const int st = (r >> 4) * 2 + (c >> 5), rr = r & 15, cc = c & 31, ob = rr * 64 + cc * 2; return st * 1024 + (ob ^ (((ob >> 9) & 1) << 5)); }
__host__ __device__ __forceinline__ void stage_rc(int b, int& R, int& C) { const int st = b / 1024, sb = b % 1024, swz = sb ^ (((sb >> 9) & 1) << 5); R = (st >> 1) * 16 + swz / 64; C = (st & 1) * 32 + (swz % 64) / 2; }
__host__ __device__ __forceinline__ int perm32(int rho) { const int n = rho >> 4, i = rho & 15; return 8 * (i >> 2) + 4 * n + (i & 3); }

struct Unit { int pm, pn; };
struct Gemm { const bf16_t* A; const bf16_t* Bt; int M, N, K; };

struct StaticOrder {
    int nM, nN, nwg, G, c;
    __host__ __device__ void init(int M, int N, int G_, int c_) { nM = M / BM; nN = N / BM; nwg = nM * nN; G = G_; c = c_; }
    __host__ __device__ bool next(int i, Unit& u) const { const long L = (long)i * G + c; if (L >= nwg) return false; unit_of((int)L, u); return true; }
    __host__ __device__ bool unit_of(int L, Unit& u) const {
        int wgid = L; { const int q = nwg / NXCD, r = nwg % NXCD, xcd = wgid % NXCD, off = wgid / NXCD; wgid = (xcd < r ? xcd * (q + 1) : r * (q + 1) + (xcd - r) * q) + off; }
        const int nig = WGM * nN, gid = wgid / nig, fm = gid * WGM, gsz = (nM - fm) < WGM ? (nM - fm) : WGM;
        u.pm = fm + ((wgid % nig) % gsz); u.pn = (wgid % nig) / gsz; return true;
    }
    __device__ __forceinline__ void a_ready(const Unit&) const {}
    __device__ __forceinline__ void done(const Unit&) const {}
};


typedef float f32x2_cv __attribute__((ext_vector_type(2))); typedef __bf16 bf16x2_cv __attribute__((ext_vector_type(2)));
__device__ __forceinline__ unsigned cvt_pk_bf16(float lo, float hi) { const f32x2_cv v = {lo, hi}; return __builtin_bit_cast(unsigned, __builtin_convertvector(v, bf16x2_cv)); }
typedef float f32x2 __attribute__((ext_vector_type(2)));

struct EpiRaw {
    static constexpr bool PERM = false, AFTER_DRAIN = false, FP8 = false, INIT_ACC = false; static constexpr int HOOK_T = -1;
    bf16_t* O; int ldc;
    __device__ __forceinline__ void operator()(const f32x4 (&acc)[2][2][4][2], const Unit& u, int wr, int wc, int fr, int fq) const {
        const int row0 = u.pm * BM + wr * 64 + fr, col0 = u.pn * BM + wc * 32 + 8 * fq;
#pragma unroll
        for (int ai = 0; ai < 2; ++ai)
#pragma unroll
            for (int m = 0; m < 4; ++m) { bf16_t* rowp = O + (size_t)(row0 + ai * HALF + m * 16) * ldc + col0;
#pragma unroll
                for (int bj = 0; bj < 2; ++bj) { const f32x4 v0 = acc[ai][bj][m][0], v1 = acc[ai][bj][m][1];
                    u32x4 w; w.x = cvt_pk_bf16(v0[0], v0[1]); w.y = cvt_pk_bf16(v0[2], v0[3]); w.z = cvt_pk_bf16(v1[0], v1[1]); w.w = cvt_pk_bf16(v1[2], v1[3]);
                    *(u32x4*)(rowp + bj * HALF) = w; } }
    }
};

struct EpiMerge {
    static constexpr bool PERM = false, AFTER_DRAIN = false, FP8 = false; static constexpr int HOOK_T = 16; static constexpr bool INIT_ACC = false;
    const bf16_t* Pz; int ldp, cza, czb; const float* bias; int nb; bf16_t* O; int ldc;
    __device__ __forceinline__ void mid(f32x4 (&acc)[2][2][4][2], const Unit& u, int wr, int wc, int fr, int fq) const {
        int row0 = u.pm * BM + wr * 64 + fr; asm volatile("" : "+v"(row0));
#pragma unroll
        for (int bj = 0; bj < 2; ++bj) { const int col0 = u.pn * BM + bj * HALF + wc * 32 + 8 * fq;
            const f32x4 ba0 = *(const f32x4*)(bias + col0), ba1 = *(const f32x4*)(bias + col0 + 4), bb0 = *(const f32x4*)(bias + nb + col0), bb1 = *(const f32x4*)(bias + nb + col0 + 4);
#pragma unroll
            for (int ai = 0; ai < 2; ++ai)
#pragma unroll
                for (int m = 0; m < 4; ++m) { const size_t ro = (size_t)(row0 + ai * HALF + m * 16) * ldp + col0;
                    const u32x4 za = *(const u32x4*)(Pz + ro + cza), zb = *(const u32x4*)(Pz + ro + czb);
                    f32x4 r0, r1;
#pragma unroll
                    for (int e = 0; e < 4; ++e) { const unsigned a = za[e], b = zb[e];
                        const float a_lo = __uint_as_float(a << 16), a_hi = __uint_as_float(a & 0xffff0000u), b_lo = __uint_as_float(b << 16), b_hi = __uint_as_float(b & 0xffff0000u);
                        const float ba_lo = (e < 2 ? ba0 : ba1)[(2 * e) & 3], ba_hi = (e < 2 ? ba0 : ba1)[(2 * e + 1) & 3], bb_lo = (e < 2 ? bb0 : bb1)[(2 * e) & 3], bb_hi = (e < 2 ? bb0 : bb1)[(2 * e + 1) & 3];
                        const float q_lo = (1.f + __expf(-(b_lo + bb_lo))) / (1.f + __expf(-(a_lo + ba_lo))), q_hi = (1.f + __expf(-(b_hi + bb_hi))) / (1.f + __expf(-(a_hi + ba_hi)));
                        if (e < 2) { r0[2 * e] = q_lo; r0[2 * e + 1] = q_hi; } else { r1[2 * e - 4] = q_lo; r1[2 * e - 3] = q_hi; } }
                    acc[ai][bj][m][0] *= r0; acc[ai][bj][m][1] *= r1; } }
    }
    __device__ __forceinline__ void operator()(const f32x4 (&acc)[2][2][4][2], const Unit& u, int wr, int wc, int fr, int fq) const {
        const int row0 = u.pm * BM + wr * 64 + fr;
#pragma unroll
        for (int bj = 0; bj < 2; ++bj) { const int col0 = u.pn * BM + bj * HALF + wc * 32 + 8 * fq;
            const f32x4 bb0 = *(const f32x4*)(bias + nb + col0), bb1 = *(const f32x4*)(bias + nb + col0 + 4);
#pragma unroll
            for (int ai = 0; ai < 2; ++ai)
#pragma unroll
                for (int m = 0; m < 4; ++m) { const int row = row0 + ai * HALF + m * 16;
                    const u32x4 zb = *(const u32x4*)(Pz + (size_t)row * ldp + col0 + czb);
                    float s[8];
#pragma unroll
                    for (int e = 0; e < 4; ++e) { const unsigned b = zb[e]; const float b_lo = __uint_as_float(b << 16), b_hi = __uint_as_float(b & 0xffff0000u);
                        const float bb_lo = (e < 2 ? bb0 : bb1)[(2 * e) & 3], bb_hi = (e < 2 ? bb0 : bb1)[(2 * e + 1) & 3];
                        s[2 * e] = 1.f / (1.f + __expf(-(b_lo + bb_lo))); s[2 * e + 1] = 1.f / (1.f + __expf(-(b_hi + bb_hi))); }
                    const f32x4 v0 = acc[ai][bj][m][0], v1 = acc[ai][bj][m][1];
                    u32x4 w; w.x = cvt_pk_bf16(v0[0] * s[0], v0[1] * s[1]); w.y = cvt_pk_bf16(v0[2] * s[2], v0[3] * s[3]); w.z = cvt_pk_bf16(v1[0] * s[4], v1[1] * s[5]); w.w = cvt_pk_bf16(v1[2] * s[6], v1[3] * s[7]);
                    *(u32x4*)(O + (size_t)row * ldc + col0) = w; } }
    }
};
struct EpiResid {
    static constexpr bool PERM = false, AFTER_DRAIN = false, FP8 = false, INIT_ACC = false; static constexpr int HOOK_T = -1;
    const float* base; float* out; int ldc; float* rowss;
    __device__ __forceinline__ void operator()(const f32x4 (&acc)[2][2][4][2], const Unit& u, int wr, int wc, int fr, int fq) const {
        const int row0 = u.pm * BM + wr * 64 + fr, col0 = u.pn * BM + wc * 32 + 4 * fq;
#pragma unroll
        for (int ai = 0; ai < 2; ++ai)
#pragma unroll
            for (int m = 0; m < 4; ++m) { const int row = row0 + ai * HALF + m * 16; const size_t off = (size_t)row * ldc + col0; float ss = 0.f;
#pragma unroll
                for (int bj = 0; bj < 2; ++bj)
#pragma unroll
                    for (int n = 0; n < 2; ++n) { const f32x4 o = *(const f32x4*)(base + off + bj * HALF + n * 16) + acc[ai][bj][m][n];
                        *(f32x4*)(out + off + bj * HALF + n * 16) = o; ss += (o[0] * o[0] + o[1] * o[1]) + (o[2] * o[2] + o[3] * o[3]); }
                ss += __shfl_xor(ss, 16); ss += __shfl_xor(ss, 32);
                if (fq == 0) atomicAdd(rowss + row, ss); }
    }
};


template <bool F8> struct EpiIn {
    static constexpr bool PERM = false, AFTER_DRAIN = false, FP8 = F8, INIT_ACC = false; static constexpr int HOOK_T = -1;
    bf16_t* O; int ldc; const float* cosa; const float* sina; const float* cosp; const float* sinp; const float* qg; const float* kg; const float* bias; bf16_t* SA; bf16_t* SB; PG8_LAS float* red; float eps; float sc;
    __device__ __forceinline__ static unsigned long long pk4(const f32x4 v) { return (unsigned long long)cvt_pk_bf16(v[0], v[1]) | ((unsigned long long)cvt_pk_bf16(v[2], v[3]) << 32); }
    __device__ __forceinline__ void operator()(const f32x4 (&acc)[2][2][4][2], const Unit& u, int wr, int wc, int fr_, int fq_) const {
        (void)fr_; (void)fq_; const int ln_ = fresh_lane(), fr = ln_ & 15, fq = ln_ >> 4;
        const int pn = F8 ? (u.pn < 14 ? u.pn : u.pn + 16) : u.pn + 14; const int row0 = u.pm * BM + wr * 64 + fr;
        if (pn < 5) {
#pragma unroll
            for (int ai = 0; ai < 2; ++ai)
#pragma unroll
                for (int m = 0; m < 4; ++m)
#pragma unroll
                    for (int bj = 0; bj < 2; ++bj) { const f32x4 v0 = (acc[ai][bj][m][0] * sc), v1 = (acc[ai][bj][m][1] * sc);
                        float ss = (v0[0] * v0[0] + v0[1] * v0[1]) + (v0[2] * v0[2] + v0[3] * v0[3]) + (v1[0] * v1[0] + v1[1] * v1[1]) + (v1[2] * v1[2] + v1[3] * v1[3]);
                        ss += __shfl_xor(ss, 16); ss += __shfl_xor(ss, 32);
                        if (fq == 0) red[(ai * HALF + wr * 64 + m * 16 + fr) * 8 + bj * 4 + wc] = ss; }
            asm volatile("s_waitcnt lgkmcnt(0)" ::: "memory"); __builtin_amdgcn_s_barrier(); asm volatile("" ::: "memory");
            const int half = wc >> 1, i0 = 16 * (wc & 1) + 4 * fq;
            const float* g = (pn < 4) ? qg : kg;
            const f32x4 g0 = *(const f32x4*)(g + 64 * half + i0), g1 = *(const f32x4*)(g + 64 * half + 32 + i0);
#pragma unroll
            for (int ai = 0; ai < 2; ++ai)
#pragma unroll
                for (int m = 0; m < 4; ++m) { const int row = row0 + ai * HALF + m * 16, sq = row & 2047, pos = half ? (sq & 63) : (sq >> 6);
                    const f32x4 c = *(const f32x4*)(cosa + pos * 32 + i0), sn = *(const f32x4*)(sina + pos * 32 + i0);
#pragma unroll
                    for (int bj = 0; bj < 2; ++bj) { const f32x4 pr = *(const PG8_LAS f32x4*)(red + (ai * HALF + wr * 64 + m * 16 + fr) * 8 + bj * 4);
                        const float rs = rsqrtf(((pr[0] + pr[1]) + (pr[2] + pr[3])) * (1.f / 128.f) + eps);
                        const f32x4 y0 = (acc[ai][bj][m][0] * sc) * rs * g0, y1 = (acc[ai][bj][m][1] * sc) * rs * g1;
                        const f32x4 lo = y0 * c - y1 * sn, hi = y0 * sn + y1 * c;
                        bf16_t* p = O + (size_t)row * ldc + pn * BM + bj * HALF + 64 * half + i0;
                        *(unsigned long long*)p = pk4(lo); *(unsigned long long*)(p + 32) = pk4(hi); } }
        } else if (pn >= 10 && pn < 22 && wc == 0) {
            const int i0 = 4 * fq;
#pragma unroll
            for (int ai = 0; ai < 2; ++ai)
#pragma unroll
                for (int m = 0; m < 4; ++m) { const int row = row0 + ai * HALF + m * 16, sq = row & 2047;
                    const f32x4 c = *(const f32x4*)(cosp + sq * 16 + i0), sn = *(const f32x4*)(sinp + sq * 16 + i0);
#pragma unroll
                    for (int bj = 0; bj < 2; ++bj) { const f32x4 y0 = (acc[ai][bj][m][0] * sc), y1 = (acc[ai][bj][m][1] * sc);
                        const f32x4 lo = y0 * c - y1 * sn, hi = y0 * sn + y1 * c;
                        bf16_t* p = O + (size_t)row * ldc + pn * BM + bj * HALF + i0;
                        *(unsigned long long*)p = pk4(lo); *(unsigned long long*)(p + 16) = pk4(hi); } }
        } else if (pn >= 30) {
            const int which = pn >= 38 ? 1 : 0, pnz = pn - (which ? 38 : 30);
            const float* bs = bias + which * 2048 + pnz * BM + wc * 32 + 8 * fq;
            bf16_t* dst = (which ? SB : SA) + ((((size_t)(u.pm * 8 + pnz) * 8 + (wr * 4 + wc)) * 16) * 64 + (fq * 16 + fr)) * 8;
#pragma unroll
            for (int bj = 0; bj < 2; ++bj) { const f32x4 b0 = *(const f32x4*)(bs + bj * HALF), b1 = *(const f32x4*)(bs + bj * HALF + 4);
#pragma unroll
                for (int ai = 0; ai < 2; ++ai)
#pragma unroll
                    for (int m = 0; m < 4; ++m) { const f32x4 v0 = (acc[ai][bj][m][0] * sc) + b0, v1 = (acc[ai][bj][m][1] * sc) + b1; float sg[8];
#pragma unroll
                        for (int e = 0; e < 4; ++e) { sg[e] = __builtin_amdgcn_rcpf(1.f + __builtin_amdgcn_exp2f(v0[e] * -1.4426950408889634f)); sg[4 + e] = __builtin_amdgcn_rcpf(1.f + __builtin_amdgcn_exp2f(v1[e] * -1.4426950408889634f)); }
                        u32x4 w; w.x = cvt_pk_bf16(sg[0], sg[1]); w.y = cvt_pk_bf16(sg[2], sg[3]); w.z = cvt_pk_bf16(sg[4], sg[5]); w.w = cvt_pk_bf16(sg[6], sg[7]);
                        __builtin_nontemporal_store(w, (u32x4*)(dst + (ai * 8 + bj * 4 + m) * 512)); } }
        } else {
            const bool act = (pn >= 6 && pn < 10) || pn == 28 || pn == 29;
            const int col0 = pn * BM + wc * 32 + 8 * fq;
#pragma unroll
            for (int ai = 0; ai < 2; ++ai)
#pragma unroll
                for (int m = 0; m < 4; ++m) { bf16_t* rowp = O + (size_t)(row0 + ai * HALF + m * 16) * ldc + col0;
#pragma unroll
                    for (int bj = 0; bj < 2; ++bj) { f32x4 v0 = (acc[ai][bj][m][0] * sc), v1 = (acc[ai][bj][m][1] * sc);
                        if (act) {
#pragma unroll
                            for (int e = 0; e < 4; ++e) { v0[e] = v0[e] * __builtin_amdgcn_rcpf(1.f + __builtin_amdgcn_exp2f(v0[e] * -1.4426950408889634f)); v1[e] = v1[e] * __builtin_amdgcn_rcpf(1.f + __builtin_amdgcn_exp2f(v1[e] * -1.4426950408889634f)); } }
                        u32x4 w; w.x = cvt_pk_bf16(v0[0], v0[1]); w.y = cvt_pk_bf16(v0[2], v0[3]); w.z = cvt_pk_bf16(v1[0], v1[1]); w.w = cvt_pk_bf16(v1[2], v1[3]);
                        *(u32x4*)(rowp + bj * HALF) = w; } }
        }
    }
};
struct EpiMerge2 {
    static constexpr bool PERM = false, AFTER_DRAIN = false, FP8 = false; static constexpr int HOOK_T = 16; static constexpr bool INIT_ACC = false;
    const bf16_t* SA; const bf16_t* SB; bf16_t* O; int ldc;
    __device__ __forceinline__ void mid(f32x4 (&acc)[2][2][4][2], const Unit& u, int wr, int wc, int fr, int fq) const {
        int lane = fq * 16 + fr; asm volatile("" : "+v"(lane));
        const size_t base = ((((size_t)(u.pm * 8 + u.pn) * 8 + (wr * 4 + wc)) * 16) * 64 + lane) * 8;
#pragma unroll
        for (int f = 0; f < 16; ++f) { const int ai = f >> 3, bj = (f >> 2) & 1, m = f & 3;
            const u32x4 a = __builtin_nontemporal_load((const u32x4*)(SA + base + f * 512)), b = *(const u32x4*)(SB + base + f * 512);
            f32x4 r0, r1;
#pragma unroll
            for (int e = 0; e < 4; ++e) { const float q_lo = __uint_as_float(a[e] << 16) * __builtin_amdgcn_rcpf(__uint_as_float(b[e] << 16)), q_hi = __uint_as_float(a[e] & 0xffff0000u) * __builtin_amdgcn_rcpf(__uint_as_float(b[e] & 0xffff0000u));
                if (e < 2) { r0[2 * e] = q_lo; r0[2 * e + 1] = q_hi; } else { r1[2 * e - 4] = q_lo; r1[2 * e - 3] = q_hi; } }
            acc[ai][bj][m][0] *= r0; acc[ai][bj][m][1] *= r1; }
    }
    __device__ __forceinline__ void operator()(const f32x4 (&acc)[2][2][4][2], const Unit& u, int wr, int wc, int fr_, int fq_) const {
        (void)fr_; (void)fq_; const int ln_ = fresh_lane(), fr = ln_ & 15, fq = ln_ >> 4;
        const int lane = fq * 16 + fr, row0 = u.pm * BM + wr * 64 + fr, col0 = u.pn * BM + wc * 32 + 8 * fq;
        const size_t base = ((((size_t)(u.pm * 8 + u.pn) * 8 + (wr * 4 + wc)) * 16) * 64 + lane) * 8;
#pragma unroll
        for (int f = 0; f < 16; ++f) { const int ai = f >> 3, bj = (f >> 2) & 1, m = f & 3;
            const u32x4 b = __builtin_nontemporal_load((const u32x4*)(SB + base + f * 512));
            const f32x4 v0 = acc[ai][bj][m][0], v1 = acc[ai][bj][m][1];
            u32x4 w; w.x = cvt_pk_bf16(v0[0] * __uint_as_float(b[0] << 16), v0[1] * __uint_as_float(b[0] & 0xffff0000u)); w.y = cvt_pk_bf16(v0[2] * __uint_as_float(b[1] << 16), v0[3] * __uint_as_float(b[1] & 0xffff0000u));
            w.z = cvt_pk_bf16(v1[0] * __uint_as_float(b[2] << 16), v1[1] * __uint_as_float(b[2] & 0xffff0000u)); w.w = cvt_pk_bf16(v1[2] * __uint_as_float(b[3] << 16), v1[3] * __uint_as_float(b[3] & 0xffff0000u));
            *(u32x4*)(O + (size_t)(row0 + ai * HALF + m * 16) * ldc + col0 + bj * HALF) = w; }
    }
};
struct EpiResidNorm {
    static constexpr bool PERM = false, AFTER_DRAIN = true, FP8 = false, INIT_ACC = true; static constexpr int HOOK_T = -1;
    const float* base; float* out; int ldc; const float* gain; float* xb; unsigned* cnt; int ntn; float eps;
    __device__ __forceinline__ void init(f32x4 (&acc)[2][2][4][2], const Unit& u, int wr, int wc, int fr, int fq) const {
        const int row0 = u.pm * BM + wr * 64 + fr, col0 = u.pn * BM + wc * 32 + 4 * fq;
#pragma unroll
        for (int ai = 0; ai < 2; ++ai)
#pragma unroll
            for (int m = 0; m < 4; ++m) { const size_t off = (size_t)(row0 + ai * HALF + m * 16) * ldc + col0;
#pragma unroll
                for (int bj = 0; bj < 2; ++bj)
#pragma unroll
                    for (int n = 0; n < 2; ++n) acc[ai][bj][m][n] = __builtin_nontemporal_load((const f32x4*)(base + off + bj * HALF + n * 16)); }
    }
    __device__ __forceinline__ void fused(f32x4 (&acc)[2][2][4][2], const Unit& u, int wr, int wc, int fr_, int fq_, PG8_LAS unsigned char* lds, int wid, int lane) const {
        (void)fr_; (void)fq_; const int ln_ = fresh_lane(), fr = ln_ & 15, fq = ln_ >> 4;
        PG8_LAS float* Pp = (PG8_LAS float*)lds;
        PG8_LAS float* Sr = (PG8_LAS float*)(lds + 4096);
        const int row0 = u.pm * BM + wr * 64 + fr, col0 = u.pn * BM + wc * 32 + 4 * fq;
#pragma unroll
        for (int ai = 0; ai < 2; ++ai)
#pragma unroll
            for (int m = 0; m < 4; ++m) { float ss = 0.f;
#pragma unroll
                for (int bj = 0; bj < 2; ++bj)
#pragma unroll
                    for (int n = 0; n < 2; ++n) { const f32x4 o = acc[ai][bj][m][n];
                        ss += (o[0] * o[0] + o[1] * o[1]) + (o[2] * o[2] + o[3] * o[3]); }
                ss += __shfl_xor(ss, 16); ss += __shfl_xor(ss, 32);
                if (fq == 0) Pp[(ai * HALF + wr * 64 + m * 16 + fr) * 4 + wc] = ss; }
        asm volatile("s_waitcnt lgkmcnt(0)" ::: "memory"); __builtin_amdgcn_s_barrier(); asm volatile("" ::: "memory");
        const int tid = wid * 64 + lane;
        if (tid < 256) { const f32x4 p = *(const PG8_LAS f32x4*)(Pp + tid * 4);
            __hip_atomic_store(xb + (size_t)(u.pm * BM + tid) * 8 + u.pn, (p[0] + p[1]) + (p[2] + p[3]), __ATOMIC_RELAXED, __HIP_MEMORY_SCOPE_AGENT); }
        asm volatile("s_waitcnt vmcnt(0)" ::: "memory"); __builtin_amdgcn_s_barrier(); asm volatile("" ::: "memory");
        if (tid == 0) __hip_atomic_fetch_add(cnt + 64 * u.pm, 1u, __ATOMIC_RELAXED, __HIP_MEMORY_SCOPE_AGENT);
        if (wid == 0) { unsigned spins = 0;
            while ((unsigned)__builtin_amdgcn_readfirstlane(__hip_atomic_load(cnt + 64 * u.pm, __ATOMIC_RELAXED, __HIP_MEMORY_SCOPE_AGENT)) < (unsigned)ntn) { __builtin_amdgcn_s_sleep(2); if (++spins > (1u << 22)) break; }
            __builtin_amdgcn_fence(__ATOMIC_ACQUIRE, "agent"); }
        asm volatile("s_waitcnt vmcnt(0) lgkmcnt(0)" ::: "memory"); __builtin_amdgcn_s_barrier(); asm volatile("" ::: "memory");
        if (tid < 256) { const float* slot = xb + (size_t)(u.pm * BM + tid) * 8; float tot = 0.f;
#pragma unroll
            for (int t = 0; t < 8; ++t) tot += __hip_atomic_load(slot + t, __ATOMIC_RELAXED, __HIP_MEMORY_SCOPE_AGENT);
            Sr[tid] = rsqrtf(tot * (1.0f / 2048.0f) + eps); }
        asm volatile("s_waitcnt lgkmcnt(0)" ::: "memory"); __builtin_amdgcn_s_barrier(); asm volatile("" ::: "memory");
#pragma unroll
        for (int bj = 0; bj < 2; ++bj)
#pragma unroll
            for (int n = 0; n < 2; ++n) { const f32x4 g = *(const f32x4*)(gain + col0 + bj * HALF + n * 16);
#pragma unroll
                for (int ai = 0; ai < 2; ++ai)
#pragma unroll
                    for (int m = 0; m < 4; ++m) { const int rl = ai * HALF + wr * 64 + m * 16 + fr; const float rs = Sr[rl];
                        __builtin_nontemporal_store(acc[ai][bj][m][n] * rs * g, (f32x4*)(out + (size_t)(u.pm * BM + rl) * ldc + col0 + bj * HALF + n * 16)); } }
    }
};

template <class Epi, class Sched, bool ALIGN_EPI = false, bool SP2 = false>
__device__ __forceinline__ void gemm_phase(PG8_LAS unsigned char* lds, const Gemm g, const Sched& S, const Epi& E, const int wave_) {
    const int wid = wave_, lane = fresh_lane(), tid = wid * 64 + lane, wr = wid >> 2, wc = wid & 3, fr = lane & 15, fq = lane >> 4;
    const int K = g.K, nt = K / BK;
    unsigned voffA[2], voffB[2];
#pragma unroll
    for (int i = 0; i < 2; ++i) { int R, C; stage_rc(tid * 16 + i * 8192, R, C); const int Rb = Epi::PERM ? ((R & ~31) + perm32(R & 31)) : R;
        voffA[i] = (unsigned)(R * K + C) * 2u; voffB[i] = (unsigned)(Rb * K + C) * 2u; }
    const unsigned kstep = (unsigned)(BK * 2);
    const unsigned hstep = (unsigned)HALF * (unsigned)K * 2u;
    const unsigned tstep = 2u * hstep;
    const __amdgpu_buffer_rsrc_t rs_voffA = __builtin_amdgcn_make_buffer_rsrc((void*)g.A, 0, (int)((unsigned)g.M * (unsigned)K * 2u), 0x00020000);
    const __amdgpu_buffer_rsrc_t rs_voffB = __builtin_amdgcn_make_buffer_rsrc((void*)g.Bt, 0, (int)((unsigned)g.N * (unsigned)K * 2u), 0x00020000);
    const unsigned ldsw = (unsigned)wid * 1024u;
    const int aoff = lds_byte(wr * 64 + fr, fq * 8), boff = lds_byte(wc * 32 + fr, fq * 8);
#define PG8_SA(b, h) (((b) * 2 + (h)) * HTB)
#define PG8_SB(b, h) ((4 + (b) * 2 + (h)) * HTB)
#define PG8_STAGE(bufoff, goff, voff) do { _Pragma("unroll") for (int _i = 0; _i < 2; ++_i) \
        __builtin_amdgcn_raw_ptr_buffer_load_lds(rs_##voff, (PG8_LAS void*)(lds + (bufoff) + ldsw + _i * 8192), 16, (int)(voff)[_i], (int)(goff), 0, 0); } while (0)
#define PG8_LDA(dst, b, h) do { _Pragma("unroll") for (int m = 0; m < 4; ++m) _Pragma("unroll") for (int k = 0; k < 2; ++k) dst[m][k] = *(const PG8_LAS bf16x8*)(lds + PG8_SA(b, h) + aoff + m * 2048 + k * 1024); } while (0)
#define PG8_LDB(dst, b, h) do { _Pragma("unroll") for (int n = 0; n < 2; ++n) _Pragma("unroll") for (int k = 0; k < 2; ++k) dst[n][k] = *(const PG8_LAS bf16x8*)(lds + PG8_SB(b, h) + boff + n * 2048 + k * 1024); } while (0)
#define PG8_CAT(x, y) __builtin_shufflevector(__builtin_bit_cast(v4i_t, x), __builtin_bit_cast(v4i_t, y), 0, 1, 2, 3, 4, 5, 6, 7)
#define PG8_MMA(ai, bj, At, Bt) do { __builtin_amdgcn_s_setprio(1); _Pragma("unroll") for (int m = 0; m < 4; ++m) _Pragma("unroll") for (int n = 0; n < 2; ++n) { \
        if constexpr (Epi::FP8) acc[ai][bj][m][n] = __builtin_amdgcn_mfma_scale_f32_16x16x128_f8f6f4(PG8_CAT(Bt[n][0], Bt[n][1]), PG8_CAT(At[m][0], At[m][1]), acc[ai][bj][m][n], 0, 0, 0, 0x7f7f7f7f, 0, 0x7f7f7f7f); \
        else { _Pragma("unroll") for (int k = 0; k < 2; ++k) acc[ai][bj][m][n] = __builtin_amdgcn_mfma_f32_16x16x32_bf16(Bt[n][k], At[m][k], acc[ai][bj][m][n], 0, 0, 0); } } \
        __builtin_amdgcn_s_setprio(0); } while (0)
#define PG8_WAIT_V(n) asm volatile("s_waitcnt vmcnt(" #n ")" ::: "memory")
#define PG8_WAIT_L(n) asm volatile("s_waitcnt lgkmcnt(" #n ")" ::: "memory")
#define PG8_BAR __builtin_amdgcn_s_barrier()
#define PG8_SCHED __builtin_amdgcn_sched_barrier(0)
    Unit cur, nxt; int ui = 0;
    if (!S.next(0, cur)) return;
    f32x4 acc[2][2][4][2];
    if constexpr (Epi::INIT_ACC) E.init(acc, cur, wr, wc, fr, fq);
    else {
#pragma unroll
    for (int a = 0; a < 2; ++a)
#pragma unroll
        for (int b = 0; b < 2; ++b)
#pragma unroll
            for (int m = 0; m < 4; ++m)
#pragma unroll
                for (int n = 0; n < 2; ++n) acc[a][b][m][n] = (f32x4){0.f, 0.f, 0.f, 0.f};
    }
    bf16x8 At[4][2], B0[2][2], B1[2][2];
    unsigned cA = (unsigned)cur.pm * tstep, cB = (unsigned)cur.pn * tstep;
    S.a_ready(cur);
    if constexpr (SP2) {
        PG8_STAGE(PG8_SB(0, 0), cB, voffB); PG8_STAGE(PG8_SB(0, 1), cB + hstep, voffB); PG8_STAGE(PG8_SA(0, 0), cA, voffA); PG8_STAGE(PG8_SA(0, 1), cA + hstep, voffA);
        if (wr == 1) PG8_BAR;
        PG8_WAIT_V(2); PG8_BAR;
        PG8_STAGE(PG8_SB(1, 0), cB + kstep, voffB); PG8_STAGE(PG8_SA(1, 0), cA + kstep, voffA); PG8_STAGE(PG8_SB(1, 1), cB + hstep + kstep, voffB);
        PG8_WAIT_V(6); PG8_BAR;
    } else {
        PG8_STAGE(PG8_SB(0, 0), cB, voffB); PG8_STAGE(PG8_SA(0, 0), cA, voffA); PG8_STAGE(PG8_SB(0, 1), cB + hstep, voffB); PG8_STAGE(PG8_SA(0, 1), cA + hstep, voffA);
        if (wr == 1) PG8_BAR;
        PG8_WAIT_V(4); PG8_BAR;
        PG8_STAGE(PG8_SB(1, 0), cB + kstep, voffB); PG8_STAGE(PG8_SA(1, 0), cA + kstep, voffA); PG8_STAGE(PG8_SB(1, 1), cB + hstep + kstep, voffB);
        PG8_WAIT_V(6); PG8_BAR;
    }
    for (;;) {
        const bool has_next = S.next(ui + 1, nxt);
        const unsigned nA = has_next ? (unsigned)nxt.pm * tstep : cA, nB = has_next ? (unsigned)nxt.pn * tstep : cB;
        for (int t = 0; t < nt; t += 2) {
            if constexpr (Epi::HOOK_T >= 0) { if (t == Epi::HOOK_T) E.mid(acc, cur, wr, wc, fr, fq); }
            const bool last = (t == nt - 2);
            const unsigned a1 = cA + (unsigned)(t + 1) * kstep;
            const unsigned a2 = last ? nA : cA + (unsigned)(t + 2) * kstep, b2 = last ? nB : cB + (unsigned)(t + 2) * kstep;
            const unsigned a3 = a2 + kstep, b3 = b2 + kstep;
            if (last && has_next) S.a_ready(nxt);
            if constexpr (SP2) {
            PG8_LDB(B0, 0, 0); PG8_LDB(B1, 0, 1); PG8_SCHED; PG8_LDA(At, 0, 0); PG8_STAGE(PG8_SA(1, 1), a1 + hstep, voffA);
            PG8_WAIT_V(8); PG8_WAIT_L(0); PG8_BAR; PG8_MMA(0, 0, At, B0); PG8_MMA(0, 1, At, B1); PG8_BAR; PG8_SCHED;
            PG8_LDA(At, 0, 1); PG8_STAGE(PG8_SB(0, 0), b2, voffB); PG8_STAGE(PG8_SB(0, 1), b2 + hstep, voffB); PG8_STAGE(PG8_SA(0, 0), a2, voffA);
            PG8_WAIT_V(8); PG8_WAIT_L(0); PG8_BAR; PG8_MMA(1, 0, At, B0); PG8_MMA(1, 1, At, B1); PG8_BAR; PG8_SCHED;
            PG8_LDB(B0, 1, 0); PG8_LDB(B1, 1, 1); PG8_SCHED; PG8_LDA(At, 1, 0); PG8_STAGE(PG8_SA(0, 1), a2 + hstep, voffA);
            PG8_WAIT_V(8); PG8_WAIT_L(0); PG8_BAR; PG8_MMA(0, 0, At, B0); PG8_MMA(0, 1, At, B1); PG8_BAR; PG8_SCHED;
            PG8_LDA(At, 1, 1); PG8_STAGE(PG8_SB(1, 0), b3, voffB); PG8_STAGE(PG8_SB(1, 1), b3 + hstep, voffB); PG8_STAGE(PG8_SA(1, 0), a3, voffA);
            PG8_WAIT_V(8); PG8_WAIT_L(0); PG8_BAR; PG8_MMA(1, 0, At, B0); PG8_MMA(1, 1, At, B1); PG8_BAR; PG8_SCHED;
            } else {
            PG8_LDB(B0, 0, 0); PG8_SCHED; PG8_LDA(At, 0, 0); PG8_STAGE(PG8_SA(1, 1), a1 + hstep, voffA);
            PG8_WAIT_L(8); PG8_BAR; PG8_WAIT_L(0); PG8_MMA(0, 0, At, B0); PG8_BAR; PG8_SCHED;
            PG8_LDB(B1, 0, 1); PG8_STAGE(PG8_SB(0, 0), b2, voffB);
            PG8_BAR; PG8_WAIT_L(0); PG8_MMA(0, 1, At, B1); PG8_BAR;
            PG8_LDA(At, 0, 1); PG8_STAGE(PG8_SA(0, 0), a2, voffA);
            PG8_BAR; PG8_WAIT_L(0); PG8_MMA(1, 0, At, B0); PG8_BAR; PG8_SCHED;
            PG8_STAGE(PG8_SB(0, 1), b2 + hstep, voffB);
            PG8_WAIT_V(6); PG8_BAR; PG8_MMA(1, 1, At, B1); PG8_BAR;
            PG8_LDB(B0, 1, 0); PG8_SCHED; PG8_LDA(At, 1, 0); PG8_STAGE(PG8_SA(0, 1), a2 + hstep, voffA);
            PG8_WAIT_L(8); PG8_BAR; PG8_WAIT_L(0); PG8_MMA(0, 0, At, B0); PG8_BAR; PG8_SCHED;
            PG8_LDB(B1, 1, 1); PG8_STAGE(PG8_SB(1, 0), b3, voffB);
            PG8_BAR; PG8_WAIT_L(0); PG8_MMA(0, 1, At, B1); PG8_BAR;
            PG8_LDA(At, 1, 1); PG8_STAGE(PG8_SA(1, 0), a3, voffA);
            PG8_BAR; PG8_WAIT_L(0); PG8_MMA(1, 0, At, B0); PG8_BAR; PG8_SCHED;
            PG8_STAGE(PG8_SB(1, 1), b3 + hstep, voffB);
            PG8_WAIT_V(6); PG8_BAR; PG8_MMA(1, 1, At, B1); PG8_BAR;
            }
        }
        if constexpr (ALIGN_EPI) { if (wr == 0) PG8_BAR; }
        if constexpr (!Epi::AFTER_DRAIN) { E(acc, cur, wr, wc, fr, fq); S.done(cur); }
        if (!has_next) break;
#pragma unroll
        for (int a = 0; a < 2; ++a)
#pragma unroll
            for (int b = 0; b < 2; ++b)
#pragma unroll
                for (int m = 0; m < 4; ++m)
#pragma unroll
                    for (int n = 0; n < 2; ++n) acc[a][b][m][n] = (f32x4){0.f, 0.f, 0.f, 0.f};
        cur = nxt; cA = nA; cB = nB; ++ui;
        if constexpr (ALIGN_EPI) { if (wr == 1) PG8_BAR; }
    }
    PG8_WAIT_V(0);
    if constexpr (!ALIGN_EPI) { if (wr == 0) PG8_BAR; }
    PG8_BAR;
    if constexpr (Epi::AFTER_DRAIN) { E.fused(acc, cur, wr, wc, fr, fq, lds, wid, lane); S.done(cur); }
#undef PG8_SA
#undef PG8_SB
#undef PG8_STAGE
#undef PG8_LDA
#undef PG8_LDB
#undef PG8_MMA
#undef PG8_CAT
#undef PG8_WAIT_V
#undef PG8_WAIT_L
#undef PG8_BAR
#undef PG8_SCHED
}
}

namespace att {
using bf16 = unsigned short;
constexpr int   D = 128, NW = 8, QBLK = 32, KVBLK = 64;
constexpr float SCALE = 0.088388347648318440f;
constexpr float THR = 8.f;
constexpr int SDEPTH = 2;
constexpr int LDQ = 7680, LDK = 7680;
constexpr int LDY = 1536;
constexpr size_t SHM_V = KVBLK * D * 2, SHM_K = KVBLK * D * 2, SHM_ATTN = 2 * SHM_V + 2 * SHM_K + NW * 64 * 4;
__device__ __forceinline__ float bf2f_(bf16 h) { return __uint_as_float(((unsigned)h) << 16); }
__device__ __forceinline__ bf16 f2bf_(float f) { unsigned u = __float_as_uint(f); return (bf16)((u + 0x7fffu + ((u >> 16) & 1u)) >> 16); }
using bf16x8 = __attribute__((ext_vector_type(8))) short;
using s16x4  = __attribute__((ext_vector_type(4))) short;
using f32x16 = __attribute__((ext_vector_type(16))) float;
using f32x8  = __attribute__((ext_vector_type(8))) float;
using u32x4  = __attribute__((ext_vector_type(4))) unsigned;
using f32x4_ = __attribute__((ext_vector_type(4))) float;
#define KSWZ(row, colB) ((row) * 256 + ((colB) ^ (((row) & 7) << 4)))
#define SBAR() __builtin_amdgcn_sched_barrier(0)
__device__ __forceinline__ int crow(int r, int hi) { return (r & 3) + 8 * (r >> 2) + 4 * hi; }
__device__ __forceinline__ unsigned cvtpk(float lo, float hi) {
  typedef float f32x2_c __attribute__((ext_vector_type(2))); typedef __bf16 bf16x2_c __attribute__((ext_vector_type(2)));
  const f32x2_c v = {lo, hi}; return __builtin_bit_cast(unsigned, __builtin_convertvector(v, bf16x2_c));
}
template <typename TIn> struct Stage;
template <> struct Stage<bf16>  { using T = bf16x8;
  __device__ static __forceinline__ T ld8(const bf16* p) { return *reinterpret_cast<const bf16x8*>(p); }
  __device__ static __forceinline__ bf16x8 tobf(T x) { return x; } };
template <> struct Stage<float> { using T = f32x8;
  __device__ static __forceinline__ T ld8(const float* p) { return *reinterpret_cast<const f32x8*>(p); }
  __device__ static __forceinline__ bf16x8 tobf(T x) {
    u32x4 w = {cvtpk(x[0], x[1]), cvtpk(x[2], x[3]), cvtpk(x[4], x[5]), cvtpk(x[6], x[7])}; return *reinterpret_cast<bf16x8*>(&w); } };

__device__ __forceinline__ void partialSM(f32x16& p0, f32x16& p1, float& m_reg, float& mn, float& alpha) {
  constexpr float C = SCALE * 1.4426950408889634f;
  float pmax = p0[0]; for (int r = 1; r < 16; ++r) pmax = fmaxf(pmax, p0[r]); for (int r = 0; r < 16; ++r) pmax = fmaxf(pmax, p1[r]);
  { auto rr = __builtin_amdgcn_permlane32_swap(__float_as_uint(pmax), __float_as_uint(pmax), false, false);
    pmax = fmaxf(__uint_as_float(rr[0]), __uint_as_float(rr[1])); }
  if (__builtin_expect(__all(pmax - m_reg <= THR / SCALE), 1)) { mn = m_reg; alpha = 1.f; }
  else { mn = fmaxf(m_reg, pmax); alpha = __builtin_amdgcn_exp2f((m_reg - mn) * C); m_reg = mn; }
  float mnC = -mn * C;
  for (int r = 0; r < 16; ++r) p0[r] = fmaf(p0[r], C, mnC); for (int r = 0; r < 16; ++r) p1[r] = fmaf(p1[r], C, mnC);
  for (int r = 0; r < 16; ++r) p0[r] = __builtin_amdgcn_exp2f(p0[r]);
}
__device__ __forceinline__ void finishSM(f32x16& p0, f32x16& p1, float alpha, float& l_reg, bf16x8& pa0, bf16x8& pa1, bf16x8& pa2, bf16x8& pa3) {
  for (int r = 0; r < 16; ++r) p1[r] = __builtin_amdgcn_exp2f(p1[r]);
  float ps = 0; for (int r = 0; r < 16; ++r) ps += p0[r]; for (int r = 0; r < 16; ++r) ps += p1[r];
  { auto rr = __builtin_amdgcn_permlane32_swap(__float_as_uint(ps), __float_as_uint(ps), false, false);
    ps = __uint_as_float(rr[0]) + __uint_as_float(rr[1]); }
  l_reg = l_reg * alpha + ps;
#define PK4(P, BASE, OUT) do { unsigned a0 = cvtpk(P[BASE + 0], P[BASE + 1]), a1 = cvtpk(P[BASE + 2], P[BASE + 3]);   \
    unsigned b0 = cvtpk(P[BASE + 4], P[BASE + 5]), b1 = cvtpk(P[BASE + 6], P[BASE + 7]);                              \
    auto r0 = __builtin_amdgcn_permlane32_swap(a0, b0, false, false); auto r1 = __builtin_amdgcn_permlane32_swap(a1, b1, false, false); \
    u32x4 w = {r0[0], r1[0], r0[1], r1[1]}; OUT = *reinterpret_cast<bf16x8*>(&w); } while (0)
  PK4(p0, 0, pa0); PK4(p0, 8, pa1); PK4(p1, 0, pa2); PK4(p1, 8, pa3);
#undef PK4
}
__device__ __forceinline__ void qkt(f32x16& p0, f32x16& p1, const bf16* Ks, const bf16x8* qr, int r32, int hi) {
  p0 = f32x16{}; p1 = f32x16{};
  for (int d0 = 0; d0 < 8; ++d0) { int cb = (d0 * 16 + hi * 8) * 2;
    bf16x8 b0 = *reinterpret_cast<const bf16x8*>((const char*)Ks + KSWZ(r32, cb));
    bf16x8 b1 = *reinterpret_cast<const bf16x8*>((const char*)Ks + KSWZ(32 + r32, cb));
    p0 = __builtin_amdgcn_mfma_f32_32x32x16_bf16(b0, qr[d0], p0, 0, 0, 0);
    p1 = __builtin_amdgcn_mfma_f32_32x32x16_bf16(b1, qr[d0], p1, 0, 0, 0); }
}
__device__ __forceinline__ int v_st(int k, int c) { const int kk = (k & ~0xC) | ((k & 4) << 1) | ((k & 8) >> 1); return ((kk >> 3) * 4 + (c >> 5)) * 512 + ((kk & 7) * 32 + (c & 31)) * 2; }
__device__ __forceinline__ int v_rd_base(int lane) { return ((lane & 3) << 3) | (((lane >> 2) & 3) << 6) | (((lane >> 4) & 1) << 5) | (((lane >> 5) & 1) << 8); }
constexpr int v_rd_off(int d0, int ks, int half) { return d0 * 512 + ks * 4096 + half * 2048; }
template <int OFF> __device__ __forceinline__ s16x4 tr_read(int vb) {
  s16x4 r; asm volatile("ds_read_b64_tr_b16 %0, %1 offset:%2" : "=&v"(r) : "v"(vb), "i"(OFF) : "memory"); return r;
}
template <int D0> __device__ __forceinline__ void pv_one(f32x16& od, int vb, bf16x8 pa0, bf16x8 pa1, bf16x8 pa2, bf16x8 pa3) {
  const s16x4 l0 = tr_read<v_rd_off(D0, 0, 0)>(vb), h0 = tr_read<v_rd_off(D0, 0, 1)>(vb), l1 = tr_read<v_rd_off(D0, 1, 0)>(vb), h1 = tr_read<v_rd_off(D0, 1, 1)>(vb);
  const s16x4 l2 = tr_read<v_rd_off(D0, 2, 0)>(vb), h2 = tr_read<v_rd_off(D0, 2, 1)>(vb), l3 = tr_read<v_rd_off(D0, 3, 0)>(vb), h3 = tr_read<v_rd_off(D0, 3, 1)>(vb);
  asm volatile("s_waitcnt lgkmcnt(0)" ::: "memory"); SBAR();
#define PK(L, H) (bf16x8){L[0], L[1], L[2], L[3], H[0], H[1], H[2], H[3]}
  od = __builtin_amdgcn_mfma_f32_32x32x16_bf16(pa0, PK(l0, h0), od, 0, 0, 0);
  od = __builtin_amdgcn_mfma_f32_32x32x16_bf16(pa1, PK(l1, h1), od, 0, 0, 0);
  od = __builtin_amdgcn_mfma_f32_32x32x16_bf16(pa2, PK(l2, h2), od, 0, 0, 0);
  od = __builtin_amdgcn_mfma_f32_32x32x16_bf16(pa3, PK(l3, h3), od, 0, 0, 0);
#undef PK
}
__device__ __forceinline__ void pv_d0(f32x16* o, int vb, bf16x8 pa0, bf16x8 pa1, bf16x8 pa2, bf16x8 pa3) {
  pv_one<0>(o[0], vb, pa0, pa1, pa2, pa3); pv_one<1>(o[1], vb, pa0, pa1, pa2, pa3); pv_one<2>(o[2], vb, pa0, pa1, pa2, pa3); pv_one<3>(o[3], vb, pa0, pa1, pa2, pa3);
}

__device__ __forceinline__ void attn_dense_body(const bf16* __restrict__ Qb, const bf16* __restrict__ Kh, const bf16* __restrict__ Vh,
                                                const bf16* __restrict__ Gb, bf16* __restrict__ Yb, int seq, char* lds, const int wave_) {
  using TQ = bf16; using St = Stage<bf16>; using SQ = Stage<TQ>;
  const int wid = wave_, lane = fresh_lane(), tid = wid * 64 + lane, r32 = lane & 31, hi = lane >> 5;
  bf16* V_lds = (bf16*)lds; bf16* K_lds = (bf16*)(lds + 2 * SHM_V);
  float* ws = (float*)(lds + 2 * SHM_V + 2 * SHM_K) + wid * 64; float* li_l = ws; float* al_l = ws + 32;
  float m_reg = -1e30f, l_reg = 0; f32x16 o[4] = {}; bf16x8 qr[8];
  const TQ* Qw = Qb + (long)(wid * QBLK + r32) * LDQ + hi * 8;
#pragma unroll
  for (int d0 = 0; d0 < 8; ++d0) qr[d0] = SQ::tobf(SQ::ld8(Qw + d0 * 16));
  const int sr = tid >> 4, sc = (tid & 15) * 8, vst0 = v_st(sr, sc), vst1 = v_st(32 + sr, sc);
  const unsigned toff = (unsigned)(sr * LDK + sc);
  const int vb0 = (int)(uintptr_t)V_lds + v_rd_base(lane);
  struct { typename St::T vs0, vs1, ks0, ks1; } sr_[SDEPTH];
#define SLOAD(i, k0) do { const bf16* vb_ = Vh + (long)(k0) * LDK; const bf16* kb_ = Kh + (long)(k0) * LDK; \
    sr_[i].vs0 = St::ld8(vb_ + toff); sr_[i].vs1 = St::ld8(vb_ + 32 * LDK + toff); \
    sr_[i].ks0 = St::ld8(kb_ + toff); sr_[i].ks1 = St::ld8(kb_ + 32 * LDK + toff); } while (0)
#define SWRITE(b, i) do { *(bf16x8*)((char*)V_lds + (b) * SHM_V + vst0) = St::tobf(sr_[i].vs0);          \
    *(bf16x8*)((char*)V_lds + (b) * SHM_V + vst1) = St::tobf(sr_[i].vs1); int kc = sc * 2;               \
    *(bf16x8*)((char*)K_lds + (b) * SHM_K + KSWZ(sr, kc)) = St::tobf(sr_[i].ks0);                       \
    *(bf16x8*)((char*)K_lds + (b) * SHM_K + KSWZ(32 + sr, kc)) = St::tobf(sr_[i].ks1); } while (0)
#define SWAIT() do { if constexpr (SDEPTH == 2) asm volatile("s_waitcnt vmcnt(4)" ::: "memory"); else asm volatile("s_waitcnt vmcnt(0)" ::: "memory"); } while (0)
#define RESC(a) do { if (__any((a) < 1.f)) { if (hi == 0) al_l[r32] = (a); asm volatile("s_waitcnt lgkmcnt(0)" ::: "memory"); \
    for (int d = 0; d < 4; ++d) for (int r = 0; r < 16; ++r) o[d][r] *= al_l[crow(r, hi)]; } } while (0)
  f32x16 pA0, pA1, pB0, pB1; float mnA, mnB, alA, alB; bf16x8 pa0, pa1, pa2, pa3; const int NT = seq / KVBLK;
  constexpr int SE = 0, SO = SDEPTH - 1;
  SLOAD(SE, 0); asm volatile("s_waitcnt vmcnt(0)" ::: "memory"); SWRITE(0, SE); __syncthreads();
  qkt(pA0, pA1, K_lds, qr, r32, hi); partialSM(pA0, pA1, m_reg, mnA, alA);
  SLOAD(SO, KVBLK); if constexpr (SDEPTH == 2) { if (2 < NT) SLOAD(SE, 2 * KVBLK); }
  SWAIT(); SWRITE(1, SO); __syncthreads();
  for (int j = 1; j + 1 < NT; j += 2) {
    SBAR(); qkt(pB0, pB1, (bf16*)((char*)K_lds + SHM_K), qr, r32, hi);
    finishSM(pA0, pA1, alA, l_reg, pa0, pa1, pa2, pa3); SBAR();
    SLOAD(SO, (j + SDEPTH) * KVBLK); SBAR();
    pv_d0(o, vb0, pa0, pa1, pa2, pa3); partialSM(pB0, pB1, m_reg, mnB, alB);
    __syncthreads(); SWAIT(); SWRITE(0, SE);
    RESC(alB); __syncthreads();
    SBAR(); qkt(pA0, pA1, K_lds, qr, r32, hi);
    finishSM(pB0, pB1, alB, l_reg, pa0, pa1, pa2, pa3); SBAR();
    if (SDEPTH == 1 || j + 3 < NT) SLOAD(SE, (j + 1 + SDEPTH) * KVBLK); SBAR();
    pv_d0(o, vb0 + (int)SHM_V, pa0, pa1, pa2, pa3); partialSM(pA0, pA1, m_reg, mnA, alA);
    __syncthreads(); SWAIT(); SWRITE(1, SO);
    RESC(alA); __syncthreads();
  }
  SBAR(); qkt(pB0, pB1, (bf16*)((char*)K_lds + SHM_K), qr, r32, hi);
  finishSM(pA0, pA1, alA, l_reg, pa0, pa1, pa2, pa3); SBAR();
  pv_d0(o, vb0, pa0, pa1, pa2, pa3); partialSM(pB0, pB1, m_reg, mnB, alB);
  __syncthreads(); RESC(alB);
  finishSM(pB0, pB1, alB, l_reg, pa0, pa1, pa2, pa3); SBAR();
  pv_d0(o, vb0 + (int)SHM_V, pa0, pa1, pa2, pa3);
  if (hi == 0) li_l[r32] = l_reg; asm volatile("s_waitcnt lgkmcnt(0)" ::: "memory");
  float rli[16];
#pragma unroll
  for (int r = 0; r < 16; ++r) rli[r] = __builtin_amdgcn_rcpf(li_l[crow(r, hi)]);
  __syncthreads();
  { float* stg = (float*)(lds + wid * 16384);
#pragma unroll
    for (int r = 0; r < 16; ++r) { const int orow = crow(r, hi);
#pragma unroll
      for (int d0 = 0; d0 < 4; ++d0) stg[orow * 128 + d0 * 32 + r32] = o[d0][r] * rli[r]; }
    asm volatile("s_waitcnt lgkmcnt(0)" ::: "memory");
    const int ch = lane & 15, rb = lane >> 4;
    const bf16* Gw = Gb + (long)(wid * QBLK + rb) * LDQ + ch * 8; bf16* Yw = Yb + (long)(wid * QBLK + rb) * LDY + ch * 8;
    u32x4 gq[8];
#pragma unroll
    for (int i = 0; i < 8; ++i) gq[i] = *(const u32x4*)(Gw + (long)(4 * i) * LDQ);
#pragma unroll
    for (int i = 0; i < 8; ++i) { const float* sp = stg + (4 * i + rb) * 128 + ch * 8;
      const f32x4_ a = *(const f32x4_*)sp, b = *(const f32x4_*)(sp + 4); u32x4 w;
      w[0] = cvtpk(a[0] * __uint_as_float(gq[i][0] << 16), a[1] * __uint_as_float(gq[i][0] & 0xffff0000u));
      w[1] = cvtpk(a[2] * __uint_as_float(gq[i][1] << 16), a[3] * __uint_as_float(gq[i][1] & 0xffff0000u));
      w[2] = cvtpk(b[0] * __uint_as_float(gq[i][2] << 16), b[1] * __uint_as_float(gq[i][2] & 0xffff0000u));
      w[3] = cvtpk(b[2] * __uint_as_float(gq[i][3] << 16), b[3] * __uint_as_float(gq[i][3] & 0xffff0000u));
      *(u32x4*)(Yw + (long)(4 * i) * LDY) = w; } }
  __syncthreads();
#undef SLOAD
#undef SWRITE
#undef SWAIT
#undef RESC
}

__device__ __forceinline__ void attn_band_unit(const bf16* __restrict__ P, bf16* __restrict__ OG, float* __restrict__ LSE, int g, int b, int h, int blk, int cqb, int ckb, int cvb, int seqlen, int ntok, char* lds, const int wave_) {
  using St = Stage<bf16>;
  const int wid = wave_, lane = fresh_lane(), tid = wid * 64 + lane, r32 = lane & 31, hi = lane >> 5;
  bf16* V_lds = (bf16*)lds; bf16* K_lds = (bf16*)(lds + 2 * SHM_V);
  float* ws = (float*)(lds + 2 * SHM_V + 2 * SHM_K) + wid * 64; float* li_l = ws; float* al_l = ws + 32;
  const int dil = (g == 0) ? 1 : (g == 1 ? 4 : 16), head = g * 4 + h;
  int rq, lq0, ntile, t_lo, res0;
  if (g < 2) { const int kb = (g == 0) ? blk : (blk & 1), nt_all = seqlen / dil / 64; res0 = (g == 0) ? 0 : (blk >> 1);
    rq = res0; lq0 = 256 * kb + 32 * wid; t_lo = (4 * kb - 1 < 0) ? 0 : 4 * kb - 1; const int t_hi = (4 * kb + 5 > nt_all) ? nt_all : 4 * kb + 5; ntile = t_hi - t_lo; }
  else { res0 = 2 * blk; rq = res0 + (wid >> 2); lq0 = 32 * (wid & 3); t_lo = 0; ntile = 4; }
  const long tok0 = (long)b * seqlen;
  const bf16* Pq = P + cqb + head * D; const bf16* Pk = P + ckb + head * D; const bf16* Pv = P + cvb + head * D;
  float m_reg = -1e30f, l_reg = 0; f32x16 o[4] = {}; bf16x8 qr[8];
  { const bf16* Qw = Pq + (tok0 + (long)(lq0 + r32) * dil + rq) * LDQ + hi * 8;
#pragma unroll
    for (int d0 = 0; d0 < 8; ++d0) qr[d0] = St::ld8(Qw + d0 * 16); }
  const int sr = tid >> 4, sc = (tid & 15) * 8, vst0 = v_st(sr, sc), vst1 = v_st(32 + sr, sc);
  const int vb0 = (int)(uintptr_t)V_lds + v_rd_base(lane);
  typename St::T vs0, vs1, ks0, ks1, vt0, vt1, kt0, kt1;
#define TILE_RK(tt) ((g < 2) ? res0 : res0 + ((tt) >> 1))
#define TILE_LK0(tt) ((g < 2) ? 64 * (t_lo + (tt)) : 64 * ((tt) & 1))
#define BLOAD(tt, V0, V1, K0, K1) do { const int rk_ = TILE_RK(tt), lk_ = TILE_LK0(tt); const long ta = (tok0 + (long)(lk_ + sr) * dil + rk_) * LDK + sc, tb = (tok0 + (long)(lk_ + 32 + sr) * dil + rk_) * LDK + sc; \
    V0 = St::ld8(Pv + ta); V1 = St::ld8(Pv + tb); K0 = St::ld8(Pk + ta); K1 = St::ld8(Pk + tb); } while (0)
#define BWRITE(V0, V1, K0, K1) do { *(bf16x8*)((char*)V_lds + vst0) = V0; *(bf16x8*)((char*)V_lds + vst1) = V1; const int kc = sc * 2; \
    *(bf16x8*)((char*)K_lds + KSWZ(sr, kc)) = K0; *(bf16x8*)((char*)K_lds + KSWZ(32 + sr, kc)) = K1; } while (0)
#define BCOMPUTE(tt) do { const int rk = TILE_RK(tt), lk0 = TILE_LK0(tt); \
    const bool need = (rk == rq) && (lk0 + 63 >= lq0 - 64) && (lk0 <= lq0 + 95); \
    if (need) { \
      f32x16 p0, p1; float mn, alpha; bf16x8 pa0, pa1, pa2, pa3; \
      qkt(p0, p1, K_lds, qr, r32, hi); \
      const int dd = lk0 - lq0 - r32 + 4 * hi;                      \
      _Pragma("unroll") for (int r = 0; r < 16; ++r) { const int d0_ = dd + (r & 3) + 8 * (r >> 2), d1_ = d0_ + 32; \
        if (d0_ < -64 || d0_ > 64) p0[r] = -INFINITY; if (d1_ < -64 || d1_ > 64) p1[r] = -INFINITY; } \
      partialSM(p0, p1, m_reg, mn, alpha); \
      if (__any(alpha < 1.f)) { if (hi == 0) al_l[r32] = alpha; asm volatile("s_waitcnt lgkmcnt(0)" ::: "memory"); \
        _Pragma("unroll") for (int d = 0; d < 4; ++d) _Pragma("unroll") for (int r = 0; r < 16; ++r) o[d][r] *= al_l[crow(r, hi)]; } \
      finishSM(p0, p1, alpha, l_reg, pa0, pa1, pa2, pa3); SBAR(); \
      pv_d0(o, vb0, pa0, pa1, pa2, pa3); \
    } } while (0)
  BLOAD(0, vs0, vs1, ks0, ks1); if (ntile > 1) BLOAD(1, vt0, vt1, kt0, kt1);
  for (int tt = 0; tt < ntile; tt += 2) {
    __syncthreads();
    BWRITE(vs0, vs1, ks0, ks1);
    __syncthreads();
    if (tt + 2 < ntile) BLOAD(tt + 2, vs0, vs1, ks0, ks1);
    BCOMPUTE(tt);
    if (tt + 1 < ntile) {
      __syncthreads();
      BWRITE(vt0, vt1, kt0, kt1);
      __syncthreads();
      if (tt + 3 < ntile) BLOAD(tt + 3, vt0, vt1, kt0, kt1);
      BCOMPUTE(tt + 1);
    }
  }
#undef BWRITE
#undef BCOMPUTE
#undef BLOAD
#undef TILE_RK
#undef TILE_LK0
  if (hi == 0) li_l[r32] = l_reg; asm volatile("s_waitcnt lgkmcnt(0)" ::: "memory");
  float rli[16];
#pragma unroll
  for (int r = 0; r < 16; ++r) rli[r] = __builtin_amdgcn_rcpf(li_l[crow(r, hi)]);
  __syncthreads();
  { float* stg = (float*)(lds + wid * 16384);
#pragma unroll
    for (int r = 0; r < 16; ++r) { const int orow = crow(r, hi);
#pragma unroll
      for (int d0 = 0; d0 < 4; ++d0) stg[orow * 128 + d0 * 32 + r32] = o[d0][r] * rli[r]; }
    asm volatile("s_waitcnt lgkmcnt(0)" ::: "memory");
    const int ch = lane & 15, rb = lane >> 4;
    bf16* Og = OG + (long)g * ntok * 512 + h * D + ch * 8;
#pragma unroll
    for (int i = 0; i < 8; ++i) { const int row = 4 * i + rb; const float* sp = stg + row * 128 + ch * 8;
      const f32x4_ a = *(const f32x4_*)sp, b = *(const f32x4_*)(sp + 4); u32x4 w;
      w[0] = cvtpk(a[0], a[1]); w[1] = cvtpk(a[2], a[3]); w[2] = cvtpk(b[0], b[1]); w[3] = cvtpk(b[2], b[3]);
      *(u32x4*)(Og + (tok0 + (long)(lq0 + row) * dil + rq) * 512) = w; } }
  if (hi == 0) LSE[((long)g * ntok + tok0 + (long)(lq0 + r32) * dil + rq) * 4 + h] = m_reg * SCALE + __logf(l_reg);
  __syncthreads();
}
}

typedef unsigned short bf16_t;
constexpr int BATCH = 4, SEQ = 2048, DM = 2048, NTOK = BATCH * SEQ, NC = 11776;
constexpr int C_QA = 0, C_KA = 1024, C_VA = 1280, C_GA = 1536, C_QB = 2560, C_KB = 4096, C_VB = 5632, C_GB = 7168, C_ZA = 7680, C_ZB = 9728;
constexpr float EPS = 1e-6f;
constexpr float H8_SCALE = 4.0f, W8_SCALE = 64.0f;
constexpr size_t MiB = 1u << 20;
constexpr int PITCH = 7680;
constexpr size_t WS_CTL = 0, WS_TAB = 1 * MiB, WS_XB = 1 * MiB + 512 * 1024, WS_WTIN = 2 * MiB, WS_WTAB = 48 * MiB, WS_WTO = 54 * MiB, WS_HB = 64 * MiB, WS_P = 96 * MiB, WS_Y = 216 * MiB, WS_OG = 240 * MiB, WS_LSE = 264 * MiB,
                 WS_SA = 266 * MiB, WS_SB = 298 * MiB, WS_H8 = 330 * MiB, WS_WTZ8 = 346 * MiB, WS_END = 361 * MiB;

#define LAS __attribute__((address_space(3)))
typedef float f32x4 __attribute__((ext_vector_type(4)));
typedef unsigned v4u __attribute__((ext_vector_type(4)));
constexpr int NWAVES = 8;
constexpr int LDS_BYTES = 147456;

__device__ __forceinline__ float bf2f(bf16_t h) { return __uint_as_float(((unsigned)h) << 16); }
__device__ __forceinline__ unsigned f2bf_u(float f) { unsigned u = __float_as_uint(f); return (u + 0x7fffu + ((u >> 16) & 1u)) >> 16; }
__device__ __forceinline__ bf16_t f2bf(float f) { return (bf16_t)f2bf_u(f); }
__device__ __forceinline__ unsigned pk2(float lo, float hi) { return f2bf_u(lo) | (f2bf_u(hi) << 16); }
__device__ __forceinline__ float wave_sum(float v) {
#pragma unroll
    for (int o = 1; o < 64; o <<= 1) v += __shfl_xor(v, o);
    return v;
}
__device__ __forceinline__ float silu(float v) { return v / (1.f + __expf(-v)); }

__device__ __forceinline__ int colmap(int kind, int p) {
    const int bj = p >> 7, wc = (p >> 5) & 3, n = (p >> 4) & 1, fq = (p >> 2) & 3, j = p & 3;
    const int gen = 128 * bj + 32 * wc + 8 * fq + 4 * n + j;
    if (kind == 0) return p;
    if (kind == 1) return gen;
    if (kind == 2) return 128 * bj + 64 * (wc >> 1) + 32 * n + 16 * (wc & 1) + 4 * fq + j;
    return wc == 0 ? p : gen;
}
__device__ __forceinline__ int kind_in(int pn) { return pn < 5 ? 2 : ((pn >= 10 && pn < 22) ? 3 : 1); }

struct TrSrc { const float* W; int N; bf16_t* WT; int ldt, koff, kindsel; unsigned char* wt8; int n8; };
__device__ __forceinline__ void tr_load(const TrSrc& t, int item, int lane, f32x4 (&v)[8]) {
    const int nblk = t.N / 32, kb = item / nblk, nb = item % nblk, k0 = 64 * kb, n0 = 32 * nb;
    const int np = n0 + 4 * (lane & 7), pn = np >> 8;
    const int kind = t.kindsel < 0 ? kind_in(pn) : t.kindsel;
    const float* src = t.W + (size_t)(k0 + (lane >> 3)) * t.N + (pn << 8) + colmap(kind, np & 255);
#pragma unroll
    for (int i = 0; i < 8; ++i) v[i] = __builtin_nontemporal_load((const f32x4*)(src + (size_t)(8 * i) * t.N));
}
__device__ __forceinline__ void tr_store(const TrSrc& t, int item, int lane, const f32x4 (&v)[8], LAS float* scr) {
    const int nblk = t.N / 32, kb = item / nblk, nb = item % nblk, k0 = 64 * kb, n0 = 32 * nb;
    { LAS float* d = scr + (lane >> 3) * 33 + 4 * (lane & 7);
#pragma unroll
      for (int i = 0; i < 8; ++i) { d[i * 264 + 0] = v[i][0]; d[i * 264 + 1] = v[i][1]; d[i * 264 + 2] = v[i][2]; d[i * 264 + 3] = v[i][3]; } }
    asm volatile("s_waitcnt lgkmcnt(0)" ::: "memory");
    const int c = lane & 7;
    const int pn_ = n0 >> 8; const bool is8 = t.wt8 != nullptr && (n0 >= t.n8 || pn_ < 14);
    const int n8row = n0 >= t.n8 ? n0 - t.n8 + 14 * 256 : n0;
    if (is8) {
#pragma unroll
        for (int j = 0; j < 4; ++j) { const int n = (lane >> 3) + 8 * j; const LAS float* sp = scr + (8 * c) * 33 + n;
            int lo = 0, hi = 0;
            lo = __builtin_amdgcn_cvt_pk_fp8_f32(sp[0 * 33] * W8_SCALE, sp[1 * 33] * W8_SCALE, lo, false); lo = __builtin_amdgcn_cvt_pk_fp8_f32(sp[2 * 33] * W8_SCALE, sp[3 * 33] * W8_SCALE, lo, true);
            hi = __builtin_amdgcn_cvt_pk_fp8_f32(sp[4 * 33] * W8_SCALE, sp[5 * 33] * W8_SCALE, hi, false); hi = __builtin_amdgcn_cvt_pk_fp8_f32(sp[6 * 33] * W8_SCALE, sp[7 * 33] * W8_SCALE, hi, true);
            *(unsigned long long*)(t.wt8 + (size_t)(n8row + n) * t.ldt + k0 + 8 * c) = (unsigned long long)(unsigned)lo | ((unsigned long long)(unsigned)hi << 32); }
    } else {
#pragma unroll
    for (int j = 0; j < 4; ++j) { const int n = (lane >> 3) + 8 * j; const LAS float* sp = scr + (8 * c) * 33 + n;
        v4u o; o.x = pk2(sp[0 * 33], sp[1 * 33]); o.y = pk2(sp[2 * 33], sp[3 * 33]); o.z = pk2(sp[4 * 33], sp[5 * 33]); o.w = pk2(sp[6 * 33], sp[7 * 33]);
        *(v4u*)(t.WT + (size_t)(n0 + n) * t.ldt + t.koff + k0 + 8 * c) = o; }
    }
    asm volatile("s_waitcnt lgkmcnt(0)" ::: "memory");
}
__device__ __forceinline__ void tr_matrix(const TrSrc& t, int nitems, int gw, int NGW, int lane, LAS float* scr) {
    f32x4 a[8], b[8];
    int it = gw;
    if (it < nitems) tr_load(t, it, lane, a);
    for (; it < nitems; it += 2 * NGW) {
        const bool hb = it + NGW < nitems;
        if (hb) tr_load(t, it + NGW, lane, b);
        tr_store(t, it, lane, a, scr);
        if (hb) { if (it + 2 * NGW < nitems) tr_load(t, it + 2 * NGW, lane, a); tr_store(t, it + NGW, lane, b, scr); }
    }
}
__device__ __forceinline__ void rms_row_load(const float* xrow, int lane, f32x4 (&v)[8]) {
    const f32x4* xr = (const f32x4*)xrow + lane;
#pragma unroll
    for (int j = 0; j < 8; ++j) v[j] = __builtin_nontemporal_load(xr + 64 * j);
}
__device__ __forceinline__ void rms_row_store(const f32x4 (&v)[8], const float* gain, bf16_t* orow, unsigned char* orow8, int lane) {
    const f32x4* gr = (const f32x4*)gain + lane; float s = 0.f;
#pragma unroll
    for (int j = 0; j < 8; ++j) s += (v[j].x * v[j].x + v[j].y * v[j].y) + (v[j].z * v[j].z + v[j].w * v[j].w);
    const float rs = rsqrtf(wave_sum(s) * (1.f / DM) + EPS);
    unsigned long long* o8 = (unsigned long long*)orow + lane;
    unsigned* q8 = (unsigned*)orow8 + lane;
#pragma unroll
    for (int j = 0; j < 8; ++j) { const f32x4 g = gr[64 * j]; const f32x4 y = v[j] * rs * g;
        o8[64 * j] = (unsigned long long)pk2(y.x, y.y) | ((unsigned long long)pk2(y.z, y.w) << 32);
        int w = 0; w = __builtin_amdgcn_cvt_pk_fp8_f32(y.x * H8_SCALE, y.y * H8_SCALE, w, false); w = __builtin_amdgcn_cvt_pk_fp8_f32(y.z * H8_SCALE, y.w * H8_SCALE, w, true);
        q8[64 * j] = (unsigned)w; }
}
__device__ __forceinline__ void rms_rows(const float* x, const float* gain, bf16_t* H, unsigned char* H8, int m0, int step, int nrows, int lane) {
    f32x4 a[8], b[8];
    int m = m0;
    if (m < nrows) rms_row_load(x + (size_t)m * DM, lane, a);
    for (; m < nrows; m += 2 * step) {
        const bool hb = m + step < nrows;
        if (hb) rms_row_load(x + (size_t)(m + step) * DM, lane, b);
        rms_row_store(a, gain, H + (size_t)m * DM, H8 + (size_t)m * DM, lane);
        if (hb) { if (m + 2 * step < nrows) rms_row_load(x + (size_t)(m + 2 * step) * DM, lane, a); rms_row_store(b, gain, H + (size_t)(m + step) * DM, H8 + (size_t)(m + step) * DM, lane); }
    }
}

#define XB_TMO      128
#define XB_XCNT(j)  (256  + 64 * (j))
#define XB_XSUB(j)  (1280 + 64 * (j))
#define XB_XGEN(j)  (2304 + 64 * (j))
#define XB_TOP      3328
#define XB_TOPGEN   3392
#define XCD_BAR_WORDS 3456
#define XB_SPIN_CAP (1u << 18)

__device__ __forceinline__ unsigned xb_ld(unsigned* p)              { return __hip_atomic_load(p, __ATOMIC_RELAXED, __HIP_MEMORY_SCOPE_AGENT); }
__device__ __forceinline__ unsigned xb_add(unsigned* p, unsigned v) { return __hip_atomic_fetch_add(p, v, __ATOMIC_RELAXED, __HIP_MEMORY_SCOPE_AGENT); }
__device__ __forceinline__ unsigned xb_xcc_id() { return (unsigned)__builtin_amdgcn_s_getreg((3 << 11) | 20) & 0xFu; }
#define XB_SPIN(cond, bar) do { unsigned _sp = 0; while (cond) { __builtin_amdgcn_s_sleep(1); \
    if ((++_sp & 255u) == 0u) { if (xb_ld(&(bar)[XB_TMO])) break; if (_sp > XB_SPIN_CAP) { atomicAdd(&(bar)[XB_TMO], 1u); break; } } } } while (0)

struct XcdBarrier {
    unsigned* bar; unsigned x;
    volatile LAS unsigned* st;
};

__device__ __forceinline__ XcdBarrier xcd_barrier_post(unsigned* bar, volatile LAS unsigned* st) {
    XcdBarrier b; b.bar = bar; b.x = xb_xcc_id(); b.st = st;
    if (threadIdx.x == 0) (void)xb_add(&bar[XB_XCNT(b.x)], 1u);
    return b;
}
__device__ __forceinline__ void xcd_barrier_complete(unsigned* bar, unsigned x, unsigned& nloc, unsigned& nx) {
    const unsigned G = gridDim.x * gridDim.y * gridDim.z;
    unsigned sum, cnt, mine, sp = 0u;
    for (;;) {
        sum = 0u; cnt = 0u; mine = 0u;
#pragma unroll
        for (unsigned j = 0; j < 16; ++j) { const unsigned c = xb_ld(&bar[XB_XCNT(j)]); sum += c; cnt += (c > 0u) ? 1u : 0u; mine = (j == x) ? c : mine; }
        if (sum == G) break;
        __builtin_amdgcn_s_sleep(1);
        if ((++sp & 255u) == 0u) { if (xb_ld(&bar[XB_TMO])) break; if (sp > XB_SPIN_CAP) { atomicAdd(&bar[XB_TMO], 1u); break; } }
    }
    nloc = mine > 0u ? mine : 1u; nx = cnt > 0u ? cnt : 1u;
}

__device__ __forceinline__ void xcd_barrier(const XcdBarrier& b, const int wave_) {
    asm volatile("s_waitcnt vmcnt(0)" ::: "memory");
    __syncthreads();
    if (wave_ == 0 && fresh_lane() == 0) {
        unsigned* bar = b.bar;
        __builtin_amdgcn_s_waitcnt(0);
        unsigned nloc = b.st[0], nx = b.st[1];
        if (nloc == 0u) { xcd_barrier_complete(bar, b.x, nloc, nx); b.st[0] = nloc; b.st[1] = nx; }
        const unsigned old = xb_add(&bar[XB_XSUB(b.x)], 1u);
        const unsigned gen = old / nloc;
        if (old + 1u == (gen + 1u) * nloc) {
            __builtin_amdgcn_fence(__ATOMIC_RELEASE, "agent");
            asm volatile("s_waitcnt vmcnt(0)" ::: "memory");
            const unsigned og = xb_add(&bar[XB_TOP], 1u);
            const unsigned tg = og / nx;
            if (og + 1u == (tg + 1u) * nx) xb_add(&bar[XB_TOPGEN], 1u);
            else XB_SPIN(xb_ld(&bar[XB_TOPGEN]) == tg, bar);
            __builtin_amdgcn_fence(__ATOMIC_ACQUIRE, "agent");
            xb_add(&bar[XB_XGEN(b.x)], 1u);
            asm volatile("s_waitcnt vmcnt(0)" ::: "memory");
        } else {
            XB_SPIN(xb_ld(&bar[XB_XGEN(b.x)]) == gen, bar);
            __builtin_amdgcn_fence(__ATOMIC_ACQUIRE, "agent");
            asm volatile("s_waitcnt vmcnt(0)" ::: "memory");
        }
    }
    __syncthreads();
}

struct Args { const float* in[10]; float* out; unsigned char* ws; int ph_lo, ph_hi; };

__global__ void __launch_bounds__(NWAVES * 64, 2) mk_fwd(Args args) {
    extern __shared__ __attribute__((aligned(16))) unsigned char lds[];
    const int wave = __builtin_amdgcn_readfirstlane((int)threadIdx.x >> 6);
#define TID_LANE const int lane = fresh_lane(); const int tid = wave * 64 + lane; (void)tid; (void)lane;
    const int G = gridDim.x, bx = blockIdx.x;
    const int vcu = (G % 8 == 0) ? (bx % 8) * (G / 8) + bx / 8 : bx;
    unsigned char* ws = args.ws;
    const float* x = args.in[0]; const float* ng = args.in[1]; const float* w_in = args.in[2];
    bf16_t* WT_IN = (bf16_t*)(ws + WS_WTIN); bf16_t* HB = (bf16_t*)(ws + WS_HB); bf16_t* P = (bf16_t*)(ws + WS_P);
    float* COSA = (float*)(ws + WS_TAB); float* SINA = COSA + 2048; float* COSP = COSA + 4096; float* SINP = COSP + 32768;
    bf16_t* OG = (bf16_t*)(ws + WS_OG); float* LSE = (float*)(ws + WS_LSE); unsigned* CTL = (unsigned*)(ws + WS_CTL) + 4096;
    bf16_t* WT_AB = (bf16_t*)(ws + WS_WTAB); bf16_t* WT_O = (bf16_t*)(ws + WS_WTO); bf16_t* Y = (bf16_t*)(ws + WS_Y); bf16_t* MG = HB; unsigned char* H8 = ws + WS_H8; unsigned char* WTZ8 = ws + WS_WTZ8; bf16_t* SA = (bf16_t*)(ws + WS_SA); bf16_t* SB = (bf16_t*)(ws + WS_SB); float* XB = (float*)(ws + WS_XB); unsigned* PCNT = (unsigned*)(ws + WS_CTL) + 8192;
    const int lo = args.ph_lo, hi = args.ph_hi;
    volatile LAS unsigned* MISC = (volatile LAS unsigned*)((LAS unsigned char*)lds + 131072 + 320);
    if (threadIdx.x < 32) MISC[threadIdx.x] = 0u;
    __syncthreads();
    XcdBarrier bar = xcd_barrier_post((unsigned*)(ws + WS_CTL), MISC + 8);
#define GRID_BAR() xcd_barrier(bar, wave)
#define IN(k) (lo <= (k) && (k) < hi)
#define BOTH(k) (IN(k) && IN((k) + 1))
    if (IN(0)) { TID_LANE
        LAS float* scr = (LAS float*)((LAS unsigned char*)lds + wave * 16384);
        const int gw = vcu * NWAVES + wave, NGW = G * NWAVES;
        constexpr int I_IN = (DM / 64) * (NC / 32);
        { const TrSrc t{w_in, NC, WT_IN, DM, 0, -1, WTZ8, 7680}; tr_matrix(t, I_IN, gw, NGW, lane, scr); }
        for (int i = bx * (NWAVES * 64) + tid; i < 2048 + 32768; i += G * NWAVES * 64) {
            if (i < 2048) { const int pos = i >> 5, fi = i & 31; const float a = (float)pos * (1.0f / powf(10000.0f, (float)fi / 32.0f)); COSA[i] = cosf(a); SINA[i] = sinf(a); }
            else { const int k = i - 2048, pos = k >> 4, fi = k & 15; const float a = (float)pos * (1.0f / powf(500000.0f, (float)fi / 16.0f)); COSP[k] = cosf(a); SINP[k] = sinf(a); }
        }
        rms_rows(x, ng, HB, H8, gw, NGW, NTOK, lane);
        if (BOTH(0)) GRID_BAR();
    }
    if (IN(1)) { TID_LANE
        const float dsc = 1.0f / (H8_SCALE * W8_SCALE);
        {
            pg8::Gemm g{HB, WT_IN + (size_t)14 * 256 * DM, NTOK, 16 * 256, DM}; pg8::StaticOrder S; S.init(NTOK, 16 * 256, G, bx);
            pg8::EpiIn<false> E{P, PITCH, COSA, SINA, COSP, SINP, args.in[3], args.in[4], args.in[5], SA, SB, (LAS float*)((LAS unsigned char*)lds + 131072 + 1024), EPS, 1.0f};
            pg8::gemm_phase<pg8::EpiIn<false>, pg8::StaticOrder, true, true>((LAS unsigned char*)lds, g, S, E, wave);
        }
        {
            pg8::Gemm g8{(const bf16_t*)H8, (const bf16_t*)WTZ8, NTOK, 30 * 256, DM / 2}; pg8::StaticOrder S8; S8.init(NTOK, 30 * 256, G, bx);
            pg8::EpiIn<true> E8{P, PITCH, COSA, SINA, COSP, SINP, args.in[3], args.in[4], args.in[5], SA, SB, (LAS float*)((LAS unsigned char*)lds + 131072 + 1024), EPS, dsc};
            pg8::gemm_phase<pg8::EpiIn<true>, pg8::StaticOrder, true, true>((LAS unsigned char*)lds, g8, S8, E8, wave);
        }
        const int nheavy = ((NTOK / 256) * 30) % G;
        {
            const int first = nheavy > 0 ? nheavy : 0, nidle = G - first;
            if (bx >= first) {
                LAS float* scr = (LAS float*)((LAS unsigned char*)lds + wave * 16384);
                const int gw2 = (bx - first) * NWAVES + wave, NGW2 = nidle * NWAVES;
                constexpr int I_A = (1024 / 64) * (DM / 32), I_B = (512 / 64) * (DM / 32), I_O = (DM / 64) * (DM / 32);
                { const TrSrc t{args.in[6], DM, WT_AB, 1536, 0, 1, nullptr, 0}; tr_matrix(t, I_A, gw2, NGW2, lane, scr); }
                { const TrSrc t{args.in[7], DM, WT_AB, 1536, 1024, 1, nullptr, 0}; tr_matrix(t, I_B, gw2, NGW2, lane, scr); }
                { const TrSrc t{args.in[8], DM, WT_O, DM, 0, 0, nullptr, 0}; tr_matrix(t, I_O, gw2, NGW2, lane, scr); }
            }
        }
        if (BOTH(1)) GRID_BAR();
    }
    if (IN(2)) { TID_LANE
        for (int u = bx; u < 384; u += G) {
            const int blk = u & 7, h = (u >> 3) & 3, b = (u >> 5) & 3, g = u >> 7;
            att::attn_band_unit(P, OG, LSE, g, b, h, blk, C_QB, C_KB, C_VB, SEQ, NTOK, (char*)lds, wave);
        }
        asm volatile("s_waitcnt vmcnt(0)" ::: "memory"); __syncthreads();
        if (tid == 0) { __builtin_amdgcn_fence(__ATOMIC_RELEASE, "agent"); asm volatile("s_waitcnt vmcnt(0)" ::: "memory"); __hip_atomic_fetch_add(CTL, 1u, __ATOMIC_RELAXED, __HIP_MEMORY_SCOPE_AGENT); }
        for (int u = bx; u < 256; u += G) {
            const int pair = u & 7, inner = u >> 3, b = pair >> 1, hkv = pair & 1, hq = hkv * 4 + (inner >> 3), qb = inner & 7;
            const size_t row0 = (size_t)b * SEQ + qb * 256;
            att::attn_dense_body(P + row0 * PITCH + C_QA + hq * 128, P + (size_t)b * SEQ * PITCH + C_KA + hkv * 128, P + (size_t)b * SEQ * PITCH + C_VA + hkv * 128,
                                 P + row0 * PITCH + C_GA + hq * 128, Y + row0 * 1536 + hq * 128, SEQ, (char*)lds, wave);
        }
        const int mfirst = (384 - G > 0 && 384 - G < G) ? 384 - G : 0, nmerge = G - mfirst;
        if (bx >= mfirst) {
            if (tid == 0) { unsigned spins = 0; while (__hip_atomic_load(CTL, __ATOMIC_RELAXED, __HIP_MEMORY_SCOPE_AGENT) < (unsigned)G) { __builtin_amdgcn_s_sleep(4); if (++spins > (1u << 24)) break; }
                __builtin_amdgcn_fence(__ATOMIC_ACQUIRE, "agent"); asm volatile("s_waitcnt vmcnt(0)" ::: "memory"); }
            __syncthreads();
            for (int c0 = (bx - mfirst) * (NWAVES * 64) + tid; c0 < NTOK * 64; c0 += 2 * nmerge * NWAVES * 64) {
                v4u a0[2], a1[2], a2[2], gz[2]; float e0[2], e1[2], e2[2]; int tok[2], c8[2]; bool ok[2];
#pragma unroll
                for (int q = 0; q < 2; ++q) { const int ci = c0 + q * nmerge * NWAVES * 64; ok[q] = ci < NTOK * 64; const int cj = ok[q] ? ci : c0; tok[q] = cj >> 6; c8[q] = (cj & 63) * 8; const int h = c8[q] >> 7;
                    e0[q] = LSE[((size_t)0 * NTOK + tok[q]) * 4 + h]; e1[q] = LSE[((size_t)1 * NTOK + tok[q]) * 4 + h]; e2[q] = LSE[((size_t)2 * NTOK + tok[q]) * 4 + h];
                    a0[q] = *(const v4u*)(OG + ((size_t)0 * NTOK + tok[q]) * 512 + c8[q]); a1[q] = *(const v4u*)(OG + ((size_t)1 * NTOK + tok[q]) * 512 + c8[q]); a2[q] = *(const v4u*)(OG + ((size_t)2 * NTOK + tok[q]) * 512 + c8[q]);
                    gz[q] = *(const v4u*)(P + (size_t)tok[q] * PITCH + C_GB + c8[q]); }
#pragma unroll
                for (int q = 0; q < 2; ++q) { const float mx = fmaxf(e0[q], fmaxf(e1[q], e2[q])); float w0 = __expf(e0[q] - mx), w1 = __expf(e1[q] - mx), w2 = __expf(e2[q] - mx); const float inv = 1.f / (w0 + w1 + w2); w0 *= inv; w1 *= inv; w2 *= inv;
                    v4u w;
#pragma unroll
                    for (int e = 0; e < 4; ++e) {
                        const float lo = w0 * __uint_as_float(a0[q][e] << 16) + w1 * __uint_as_float(a1[q][e] << 16) + w2 * __uint_as_float(a2[q][e] << 16);
                        const float hh = w0 * __uint_as_float(a0[q][e] & 0xffff0000u) + w1 * __uint_as_float(a1[q][e] & 0xffff0000u) + w2 * __uint_as_float(a2[q][e] & 0xffff0000u);
                        w[e] = pk2(lo * __uint_as_float(gz[q][e] << 16), hh * __uint_as_float(gz[q][e] & 0xffff0000u)); }
                    if (ok[q]) *(v4u*)(Y + (size_t)tok[q] * 1536 + 1024 + c8[q]) = w; }
            }
        }
        if (BOTH(2)) GRID_BAR();
    }
    if (IN(3)) {
        pg8::Gemm g{Y, WT_AB, NTOK, DM, 1536}; pg8::StaticOrder S; S.init(NTOK, DM, G, bx);
        pg8::EpiMerge2 E{SA, SB, MG, DM};
        pg8::gemm_phase<pg8::EpiMerge2, pg8::StaticOrder, true, true>((LAS unsigned char*)lds, g, S, E, wave);
        if (BOTH(3)) GRID_BAR();
    }
    if (IN(4)) {
        pg8::Gemm g{MG, WT_O, NTOK, DM, DM}; pg8::StaticOrder S; S.init(NTOK, DM, G, bx);
        pg8::EpiResidNorm E{x, args.out, DM, args.in[9], XB, PCNT, 8, EPS};
        if (G == 256) pg8::gemm_phase<pg8::EpiResidNorm, pg8::StaticOrder, false, true>((LAS unsigned char*)lds, g, S, E, wave);
    }
#undef IN
#undef BOTH
}


extern "C" void kernel_launch(void* const* d_in, const int* in_sizes, int n_in, void* d_out, int out_size, void* d_ws, size_t ws_size, hipStream_t stream) {
    static int grid = 0;
    if (grid == 0) {
        if (n_in != 10 || in_sizes[0] != NTOK * DM || out_size != NTOK * DM || ws_size < WS_END) { fprintf(stderr, "kernel_launch: unexpected shapes / workspace (%zu)\n", ws_size); grid = -1; return; }
        int dev = 0, cus = 0, per_cu = 0;
        if (hipGetDevice(&dev) != hipSuccess || hipDeviceGetAttribute(&cus, hipDeviceAttributeMultiprocessorCount, dev) != hipSuccess) { grid = -1; return; }
        if (hipFuncSetAttribute((const void*)mk_fwd, hipFuncAttributeMaxDynamicSharedMemorySize, LDS_BYTES) != hipSuccess) { fprintf(stderr, "kernel_launch: hipFuncSetAttribute failed\n"); grid = -1; return; }
        if (hipOccupancyMaxActiveBlocksPerMultiprocessor(&per_cu, (const void*)mk_fwd, NWAVES * 64, LDS_BYTES) != hipSuccess || per_cu < 1) { fprintf(stderr, "kernel_launch: occupancy query says %d\n", per_cu); grid = -1; return; }
        grid = cus;
    }
    if (grid < 0) return;
    if (hipMemsetAsync((char*)d_ws + WS_CTL, 0, 131072, stream) != hipSuccess) { fprintf(stderr, "kernel_launch: memset failed\n"); return; }
    Args a{};
    for (int i = 0; i < 10; ++i) a.in[i] = (const float*)d_in[i];
    a.out = (float*)d_out; a.ws = (unsigned char*)d_ws; a.ph_lo = 0; a.ph_hi = 5;
    void* kargs[] = {&a};
    hipError_t e = hipLaunchCooperativeKernel((const void*)mk_fwd, dim3(grid), dim3(NWAVES * 64), kargs, LDS_BYTES, stream);
    if (e != hipSuccess) fprintf(stderr, "kernel_launch: cooperative launch failed: %s (grid %d)\n", hipGetErrorString(e), grid);
}
```

```cpp
#include <hip/hip_runtime.h>
#include <cstdio>
#include <cstdint>
#include <cmath>
__device__ __forceinline__ int fresh_lane() { int l; asm volatile("v_mbcnt_lo_u32_b32 %0, -1, 0\n\tv_mbcnt_hi_u32_b32 %0, -1, %0" : "=v"(l)); return l; }
namespace pg8 {
#define PG8_LAS __attribute__((address_space(3)))
typedef unsigned short bf16_t;
typedef short bf16x8 __attribute__((ext_vector_type(8)));
typedef float f32x4 __attribute__((ext_vector_type(4)));
typedef unsigned u32x4 __attribute__((ext_vector_type(4)));
typedef int v4i_t __attribute__((ext_vector_type(4)));
constexpr int BM = 256, BK = 64, HALF = 128, HTB = HALF * BK * 2  , STAGE_BYTES = 8 * HTB, NXCD = 8, WGM = 8;

__host__ __device__ __forceinline__ int lds_byte(int r, int c) { const int st = (r >> 4) * 2 + (c >> 5), rr = r & 15, cc = c & 31, ob = rr * 64 + cc * 2; return st * 1024 + (ob ^ (((ob >> 9) & 1) << 5)); }
__host__ __device__ __forceinline__ void stage_rc(int b, int& R, int& C) { const int st = b / 1024, sb = b % 1024, swz = sb ^ (((sb >> 9) & 1) << 5); R = (st >> 1) * 16 + swz / 64; C = (st & 1) * 32 + (swz % 64) / 2; }
__host__ __device__ __forceinline__ int perm32(int rho) { const int n = rho >> 4, i = rho & 15; return 8 * (i >> 2) + 4 * n + (i & 3); }

struct Unit { int pm, pn; };
struct Gemm { const bf16_t* A; const bf16_t* Bt; int M, N, K; };

struct StaticOrder {
    int nM, nN, nwg, G, c;
    __host__ __device__ void init(int M, int N, int G_, int c_) { nM = M / BM; nN = N / BM; nwg = nM * nN; G = G_; c = c_; }
    __host__ __device__ bool next(int i, Unit& u) const { const long L = (long)i * G + c; if (L >= nwg) return false; unit_of((int)L, u); return true; }
    __host__ __device__ bool unit_of(int L, Unit& u) const {
        int wgid = L; { const int q = nwg / NXCD, r = nwg % NXCD, xcd = wgid % NXCD, off = wgid / NXCD; wgid = (xcd < r ? xcd * (q + 1) : r * (q + 1) + (xcd - r) * q) + off; }
        const int nig = WGM * nN, gid = wgid / nig, fm = gid * WGM, gsz = (nM - fm) < WGM ? (nM - fm) : WGM;
        u.pm = fm + ((wgid % nig) % gsz); u.pn = (wgid % nig) / gsz; return true;
    }
    __device__ __forceinline__ void a_ready(const Unit&) const {}
    __device__ __forceinline__ void done(const Unit&) const {}
};


typedef float f32x2_cv __attribute__((ext_vector_type(2))); typedef __bf16 bf16x2_cv __attribute__((ext_vector_type(2)));
__device__ __forceinline__ unsigned cvt_pk_bf16(float lo, float hi) { const f32x2_cv v = {lo, hi}; return __builtin_bit_cast(unsigned, __builtin_convertvector(v, bf16x2_cv)); }
typedef float f32x2 __attribute__((ext_vector_type(2)));

template <bool F8> struct EpiIn {
    static constexpr bool PERM = false, AFTER_DRAIN = false, FP8 = F8, INIT_ACC = false; static constexpr int HOOK_T = -1;
    bf16_t* O; int ldc; const float* cosa; const float* sina; const float* cosp; const float* sinp; const float* qg; const float* kg; const float* bias; bf16_t* SA; bf16_t* SB; PG8_LAS float* red; float eps; float sc;
    __device__ __forceinline__ static unsigned long long pk4(const f32x4 v) { return (unsigned long long)cvt_pk_bf16(v[0], v[1]) | ((unsigned long long)cvt_pk_bf16(v[2], v[3]) << 32); }
    __device__ __forceinline__ void operator()(const f32x4 (&acc)[2][2][4][2], const Unit& u, int wr, int wc, int fr_, int fq_) const {
        (void)fr_; (void)fq_; const int ln_ = fresh_lane(), fr = ln_ & 15, fq = ln_ >> 4;
        const int pn = F8 ? (u.pn < 14 ? u.pn : u.pn + 16) : u.pn + 14; const int row0 = u.pm * BM + wr * 64 + fr;
        if (pn < 5) {
#pragma unroll
            for (int ai = 0; ai < 2; ++ai)
#pragma unroll
                for (int m = 0; m < 4; ++m)
#pragma unroll
                    for (int bj = 0; bj < 2; ++bj) { const f32x4 v0 = (acc[ai][bj][m][0] * sc), v1 = (acc[ai][bj][m][1] * sc);
                        float ss = (v0[0] * v0[0] + v0[1] * v0[1]) + (v0[2] * v0[2] + v0[3] * v0[3]) + (v1[0] * v1[0] + v1[1] * v1[1]) + (v1[2] * v1[2] + v1[3] * v1[3]);
                        ss += __shfl_xor(ss, 16); ss += __shfl_xor(ss, 32);
                        if (fq == 0) red[(ai * HALF + wr * 64 + m * 16 + fr) * 8 + bj * 4 + wc] = ss; }
            asm volatile("s_waitcnt lgkmcnt(0)" ::: "memory"); __builtin_amdgcn_s_barrier(); asm volatile("" ::: "memory");
            const int half = wc >> 1, i0 = 16 * (wc & 1) + 4 * fq;
            const float* g = (pn < 4) ? qg : kg;
            const f32x4 g0 = *(const f32x4*)(g + 64 * half + i0), g1 = *(const f32x4*)(g + 64 * half + 32 + i0);
#pragma unroll
            for (int ai = 0; ai < 2; ++ai)
#pragma unroll
                for (int m = 0; m < 4; ++m) { const int row = row0 + ai * HALF + m * 16, sq = row & 2047, pos = half ? (sq & 63) : (sq >> 6);
                    const f32x4 c = *(const f32x4*)(cosa + pos * 32 + i0), sn = *(const f32x4*)(sina + pos * 32 + i0);
#pragma unroll
                    for (int bj = 0; bj < 2; ++bj) { const f32x4 pr = *(const PG8_LAS f32x4*)(red + (ai * HALF + wr * 64 + m * 16 + fr) * 8 + bj * 4);
                        const float rs = rsqrtf(((pr[0] + pr[1]) + (pr[2] + pr[3])) * (1.f / 128.f) + eps);
                        const f32x4 y0 = (acc[ai][bj][m][0] * sc) * rs * g0, y1 = (acc[ai][bj][m][1] * sc) * rs * g1;
                        const f32x4 lo = y0 * c - y1 * sn, hi = y0 * sn + y1 * c;
                        bf16_t* p = O + (size_t)row * ldc + pn * BM + bj * HALF + 64 * half + i0;
                        *(unsigned long long*)p = pk4(lo); *(unsigned long long*)(p + 32) = pk4(hi); } }
        } else if (pn >= 10 && pn < 22 && wc == 0) {
            const int i0 = 4 * fq;
#pragma unroll
            for (int ai = 0; ai < 2; ++ai)
#pragma unroll
                for (int m = 0; m < 4; ++m) { const int row = row0 + ai * HALF + m * 16, sq = row & 2047;
                    const f32x4 c = *(const f32x4*)(cosp + sq * 16 + i0), sn = *(const f32x4*)(sinp + sq * 16 + i0);
#pragma unroll
                    for (int bj = 0; bj < 2; ++bj) { const f32x4 y0 = (acc[ai][bj][m][0] * sc), y1 = (acc[ai][bj][m][1] * sc);
                        const f32x4 lo = y0 * c - y1 * sn, hi = y0 * sn + y1 * c;
                        bf16_t* p = O + (size_t)row * ldc + pn * BM + bj * HALF + i0;
                        *(unsigned long long*)p = pk4(lo); *(unsigned long long*)(p + 16) = pk4(hi); } }
        } else if (pn >= 30) {
            const int which = pn >= 38 ? 1 : 0, pnz = pn - (which ? 38 : 30);
            const float* bs = bias + which * 2048 + pnz * BM + wc * 32 + 8 * fq;
            bf16_t* dst = (which ? SB : SA) + ((((size_t)(u.pm * 8 + pnz) * 8 + (wr * 4 + wc)) * 16) * 64 + (fq * 16 + fr)) * 8;
#pragma unroll
            for (int bj = 0; bj < 2; ++bj) { const f32x4 b0 = *(const f32x4*)(bs + bj * HALF), b1 = *(const f32x4*)(bs + bj * HALF + 4);
#pragma unroll
                for (int ai = 0; ai < 2; ++ai)
#pragma unroll
                    for (int m = 0; m < 4; ++m) { const f32x4 v0 = (acc[ai][bj][m][0] * sc) + b0, v1 = (acc[ai][bj][m][1] * sc) + b1; float sg[8];
#pragma unroll
                        for (int e = 0; e < 4; ++e) { sg[e] = __builtin_amdgcn_rcpf(1.f + __builtin_amdgcn_exp2f(v0[e] * -1.4426950408889634f)); sg[4 + e] = __builtin_amdgcn_rcpf(1.f + __builtin_amdgcn_exp2f(v1[e] * -1.4426950408889634f)); }
                        u32x4 w; w.x = cvt_pk_bf16(sg[0], sg[1]); w.y = cvt_pk_bf16(sg[2], sg[3]); w.z = cvt_pk_bf16(sg[4], sg[5]); w.w = cvt_pk_bf16(sg[6], sg[7]);
                        __builtin_nontemporal_store(w, (u32x4*)(dst + (ai * 8 + bj * 4 + m) * 512)); } }
        } else {
            const bool act = (pn >= 6 && pn < 10) || pn == 28 || pn == 29;
            const int col0 = pn * BM + wc * 32 + 8 * fq;
#pragma unroll
            for (int ai = 0; ai < 2; ++ai)
#pragma unroll
                for (int m = 0; m < 4; ++m) { bf16_t* rowp = O + (size_t)(row0 + ai * HALF + m * 16) * ldc + col0;
#pragma unroll
                    for (int bj = 0; bj < 2; ++bj) { f32x4 v0 = (acc[ai][bj][m][0] * sc), v1 = (acc[ai][bj][m][1] * sc);
                        if (act) {
#pragma unroll
                            for (int e = 0; e < 4; ++e) { v0[e] = v0[e] * __builtin_amdgcn_rcpf(1.f + __builtin_amdgcn_exp2f(v0[e] * -1.4426950408889634f)); v1[e] = v1[e] * __builtin_amdgcn_rcpf(1.f + __builtin_amdgcn_exp2f(v1[e] * -1.4426950408889634f)); } }
                        u32x4 w; w.x = cvt_pk_bf16(v0[0], v0[1]); w.y = cvt_pk_bf16(v0[2], v0[3]); w.z = cvt_pk_bf16(v1[0], v1[1]); w.w = cvt_pk_bf16(v1[2], v1[3]);
                        *(u32x4*)(rowp + bj * HALF) = w; } }
        }
    }
};
struct EpiMerge2 {
    static constexpr bool PERM = false, AFTER_DRAIN = false, FP8 = false; static constexpr int HOOK_T = 16; static constexpr bool INIT_ACC = false;
    const bf16_t* SA; const bf16_t* SB; bf16_t* O; int ldc;
    __device__ __forceinline__ void mid(f32x4 (&acc)[2][2][4][2], const Unit& u, int wr, int wc, int fr, int fq) const {
        int lane = fq * 16 + fr; asm volatile("" : "+v"(lane));
        const size_t base = ((((size_t)(u.pm * 8 + u.pn) * 8 + (wr * 4 + wc)) * 16) * 64 + lane) * 8;
#pragma unroll
        for (int f = 0; f < 16; ++f) { const int ai = f >> 3, bj = (f >> 2) & 1, m = f & 3;
            const u32x4 a = __builtin_nontemporal_load((const u32x4*)(SA + base + f * 512)), b = *(const u32x4*)(SB + base + f * 512);
            f32x4 r0, r1;
#pragma unroll
            for (int e = 0; e < 4; ++e) { const float q_lo = __uint_as_float(a[e] << 16) * __builtin_amdgcn_rcpf(__uint_as_float(b[e] << 16)), q_hi = __uint_as_float(a[e] & 0xffff0000u) * __builtin_amdgcn_rcpf(__uint_as_float(b[e] & 0xffff0000u));
                if (e < 2) { r0[2 * e] = q_lo; r0[2 * e + 1] = q_hi; } else { r1[2 * e - 4] = q_lo; r1[2 * e - 3] = q_hi; } }
            acc[ai][bj][m][0] *= r0; acc[ai][bj][m][1] *= r1; }
    }
    __device__ __forceinline__ void operator()(const f32x4 (&acc)[2][2][4][2], const Unit& u, int wr, int wc, int fr_, int fq_) const {
        (void)fr_; (void)fq_; const int ln_ = fresh_lane(), fr = ln_ & 15, fq = ln_ >> 4;
        const int lane = fq * 16 + fr, row0 = u.pm * BM + wr * 64 + fr, col0 = u.pn * BM + wc * 32 + 8 * fq;
        const size_t base = ((((size_t)(u.pm * 8 + u.pn) * 8 + (wr * 4 + wc)) * 16) * 64 + lane) * 8;
#pragma unroll
        for (int f = 0; f < 16; ++f) { const int ai = f >> 3, bj = (f >> 2) & 1, m = f & 3;
            const u32x4 b = __builtin_nontemporal_load((const u32x4*)(SB + base + f * 512));
            const f32x4 v0 = acc[ai][bj][m][0], v1 = acc[ai][bj][m][1];
            u32x4 w; w.x = cvt_pk_bf16(v0[0] * __uint_as_float(b[0] << 16), v0[1] * __uint_as_float(b[0] & 0xffff0000u)); w.y = cvt_pk_bf16(v0[2] * __uint_as_float(b[1] << 16), v0[3] * __uint_as_float(b[1] & 0xffff0000u));
            w.z = cvt_pk_bf16(v1[0] * __uint_as_float(b[2] << 16), v1[1] * __uint_as_float(b[2] & 0xffff0000u)); w.w = cvt_pk_bf16(v1[2] * __uint_as_float(b[3] << 16), v1[3] * __uint_as_float(b[3] & 0xffff0000u));
            *(u32x4*)(O + (size_t)(row0 + ai * HALF + m * 16) * ldc + col0 + bj * HALF) = w; }
    }
};
struct EpiResidNorm {
    static constexpr bool PERM = false, AFTER_DRAIN = true, FP8 = false, INIT_ACC = true; static constexpr int HOOK_T = -1;
    const float* base; float* out; int ldc; const float* gain; float* xb; unsigned* cnt; int ntn; float eps;
    __device__ __forceinline__ void init(f32x4 (&acc)[2][2][4][2], const Unit& u, int wr, int wc, int fr, int fq) const {
        const int row0 = u.pm * BM + wr * 64 + fr, col0 = u.pn * BM + wc * 32 + 4 * fq;
#pragma unroll
        for (int ai = 0; ai < 2; ++ai)
#pragma unroll
            for (int m = 0; m < 4; ++m) { const size_t off = (size_t)(row0 + ai * HALF + m * 16) * ldc + col0;
#pragma unroll
                for (int bj = 0; bj < 2; ++bj)
#pragma unroll
                    for (int n = 0; n < 2; ++n) acc[ai][bj][m][n] = __builtin_nontemporal_load((const f32x4*)(base + off + bj * HALF + n * 16)); }
    }
    __device__ __forceinline__ void fused(f32x4 (&acc)[2][2][4][2], const Unit& u, int wr, int wc, int fr_, int fq_, PG8_LAS unsigned char* lds, int wid, int lane) const {
        (void)fr_; (void)fq_; const int ln_ = fresh_lane(), fr = ln_ & 15, fq = ln_ >> 4;
        PG8_LAS float* Pp = (PG8_LAS float*)lds;
        PG8_LAS float* Sr = (PG8_LAS float*)(lds + 4096);
        const int row0 = u.pm * BM + wr * 64 + fr, col0 = u.pn * BM + wc * 32 + 4 * fq;
#pragma unroll
        for (int ai = 0; ai < 2; ++ai)
#pragma unroll
            for (int m = 0; m < 4; ++m) { float ss = 0.f;
#pragma unroll
                for (int bj = 0; bj < 2; ++bj)
#pragma unroll
                    for (int n = 0; n < 2; ++n) { const f32x4 o = acc[ai][bj][m][n];
                        ss += (o[0] * o[0] + o[1] * o[1]) + (o[2] * o[2] + o[3] * o[3]); }
                ss += __shfl_xor(ss, 16); ss += __shfl_xor(ss, 32);
                if (fq == 0) Pp[(ai * HALF + wr * 64 + m * 16 + fr) * 4 + wc] = ss; }
        asm volatile("s_waitcnt lgkmcnt(0)" ::: "memory"); __builtin_amdgcn_s_barrier(); asm volatile("" ::: "memory");
        const int tid = wid * 64 + lane;
        if (tid < 256) { const f32x4 p = *(const PG8_LAS f32x4*)(Pp + tid * 4);
            __hip_atomic_store(xb + (size_t)(u.pm * BM + tid) * 8 + u.pn, (p[0] + p[1]) + (p[2] + p[3]), __ATOMIC_RELAXED, __HIP_MEMORY_SCOPE_AGENT); }
        asm volatile("s_waitcnt vmcnt(0)" ::: "memory"); __builtin_amdgcn_s_barrier(); asm volatile("" ::: "memory");
        if (tid == 0) __hip_atomic_fetch_add(cnt + 64 * u.pm, 1u, __ATOMIC_RELAXED, __HIP_MEMORY_SCOPE_AGENT);
        if (wid == 0) { unsigned spins = 0;
            while ((unsigned)__builtin_amdgcn_readfirstlane(__hip_atomic_load(cnt + 64 * u.pm, __ATOMIC_RELAXED, __HIP_MEMORY_SCOPE_AGENT)) < (unsigned)ntn) { __builtin_amdgcn_s_sleep(2); if (++spins > (1u << 22)) break; }
            __builtin_amdgcn_fence(__ATOMIC_ACQUIRE, "agent"); }
        asm volatile("s_waitcnt vmcnt(0) lgkmcnt(0)" ::: "memory"); __builtin_amdgcn_s_barrier(); asm volatile("" ::: "memory");
        if (tid < 256) { const float* slot = xb + (size_t)(u.pm * BM + tid) * 8; float tot = 0.f;
#pragma unroll
            for (int t = 0; t < 8; ++t) tot += __hip_atomic_load(slot + t, __ATOMIC_RELAXED, __HIP_MEMORY_SCOPE_AGENT);
            Sr[tid] = rsqrtf(tot * (1.0f / 2048.0f) + eps); }
        asm volatile("s_waitcnt lgkmcnt(0)" ::: "memory"); __builtin_amdgcn_s_barrier(); asm volatile("" ::: "memory");
#pragma unroll
        for (int bj = 0; bj < 2; ++bj)
#pragma unroll
            for (int n = 0; n < 2; ++n) { const f32x4 g = *(const f32x4*)(gain + col0 + bj * HALF + n * 16);
#pragma unroll
                for (int ai = 0; ai < 2; ++ai)
#pragma unroll
                    for (int m = 0; m < 4; ++m) { const int rl = ai * HALF + wr * 64 + m * 16 + fr; const float rs = Sr[rl];
                        __builtin_nontemporal_store(acc[ai][bj][m][n] * rs * g, (f32x4*)(out + (size_t)(u.pm * BM + rl) * ldc + col0 + bj * HALF + n * 16)); } }
    }
};

template <class Epi, class Sched, bool ALIGN_EPI = false, bool SP2 = false>
__device__ __forceinline__ void gemm_phase(PG8_LAS unsigned char* lds, const Gemm g, const Sched& S, const Epi& E, const int wave_) {
    const int wid = wave_, lane = fresh_lane(), tid = wid * 64 + lane, wr = wid >> 2, wc = wid & 3, fr = lane & 15, fq = lane >> 4;
    const int K = g.K, nt = K / BK;
    unsigned voffA[2], voffB[2];
#pragma unroll
    for (int i = 0; i < 2; ++i) { int R, C; stage_rc(tid * 16 + i * 8192, R, C); const int Rb = Epi::PERM ? ((R & ~31) + perm32(R & 31)) : R;
        voffA[i] = (unsigned)(R * K + C) * 2u; voffB[i] = (unsigned)(Rb * K + C) * 2u; }
    const unsigned kstep = (unsigned)(BK * 2);
    const unsigned hstep = (unsigned)HALF * (unsigned)K * 2u;
    const unsigned tstep = 2u * hstep;
    const __amdgpu_buffer_rsrc_t rs_voffA = __builtin_amdgcn_make_buffer_rsrc((void*)g.A, 0, (int)((unsigned)g.M * (unsigned)K * 2u), 0x00020000);
    const __amdgpu_buffer_rsrc_t rs_voffB = __builtin_amdgcn_make_buffer_rsrc((void*)g.Bt, 0, (int)((unsigned)g.N * (unsigned)K * 2u), 0x00020000);
    const unsigned ldsw = (unsigned)wid * 1024u;
    const int aoff = lds_byte(wr * 64 + fr, fq * 8), boff = lds_byte(wc * 32 + fr, fq * 8);
#define PG8_SA(b, h) (((b) * 2 + (h)) * HTB)
#define PG8_SB(b, h) ((4 + (b) * 2 + (h)) * HTB)
#define PG8_STAGE(bufoff, goff, voff) do { _Pragma("unroll") for (int _i = 0; _i < 2; ++_i) \
        __builtin_amdgcn_raw_ptr_buffer_load_lds(rs_##voff, (PG8_LAS void*)(lds + (bufoff) + ldsw + _i * 8192), 16, (int)(voff)[_i], (int)(goff), 0, 0); } while (0)
#define PG8_LDA(dst, b, h) do { _Pragma("unroll") for (int m = 0; m < 4; ++m) _Pragma("unroll") for (int k = 0; k < 2; ++k) dst[m][k] = *(const PG8_LAS bf16x8*)(lds + PG8_SA(b, h) + aoff + m * 2048 + k * 1024); } while (0)
#define PG8_LDB(dst, b, h) do { _Pragma("unroll") for (int n = 0; n < 2; ++n) _Pragma("unroll") for (int k = 0; k < 2; ++k) dst[n][k] = *(const PG8_LAS bf16x8*)(lds + PG8_SB(b, h) + boff + n * 2048 + k * 1024); } while (0)
#define PG8_CAT(x, y) __builtin_shufflevector(__builtin_bit_cast(v4i_t, x), __builtin_bit_cast(v4i_t, y), 0, 1, 2, 3, 4, 5, 6, 7)
#define PG8_MMA(ai, bj, At, Bt) do { __builtin_amdgcn_s_setprio(1); _Pragma("unroll") for (int m = 0; m < 4; ++m) _Pragma("unroll") for (int n = 0; n < 2; ++n) { \
        if constexpr (Epi::FP8) acc[ai][bj][m][n] = __builtin_amdgcn_mfma_scale_f32_16x16x128_f8f6f4(PG8_CAT(Bt[n][0], Bt[n][1]), PG8_CAT(At[m][0], At[m][1]), acc[ai][bj][m][n], 0, 0, 0, 0x7f7f7f7f, 0, 0x7f7f7f7f); \
        else { _Pragma("unroll") for (int k = 0; k < 2; ++k) acc[ai][bj][m][n] = __builtin_amdgcn_mfma_f32_16x16x32_bf16(Bt[n][k], At[m][k], acc[ai][bj][m][n], 0, 0, 0); } } \
        __builtin_amdgcn_s_setprio(0); } while (0)
#define PG8_WAIT_V(n) asm volatile("s_waitcnt vmcnt(" #n ")" ::: "memory")
#define PG8_WAIT_L(n) asm volatile("s_waitcnt lgkmcnt(" #n ")" ::: "memory")
#define PG8_BAR __builtin_amdgcn_s_barrier()
#define PG8_SCHED __builtin_amdgcn_sched_barrier(0)
    Unit cur, nxt; int ui = 0;
    if (!S.next(0, cur)) return;
    f32x4 acc[2][2][4][2];
    if constexpr (Epi::INIT_ACC) E.init(acc, cur, wr, wc, fr, fq);
    else {
#pragma unroll
    for (int a = 0; a < 2; ++a)
#pragma unroll
        for (int b = 0; b < 2; ++b)
#pragma unroll
            for (int m = 0; m < 4; ++m)
#pragma unroll
                for (int n = 0; n < 2; ++n) acc[a][b][m][n] = (f32x4){0.f, 0.f, 0.f, 0.f};
    }
    bf16x8 At[4][2], B0[2][2], B1[2][2];
    unsigned cA = (unsigned)cur.pm * tstep, cB = (unsigned)cur.pn * tstep;
    S.a_ready(cur);
    if constexpr (SP2) {
        PG8_STAGE(PG8_SB(0, 0), cB, voffB); PG8_STAGE(PG8_SB(0, 1), cB + hstep, voffB); PG8_STAGE(PG8_SA(0, 0), cA, voffA); PG8_STAGE(PG8_SA(0, 1), cA + hstep, voffA);
        if (wr == 1) PG8_BAR;
        PG8_WAIT_V(2); PG8_BAR;
        PG8_STAGE(PG8_SB(1, 0), cB + kstep, voffB); PG8_STAGE(PG8_SA(1, 0), cA + kstep, voffA); PG8_STAGE(PG8_SB(1, 1), cB + hstep + kstep, voffB);
        PG8_WAIT_V(6); PG8_BAR;
    } else {
        PG8_STAGE(PG8_SB(0, 0), cB, voffB); PG8_STAGE(PG8_SA(0, 0), cA, voffA); PG8_STAGE(PG8_SB(0, 1), cB + hstep, voffB); PG8_STAGE(PG8_SA(0, 1), cA + hstep, voffA);
        if (wr == 1) PG8_BAR;
        PG8_WAIT_V(4); PG8_BAR;
        PG8_STAGE(PG8_SB(1, 0), cB + kstep, voffB); PG8_STAGE(PG8_SA(1, 0), cA + kstep, voffA); PG8_STAGE(PG8_SB(1, 1), cB + hstep + kstep, voffB);
        PG8_WAIT_V(6); PG8_BAR;
    }
    for (;;) {
        const bool has_next = S.next(ui + 1, nxt);
        const unsigned nA = has_next ? (unsigned)nxt.pm * tstep : cA, nB = has_next ? (unsigned)nxt.pn * tstep : cB;
        for (int t = 0; t < nt; t += 2) {
            if constexpr (Epi::HOOK_T >= 0) { if (t == Epi::HOOK_T) E.mid(acc, cur, wr, wc, fr, fq); }
            const bool last = (t == nt - 2);
            const unsigned a1 = cA + (unsigned)(t + 1) * kstep;
            const unsigned a2 = last ? nA : cA + (unsigned)(t + 2) * kstep, b2 = last ? nB : cB + (unsigned)(t + 2) * kstep;
            const unsigned a3 = a2 + kstep, b3 = b2 + kstep;
            if (last && has_next) S.a_ready(nxt);
            if constexpr (SP2) {
            PG8_LDB(B0, 0, 0); PG8_LDB(B1, 0, 1); PG8_SCHED; PG8_LDA(At, 0, 0); PG8_STAGE(PG8_SA(1, 1), a1 + hstep, voffA);
            PG8_WAIT_V(8); PG8_WAIT_L(0); PG8_BAR; PG8_MMA(0, 0, At, B0); PG8_MMA(0, 1, At, B1); PG8_BAR; PG8_SCHED;
            PG8_LDA(At, 0, 1); PG8_STAGE(PG8_SB(0, 0), b2, voffB); PG8_STAGE(PG8_SB(0, 1), b2 + hstep, voffB); PG8_STAGE(PG8_SA(0, 0), a2, voffA);
            PG8_WAIT_V(8); PG8_WAIT_L(0); PG8_BAR; PG8_MMA(1, 0, At, B0); PG8_MMA(1, 1, At, B1); PG8_BAR; PG8_SCHED;
            PG8_LDB(B0, 1, 0); PG8_LDB(B1, 1, 1); PG8_SCHED; PG8_LDA(At, 1, 0); PG8_STAGE(PG8_SA(0, 1), a2 + hstep, voffA);
            PG8_WAIT_V(8); PG8_WAIT_L(0); PG8_BAR; PG8_MMA(0, 0, At, B0); PG8_MMA(0, 1, At, B1); PG8_BAR; PG8_SCHED;
            PG8_LDA(At, 1, 1); PG8_STAGE(PG8_SB(1, 0), b3, voffB); PG8_STAGE(PG8_SB(1, 1), b3 + hstep, voffB); PG8_STAGE(PG8_SA(1, 0), a3, voffA);
            PG8_WAIT_V(8); PG8_WAIT_L(0); PG8_BAR; PG8_MMA(1, 0, At, B0); PG8_MMA(1, 1, At, B1); PG8_BAR; PG8_SCHED;
            } else {
            PG8_LDB(B0, 0, 0); PG8_SCHED; PG8_LDA(At, 0, 0); PG8_STAGE(PG8_SA(1, 1), a1 + hstep, voffA);
            PG8_WAIT_L(8); PG8_BAR; PG8_WAIT_L(0); PG8_MMA(0, 0, At, B0); PG8_BAR; PG8_SCHED;
            PG8_LDB(B1, 0, 1); PG8_STAGE(PG8_SB(0, 0), b2, voffB);
            PG8_BAR; PG8_WAIT_L(0); PG8_MMA(0, 1, At, B1); PG8_BAR;
            PG8_LDA(At, 0, 1); PG8_STAGE(PG8_SA(0, 0), a2, voffA);
            PG8_BAR; PG8_WAIT_L(0); PG8_MMA(1, 0, At, B0); PG8_BAR; PG8_SCHED;
            PG8_STAGE(PG8_SB(0, 1), b2 + hstep, voffB);
            PG8_WAIT_V(6); PG8_BAR; PG8_MMA(1, 1, At, B1); PG8_BAR;
            PG8_LDB(B0, 1, 0); PG8_SCHED; PG8_LDA(At, 1, 0); PG8_STAGE(PG8_SA(0, 1), a2 + hstep, voffA);
            PG8_WAIT_L(8); PG8_BAR; PG8_WAIT_L(0); PG8_MMA(0, 0, At, B0); PG8_BAR; PG8_SCHED;
            PG8_LDB(B1, 1, 1); PG8_STAGE(PG8_SB(1, 0), b3, voffB);
            PG8_BAR; PG8_WAIT_L(0); PG8_MMA(0, 1, At, B1); PG8_BAR;
            PG8_LDA(At, 1, 1); PG8_STAGE(PG8_SA(1, 0), a3, voffA);
            PG8_BAR; PG8_WAIT_L(0); PG8_MMA(1, 0, At, B0); PG8_BAR; PG8_SCHED;
            PG8_STAGE(PG8_SB(1, 1), b3 + hstep, voffB);
            PG8_WAIT_V(6); PG8_BAR; PG8_MMA(1, 1, At, B1); PG8_BAR;
            }
        }
        if constexpr (ALIGN_EPI) { if (wr == 0) PG8_BAR; }
        if constexpr (!Epi::AFTER_DRAIN) { E(acc, cur, wr, wc, fr, fq); S.done(cur); }
        if (!has_next) break;
#pragma unroll
        for (int a = 0; a < 2; ++a)
#pragma unroll
            for (int b = 0; b < 2; ++b)
#pragma unroll
                for (int m = 0; m < 4; ++m)
#pragma unroll
                    for (int n = 0; n < 2; ++n) acc[a][b][m][n] = (f32x4){0.f, 0.f, 0.f, 0.f};
        cur = nxt; cA = nA; cB = nB; ++ui;
        if constexpr (ALIGN_EPI) { if (wr == 1) PG8_BAR; }
    }
    PG8_WAIT_V(0);
    if constexpr (!ALIGN_EPI) { if (wr == 0) PG8_BAR; }
    PG8_BAR;
    if constexpr (Epi::AFTER_DRAIN) { E.fused(acc, cur, wr, wc, fr, fq, lds, wid, lane); S.done(cur); }
#undef PG8_SA
#undef PG8_SB
#undef PG8_STAGE
#undef PG8_LDA
#undef PG8_LDB
#undef PG8_MMA
#undef PG8_CAT
#undef PG8_WAIT_V
#undef PG8_WAIT_L
#undef PG8_BAR
#undef PG8_SCHED
}
}

namespace att {
using bf16 = unsigned short;
constexpr int   D = 128, NW = 8, QBLK = 32, KVBLK = 64;
constexpr float SCALE = 0.088388347648318440f;
constexpr float THR = 8.f;
constexpr int SDEPTH = 2;
constexpr int LDQ = 7680, LDK = 7680;
constexpr int LDY = 1536;
constexpr size_t SHM_V = KVBLK * D * 2, SHM_K = KVBLK * D * 2, SHM_ATTN = 2 * SHM_V + 2 * SHM_K + NW * 64 * 4;
__device__ __forceinline__ float bf2f_(bf16 h) { return __uint_as_float(((unsigned)h) << 16); }
__device__ __forceinline__ bf16 f2bf_(float f) { unsigned u = __float_as_uint(f); return (bf16)((u + 0x7fffu + ((u >> 16) & 1u)) >> 16); }
using bf16x8 = __attribute__((ext_vector_type(8))) short;
using s16x4  = __attribute__((ext_vector_type(4))) short;
using f32x16 = __attribute__((ext_vector_type(16))) float;
using f32x8  = __attribute__((ext_vector_type(8))) float;
using u32x4  = __attribute__((ext_vector_type(4))) unsigned;
using f32x4_ = __attribute__((ext_vector_type(4))) float;
#define KSWZ(row, colB) ((row) * 256 + ((colB) ^ (((row) & 7) << 4)))
#define SBAR() __builtin_amdgcn_sched_barrier(0)
__device__ __forceinline__ int crow(int r, int hi) { return (r & 3) + 8 * (r >> 2) + 4 * hi; }
__device__ __forceinline__ unsigned cvtpk(float lo, float hi) {
  typedef float f32x2_c __attribute__((ext_vector_type(2))); typedef __bf16 bf16x2_c __attribute__((ext_vector_type(2)));
  const f32x2_c v = {lo, hi}; return __builtin_bit_cast(unsigned, __builtin_convertvector(v, bf16x2_c));
}
template <typename TIn> struct Stage;
template <> struct Stage<bf16>  { using T = bf16x8;
  __device__ static __forceinline__ T ld8(const bf16* p) { return *reinterpret_cast<const bf16x8*>(p); }
  __device__ static __forceinline__ bf16x8 tobf(T x) { return x; } };
template <> struct Stage<float> { using T = f32x8;
  __device__ static __forceinline__ T ld8(const float* p) { return *reinterpret_cast<const f32x8*>(p); }
  __device__ static __forceinline__ bf16x8 tobf(T x) {
    u32x4 w = {cvtpk(x[0], x[1]), cvtpk(x[2], x[3]), cvtpk(x[4], x[5]), cvtpk(x[6], x[7])}; return *reinterpret_cast<bf16x8*>(&w); } };

__device__ __forceinline__ void partialSM(f32x16& p0, f32x16& p1, float& m_reg, float& mn, float& alpha) {
  constexpr float C = SCALE * 1.4426950408889634f;
  float pmax = p0[0]; for (int r = 1; r < 16; ++r) pmax = fmaxf(pmax, p0[r]); for (int r = 0; r < 16; ++r) pmax = fmaxf(pmax, p1[r]);
  { auto rr = __builtin_amdgcn_permlane32_swap(__float_as_uint(pmax), __float_as_uint(pmax), false, false);
    pmax = fmaxf(__uint_as_float(rr[0]), __uint_as_float(rr[1])); }
  if (__builtin_expect(__all(pmax - m_reg <= THR / SCALE), 1)) { mn = m_reg; alpha = 1.f; }
  else { mn = fmaxf(m_reg, pmax); alpha = __builtin_amdgcn_exp2f((m_reg - mn) * C); m_reg = mn; }
  float mnC = -mn * C;
  for (int r = 0; r < 16; ++r) p0[r] = fmaf(p0[r], C, mnC); for (int r = 0; r < 16; ++r) p1[r] = fmaf(p1[r], C, mnC);
  for (int r = 0; r < 16; ++r) p0[r] = __builtin_amdgcn_exp2f(p0[r]);
}
__device__ __forceinline__ void finishSM(f32x16& p0, f32x16& p1, float alpha, float& l_reg, bf16x8& pa0, bf16x8& pa1, bf16x8& pa2, bf16x8& pa3) {
  for (int r = 0; r < 16; ++r) p1[r] = __builtin_amdgcn_exp2f(p1[r]);
  float ps = 0; for (int r = 0; r < 16; ++r) ps += p0[r]; for (int r = 0; r < 16; ++r) ps += p1[r];
  { auto rr = __builtin_amdgcn_permlane32_swap(__float_as_uint(ps), __float_as_uint(ps), false, false);
    ps = __uint_as_float(rr[0]) + __uint_as_float(rr[1]); }
  l_reg = l_reg * alpha + ps;
#define PK4(P, BASE, OUT) do { unsigned a0 = cvtpk(P[BASE + 0], P[BASE + 1]), a1 = cvtpk(P[BASE + 2], P[BASE + 3]);   \
    unsigned b0 = cvtpk(P[BASE + 4], P[BASE + 5]), b1 = cvtpk(P[BASE + 6], P[BASE + 7]);                              \
    auto r0 = __builtin_amdgcn_permlane32_swap(a0, b0, false, false); auto r1 = __builtin_amdgcn_permlane32_swap(a1, b1, false, false); \
    u32x4 w = {r0[0], r1[0], r0[1], r1[1]}; OUT = *reinterpret_cast<bf16x8*>(&w); } while (0)
  PK4(p0, 0, pa0); PK4(p0, 8, pa1); PK4(p1, 0, pa2); PK4(p1, 8, pa3);
#undef PK4
}
__device__ __forceinline__ void qkt(f32x16& p0, f32x16& p1, const bf16* Ks, const bf16x8* qr, int r32, int hi) {
  p0 = f32x16{}; p1 = f32x16{};
  for (int d0 = 0; d0 < 8; ++d0) { int cb = (d0 * 16 + hi * 8) * 2;
    bf16x8 b0 = *reinterpret_cast<const bf16x8*>((const char*)Ks + KSWZ(r32, cb));
    bf16x8 b1 = *reinterpret_cast<const bf16x8*>((const char*)Ks + KSWZ(32 + r32, cb));
    p0 = __builtin_amdgcn_mfma_f32_32x32x16_bf16(b0, qr[d0], p0, 0, 0, 0);
    p1 = __builtin_amdgcn_mfma_f32_32x32x16_bf16(b1, qr[d0], p1, 0, 0, 0); }
}
__device__ __forceinline__ int v_st(int k, int c) { const int kk = (k & ~0xC) | ((k & 4) << 1) | ((k & 8) >> 1); return ((kk >> 3) * 4 + (c >> 5)) * 512 + ((kk & 7) * 32 + (c & 31)) * 2; }
__device__ __forceinline__ int v_rd_base(int lane) { return ((lane & 3) << 3) | (((lane >> 2) & 3) << 6) | (((lane >> 4) & 1) << 5) | (((lane >> 5) & 1) << 8); }
constexpr int v_rd_off(int d0, int ks, int half) { return d0 * 512 + ks * 4096 + half * 2048; }
template <int OFF> __device__ __forceinline__ s16x4 tr_read(int vb) {
  s16x4 r; asm volatile("ds_read_b64_tr_b16 %0, %1 offset:%2" : "=&v"(r) : "v"(vb), "i"(OFF) : "memory"); return r;
}
template <int D0> __device__ __forceinline__ void pv_one(f32x16& od, int vb, bf16x8 pa0, bf16x8 pa1, bf16x8 pa2, bf16x8 pa3) {
  const s16x4 l0 = tr_read<v_rd_off(D0, 0, 0)>(vb), h0 = tr_read<v_rd_off(D0, 0, 1)>(vb), l1 = tr_read<v_rd_off(D0, 1, 0)>(vb), h1 = tr_read<v_rd_off(D0, 1, 1)>(vb);
  const s16x4 l2 = tr_read<v_rd_off(D0, 2, 0)>(vb), h2 = tr_read<v_rd_off(D0, 2, 1)>(vb), l3 = tr_read<v_rd_off(D0, 3, 0)>(vb), h3 = tr_read<v_rd_off(D0, 3, 1)>(vb);
  asm volatile("s_waitcnt lgkmcnt(0)" ::: "memory"); SBAR();
#define PK(L, H) (bf16x8){L[0], L[1], L[2], L[3], H[0], H[1], H[2], H[3]}
  od = __builtin_amdgcn_mfma_f32_32x32x16_bf16(pa0, PK(l0, h0), od, 0, 0, 0);
  od = __builtin_amdgcn_mfma_f32_32x32x16_bf16(pa1, PK(l1, h1), od, 0, 0, 0);
  od = __builtin_amdgcn_mfma_f32_32x32x16_bf16(pa2, PK(l2, h2), od, 0, 0, 0);
  od = __builtin_amdgcn_mfma_f32_32x32x16_bf16(pa3, PK(l3, h3), od, 0, 0, 0);
#undef PK
}
__device__ __forceinline__ void pv_d0(f32x16* o, int vb, bf16x8 pa0, bf16x8 pa1, bf16x8 pa2, bf16x8 pa3) {
  pv_one<0>(o[0], vb, pa0, pa1, pa2, pa3); pv_one<1>(o[1], vb, pa0, pa1, pa2, pa3); pv_one<2>(o[2], vb, pa0, pa1, pa2, pa3); pv_one<3>(o[3], vb, pa0, pa1, pa2, pa3);
}

__device__ __forceinline__ void attn_dense_body(const bf16* __restrict__ Qb, const bf16* __restrict__ Kh, const bf16* __restrict__ Vh,
                                                const bf16* __restrict__ Gb, bf16* __restrict__ Yb, int seq, char* lds, const int wave_) {
  using TQ = bf16; using St = Stage<bf16>; using SQ = Stage<TQ>;
  const int wid = wave_, lane = fresh_lane(), tid = wid * 64 + lane, r32 = lane & 31, hi = lane >> 5;
  bf16* V_lds = (bf16*)lds; bf16* K_lds = (bf16*)(lds + 2 * SHM_V);
  float* ws = (float*)(lds + 2 * SHM_V + 2 * SHM_K) + wid * 64; float* li_l = ws; float* al_l = ws + 32;
  float m_reg = -1e30f, l_reg = 0; f32x16 o[4] = {}; bf16x8 qr[8];
  const TQ* Qw = Qb + (long)(wid * QBLK + r32) * LDQ + hi * 8;
#pragma unroll
  for (int d0 = 0; d0 < 8; ++d0) qr[d0] = SQ::tobf(SQ::ld8(Qw + d0 * 16));
  const int sr = tid >> 4, sc = (tid & 15) * 8, vst0 = v_st(sr, sc), vst1 = v_st(32 + sr, sc);
  const unsigned toff = (unsigned)(sr * LDK + sc);
  const int vb0 = (int)(uintptr_t)V_lds + v_rd_base(lane);
  struct { typename St::T vs0, vs1, ks0, ks1; } sr_[SDEPTH];
#define SLOAD(i, k0) do { const bf16* vb_ = Vh + (long)(k0) * LDK; const bf16* kb_ = Kh + (long)(k0) * LDK; \
    sr_[i].vs0 = St::ld8(vb_ + toff); sr_[i].vs1 = St::ld8(vb_ + 32 * LDK + toff); \
    sr_[i].ks0 = St::ld8(kb_ + toff); sr_[i].ks1 = St::ld8(kb_ + 32 * LDK + toff); } while (0)
#define SWRITE(b, i) do { *(bf16x8*)((char*)V_lds + (b) * SHM_V + vst0) = St::tobf(sr_[i].vs0);          \
    *(bf16x8*)((char*)V_lds + (b) * SHM_V + vst1) = St::tobf(sr_[i].vs1); int kc = sc * 2;               \
    *(bf16x8*)((char*)K_lds + (b) * SHM_K + KSWZ(sr, kc)) = St::tobf(sr_[i].ks0);                       \
    *(bf16x8*)((char*)K_lds + (b) * SHM_K + KSWZ(32 + sr, kc)) = St::tobf(sr_[i].ks1); } while (0)
#define SWAIT() do { if constexpr (SDEPTH == 2) asm volatile("s_waitcnt vmcnt(4)" ::: "memory"); else asm volatile("s_waitcnt vmcnt(0)" ::: "memory"); } while (0)
#define RESC(a) do { if (__any((a) < 1.f)) { if (hi == 0) al_l[r32] = (a); asm volatile("s_waitcnt lgkmcnt(0)" ::: "memory"); \
    for (int d = 0; d < 4; ++d) for (int r = 0; r < 16; ++r) o[d][r] *= al_l[crow(r, hi)]; } } while (0)
  f32x16 pA0, pA1, pB0, pB1; float mnA, mnB, alA, alB; bf16x8 pa0, pa1, pa2, pa3; const int NT = seq / KVBLK;
  constexpr int SE = 0, SO = SDEPTH - 1;
  SLOAD(SE, 0); asm volatile("s_waitcnt vmcnt(0)" ::: "memory"); SWRITE(0, SE); __syncthreads();
  qkt(pA0, pA1, K_lds, qr, r32, hi); partialSM(pA0, pA1, m_reg, mnA, alA);
  SLOAD(SO, KVBLK); if constexpr (SDEPTH == 2) { if (2 < NT) SLOAD(SE, 2 * KVBLK); }
  SWAIT(); SWRITE(1, SO); __syncthreads();
  for (int j = 1; j + 1 < NT; j += 2) {
    SBAR(); qkt(pB0, pB1, (bf16*)((char*)K_lds + SHM_K), qr, r32, hi);
    finishSM(pA0, pA1, alA, l_reg, pa0, pa1, pa2, pa3); SBAR();
    SLOAD(SO, (j + SDEPTH) * KVBLK); SBAR();
    pv_d0(o, vb0, pa0, pa1, pa2, pa3); partialSM(pB0, pB1, m_reg, mnB, alB);
    __syncthreads(); SWAIT(); SWRITE(0, SE);
    RESC(alB); __syncthreads();
    SBAR(); qkt(pA0, pA1, K_lds, qr, r32, hi);
    finishSM(pB0, pB1, alB, l_reg, pa0, pa1, pa2, pa3); SBAR();
    if (SDEPTH == 1 || j + 3 < NT) SLOAD(SE, (j + 1 + SDEPTH) * KVBLK); SBAR();
    pv_d0(o, vb0 + (int)SHM_V, pa0, pa1, pa2, pa3); partialSM(pA0, pA1, m_reg, mnA, alA);
    __syncthreads(); SWAIT(); SWRITE(1, SO);
    RESC(alA); __syncthreads();
  }
  SBAR(); qkt(pB0, pB1, (bf16*)((char*)K_lds + SHM_K), qr, r32, hi);
  finishSM(pA0, pA1, alA, l_reg, pa0, pa1, pa2, pa3); SBAR();
  pv_d0(o, vb0, pa0, pa1, pa2, pa3); partialSM(pB0, pB1, m_reg, mnB, alB);
  __syncthreads(); RESC(alB);
  finishSM(pB0, pB1, alB, l_reg, pa0, pa1, pa2, pa3); SBAR();
  pv_d0(o, vb0 + (int)SHM_V, pa0, pa1, pa2, pa3);
  if (hi == 0) li_l[r32] = l_reg; asm volatile("s_waitcnt lgkmcnt(0)" ::: "memory");
  float rli[16];
#pragma unroll
  for (int r = 0; r < 16; ++r) rli[r] = __builtin_amdgcn_rcpf(li_l[crow(r, hi)]);
  __syncthreads();
  { float* stg = (float*)(lds + wid * 16384);
#pragma unroll
    for (int r = 0; r < 16; ++r) { const int orow = crow(r, hi);
#pragma unroll
      for (int d0 = 0; d0 < 4; ++d0) stg[orow * 128 + d0 * 32 + r32] = o[d0][r] * rli[r]; }
    asm volatile("s_waitcnt lgkmcnt(0)" ::: "memory");
    const int ch = lane & 15, rb = lane >> 4;
    const bf16* Gw = Gb + (long)(wid * QBLK + rb) * LDQ + ch * 8; bf16* Yw = Yb + (long)(wid * QBLK + rb) * LDY + ch * 8;
    u32x4 gq[8];
#pragma unroll
    for (int i = 0; i < 8; ++i) gq[i] = *(const u32x4*)(Gw + (long)(4 * i) * LDQ);
#pragma unroll
    for (int i = 0; i < 8; ++i) { const float* sp = stg + (4 * i + rb) * 128 + ch * 8;
      const f32x4_ a = *(const f32x4_*)sp, b = *(const f32x4_*)(sp + 4); u32x4 w;
      w[0] = cvtpk(a[0] * __uint_as_float(gq[i][0] << 16), a[1] * __uint_as_float(gq[i][0] & 0xffff0000u));
      w[1] = cvtpk(a[2] * __uint_as_float(gq[i][1] << 16), a[3] * __uint_as_float(gq[i][1] & 0xffff0000u));
      w[2] = cvtpk(b[0] * __uint_as_float(gq[i][2] << 16), b[1] * __uint_as_float(gq[i][2] & 0xffff0000u));
      w[3] = cvtpk(b[2] * __uint_as_float(gq[i][3] << 16), b[3] * __uint_as_float(gq[i][3] & 0xffff0000u));
      *(u32x4*)(Yw + (long)(4 * i) * LDY) = w; } }
  __syncthreads();
#undef SLOAD
#undef SWRITE
#undef SWAIT
#undef RESC
}

__device__ __forceinline__ void attn_band_unit(const bf16* __restrict__ P, bf16* __restrict__ OG, float* __restrict__ LSE, int g, int b, int h, int blk, int cqb, int ckb, int cvb, int seqlen, int ntok, char* lds, const int wave_) {
  using St = Stage<bf16>;
  const int wid = wave_, lane = fresh_lane(), tid = wid * 64 + lane, r32 = lane & 31, hi = lane >> 5;
  bf16* V_lds = (bf16*)lds; bf16* K_lds = (bf16*)(lds + 2 * SHM_V);
  float* ws = (float*)(lds + 2 * SHM_V + 2 * SHM_K) + wid * 64; float* li_l = ws; float* al_l = ws + 32;
  const int dil = (g == 0) ? 1 : (g == 1 ? 4 : 16), head = g * 4 + h;
  int rq, lq0, ntile, t_lo, res0;
  if (g < 2) { const int kb = (g == 0) ? blk : (blk & 1), nt_all = seqlen / dil / 64; res0 = (g == 0) ? 0 : (blk >> 1);
    rq = res0; lq0 = 256 * kb + 32 * wid; t_lo = (4 * kb - 1 < 0) ? 0 : 4 * kb - 1; const int t_hi = (4 * kb + 5 > nt_all) ? nt_all : 4 * kb + 5; ntile = t_hi - t_lo; }
  else { res0 = 2 * blk; rq = res0 + (wid >> 2); lq0 = 32 * (wid & 3); t_lo = 0; ntile = 4; }
  const long tok0 = (long)b * seqlen;
  const bf16* Pq = P + cqb + head * D; const bf16* Pk = P + ckb + head * D; const bf16* Pv = P + cvb + head * D;
  float m_reg = -1e30f, l_reg = 0; f32x16 o[4] = {}; bf16x8 qr[8];
  { const bf16* Qw = Pq + (tok0 + (long)(lq0 + r32) * dil + rq) * LDQ + hi * 8;
#pragma unroll
    for (int d0 = 0; d0 < 8; ++d0) qr[d0] = St::ld8(Qw + d0 * 16); }
  const int sr = tid >> 4, sc = (tid & 15) * 8, vst0 = v_st(sr, sc), vst1 = v_st(32 + sr, sc);
  const int vb0 = (int)(uintptr_t)V_lds + v_rd_base(lane);
  typename St::T vs0, vs1, ks0, ks1, vt0, vt1, kt0, kt1;
#define TILE_RK(tt) ((g < 2) ? res0 : res0 + ((tt) >> 1))
#define TILE_LK0(tt) ((g < 2) ? 64 * (t_lo + (tt)) : 64 * ((tt) & 1))
#define BLOAD(tt, V0, V1, K0, K1) do { const int rk_ = TILE_RK(tt), lk_ = TILE_LK0(tt); const long ta = (tok0 + (long)(lk_ + sr) * dil + rk_) * LDK + sc, tb = (tok0 + (long)(lk_ + 32 + sr) * dil + rk_) * LDK + sc; \
    V0 = St::ld8(Pv + ta); V1 = St::ld8(Pv + tb); K0 = St::ld8(Pk + ta); K1 = St::ld8(Pk + tb); } while (0)
#define BWRITE(V0, V1, K0, K1) do { *(bf16x8*)((char*)V_lds + vst0) = V0; *(bf16x8*)((char*)V_lds + vst1) = V1; const int kc = sc * 2; \
    *(bf16x8*)((char*)K_lds + KSWZ(sr, kc)) = K0; *(bf16x8*)((char*)K_lds + KSWZ(32 + sr, kc)) = K1; } while (0)
#define BCOMPUTE(tt) do { const int rk = TILE_RK(tt), lk0 = TILE_LK0(tt); \
    const bool need = (rk == rq) && (lk0 + 63 >= lq0 - 64) && (lk0 <= lq0 + 95); \
    if (need) { \
      f32x16 p0, p1; float mn, alpha; bf16x8 pa0, pa1, pa2, pa3; \
      qkt(p0, p1, K_lds, qr, r32, hi); \
      const int dd = lk0 - lq0 - r32 + 4 * hi;                      \
      _Pragma("unroll") for (int r = 0; r < 16; ++r) { const int d0_ = dd + (r & 3) + 8 * (r >> 2), d1_ = d0_ + 32; \
        if (d0_ < -64 || d0_ > 64) p0[r] = -INFINITY; if (d1_ < -64 || d1_ > 64) p1[r] = -INFINITY; } \
      partialSM(p0, p1, m_reg, mn, alpha); \
      if (__any(alpha < 1.f)) { if (hi == 0) al_l[r32] = alpha; asm volatile("s_waitcnt lgkmcnt(0)" ::: "memory"); \
        _Pragma("unroll") for (int d = 0; d < 4; ++d) _Pragma("unroll") for (int r = 0; r < 16; ++r) o[d][r] *= al_l[crow(r, hi)]; } \
      finishSM(p0, p1, alpha, l_reg, pa0, pa1, pa2, pa3); SBAR(); \
      pv_d0(o, vb0, pa0, pa1, pa2, pa3); \
    } } while (0)
  BLOAD(0, vs0, vs1, ks0, ks1); if (ntile > 1) BLOAD(1, vt0, vt1, kt0, kt1);
  for (int tt = 0; tt < ntile; tt += 2) {
    __syncthreads();
    BWRITE(vs0, vs1, ks0, ks1);
    __syncthreads();
    if (tt + 2 < ntile) BLOAD(tt + 2, vs0, vs1, ks0, ks1);
    BCOMPUTE(tt);
    if (tt + 1 < ntile) {
      __syncthreads();
      BWRITE(vt0, vt1, kt0, kt1);
      __syncthreads();
      if (tt + 3 < ntile) BLOAD(tt + 3, vt0, vt1, kt0, kt1);
      BCOMPUTE(tt + 1);
    }
  }
#undef BWRITE
#undef BCOMPUTE
#undef BLOAD
#undef TILE_RK
#undef TILE_LK0
  if (hi == 0) li_l[r32] = l_reg; asm volatile("s_waitcnt lgkmcnt(0)" ::: "memory");
  float rli[16];
#pragma unroll
  for (int r = 0; r < 16; ++r) rli[r] = __builtin_amdgcn_rcpf(li_l[crow(r, hi)]);
  __syncthreads();
  { float* stg = (float*)(lds + wid * 16384);
#pragma unroll
    for (int r = 0; r < 16; ++r) { const int orow = crow(r, hi);
#pragma unroll
      for (int d0 = 0; d0 < 4; ++d0) stg[orow * 128 + d0 * 32 + r32] = o[d0][r] * rli[r]; }
    asm volatile("s_waitcnt lgkmcnt(0)" ::: "memory");
    const int ch = lane & 15, rb = lane >> 4;
    bf16* Og = OG + (long)g * ntok * 512 + h * D + ch * 8;
#pragma unroll
    for (int i = 0; i < 8; ++i) { const int row = 4 * i + rb; const float* sp = stg + row * 128 + ch * 8;
      const f32x4_ a = *(const f32x4_*)sp, b = *(const f32x4_*)(sp + 4); u32x4 w;
      w[0] = cvtpk(a[0], a[1]); w[1] = cvtpk(a[2], a[3]); w[2] = cvtpk(b[0], b[1]); w[3] = cvtpk(b[2], b[3]);
      *(u32x4*)(Og + (tok0 + (long)(lq0 + row) * dil + rq) * 512) = w; } }
  if (hi == 0) LSE[((long)g * ntok + tok0 + (long)(lq0 + r32) * dil + rq) * 4 + h] = m_reg * SCALE + __logf(l_reg);
  __syncthreads();
}
}

typedef unsigned short bf16_t;
constexpr int BATCH = 4, SEQ = 2048, DM = 2048, NTOK = BATCH * SEQ, NC = 11776;
constexpr int C_QA = 0, C_KA = 1024, C_VA = 1280, C_GA = 1536, C_QB = 2560, C_KB = 4096, C_VB = 5632, C_GB = 7168, C_ZA = 7680, C_ZB = 9728;
constexpr float EPS = 1e-6f;
constexpr float H8_SCALE = 4.0f, W8_SCALE = 64.0f;
constexpr size_t MiB = 1u << 20;
constexpr int PITCH = 7680;
constexpr size_t WS_CTL = 0, WS_TAB = 1 * MiB, WS_XB = 1 * MiB + 512 * 1024, WS_WTIN = 2 * MiB, WS_WTAB = 48 * MiB, WS_WTO = 54 * MiB, WS_HB = 64 * MiB, WS_P = 96 * MiB, WS_Y = 216 * MiB, WS_OG = 240 * MiB, WS_LSE = 264 * MiB,
                 WS_SA = 266 * MiB, WS_SB = 298 * MiB, WS_H8 = 330 * MiB, WS_WTZ8 = 346 * MiB, WS_END = 361 * MiB;

#define LAS __attribute__((address_space(3)))
typedef float f32x4 __attribute__((ext_vector_type(4)));
typedef unsigned v4u __attribute__((ext_vector_type(4)));
constexpr int NWAVES = 8;
constexpr int LDS_BYTES = 147456;

__device__ __forceinline__ float bf2f(bf16_t h) { return __uint_as_float(((unsigned)h) << 16); }
__device__ __forceinline__ unsigned f2bf_u(float f) { unsigned u = __float_as_uint(f); return (u + 0x7fffu + ((u >> 16) & 1u)) >> 16; }
__device__ __forceinline__ bf16_t f2bf(float f) { return (bf16_t)f2bf_u(f); }
__device__ __forceinline__ unsigned pk2(float lo, float hi) { return f2bf_u(lo) | (f2bf_u(hi) << 16); }
__device__ __forceinline__ float wave_sum(float v) {
#pragma unroll
    for (int o = 1; o < 64; o <<= 1) v += __shfl_xor(v, o);
    return v;
}

__device__ __forceinline__ int colmap(int kind, int p) {
    const int bj = p >> 7, wc = (p >> 5) & 3, n = (p >> 4) & 1, fq = (p >> 2) & 3, j = p & 3;
    const int gen = 128 * bj + 32 * wc + 8 * fq + 4 * n + j;
    if (kind == 0) return p;
    if (kind == 1) return gen;
    if (kind == 2) return 128 * bj + 64 * (wc >> 1) + 32 * n + 16 * (wc & 1) + 4 * fq + j;
    return wc == 0 ? p : gen;
}
__device__ __forceinline__ int kind_in(int pn) { return pn < 5 ? 2 : ((pn >= 10 && pn < 22) ? 3 : 1); }

struct TrSrc { const float* W; int N; bf16_t* WT; int ldt, koff, kindsel; unsigned char* wt8; int n8; };
__device__ __forceinline__ void tr_load(const TrSrc& t, int item, int lane, f32x4 (&v)[8]) {
    const int nblk = t.N / 32, kb = item / nblk, nb = item % nblk, k0 = 64 * kb, n0 = 32 * nb;
    const int np = n0 + 4 * (lane & 7), pn = np >> 8;
    const int kind = t.kindsel < 0 ? kind_in(pn) : t.kindsel;
    const float* src = t.W + (size_t)(k0 + (lane >> 3)) * t.N + (pn << 8) + colmap(kind, np & 255);
#pragma unroll
    for (int i = 0; i < 8; ++i) v[i] = __builtin_nontemporal_load((const f32x4*)(src + (size_t)(8 * i) * t.N));
}
__device__ __forceinline__ void tr_store(const TrSrc& t, int item, int lane, const f32x4 (&v)[8], LAS float* scr) {
    const int nblk = t.N / 32, kb = item / nblk, nb = item % nblk, k0 = 64 * kb, n0 = 32 * nb;
    { LAS float* d = scr + (lane >> 3) * 33 + 4 * (lane & 7);
#pragma unroll
      for (int i = 0; i < 8; ++i) { d[i * 264 + 0] = v[i][0]; d[i * 264 + 1] = v[i][1]; d[i * 264 + 2] = v[i][2]; d[i * 264 + 3] = v[i][3]; } }
    asm volatile("s_waitcnt lgkmcnt(0)" ::: "memory");
    const int c = lane & 7;
    const int pn_ = n0 >> 8; const bool is8 = t.wt8 != nullptr && (n0 >= t.n8 || pn_ < 14);
    const int n8row = n0 >= t.n8 ? n0 - t.n8 + 14 * 256 : n0;
    if (is8) {
#pragma unroll
        for (int j = 0; j < 4; ++j) { const int n = (lane >> 3) + 8 * j; const LAS float* sp = scr + (8 * c) * 33 + n;
            int lo = 0, hi = 0;
            lo = __builtin_amdgcn_cvt_pk_fp8_f32(sp[0 * 33] * W8_SCALE, sp[1 * 33] * W8_SCALE, lo, false); lo = __builtin_amdgcn_cvt_pk_fp8_f32(sp[2 * 33] * W8_SCALE, sp[3 * 33] * W8_SCALE, lo, true);
            hi = __builtin_amdgcn_cvt_pk_fp8_f32(sp[4 * 33] * W8_SCALE, sp[5 * 33] * W8_SCALE, hi, false); hi = __builtin_amdgcn_cvt_pk_fp8_f32(sp[6 * 33] * W8_SCALE, sp[7 * 33] * W8_SCALE, hi, true);
            *(unsigned long long*)(t.wt8 + (size_t)(n8row + n) * t.ldt + k0 + 8 * c) = (unsigned long long)(unsigned)lo | ((unsigned long long)(unsigned)hi << 32); }
    } else {
#pragma unroll
    for (int j = 0; j < 4; ++j) { const int n = (lane >> 3) + 8 * j; const LAS float* sp = scr + (8 * c) * 33 + n;
        v4u o; o.x = pk2(sp[0 * 33], sp[1 * 33]); o.y = pk2(sp[2 * 33], sp[3 * 33]); o.z = pk2(sp[4 * 33], sp[5 * 33]); o.w = pk2(sp[6 * 33], sp[7 * 33]);
        *(v4u*)(t.WT + (size_t)(n0 + n) * t.ldt + t.koff + k0 + 8 * c) = o; }
    }
    asm volatile("s_waitcnt lgkmcnt(0)" ::: "memory");
}
__device__ __forceinline__ void tr_matrix(const TrSrc& t, int nitems, int gw, int NGW, int lane, LAS float* scr) {
    f32x4 a[8], b[8];
    int it = gw;
    if (it < nitems) tr_load(t, it, lane, a);
    for (; it < nitems; it += 2 * NGW) {
        const bool hb = it + NGW < nitems;
        if (hb) tr_load(t, it + NGW, lane, b);
        tr_store(t, it, lane, a, scr);
        if (hb) { if (it + 2 * NGW < nitems) tr_load(t, it + 2 * NGW, lane, a); tr_store(t, it + NGW, lane, b, scr); }
    }
}
__device__ __forceinline__ void rms_row_load(const float* xrow, int lane, f32x4 (&v)[8]) {
    const f32x4* xr = (const f32x4*)xrow + lane;
#pragma unroll
    for (int j = 0; j < 8; ++j) v[j] = __builtin_nontemporal_load(xr + 64 * j);
}
__device__ __forceinline__ void rms_row_store(const f32x4 (&v)[8], const float* gain, bf16_t* orow, unsigned char* orow8, int lane) {
    const f32x4* gr = (const f32x4*)gain + lane; float s = 0.f;
#pragma unroll
    for (int j = 0; j < 8; ++j) s += (v[j].x * v[j].x + v[j].y * v[j].y) + (v[j].z * v[j].z + v[j].w * v[j].w);
    const float rs = rsqrtf(wave_sum(s) * (1.f / DM) + EPS);
    unsigned long long* o8 = (unsigned long long*)orow + lane;
    unsigned* q8 = (unsigned*)orow8 + lane;
#pragma unroll
    for (int j = 0; j < 8; ++j) { const f32x4 g = gr[64 * j]; const f32x4 y = v[j] * rs * g;
        o8[64 * j] = (unsigned long long)pk2(y.x, y.y) | ((unsigned long long)pk2(y.z, y.w) << 32);
        int w = 0; w = __builtin_amdgcn_cvt_pk_fp8_f32(y.x * H8_SCALE, y.y * H8_SCALE, w, false); w = __builtin_amdgcn_cvt_pk_fp8_f32(y.z * H8_SCALE, y.w * H8_SCALE, w, true);
        q8[64 * j] = (unsigned)w; }
}
__device__ __forceinline__ void rms_rows(const float* x, const float* gain, bf16_t* H, unsigned char* H8, int m0, int step, int nrows, int lane) {
    f32x4 a[8], b[8];
    int m = m0;
    if (m < nrows) rms_row_load(x + (size_t)m * DM, lane, a);
    for (; m < nrows; m += 2 * step) {
        const bool hb = m + step < nrows;
        if (hb) rms_row_load(x + (size_t)(m + step) * DM, lane, b);
        rms_row_store(a, gain, H + (size_t)m * DM, H8 + (size_t)m * DM, lane);
        if (hb) { if (m + 2 * step < nrows) rms_row_load(x + (size_t)(m + 2 * step) * DM, lane, a); rms_row_store(b, gain, H + (size_t)(m + step) * DM, H8 + (size_t)(m + step) * DM, lane); }
    }
}

#define XB_TMO      128
#define XB_XCNT(j)  (256  + 64 * (j))
#define XB_XSUB(j)  (1280 + 64 * (j))
#define XB_XGEN(j)  (2304 + 64 * (j))
#define XB_TOP      3328
#define XB_TOPGEN   3392
#define XCD_BAR_WORDS 3456
#define XB_SPIN_CAP (1u << 18)

__device__ __forceinline__ unsigned xb_ld(unsigned* p)              { return __hip_atomic_load(p, __ATOMIC_RELAXED, __HIP_MEMORY_SCOPE_AGENT); }
__device__ __forceinline__ unsigned xb_add(unsigned* p, unsigned v) { return __hip_atomic_fetch_add(p, v, __ATOMIC_RELAXED, __HIP_MEMORY_SCOPE_AGENT); }
__device__ __forceinline__ unsigned xb_xcc_id() { return (unsigned)__builtin_amdgcn_s_getreg((3 << 11) | 20) & 0xFu; }
#define XB_SPIN(cond, bar) do { unsigned _sp = 0; while (cond) { __builtin_amdgcn_s_sleep(1); \
    if ((++_sp & 255u) == 0u) { if (xb_ld(&(bar)[XB_TMO])) break; if (_sp > XB_SPIN_CAP) { atomicAdd(&(bar)[XB_TMO], 1u); break; } } } } while (0)

struct XcdBarrier {
    unsigned* bar; unsigned x;
    volatile LAS unsigned* st;
};

__device__ __forceinline__ XcdBarrier xcd_barrier_post(unsigned* bar, volatile LAS unsigned* st) {
    XcdBarrier b; b.bar = bar; b.x = xb_xcc_id(); b.st = st;
    if (threadIdx.x == 0) (void)xb_add(&bar[XB_XCNT(b.x)], 1u);
    return b;
}
__device__ __forceinline__ void xcd_barrier_complete(unsigned* bar, unsigned x, unsigned& nloc, unsigned& nx) {
    const unsigned G = gridDim.x * gridDim.y * gridDim.z;
    unsigned sum, cnt, mine, sp = 0u;
    for (;;) {
        sum = 0u; cnt = 0u; mine = 0u;
#pragma unroll
        for (unsigned j = 0; j < 16; ++j) { const unsigned c = xb_ld(&bar[XB_XCNT(j)]); sum += c; cnt += (c > 0u) ? 1u : 0u; mine = (j == x) ? c : mine; }
        if (sum == G) break;
        __builtin_amdgcn_s_sleep(1);
        if ((++sp & 255u) == 0u) { if (xb_ld(&bar[XB_TMO])) break; if (sp > XB_SPIN_CAP) { atomicAdd(&bar[XB_TMO], 1u); break; } }
    }
    nloc = mine > 0u ? mine : 1u; nx = cnt > 0u ? cnt : 1u;
}

__device__ __forceinline__ void xcd_barrier(const XcdBarrier& b, const int wave_) {
    asm volatile("s_waitcnt vmcnt(0)" ::: "memory");
    __syncthreads();
    if (wave_ == 0 && fresh_lane() == 0) {
        unsigned* bar = b.bar;
        __builtin_amdgcn_s_waitcnt(0);
        unsigned nloc = b.st[0], nx = b.st[1];
        if (nloc == 0u) { xcd_barrier_complete(bar, b.x, nloc, nx); b.st[0] = nloc; b.st[1] = nx; }
        const unsigned old = xb_add(&bar[XB_XSUB(b.x)], 1u);
        const unsigned gen = old / nloc;
        if (old + 1u == (gen + 1u) * nloc) {
            __builtin_amdgcn_fence(__ATOMIC_RELEASE, "agent");
            asm volatile("s_waitcnt vmcnt(0)" ::: "memory");
            const unsigned og = xb_add(&bar[XB_TOP], 1u);
            const unsigned tg = og / nx;
            if (og + 1u == (tg + 1u) * nx) xb_add(&bar[XB_TOPGEN], 1u);
            else XB_SPIN(xb_ld(&bar[XB_TOPGEN]) == tg, bar);
            __builtin_amdgcn_fence(__ATOMIC_ACQUIRE, "agent");
            xb_add(&bar[XB_XGEN(b.x)], 1u);
            asm volatile("s_waitcnt vmcnt(0)" ::: "memory");
        } else {
            XB_SPIN(xb_ld(&bar[XB_XGEN(b.x)]) == gen, bar);
            __builtin_amdgcn_fence(__ATOMIC_ACQUIRE, "agent");
            asm volatile("s_waitcnt vmcnt(0)" ::: "memory");
        }
    }
    __syncthreads();
}

struct Args { const float* in[10]; float* out; unsigned char* ws; int ph_lo, ph_hi; };

__global__ void __launch_bounds__(NWAVES * 64, 2) mk_fwd(Args args) {
    extern __shared__ __attribute__((aligned(16))) unsigned char lds[];
    const int wave = __builtin_amdgcn_readfirstlane((int)threadIdx.x >> 6);
#define TID_LANE const int lane = fresh_lane(); const int tid = wave * 64 + lane; (void)tid; (void)lane;
    const int G = gridDim.x, bx = blockIdx.x;
    const int vcu = (G % 8 == 0) ? (bx % 8) * (G / 8) + bx / 8 : bx;
    unsigned char* ws = args.ws;
    const float* x = args.in[0]; const float* ng = args.in[1]; const float* w_in = args.in[2];
    bf16_t* WT_IN = (bf16_t*)(ws + WS_WTIN); bf16_t* HB = (bf16_t*)(ws + WS_HB); bf16_t* P = (bf16_t*)(ws + WS_P);
    float* COSA = (float*)(ws + WS_TAB); float* SINA = COSA + 2048; float* COSP = COSA + 4096; float* SINP = COSP + 32768;
    bf16_t* OG = (bf16_t*)(ws + WS_OG); float* LSE = (float*)(ws + WS_LSE); unsigned* CTL = (unsigned*)(ws + WS_CTL) + 4096;
    bf16_t* WT_AB = (bf16_t*)(ws + WS_WTAB); bf16_t* WT_O = (bf16_t*)(ws + WS_WTO); bf16_t* Y = (bf16_t*)(ws + WS_Y); bf16_t* MG = HB; unsigned char* H8 = ws + WS_H8; unsigned char* WTZ8 = ws + WS_WTZ8; bf16_t* SA = (bf16_t*)(ws + WS_SA); bf16_t* SB = (bf16_t*)(ws + WS_SB); float* XB = (float*)(ws + WS_XB); unsigned* PCNT = (unsigned*)(ws + WS_CTL) + 8192;
    const int lo = args.ph_lo, hi = args.ph_hi;
    volatile LAS unsigned* MISC = (volatile LAS unsigned*)((LAS unsigned char*)lds + 131072 + 320);
    if (threadIdx.x < 32) MISC[threadIdx.x] = 0u;
    __syncthreads();
    XcdBarrier bar = xcd_barrier_post((unsigned*)(ws + WS_CTL), MISC + 8);
#define GRID_BAR() xcd_barrier(bar, wave)
#define IN(k) (lo <= (k) && (k) < hi)
#define BOTH(k) (IN(k) && IN((k) + 1))
    if (IN(0)) { TID_LANE
        LAS float* scr = (LAS float*)((LAS unsigned char*)lds + wave * 16384);
        const int gw = vcu * NWAVES + wave, NGW = G * NWAVES;
        constexpr int I_IN = (DM / 64) * (NC / 32);
        { const TrSrc t{w_in, NC, WT_IN, DM, 0, -1, WTZ8, 7680}; tr_matrix(t, I_IN, gw, NGW, lane, scr); }
        for (int i = bx * (NWAVES * 64) + tid; i < 2048 + 32768; i += G * NWAVES * 64) {
            if (i < 2048) { const int pos = i >> 5, fi = i & 31; const float a = (float)pos * (1.0f / powf(10000.0f, (float)fi / 32.0f)); COSA[i] = cosf(a); SINA[i] = sinf(a); }
            else { const int k = i - 2048, pos = k >> 4, fi = k & 15; const float a = (float)pos * (1.0f / powf(500000.0f, (float)fi / 16.0f)); COSP[k] = cosf(a); SINP[k] = sinf(a); }
        }
        rms_rows(x, ng, HB, H8, gw, NGW, NTOK, lane);
        if (BOTH(0)) GRID_BAR();
    }
    if (IN(1)) { TID_LANE
        const float dsc = 1.0f / (H8_SCALE * W8_SCALE);
        {
            pg8::Gemm g{HB, WT_IN + (size_t)14 * 256 * DM, NTOK, 16 * 256, DM}; pg8::StaticOrder S; S.init(NTOK, 16 * 256, G, bx);
            pg8::EpiIn<false> E{P, PITCH, COSA, SINA, COSP, SINP, args.in[3], args.in[4], args.in[5], SA, SB, (LAS float*)((LAS unsigned char*)lds + 131072 + 1024), EPS, 1.0f};
            pg8::gemm_phase<pg8::EpiIn<false>, pg8::StaticOrder, true, true>((LAS unsigned char*)lds, g, S, E, wave);
        }
        {
            pg8::Gemm g8{(const bf16_t*)H8, (const bf16_t*)WTZ8, NTOK, 30 * 256, DM / 2}; pg8::StaticOrder S8; S8.init(NTOK, 30 * 256, G, bx);
            pg8::EpiIn<true> E8{P, PITCH, COSA, SINA, COSP, SINP, args.in[3], args.in[4], args.in[5], SA, SB, (LAS float*)((LAS unsigned char*)lds + 131072 + 1024), EPS, dsc};
            pg8::gemm_phase<pg8::EpiIn<true>, pg8::StaticOrder, true, true>((LAS unsigned char*)lds, g8, S8, E8, wave);
        }
        const int nheavy = ((NTOK / 256) * 30) % G;
        {
            const int first = nheavy > 0 ? nheavy : 0, nidle = G - first;
            if (bx >= first) {
                LAS float* scr = (LAS float*)((LAS unsigned char*)lds + wave * 16384);
                const int gw2 = (bx - first) * NWAVES + wave, NGW2 = nidle * NWAVES;
                constexpr int I_A = (1024 / 64) * (DM / 32), I_B = (512 / 64) * (DM / 32), I_O = (DM / 64) * (DM / 32);
                { const TrSrc t{args.in[6], DM, WT_AB, 1536, 0, 1, nullptr, 0}; tr_matrix(t, I_A, gw2, NGW2, lane, scr); }
                { const TrSrc t{args.in[7], DM, WT_AB, 1536, 1024, 1, nullptr, 0}; tr_matrix(t, I_B, gw2, NGW2, lane, scr); }
                { const TrSrc t{args.in[8], DM, WT_O, DM, 0, 0, nullptr, 0}; tr_matrix(t, I_O, gw2, NGW2, lane, scr); }
            }
        }
        if (BOTH(1)) GRID_BAR();
    }
    if (IN(2)) { TID_LANE
        for (int u = bx; u < 384; u += G) {
            const int blk = u & 7, h = (u >> 3) & 3, b = (u >> 5) & 3, g = u >> 7;
            att::attn_band_unit(P, OG, LSE, g, b, h, blk, C_QB, C_KB, C_VB, SEQ, NTOK, (char*)lds, wave);
        }
        asm volatile("s_waitcnt vmcnt(0)" ::: "memory"); __syncthreads();
        if (tid == 0) { __builtin_amdgcn_fence(__ATOMIC_RELEASE, "agent"); asm volatile("s_waitcnt vmcnt(0)" ::: "memory"); __hip_atomic_fetch_add(CTL, 1u, __ATOMIC_RELAXED, __HIP_MEMORY_SCOPE_AGENT); }
        for (int u = bx; u < 256; u += G) {
            const int pair = u & 7, inner = u >> 3, b = pair >> 1, hkv = pair & 1, hq = hkv * 4 + (inner >> 3), qb = inner & 7;
            const size_t row0 = (size_t)b * SEQ + qb * 256;
            att::attn_dense_body(P + row0 * PITCH + C_QA + hq * 128, P + (size_t)b * SEQ * PITCH + C_KA + hkv * 128, P + (size_t)b * SEQ * PITCH + C_VA + hkv * 128,
                                 P + row0 * PITCH + C_GA + hq * 128, Y + row0 * 1536 + hq * 128, SEQ, (char*)lds, wave);
        }
        const int mfirst = (384 - G > 0 && 384 - G < G) ? 384 - G : 0, nmerge = G - mfirst;
        if (bx >= mfirst) {
            if (tid == 0) { unsigned spins = 0; while (__hip_atomic_load(CTL, __ATOMIC_RELAXED, __HIP_MEMORY_SCOPE_AGENT) < (unsigned)G) { __builtin_amdgcn_s_sleep(4); if (++spins > (1u << 24)) break; }
                __builtin_amdgcn_fence(__ATOMIC_ACQUIRE, "agent"); asm volatile("s_waitcnt vmcnt(0)" ::: "memory"); }
            __syncthreads();
            for (int c0 = (bx - mfirst) * (NWAVES * 64) + tid; c0 < NTOK * 64; c0 += 2 * nmerge * NWAVES * 64) {
                v4u a0[2], a1[2], a2[2], gz[2]; float e0[2], e1[2], e2[2]; int tok[2], c8[2]; bool ok[2];
#pragma unroll
                for (int q = 0; q < 2; ++q) { const int ci = c0 + q * nmerge * NWAVES * 64; ok[q] = ci < NTOK * 64; const int cj = ok[q] ? ci : c0; tok[q] = cj >> 6; c8[q] = (cj & 63) * 8; const int h = c8[q] >> 7;
                    e0[q] = LSE[((size_t)0 * NTOK + tok[q]) * 4 + h]; e1[q] = LSE[((size_t)1 * NTOK + tok[q]) * 4 + h]; e2[q] = LSE[((size_t)2 * NTOK + tok[q]) * 4 + h];
                    a0[q] = *(const v4u*)(OG + ((size_t)0 * NTOK + tok[q]) * 512 + c8[q]); a1[q] = *(const v4u*)(OG + ((size_t)1 * NTOK + tok[q]) * 512 + c8[q]); a2[q] = *(const v4u*)(OG + ((size_t)2 * NTOK + tok[q]) * 512 + c8[q]);
                    gz[q] = *(const v4u*)(P + (size_t)tok[q] * PITCH + C_GB + c8[q]); }
#pragma unroll
                for (int q = 0; q < 2; ++q) { const float mx = fmaxf(e0[q], fmaxf(e1[q], e2[q])); float w0 = __expf(e0[q] - mx), w1 = __expf(e1[q] - mx), w2 = __expf(e2[q] - mx); const float inv = 1.f / (w0 + w1 + w2); w0 *= inv; w1 *= inv; w2 *= inv;
                    v4u w;
#pragma unroll
                    for (int e = 0; e < 4; ++e) {
                        const float lo = w0 * __uint_as_float(a0[q][e] << 16) + w1 * __uint_as_float(a1[q][e] << 16) + w2 * __uint_as_float(a2[q][e] << 16);
                        const float hh = w0 * __uint_as_float(a0[q][e] & 0xffff0000u) + w1 * __uint_as_float(a1[q][e] & 0xffff0000u) + w2 * __uint_as_float(a2[q][e] & 0xffff0000u);
                        w[e] = pk2(lo * __uint_as_float(gz[q][e] << 16), hh * __uint_as_float(gz[q][e] & 0xffff0000u)); }
                    if (ok[q]) *(v4u*)(Y + (size_t)tok[q] * 1536 + 1024 + c8[q]) = w; }
            }
        }
        if (BOTH(2)) GRID_BAR();
    }
    if (IN(3)) {
        pg8::Gemm g{Y, WT_AB, NTOK, DM, 1536}; pg8::StaticOrder S; S.init(NTOK, DM, G, bx);
        pg8::EpiMerge2 E{SA, SB, MG, DM};
        pg8::gemm_phase<pg8::EpiMerge2, pg8::StaticOrder, true, true>((LAS unsigned char*)lds, g, S, E, wave);
        if (BOTH(3)) GRID_BAR();
    }
    if (IN(4)) {
        pg8::Gemm g{MG, WT_O, NTOK, DM, DM}; pg8::StaticOrder S; S.init(NTOK, DM, G, bx);
        pg8::EpiResidNorm E{x, args.out, DM, args.in[9], XB, PCNT, 8, EPS};
        if (G == 256) pg8::gemm_phase<pg8::EpiResidNorm, pg8::StaticOrder, false, true>((LAS unsigned char*)lds, g, S, E, wave);
    }
#undef IN
#undef BOTH
}


extern "C" void kernel_launch(void* const* d_in, const int* in_sizes, int n_in, void* d_out, int out_size, void* d_ws, size_t ws_size, hipStream_t stream) {
    static int grid = 0;
    if (grid == 0) {
        if (n_in != 10 || in_sizes[0] != NTOK * DM || out_size != NTOK * DM || ws_size < WS_END) { fprintf(stderr, "kernel_launch: unexpected shapes / workspace (%zu)\n", ws_size); grid = -1; return; }
        int dev = 0, cus = 0, per_cu = 0;
        if (hipGetDevice(&dev) != hipSuccess || hipDeviceGetAttribute(&cus, hipDeviceAttributeMultiprocessorCount, dev) != hipSuccess) { grid = -1; return; }
        if (hipFuncSetAttribute((const void*)mk_fwd, hipFuncAttributeMaxDynamicSharedMemorySize, LDS_BYTES) != hipSuccess) { fprintf(stderr, "kernel_launch: hipFuncSetAttribute failed\n"); grid = -1; return; }
        if (hipOccupancyMaxActiveBlocksPerMultiprocessor(&per_cu, (const void*)mk_fwd, NWAVES * 64, LDS_BYTES) != hipSuccess || per_cu < 1) { fprintf(stderr, "kernel_launch: occupancy query says %d\n", per_cu); grid = -1; return; }
        grid = cus;
    }
    if (grid < 0) return;
    if (hipMemsetAsync((char*)d_ws + WS_CTL, 0, 131072, stream) != hipSuccess) { fprintf(stderr, "kernel_launch: memset failed\n"); return; }
    Args a{};
    for (int i = 0; i < 10; ++i) a.in[i] = (const float*)d_in[i];
    a.out = (float*)d_out; a.ws = (unsigned char*)d_ws; a.ph_lo = 0; a.ph_hi = 5;
    void* kargs[] = {&a};
    hipError_t e = hipLaunchCooperativeKernel((const void*)mk_fwd, dim3(grid), dim3(NWAVES * 64), kargs, LDS_BYTES, stream);
    if (e != hipSuccess) fprintf(stderr, "kernel_launch: cooperative launch failed: %s (grid %d)\n", hipGetErrorString(e), grid);
}
```

```cpp
#include <hip/hip_runtime.h>
#include <cstdio>
#include <cstdint>
#include <cmath>
__device__ __forceinline__ int fresh_lane() { int l; asm volatile("v_mbcnt_lo_u32_b32 %0, -1, 0\n\tv_mbcnt_hi_u32_b32 %0, -1, %0" : "=v"(l)); return l; }
namespace pg8 {
#define PG8_LAS __attribute__((address_space(3)))
typedef unsigned short bf16_t;
typedef short bf16x8 __attribute__((ext_vector_type(8)));
typedef float f32x4 __attribute__((ext_vector_type(4)));
typedef unsigned u32x4 __attribute__((ext_vector_type(4)));
typedef int v4i_t __attribute__((ext_vector_type(4)));
constexpr int BM = 256, BK = 64, HALF = 128, HTB = HALF * BK * 2  , STAGE_BYTES = 8 * HTB, NXCD = 8;

__host__ __device__ __forceinline__ int lds_byte(int r, int c) { const int st = (r >> 4) * 2 + (c >> 5), rr = r & 15, cc = c & 31, ob = rr * 64 + cc * 2; return st * 1024 + (ob ^ (((ob >> 9) & 1) << 5)); }
__host__ __device__ __forceinline__ void stage_rc(int b, int& R, int& C) { const int st = b / 1024, sb = b % 1024, swz = sb ^ (((sb >> 9) & 1) << 5); R = (st >> 1) * 16 + swz / 64; C = (st & 1) * 32 + (swz % 64) / 2; }
__host__ __device__ __forceinline__ int perm32(int rho) { const int n = rho >> 4, i = rho & 15; return 8 * (i >> 2) + 4 * n + (i & 3); }

struct Unit { int pm, pn; };
struct Gemm { const bf16_t* A; const bf16_t* Bt; int M, N, K; };

struct StaticOrder {
    int nM, nN, nwg, G, c, WGM;
    __host__ __device__ void init(int M, int N, int G_, int c_, int wgm = 4) { nM = M / BM; nN = N / BM; nwg = nM * nN; G = G_; c = c_; WGM = wgm; }
    __host__ __device__ bool next(int i, Unit& u) const { const long L = (long)i * G + c; if (L >= nwg) return false; unit_of((int)L, u); return true; }
    __host__ __device__ bool unit_of(int L, Unit& u) const {
        int wgid = L; { const int q = nwg / NXCD, r = nwg % NXCD, xcd = wgid % NXCD, off = wgid / NXCD; wgid = (xcd < r ? xcd * (q + 1) : r * (q + 1) + (xcd - r) * q) + off; }
        const int nig = WGM * nN, gid = wgid / nig, fm = gid * WGM, gsz = (nM - fm) < WGM ? (nM - fm) : WGM;
        u.pm = fm + ((wgid % nig) % gsz); u.pn = (wgid % nig) / gsz; return true;
    }
    __device__ __forceinline__ void a_ready(const Unit&) const {}
    __device__ __forceinline__ void done(const Unit&) const {}
};


typedef float f32x2_cv __attribute__((ext_vector_type(2))); typedef __bf16 bf16x2_cv __attribute__((ext_vector_type(2)));
__device__ __forceinline__ unsigned cvt_pk_bf16(float lo, float hi) { const f32x2_cv v = {lo, hi}; return __builtin_bit_cast(unsigned, __builtin_convertvector(v, bf16x2_cv)); }
typedef float f32x2 __attribute__((ext_vector_type(2)));

template <bool F8> struct EpiIn {
    static constexpr bool PERM = false, AFTER_DRAIN = false, FP8 = F8, INIT_ACC = false; static constexpr int HOOK_T = -1;
    bf16_t* O; int ldc; const float* cosa; const float* sina; const float* cosp; const float* sinp; const float* qg; const float* kg; const float* bias; bf16_t* SA; bf16_t* SB; PG8_LAS float* red; float eps; float sc;
    __device__ __forceinline__ static unsigned long long pk4(const f32x4 v) { return (unsigned long long)cvt_pk_bf16(v[0], v[1]) | ((unsigned long long)cvt_pk_bf16(v[2], v[3]) << 32); }
    __device__ __forceinline__ void operator()(const f32x4 (&acc)[2][2][4][2], const Unit& u, int wr, int wc, int fr_, int fq_) const {
        (void)fr_; (void)fq_; const int ln_ = fresh_lane(), fr = ln_ & 15, fq = ln_ >> 4;
        const int pn = F8 ? (u.pn < 14 ? u.pn : u.pn + 16) : u.pn + 14; const int row0 = u.pm * BM + wr * 64 + fr;
        if (pn < 5) {
#pragma unroll
            for (int ai = 0; ai < 2; ++ai)
#pragma unroll
                for (int m = 0; m < 4; ++m)
#pragma unroll
                    for (int bj = 0; bj < 2; ++bj) { const f32x4 v0 = (acc[ai][bj][m][0] * sc), v1 = (acc[ai][bj][m][1] * sc);
                        float ss = (v0[0] * v0[0] + v0[1] * v0[1]) + (v0[2] * v0[2] + v0[3] * v0[3]) + (v1[0] * v1[0] + v1[1] * v1[1]) + (v1[2] * v1[2] + v1[3] * v1[3]);
                        ss += __shfl_xor(ss, 16); ss += __shfl_xor(ss, 32);
                        if (fq == 0) red[(ai * HALF + wr * 64 + m * 16 + fr) * 8 + bj * 4 + wc] = ss; }
            asm volatile("s_waitcnt lgkmcnt(0)" ::: "memory"); __builtin_amdgcn_s_barrier(); asm volatile("" ::: "memory");
            const int half = wc >> 1, i0 = 16 * (wc & 1) + 4 * fq;
            const float* g = (pn < 4) ? qg : kg;
            const f32x4 g0 = *(const f32x4*)(g + 64 * half + i0), g1 = *(const f32x4*)(g + 64 * half + 32 + i0);
#pragma unroll
            for (int ai = 0; ai < 2; ++ai)
#pragma unroll
                for (int m = 0; m < 4; ++m) { const int row = row0 + ai * HALF + m * 16, sq = row & 2047, pos = half ? (sq & 63) : (sq >> 6);
                    const f32x4 c = *(const f32x4*)(cosa + pos * 32 + i0), sn = *(const f32x4*)(sina + pos * 32 + i0);
#pragma unroll
                    for (int bj = 0; bj < 2; ++bj) { const f32x4 pr = *(const PG8_LAS f32x4*)(red + (ai * HALF + wr * 64 + m * 16 + fr) * 8 + bj * 4);
                        const float rs = rsqrtf(((pr[0] + pr[1]) + (pr[2] + pr[3])) * (1.f / 128.f) + eps);
                        const f32x4 y0 = (acc[ai][bj][m][0] * sc) * rs * g0, y1 = (acc[ai][bj][m][1] * sc) * rs * g1;
                        const f32x4 lo = y0 * c - y1 * sn, hi = y0 * sn + y1 * c;
                        bf16_t* p = O + (size_t)row * ldc + pn * BM + bj * HALF + 64 * half + i0;
                        *(unsigned long long*)p = pk4(lo); *(unsigned long long*)(p + 32) = pk4(hi); } }
        } else if (pn >= 10 && pn < 22 && wc == 0) {
            const int i0 = 4 * fq;
#pragma unroll
            for (int ai = 0; ai < 2; ++ai)
#pragma unroll
                for (int m = 0; m < 4; ++m) { const int row = row0 + ai * HALF + m * 16, sq = row & 2047;
                    const f32x4 c = *(const f32x4*)(cosp + sq * 16 + i0), sn = *(const f32x4*)(sinp + sq * 16 + i0);
#pragma unroll
                    for (int bj = 0; bj < 2; ++bj) { const f32x4 y0 = (acc[ai][bj][m][0] * sc), y1 = (acc[ai][bj][m][1] * sc);
                        const f32x4 lo = y0 * c - y1 * sn, hi = y0 * sn + y1 * c;
                        bf16_t* p = O + (size_t)row * ldc + pn * BM + bj * HALF + i0;
                        *(unsigned long long*)p = pk4(lo); *(unsigned long long*)(p + 16) = pk4(hi); } }
        } else if (pn >= 30) {
            const int which = pn >= 38 ? 1 : 0, pnz = pn - (which ? 38 : 30);
            const float* bs = bias + which * 2048 + pnz * BM + wc * 32 + 8 * fq;
            bf16_t* dst = (which ? SB : SA) + ((((size_t)(u.pm * 8 + pnz) * 8 + (wr * 4 + wc)) * 16) * 64 + (fq * 16 + fr)) * 8;
#pragma unroll
            for (int bj = 0; bj < 2; ++bj) { const f32x4 b0 = *(const f32x4*)(bs + bj * HALF), b1 = *(const f32x4*)(bs + bj * HALF + 4);
#pragma unroll
                for (int ai = 0; ai < 2; ++ai)
#pragma unroll
                    for (int m = 0; m < 4; ++m) { const f32x4 v0 = (acc[ai][bj][m][0] * sc) + b0, v1 = (acc[ai][bj][m][1] * sc) + b1; float sg[8];
#pragma unroll
                        for (int e = 0; e < 4; ++e) { sg[e] = __builtin_amdgcn_rcpf(1.f + __builtin_amdgcn_exp2f(v0[e] * -1.4426950408889634f)); sg[4 + e] = __builtin_amdgcn_rcpf(1.f + __builtin_amdgcn_exp2f(v1[e] * -1.4426950408889634f)); }
                        u32x4 w; w.x = cvt_pk_bf16(sg[0], sg[1]); w.y = cvt_pk_bf16(sg[2], sg[3]); w.z = cvt_pk_bf16(sg[4], sg[5]); w.w = cvt_pk_bf16(sg[6], sg[7]);
                        __builtin_nontemporal_store(w, (u32x4*)(dst + (ai * 8 + bj * 4 + m) * 512)); } }
        } else {
            const bool act = (pn >= 6 && pn < 10) || pn == 28 || pn == 29;
            const int col0 = pn * BM + wc * 32 + 8 * fq;
#pragma unroll
            for (int ai = 0; ai < 2; ++ai)
#pragma unroll
                for (int m = 0; m < 4; ++m) { bf16_t* rowp = O + (size_t)(row0 + ai * HALF + m * 16) * ldc + col0;
#pragma unroll
                    for (int bj = 0; bj < 2; ++bj) { f32x4 v0 = (acc[ai][bj][m][0] * sc), v1 = (acc[ai][bj][m][1] * sc);
                        if (act) {
#pragma unroll
                            for (int e = 0; e < 4; ++e) { v0[e] = v0[e] * __builtin_amdgcn_rcpf(1.f + __builtin_amdgcn_exp2f(v0[e] * -1.4426950408889634f)); v1[e] = v1[e] * __builtin_amdgcn_rcpf(1.f + __builtin_amdgcn_exp2f(v1[e] * -1.4426950408889634f)); } }
                        u32x4 w; w.x = cvt_pk_bf16(v0[0], v0[1]); w.y = cvt_pk_bf16(v0[2], v0[3]); w.z = cvt_pk_bf16(v1[0], v1[1]); w.w = cvt_pk_bf16(v1[2], v1[3]);
                        *(u32x4*)(rowp + bj * HALF) = w; } }
        }
    }
};
struct EpiMerge2 {
    static constexpr bool PERM = false, AFTER_DRAIN = false, FP8 = false; static constexpr int HOOK_T = 16; static constexpr bool INIT_ACC = false;
    const bf16_t* SA; const bf16_t* SB; bf16_t* O; int ldc;
    __device__ __forceinline__ void mid(f32x4 (&acc)[2][2][4][2], const Unit& u, int wr, int wc, int fr, int fq) const {
        int lane = fq * 16 + fr; asm volatile("" : "+v"(lane));
        const size_t base = ((((size_t)(u.pm * 8 + u.pn) * 8 + (wr * 4 + wc)) * 16) * 64 + lane) * 8;
#pragma unroll
        for (int f = 0; f < 16; ++f) { const int ai = f >> 3, bj = (f >> 2) & 1, m = f & 3;
            const u32x4 a = __builtin_nontemporal_load((const u32x4*)(SA + base + f * 512)), b = *(const u32x4*)(SB + base + f * 512);
            f32x4 r0, r1;
#pragma unroll
            for (int e = 0; e < 4; ++e) { const float q_lo = __uint_as_float(a[e] << 16) * __builtin_amdgcn_rcpf(__uint_as_float(b[e] << 16)), q_hi = __uint_as_float(a[e] & 0xffff0000u) * __builtin_amdgcn_rcpf(__uint_as_float(b[e] & 0xffff0000u));
                if (e < 2) { r0[2 * e] = q_lo; r0[2 * e + 1] = q_hi; } else { r1[2 * e - 4] = q_lo; r1[2 * e - 3] = q_hi; } }
            acc[ai][bj][m][0] *= r0; acc[ai][bj][m][1] *= r1; }
    }
    __device__ __forceinline__ void operator()(const f32x4 (&acc)[2][2][4][2], const Unit& u, int wr, int wc, int fr_, int fq_) const {
        (void)fr_; (void)fq_; const int ln_ = fresh_lane(), fr = ln_ & 15, fq = ln_ >> 4;
        const int lane = fq * 16 + fr, row0 = u.pm * BM + wr * 64 + fr, col0 = u.pn * BM + wc * 32 + 8 * fq;
        const size_t base = ((((size_t)(u.pm * 8 + u.pn) * 8 + (wr * 4 + wc)) * 16) * 64 + lane) * 8;
#pragma unroll
        for (int f = 0; f < 16; ++f) { const int ai = f >> 3, bj = (f >> 2) & 1, m = f & 3;
            const u32x4 b = __builtin_nontemporal_load((const u32x4*)(SB + base + f * 512));
            const f32x4 v0 = acc[ai][bj][m][0], v1 = acc[ai][bj][m][1];
            u32x4 w; w.x = cvt_pk_bf16(v0[0] * __uint_as_float(b[0] << 16), v0[1] * __uint_as_float(b[0] & 0xffff0000u)); w.y = cvt_pk_bf16(v0[2] * __uint_as_float(b[1] << 16), v0[3] * __uint_as_float(b[1] & 0xffff0000u));
            w.z = cvt_pk_bf16(v1[0] * __uint_as_float(b[2] << 16), v1[1] * __uint_as_float(b[2] & 0xffff0000u)); w.w = cvt_pk_bf16(v1[2] * __uint_as_float(b[3] << 16), v1[3] * __uint_as_float(b[3] & 0xffff0000u));
            *(u32x4*)(O + (size_t)(row0 + ai * HALF + m * 16) * ldc + col0 + bj * HALF) = w; }
    }
};
struct EpiResidNorm {
    static constexpr bool PERM = false, AFTER_DRAIN = true, FP8 = false, INIT_ACC = true; static constexpr int HOOK_T = -1;
    const float* base; float* out; int ldc; const float* gain; float* xb; unsigned* cnt; int ntn; float eps;
    __device__ __forceinline__ void init(f32x4 (&acc)[2][2][4][2], const Unit& u, int wr, int wc, int fr, int fq) const {
        const int row0 = u.pm * BM + wr * 64 + fr, col0 = u.pn * BM + wc * 32 + 4 * fq;
#pragma unroll
        for (int ai = 0; ai < 2; ++ai)
#pragma unroll
            for (int m = 0; m < 4; ++m) { const size_t off = (size_t)(row0 + ai * HALF + m * 16) * ldc + col0;
#pragma unroll
                for (int bj = 0; bj < 2; ++bj)
#pragma unroll
                    for (int n = 0; n < 2; ++n) acc[ai][bj][m][n] = __builtin_nontemporal_load((const f32x4*)(base + off + bj * HALF + n * 16)); }
    }
    __device__ __forceinline__ void fused(f32x4 (&acc)[2][2][4][2], const Unit& u, int wr, int wc, int fr_, int fq_, PG8_LAS unsigned char* lds, int wid, int lane) const {
        (void)fr_; (void)fq_; const int ln_ = fresh_lane(), fr = ln_ & 15, fq = ln_ >> 4;
        PG8_LAS float* Pp = (PG8_LAS float*)lds;
        PG8_LAS float* Sr = (PG8_LAS float*)(lds + 4096);
        const int row0 = u.pm * BM + wr * 64 + fr, col0 = u.pn * BM + wc * 32 + 4 * fq;
#pragma unroll
        for (int ai = 0; ai < 2; ++ai)
#pragma unroll
            for (int m = 0; m < 4; ++m) { float ss = 0.f;
#pragma unroll
                for (int bj = 0; bj < 2; ++bj)
#pragma unroll
                    for (int n = 0; n < 2; ++n) { const f32x4 o = acc[ai][bj][m][n];
                        ss += (o[0] * o[0] + o[1] * o[1]) + (o[2] * o[2] + o[3] * o[3]); }
                ss += __shfl_xor(ss, 16); ss += __shfl_xor(ss, 32);
                if (fq == 0) Pp[(ai * HALF + wr * 64 + m * 16 + fr) * 4 + wc] = ss; }
        asm volatile("s_waitcnt lgkmcnt(0)" ::: "memory"); __builtin_amdgcn_s_barrier(); asm volatile("" ::: "memory");
        const int tid = wid * 64 + lane;
        if (tid < 256) { const f32x4 p = *(const PG8_LAS f32x4*)(Pp + tid * 4);
            __hip_atomic_store(xb + (size_t)(u.pm * BM + tid) * 8 + u.pn, (p[0] + p[1]) + (p[2] + p[3]), __ATOMIC_RELAXED, __HIP_MEMORY_SCOPE_AGENT); }
        asm volatile("s_waitcnt vmcnt(0)" ::: "memory"); __builtin_amdgcn_s_barrier(); asm volatile("" ::: "memory");
        if (tid == 0) __hip_atomic_fetch_add(cnt + 64 * u.pm, 1u, __ATOMIC_RELAXED, __HIP_MEMORY_SCOPE_AGENT);
        if (wid == 0) { unsigned spins = 0;
            while ((unsigned)__builtin_amdgcn_readfirstlane(__hip_atomic_load(cnt + 64 * u.pm, __ATOMIC_RELAXED, __HIP_MEMORY_SCOPE_AGENT)) < (unsigned)ntn) { __builtin_amdgcn_s_sleep(2); if (++spins > (1u << 22)) break; }
            __builtin_amdgcn_fence(__ATOMIC_ACQUIRE, "agent"); }
        asm volatile("s_waitcnt vmcnt(0) lgkmcnt(0)" ::: "memory"); __builtin_amdgcn_s_barrier(); asm volatile("" ::: "memory");
        if (tid < 256) { const float* slot = xb + (size_t)(u.pm * BM + tid) * 8; float tot = 0.f;
#pragma unroll
            for (int t = 0; t < 8; ++t) tot += __hip_atomic_load(slot + t, __ATOMIC_RELAXED, __HIP_MEMORY_SCOPE_AGENT);
            Sr[tid] = rsqrtf(tot * (1.0f / 2048.0f) + eps); }
        asm volatile("s_waitcnt lgkmcnt(0)" ::: "memory"); __builtin_amdgcn_s_barrier(); asm volatile("" ::: "memory");
#pragma unroll
        for (int bj = 0; bj < 2; ++bj)
#pragma unroll
            for (int n = 0; n < 2; ++n) { const f32x4 g = *(const f32x4*)(gain + col0 + bj * HALF + n * 16);
#pragma unroll
                for (int ai = 0; ai < 2; ++ai)
#pragma unroll
                    for (int m = 0; m < 4; ++m) { const int rl = ai * HALF + wr * 64 + m * 16 + fr; const float rs = Sr[rl];
                        __builtin_nontemporal_store(acc[ai][bj][m][n] * rs * g, (f32x4*)(out + (size_t)(u.pm * BM + rl) * ldc + col0 + bj * HALF + n * 16)); } }
    }
};

template <class Epi, class Sched, bool ALIGN_EPI = false, bool SP2 = false>
__device__ __forceinline__ void gemm_phase(PG8_LAS unsigned char* lds, const Gemm g, const Sched& S, const Epi& E, const int wave_) {
    const int wid = wave_, lane = fresh_lane(), tid = wid * 64 + lane, wr = wid >> 2, wc = wid & 3, fr = lane & 15, fq = lane >> 4;
    const int K = g.K, nt = K / BK;
    unsigned voffA[2], voffB[2];
#pragma unroll
    for (int i = 0; i < 2; ++i) { int R, C; stage_rc(tid * 16 + i * 8192, R, C); const int Rb = Epi::PERM ? ((R & ~31) + perm32(R & 31)) : R;
        voffA[i] = (unsigned)(R * K + C) * 2u; voffB[i] = (unsigned)(Rb * K + C) * 2u; }
    const unsigned kstep = (unsigned)(BK * 2);
    const unsigned hstep = (unsigned)HALF * (unsigned)K * 2u;
    const unsigned tstep = 2u * hstep;
    const __amdgpu_buffer_rsrc_t rs_voffA = __builtin_amdgcn_make_buffer_rsrc((void*)g.A, 0, (int)((unsigned)g.M * (unsigned)K * 2u), 0x00020000);
    const __amdgpu_buffer_rsrc_t rs_voffB = __builtin_amdgcn_make_buffer_rsrc((void*)g.Bt, 0, (int)((unsigned)g.N * (unsigned)K * 2u), 0x00020000);
    const unsigned ldsw = (unsigned)wid * 1024u;
    const int aoff = lds_byte(wr * 64 + fr, fq * 8), boff = lds_byte(wc * 32 + fr, fq * 8);
#define PG8_SA(b, h) (((b) * 2 + (h)) * HTB)
#define PG8_SB(b, h) ((4 + (b) * 2 + (h)) * HTB)
#define PG8_STAGE(bufoff, goff, voff) do { _Pragma("unroll") for (int _i = 0; _i < 2; ++_i) \
        __builtin_amdgcn_raw_ptr_buffer_load_lds(rs_##voff, (PG8_LAS void*)(lds + (bufoff) + ldsw + _i * 8192), 16, (int)(voff)[_i], (int)(goff), 0, 0); } while (0)
#define PG8_LDA(dst, b, h) do { _Pragma("unroll") for (int m = 0; m < 4; ++m) _Pragma("unroll") for (int k = 0; k < 2; ++k) dst[m][k] = *(const PG8_LAS bf16x8*)(lds + PG8_SA(b, h) + aoff + m * 2048 + k * 1024); } while (0)
#define PG8_LDB(dst, b, h) do { _Pragma("unroll") for (int n = 0; n < 2; ++n) _Pragma("unroll") for (int k = 0; k < 2; ++k) dst[n][k] = *(const PG8_LAS bf16x8*)(lds + PG8_SB(b, h) + boff + n * 2048 + k * 1024); } while (0)
#define PG8_CAT(x, y) __builtin_shufflevector(__builtin_bit_cast(v4i_t, x), __builtin_bit_cast(v4i_t, y), 0, 1, 2, 3, 4, 5, 6, 7)
#define PG8_MMA(ai, bj, At, Bt) do { __builtin_amdgcn_s_setprio(1); _Pragma("unroll") for (int m = 0; m < 4; ++m) _Pragma("unroll") for (int n = 0; n < 2; ++n) { \
        if constexpr (Epi::FP8) acc[ai][bj][m][n] = __builtin_amdgcn_mfma_scale_f32_16x16x128_f8f6f4(PG8_CAT(Bt[n][0], Bt[n][1]), PG8_CAT(At[m][0], At[m][1]), acc[ai][bj][m][n], 0, 0, 0, 0x7f7f7f7f, 0, 0x7f7f7f7f); \
        else { _Pragma("unroll") for (int k = 0; k < 2; ++k) acc[ai][bj][m][n] = __builtin_amdgcn_mfma_f32_16x16x32_bf16(Bt[n][k], At[m][k], acc[ai][bj][m][n], 0, 0, 0); } } \
        __builtin_amdgcn_s_setprio(0); } while (0)
#define PG8_WAIT_V(n) asm volatile("s_waitcnt vmcnt(" #n ")" ::: "memory")
#define PG8_WAIT_L(n) asm volatile("s_waitcnt lgkmcnt(" #n ")" ::: "memory")
#define PG8_BAR __builtin_amdgcn_s_barrier()
#define PG8_SCHED __builtin_amdgcn_sched_barrier(0)
    Unit cur, nxt; int ui = 0;
    if (!S.next(0, cur)) return;
    f32x4 acc[2][2][4][2];
    if constexpr (Epi::INIT_ACC) E.init(acc, cur, wr, wc, fr, fq);
    else {
#pragma unroll
    for (int a = 0; a < 2; ++a)
#pragma unroll
        for (int b = 0; b < 2; ++b)
#pragma unroll
            for (int m = 0; m < 4; ++m)
#pragma unroll
                for (int n = 0; n < 2; ++n) acc[a][b][m][n] = (f32x4){0.f, 0.f, 0.f, 0.f};
    }
    bf16x8 At[4][2], B0[2][2], B1[2][2];
    unsigned cA = (unsigned)cur.pm * tstep, cB = (unsigned)cur.pn * tstep;
    S.a_ready(cur);
    if constexpr (SP2) {
        PG8_STAGE(PG8_SB(0, 0), cB, voffB); PG8_STAGE(PG8_SB(0, 1), cB + hstep, voffB); PG8_STAGE(PG8_SA(0, 0), cA, voffA); PG8_STAGE(PG8_SA(0, 1), cA + hstep, voffA);
        if (wr == 1) PG8_BAR;
        PG8_WAIT_V(2); PG8_BAR;
        PG8_STAGE(PG8_SB(1, 0), cB + kstep, voffB); PG8_STAGE(PG8_SA(1, 0), cA + kstep, voffA); PG8_STAGE(PG8_SB(1, 1), cB + hstep + kstep, voffB);
        PG8_WAIT_V(6); PG8_BAR;
    } else {
        PG8_STAGE(PG8_SB(0, 0), cB, voffB); PG8_STAGE(PG8_SA(0, 0), cA, voffA); PG8_STAGE(PG8_SB(0, 1), cB + hstep, voffB); PG8_STAGE(PG8_SA(0, 1), cA + hstep, voffA);
        if (wr == 1) PG8_BAR;
        PG8_WAIT_V(4); PG8_BAR;
        PG8_STAGE(PG8_SB(1, 0), cB + kstep, voffB); PG8_STAGE(PG8_SA(1, 0), cA + kstep, voffA); PG8_STAGE(PG8_SB(1, 1), cB + hstep + kstep, voffB);
        PG8_WAIT_V(6); PG8_BAR;
    }
    for (;;) {
        const bool has_next = S.next(ui + 1, nxt);
        const unsigned nA = has_next ? (unsigned)nxt.pm * tstep : cA, nB = has_next ? (unsigned)nxt.pn * tstep : cB;
        for (int t = 0; t < nt; t += 2) {
            if constexpr (Epi::HOOK_T >= 0) { if (t == Epi::HOOK_T) E.mid(acc, cur, wr, wc, fr, fq); }
            const bool last = (t == nt - 2);
            const unsigned a1 = cA + (unsigned)(t + 1) * kstep;
            const unsigned a2 = last ? nA : cA + (unsigned)(t + 2) * kstep, b2 = last ? nB : cB + (unsigned)(t + 2) * kstep;
            const unsigned a3 = a2 + kstep, b3 = b2 + kstep;
            if (last && has_next) S.a_ready(nxt);
            if constexpr (SP2) {
            PG8_LDB(B0, 0, 0); PG8_LDB(B1, 0, 1); PG8_SCHED; PG8_LDA(At, 0, 0); PG8_STAGE(PG8_SA(1, 1), a1 + hstep, voffA);
            PG8_WAIT_V(8); PG8_WAIT_L(0); PG8_BAR; PG8_MMA(0, 0, At, B0); PG8_MMA(0, 1, At, B1); PG8_BAR; PG8_SCHED;
            PG8_LDA(At, 0, 1); PG8_STAGE(PG8_SB(0, 0), b2, voffB); PG8_STAGE(PG8_SB(0, 1), b2 + hstep, voffB); PG8_STAGE(PG8_SA(0, 0), a2, voffA);
            PG8_WAIT_V(8); PG8_WAIT_L(0); PG8_BAR; PG8_MMA(1, 0, At, B0); PG8_MMA(1, 1, At, B1); PG8_BAR; PG8_SCHED;
            PG8_LDB(B0, 1, 0); PG8_LDB(B1, 1, 1); PG8_SCHED; PG8_LDA(At, 1, 0); PG8_STAGE(PG8_SA(0, 1), a2 + hstep, voffA);
            PG8_WAIT_V(8); PG8_WAIT_L(0); PG8_BAR; PG8_MMA(0, 0, At, B0); PG8_MMA(0, 1, At, B1); PG8_BAR; PG8_SCHED;
            PG8_LDA(At, 1, 1); PG8_STAGE(PG8_SB(1, 0), b3, voffB); PG8_STAGE(PG8_SB(1, 1), b3 + hstep, voffB); PG8_STAGE(PG8_SA(1, 0), a3, voffA);
            PG8_WAIT_V(8); PG8_WAIT_L(0); PG8_BAR; PG8_MMA(1, 0, At, B0); PG8_MMA(1, 1, At, B1); PG8_BAR; PG8_SCHED;
            } else {
            PG8_LDB(B0, 0, 0); PG8_SCHED; PG8_LDA(At, 0, 0); PG8_STAGE(PG8_SA(1, 1), a1 + hstep, voffA);
            PG8_WAIT_L(8); PG8_BAR; PG8_WAIT_L(0); PG8_MMA(0, 0, At, B0); PG8_BAR; PG8_SCHED;
            PG8_LDB(B1, 0, 1); PG8_STAGE(PG8_SB(0, 0), b2, voffB);
            PG8_BAR; PG8_WAIT_L(0); PG8_MMA(0, 1, At, B1); PG8_BAR;
            PG8_LDA(At, 0, 1); PG8_STAGE(PG8_SA(0, 0), a2, voffA);
            PG8_BAR; PG8_WAIT_L(0); PG8_MMA(1, 0, At, B0); PG8_BAR; PG8_SCHED;
            PG8_STAGE(PG8_SB(0, 1), b2 + hstep, voffB);
            PG8_WAIT_V(6); PG8_BAR; PG8_MMA(1, 1, At, B1); PG8_BAR;
            PG8_LDB(B0, 1, 0); PG8_SCHED; PG8_LDA(At, 1, 0); PG8_STAGE(PG8_SA(0, 1), a2 + hstep, voffA);
            PG8_WAIT_L(8); PG8_BAR; PG8_WAIT_L(0); PG8_MMA(0, 0, At, B0); PG8_BAR; PG8_SCHED;
            PG8_LDB(B1, 1, 1); PG8_STAGE(PG8_SB(1, 0), b3, voffB);
            PG8_BAR; PG8_WAIT_L(0); PG8_MMA(0, 1, At, B1); PG8_BAR;
            PG8_LDA(At, 1, 1); PG8_STAGE(PG8_SA(1, 0), a3, voffA);
            PG8_BAR; PG8_WAIT_L(0); PG8_MMA(1, 0, At, B0); PG8_BAR; PG8_SCHED;
            PG8_STAGE(PG8_SB(1, 1), b3 + hstep, voffB);
            PG8_WAIT_V(6); PG8_BAR; PG8_MMA(1, 1, At, B1); PG8_BAR;
            }
        }
        if constexpr (ALIGN_EPI) { if (wr == 0) PG8_BAR; }
        if constexpr (!Epi::AFTER_DRAIN) { E(acc, cur, wr, wc, fr, fq); S.done(cur); }
        if (!has_next) break;
#pragma unroll
        for (int a = 0; a < 2; ++a)
#pragma unroll
            for (int b = 0; b < 2; ++b)
#pragma unroll
                for (int m = 0; m < 4; ++m)
#pragma unroll
                    for (int n = 0; n < 2; ++n) acc[a][b][m][n] = (f32x4){0.f, 0.f, 0.f, 0.f};
        cur = nxt; cA = nA; cB = nB; ++ui;
        if constexpr (ALIGN_EPI) { if (wr == 1) PG8_BAR; }
    }
    PG8_WAIT_V(0);
    if constexpr (!ALIGN_EPI) { if (wr == 0) PG8_BAR; }
    PG8_BAR;
    if constexpr (Epi::AFTER_DRAIN) { E.fused(acc, cur, wr, wc, fr, fq, lds, wid, lane); S.done(cur); }
#undef PG8_SA
#undef PG8_SB
#undef PG8_STAGE
#undef PG8_LDA
#undef PG8_LDB
#undef PG8_MMA
#undef PG8_CAT
#undef PG8_WAIT_V
#undef PG8_WAIT_L
#undef PG8_BAR
#undef PG8_SCHED
}
}

namespace att {
using bf16 = unsigned short;
constexpr int   D = 128, NW = 8, QBLK = 32, KVBLK = 64;
constexpr float SCALE = 0.088388347648318440f;
constexpr float THR = 8.f;
constexpr int SDEPTH = 2;
constexpr int LDQ = 7680, LDK = 7680;
constexpr int LDY = 1536;
constexpr size_t SHM_V = KVBLK * D * 2, SHM_K = KVBLK * D * 2, SHM_ATTN = 2 * SHM_V + 2 * SHM_K + NW * 64 * 4;
__device__ __forceinline__ float bf2f_(bf16 h) { return __uint_as_float(((unsigned)h) << 16); }
__device__ __forceinline__ bf16 f2bf_(float f) { unsigned u = __float_as_uint(f); return (bf16)((u + 0x7fffu + ((u >> 16) & 1u)) >> 16); }
using bf16x8 = __attribute__((ext_vector_type(8))) short;
using s16x4  = __attribute__((ext_vector_type(4))) short;
using f32x16 = __attribute__((ext_vector_type(16))) float;
using f32x8  = __attribute__((ext_vector_type(8))) float;
using u32x4  = __attribute__((ext_vector_type(4))) unsigned;
using f32x4_ = __attribute__((ext_vector_type(4))) float;
#define KSWZ(row, colB) ((row) * 256 + ((colB) ^ (((row) & 7) << 4)))
#define SBAR() __builtin_amdgcn_sched_barrier(0)
__device__ __forceinline__ int crow(int r, int hi) { return (r & 3) + 8 * (r >> 2) + 4 * hi; }
__device__ __forceinline__ unsigned cvtpk(float lo, float hi) {
  typedef float f32x2_c __attribute__((ext_vector_type(2))); typedef __bf16 bf16x2_c __attribute__((ext_vector_type(2)));
  const f32x2_c v = {lo, hi}; return __builtin_bit_cast(unsigned, __builtin_convertvector(v, bf16x2_c));
}
template <typename TIn> struct Stage;
template <> struct Stage<bf16>  { using T = bf16x8;
  __device__ static __forceinline__ T ld8(const bf16* p) { return *reinterpret_cast<const bf16x8*>(p); }
  __device__ static __forceinline__ bf16x8 tobf(T x) { return x; } };
template <> struct Stage<float> { using T = f32x8;
  __device__ static __forceinline__ T ld8(const float* p) { return *reinterpret_cast<const f32x8*>(p); }
  __device__ static __forceinline__ bf16x8 tobf(T x) {
    u32x4 w = {cvtpk(x[0], x[1]), cvtpk(x[2], x[3]), cvtpk(x[4], x[5]), cvtpk(x[6], x[7])}; return *reinterpret_cast<bf16x8*>(&w); } };

__device__ __forceinline__ void partialSM(f32x16& p0, f32x16& p1, float& m_reg, float& mn, float& alpha) {
  constexpr float C = SCALE * 1.4426950408889634f;
  float pmax = p0[0]; for (int r = 1; r < 16; ++r) pmax = fmaxf(pmax, p0[r]); for (int r = 0; r < 16; ++r) pmax = fmaxf(pmax, p1[r]);
  { auto rr = __builtin_amdgcn_permlane32_swap(__float_as_uint(pmax), __float_as_uint(pmax), false, false);
    pmax = fmaxf(__uint_as_float(rr[0]), __uint_as_float(rr[1])); }
  if (__builtin_expect(__all(pmax - m_reg <= THR / SCALE), 1)) { mn = m_reg; alpha = 1.f; }
  else { mn = fmaxf(m_reg, pmax); alpha = __builtin_amdgcn_exp2f((m_reg - mn) * C); m_reg = mn; }
  float mnC = -mn * C;
  for (int r = 0; r < 16; ++r) p0[r] = fmaf(p0[r], C, mnC); for (int r = 0; r < 16; ++r) p1[r] = fmaf(p1[r], C, mnC);
  for (int r = 0; r < 16; ++r) p0[r] = __builtin_amdgcn_exp2f(p0[r]);
}
__device__ __forceinline__ void finishSM(f32x16& p0, f32x16& p1, float alpha, float& l_reg, bf16x8& pa0, bf16x8& pa1, bf16x8& pa2, bf16x8& pa3) {
  for (int r = 0; r < 16; ++r) p1[r] = __builtin_amdgcn_exp2f(p1[r]);
  float ps = 0; for (int r = 0; r < 16; ++r) ps += p0[r]; for (int r = 0; r < 16; ++r) ps += p1[r];
  { auto rr = __builtin_amdgcn_permlane32_swap(__float_as_uint(ps), __float_as_uint(ps), false, false);
    ps = __uint_as_float(rr[0]) + __uint_as_float(rr[1]); }
  l_reg = l_reg * alpha + ps;
#define PK4(P, BASE, OUT) do { unsigned a0 = cvtpk(P[BASE + 0], P[BASE + 1]), a1 = cvtpk(P[BASE + 2], P[BASE + 3]);   \
    unsigned b0 = cvtpk(P[BASE + 4], P[BASE + 5]), b1 = cvtpk(P[BASE + 6], P[BASE + 7]);                              \
    auto r0 = __builtin_amdgcn_permlane32_swap(a0, b0, false, false); auto r1 = __builtin_amdgcn_permlane32_swap(a1, b1, false, false); \
    u32x4 w = {r0[0], r1[0], r0[1], r1[1]}; OUT = *reinterpret_cast<bf16x8*>(&w); } while (0)
  PK4(p0, 0, pa0); PK4(p0, 8, pa1); PK4(p1, 0, pa2); PK4(p1, 8, pa3);
#undef PK4
}
__device__ __forceinline__ void qkt(f32x16& p0, f32x16& p1, const bf16* Ks, const bf16x8* qr, int r32, int hi) {
  p0 = f32x16{}; p1 = f32x16{};
  for (int d0 = 0; d0 < 8; ++d0) { int cb = (d0 * 16 + hi * 8) * 2;
    bf16x8 b0 = *reinterpret_cast<const bf16x8*>((const char*)Ks + KSWZ(r32, cb));
    bf16x8 b1 = *reinterpret_cast<const bf16x8*>((const char*)Ks + KSWZ(32 + r32, cb));
    p0 = __builtin_amdgcn_mfma_f32_32x32x16_bf16(b0, qr[d0], p0, 0, 0, 0);
    p1 = __builtin_amdgcn_mfma_f32_32x32x16_bf16(b1, qr[d0], p1, 0, 0, 0); }
}
__device__ __forceinline__ int v_st(int k, int c) { const int kk = (k & ~0xC) | ((k & 4) << 1) | ((k & 8) >> 1); return ((kk >> 3) * 4 + (c >> 5)) * 512 + ((kk & 7) * 32 + (c & 31)) * 2; }
__device__ __forceinline__ int v_rd_base(int lane) { return ((lane & 3) << 3) | (((lane >> 2) & 3) << 6) | (((lane >> 4) & 1) << 5) | (((lane >> 5) & 1) << 8); }
constexpr int v_rd_off(int d0, int ks, int half) { return d0 * 512 + ks * 4096 + half * 2048; }
template <int OFF> __device__ __forceinline__ s16x4 tr_read(int vb) {
  s16x4 r; asm volatile("ds_read_b64_tr_b16 %0, %1 offset:%2" : "=&v"(r) : "v"(vb), "i"(OFF) : "memory"); return r;
}
template <int D0> __device__ __forceinline__ void pv_one(f32x16& od, int vb, bf16x8 pa0, bf16x8 pa1, bf16x8 pa2, bf16x8 pa3) {
  const s16x4 l0 = tr_read<v_rd_off(D0, 0, 0)>(vb), h0 = tr_read<v_rd_off(D0, 0, 1)>(vb), l1 = tr_read<v_rd_off(D0, 1, 0)>(vb), h1 = tr_read<v_rd_off(D0, 1, 1)>(vb);
  const s16x4 l2 = tr_read<v_rd_off(D0, 2, 0)>(vb), h2 = tr_read<v_rd_off(D0, 2, 1)>(vb), l3 = tr_read<v_rd_off(D0, 3, 0)>(vb), h3 = tr_read<v_rd_off(D0, 3, 1)>(vb);
  asm volatile("s_waitcnt lgkmcnt(0)" ::: "memory"); SBAR();
#define PK(L, H) (bf16x8){L[0], L[1], L[2], L[3], H[0], H[1], H[2], H[3]}
  od = __builtin_amdgcn_mfma_f32_32x32x16_bf16(pa0, PK(l0, h0), od, 0, 0, 0);
  od = __builtin_amdgcn_mfma_f32_32x32x16_bf16(pa1, PK(l1, h1), od, 0, 0, 0);
  od = __builtin_amdgcn_mfma_f32_32x32x16_bf16(pa2, PK(l2, h2), od, 0, 0, 0);
  od = __builtin_amdgcn_mfma_f32_32x32x16_bf16(pa3, PK(l3, h3), od, 0, 0, 0);
#undef PK
}
__device__ __forceinline__ void pv_d0(f32x16* o, int vb, bf16x8 pa0, bf16x8 pa1, bf16x8 pa2, bf16x8 pa3) {
  pv_one<0>(o[0], vb, pa0, pa1, pa2, pa3); pv_one<1>(o[1], vb, pa0, pa1, pa2, pa3); pv_one<2>(o[2], vb, pa0, pa1, pa2, pa3); pv_one<3>(o[3], vb, pa0, pa1, pa2, pa3);
}

__device__ __forceinline__ void attn_dense_body(const bf16* __restrict__ Qb, const bf16* __restrict__ Kh, const bf16* __restrict__ Vh,
                                                const bf16* __restrict__ Gb, bf16* __restrict__ Yb, int seq, char* lds, const int wave_) {
  using TQ = bf16; using St = Stage<bf16>; using SQ = Stage<TQ>;
  const int wid = wave_, lane = fresh_lane(), tid = wid * 64 + lane, r32 = lane & 31, hi = lane >> 5;
  bf16* V_lds = (bf16*)lds; bf16* K_lds = (bf16*)(lds + 2 * SHM_V);
  float* ws = (float*)(lds + 2 * SHM_V + 2 * SHM_K) + wid * 64; float* li_l = ws; float* al_l = ws + 32;
  float m_reg = -1e30f, l_reg = 0; f32x16 o[4] = {}; bf16x8 qr[8];
  const TQ* Qw = Qb + (long)(wid * QBLK + r32) * LDQ + hi * 8;
#pragma unroll
  for (int d0 = 0; d0 < 8; ++d0) qr[d0] = SQ::tobf(SQ::ld8(Qw + d0 * 16));
  const int sr = tid >> 4, sc = (tid & 15) * 8, vst0 = v_st(sr, sc), vst1 = v_st(32 + sr, sc);
  const unsigned toff = (unsigned)(sr * LDK + sc);
  const int vb0 = (int)(uintptr_t)V_lds + v_rd_base(lane);
  struct { typename St::T vs0, vs1, ks0, ks1; } sr_[SDEPTH];
#define SLOAD(i, k0) do { const bf16* vb_ = Vh + (long)(k0) * LDK; const bf16* kb_ = Kh + (long)(k0) * LDK; \
    sr_[i].vs0 = St::ld8(vb_ + toff); sr_[i].vs1 = St::ld8(vb_ + 32 * LDK + toff); \
    sr_[i].ks0 = St::ld8(kb_ + toff); sr_[i].ks1 = St::ld8(kb_ + 32 * LDK + toff); } while (0)
#define SWRITE(b, i) do { *(bf16x8*)((char*)V_lds + (b) * SHM_V + vst0) = St::tobf(sr_[i].vs0);          \
    *(bf16x8*)((char*)V_lds + (b) * SHM_V + vst1) = St::tobf(sr_[i].vs1); int kc = sc * 2;               \
    *(bf16x8*)((char*)K_lds + (b) * SHM_K + KSWZ(sr, kc)) = St::tobf(sr_[i].ks0);                       \
    *(bf16x8*)((char*)K_lds + (b) * SHM_K + KSWZ(32 + sr, kc)) = St::tobf(sr_[i].ks1); } while (0)
#define SWAIT() do { if constexpr (SDEPTH == 2) asm volatile("s_waitcnt vmcnt(4)" ::: "memory"); else asm volatile("s_waitcnt vmcnt(0)" ::: "memory"); } while (0)
#define RESC(a) do { if (__any((a) < 1.f)) { if (hi == 0) al_l[r32] = (a); asm volatile("s_waitcnt lgkmcnt(0)" ::: "memory"); \
    for (int d = 0; d < 4; ++d) for (int r = 0; r < 16; ++r) o[d][r] *= al_l[crow(r, hi)]; } } while (0)
  f32x16 pA0, pA1, pB0, pB1; float mnA, mnB, alA, alB; bf16x8 pa0, pa1, pa2, pa3; const int NT = seq / KVBLK;
  constexpr int SE = 0, SO = SDEPTH - 1;
  SLOAD(SE, 0); asm volatile("s_waitcnt vmcnt(0)" ::: "memory"); SWRITE(0, SE); __syncthreads();
  qkt(pA0, pA1, K_lds, qr, r32, hi); partialSM(pA0, pA1, m_reg, mnA, alA);
  SLOAD(SO, KVBLK); if constexpr (SDEPTH == 2) { if (2 < NT) SLOAD(SE, 2 * KVBLK); }
  SWAIT(); SWRITE(1, SO); __syncthreads();
  for (int j = 1; j + 1 < NT; j += 2) {
    SBAR(); qkt(pB0, pB1, (bf16*)((char*)K_lds + SHM_K), qr, r32, hi);
    finishSM(pA0, pA1, alA, l_reg, pa0, pa1, pa2, pa3); SBAR();
    SLOAD(SO, (j + SDEPTH) * KVBLK); SBAR();
    pv_d0(o, vb0, pa0, pa1, pa2, pa3); partialSM(pB0, pB1, m_reg, mnB, alB);
    __syncthreads(); SWAIT(); SWRITE(0, SE);
    RESC(alB); __syncthreads();
    SBAR(); qkt(pA0, pA1, K_lds, qr, r32, hi);
    finishSM(pB0, pB1, alB, l_reg, pa0, pa1, pa2, pa3); SBAR();
    if (SDEPTH == 1 || j + 3 < NT) SLOAD(SE, (j + 1 + SDEPTH) * KVBLK); SBAR();
    pv_d0(o, vb0 + (int)SHM_V, pa0, pa1, pa2, pa3); partialSM(pA0, pA1, m_reg, mnA, alA);
    __syncthreads(); SWAIT(); SWRITE(1, SO);
    RESC(alA); __syncthreads();
  }
  SBAR(); qkt(pB0, pB1, (bf16*)((char*)K_lds + SHM_K), qr, r32, hi);
  finishSM(pA0, pA1, alA, l_reg, pa0, pa1, pa2, pa3); SBAR();
  pv_d0(o, vb0, pa0, pa1, pa2, pa3); partialSM(pB0, pB1, m_reg, mnB, alB);
  __syncthreads(); RESC(alB);
  finishSM(pB0, pB1, alB, l_reg, pa0, pa1, pa2, pa3); SBAR();
  pv_d0(o, vb0 + (int)SHM_V, pa0, pa1, pa2, pa3);
  if (hi == 0) li_l[r32] = l_reg; asm volatile("s_waitcnt lgkmcnt(0)" ::: "memory");
  float rli[16];
#pragma unroll
  for (int r = 0; r < 16; ++r) rli[r] = __builtin_amdgcn_rcpf(li_l[crow(r, hi)]);
  __syncthreads();
  { float* stg = (float*)(lds + wid * 16384);
#pragma unroll
    for (int r = 0; r < 16; ++r) { const int orow = crow(r, hi);
#pragma unroll
      for (int d0 = 0; d0 < 4; ++d0) stg[orow * 128 + d0 * 32 + r32] = o[d0][r] * rli[r]; }
    asm volatile("s_waitcnt lgkmcnt(0)" ::: "memory");
    const int ch = lane & 15, rb = lane >> 4;
    const bf16* Gw = Gb + (long)(wid * QBLK + rb) * LDQ + ch * 8; bf16* Yw = Yb + (long)(wid * QBLK + rb) * LDY + ch * 8;
    u32x4 gq[8];
#pragma unroll
    for (int i = 0; i < 8; ++i) gq[i] = *(const u32x4*)(Gw + (long)(4 * i) * LDQ);
#pragma unroll
    for (int i = 0; i < 8; ++i) { const float* sp = stg + (4 * i + rb) * 128 + ch * 8;
      const f32x4_ a = *(const f32x4_*)sp, b = *(const f32x4_*)(sp + 4); u32x4 w;
      w[0] = cvtpk(a[0] * __uint_as_float(gq[i][0] << 16), a[1] * __uint_as_float(gq[i][0] & 0xffff0000u));
      w[1] = cvtpk(a[2] * __uint_as_float(gq[i][1] << 16), a[3] * __uint_as_float(gq[i][1] & 0xffff0000u));
      w[2] = cvtpk(b[0] * __uint_as_float(gq[i][2] << 16), b[1] * __uint_as_float(gq[i][2] & 0xffff0000u));
      w[3] = cvtpk(b[2] * __uint_as_float(gq[i][3] << 16), b[3] * __uint_as_float(gq[i][3] & 0xffff0000u));
      *(u32x4*)(Yw + (long)(4 * i) * LDY) = w; } }
  __syncthreads();
#undef SLOAD
#undef SWRITE
#undef SWAIT
#undef RESC
}

__device__ __forceinline__ void attn_band_unit(const bf16* __restrict__ P, bf16* __restrict__ OG, float* __restrict__ LSE, int g, int b, int h, int blk, int cqb, int ckb, int cvb, int seqlen, int ntok, char* lds, const int wave_) {
  using St = Stage<bf16>;
  const int wid = wave_, lane = fresh_lane(), tid = wid * 64 + lane, r32 = lane & 31, hi = lane >> 5;
  bf16* V_lds = (bf16*)lds; bf16* K_lds = (bf16*)(lds + 2 * SHM_V);
  float* ws = (float*)(lds + 2 * SHM_V + 2 * SHM_K) + wid * 64; float* li_l = ws; float* al_l = ws + 32;
  const int dil = (g == 0) ? 1 : (g == 1 ? 4 : 16), head = g * 4 + h;
  int rq, lq0, ntile, t_lo, res0;
  if (g < 2) { const int kb = (g == 0) ? blk : (blk & 1), nt_all = seqlen / dil / 64; res0 = (g == 0) ? 0 : (blk >> 1);
    rq = res0; lq0 = 256 * kb + 32 * wid; t_lo = (4 * kb - 1 < 0) ? 0 : 4 * kb - 1; const int t_hi = (4 * kb + 5 > nt_all) ? nt_all : 4 * kb + 5; ntile = t_hi - t_lo; }
  else { res0 = 2 * blk; rq = res0 + (wid >> 2); lq0 = 32 * (wid & 3); t_lo = 0; ntile = 4; }
  const long tok0 = (long)b * seqlen;
  const bf16* Pq = P + cqb + head * D; const bf16* Pk = P + ckb + head * D; const bf16* Pv = P + cvb + head * D;
  float m_reg = -1e30f, l_reg = 0; f32x16 o[4] = {}; bf16x8 qr[8];
  { const bf16* Qw = Pq + (tok0 + (long)(lq0 + r32) * dil + rq) * LDQ + hi * 8;
#pragma unroll
    for (int d0 = 0; d0 < 8; ++d0) qr[d0] = St::ld8(Qw + d0 * 16); }
  const int sr = tid >> 4, sc = (tid & 15) * 8, vst0 = v_st(sr, sc), vst1 = v_st(32 + sr, sc);
  const int vb0 = (int)(uintptr_t)V_lds + v_rd_base(lane);
  typename St::T vs0, vs1, ks0, ks1, vt0, vt1, kt0, kt1;
#define TILE_RK(tt) ((g < 2) ? res0 : res0 + ((tt) >> 1))
#define TILE_LK0(tt) ((g < 2) ? 64 * (t_lo + (tt)) : 64 * ((tt) & 1))
#define BLOAD(tt, V0, V1, K0, K1) do { const int rk_ = TILE_RK(tt), lk_ = TILE_LK0(tt); const long ta = (tok0 + (long)(lk_ + sr) * dil + rk_) * LDK + sc, tb = (tok0 + (long)(lk_ + 32 + sr) * dil + rk_) * LDK + sc; \
    V0 = St::ld8(Pv + ta); V1 = St::ld8(Pv + tb); K0 = St::ld8(Pk + ta); K1 = St::ld8(Pk + tb); } while (0)
#define BWRITE(V0, V1, K0, K1) do { *(bf16x8*)((char*)V_lds + vst0) = V0; *(bf16x8*)((char*)V_lds + vst1) = V1; const int kc = sc * 2; \
    *(bf16x8*)((char*)K_lds + KSWZ(sr, kc)) = K0; *(bf16x8*)((char*)K_lds + KSWZ(32 + sr, kc)) = K1; } while (0)
#define BCOMPUTE(tt) do { const int rk = TILE_RK(tt), lk0 = TILE_LK0(tt); \
    const bool need = (rk == rq) && (lk0 + 63 >= lq0 - 64) && (lk0 <= lq0 + 95); \
    if (need) { \
      f32x16 p0, p1; float mn, alpha; bf16x8 pa0, pa1, pa2, pa3; \
      qkt(p0, p1, K_lds, qr, r32, hi); \
      const int dd = lk0 - lq0 - r32 + 4 * hi;                      \
      _Pragma("unroll") for (int r = 0; r < 16; ++r) { const int d0_ = dd + (r & 3) + 8 * (r >> 2), d1_ = d0_ + 32; \
        if (d0_ < -64 || d0_ > 64) p0[r] = -INFINITY; if (d1_ < -64 || d1_ > 64) p1[r] = -INFINITY; } \
      partialSM(p0, p1, m_reg, mn, alpha); \
      if (__any(alpha < 1.f)) { if (hi == 0) al_l[r32] = alpha; asm volatile("s_waitcnt lgkmcnt(0)" ::: "memory"); \
        _Pragma("unroll") for (int d = 0; d < 4; ++d) _Pragma("unroll") for (int r = 0; r < 16; ++r) o[d][r] *= al_l[crow(r, hi)]; } \
      finishSM(p0, p1, alpha, l_reg, pa0, pa1, pa2, pa3); SBAR(); \
      pv_d0(o, vb0, pa0, pa1, pa2, pa3); \
    } } while (0)
  BLOAD(0, vs0, vs1, ks0, ks1); if (ntile > 1) BLOAD(1, vt0, vt1, kt0, kt1);
  for (int tt = 0; tt < ntile; tt += 2) {
    __syncthreads();
    BWRITE(vs0, vs1, ks0, ks1);
    __syncthreads();
    if (tt + 2 < ntile) BLOAD(tt + 2, vs0, vs1, ks0, ks1);
    BCOMPUTE(tt);
    if (tt + 1 < ntile) {
      __syncthreads();
      BWRITE(vt0, vt1, kt0, kt1);
      __syncthreads();
      if (tt + 3 < ntile) BLOAD(tt + 3, vt0, vt1, kt0, kt1);
      BCOMPUTE(tt + 1);
    }
  }
#undef BWRITE
#undef BCOMPUTE
#undef BLOAD
#undef TILE_RK
#undef TILE_LK0
  if (hi == 0) li_l[r32] = l_reg; asm volatile("s_waitcnt lgkmcnt(0)" ::: "memory");
  float rli[16];
#pragma unroll
  for (int r = 0; r < 16; ++r) rli[r] = __builtin_amdgcn_rcpf(li_l[crow(r, hi)]);
  __syncthreads();
  { float* stg = (float*)(lds + wid * 16384);
#pragma unroll
    for (int r = 0; r < 16; ++r) { const int orow = crow(r, hi);
#pragma unroll
      for (int d0 = 0; d0 < 4; ++d0) stg[orow * 128 + d0 * 32 + r32] = o[d0][r] * rli[r]; }
    asm volatile("s_waitcnt lgkmcnt(0)" ::: "memory");
    const int ch = lane & 15, rb = lane >> 4;
    bf16* Og = OG + (long)g * ntok * 512 + h * D + ch * 8;
#pragma unroll
    for (int i = 0; i < 8; ++i) { const int row = 4 * i + rb; const float* sp = stg + row * 128 + ch * 8;
      const f32x4_ a = *(const f32x4_*)sp, b = *(const f32x4_*)(sp + 4); u32x4 w;
      w[0] = cvtpk(a[0], a[1]); w[1] = cvtpk(a[2], a[3]); w[2] = cvtpk(b[0], b[1]); w[3] = cvtpk(b[2], b[3]);
      *(u32x4*)(Og + (tok0 + (long)(lq0 + row) * dil + rq) * 512) = w; } }
  if (hi == 0) LSE[((long)g * ntok + tok0 + (long)(lq0 + r32) * dil + rq) * 4 + h] = m_reg * SCALE + __logf(l_reg);
  __syncthreads();
}
}

typedef unsigned short bf16_t;
constexpr int BATCH = 4, SEQ = 2048, DM = 2048, NTOK = BATCH * SEQ, NC = 11776;
constexpr int C_QA = 0, C_KA = 1024, C_VA = 1280, C_GA = 1536, C_QB = 2560, C_KB = 4096, C_VB = 5632, C_GB = 7168, C_ZA = 7680, C_ZB = 9728;
constexpr float EPS = 1e-6f;
constexpr float H8_SCALE = 4.0f, W8_SCALE = 64.0f;
constexpr size_t MiB = 1u << 20;
constexpr int PITCH = 7680;
constexpr size_t WS_CTL = 0, WS_TAB = 1 * MiB, WS_XB = 1 * MiB + 512 * 1024, WS_WTIN = 2 * MiB, WS_WTAB = 48 * MiB, WS_WTO = 54 * MiB, WS_HB = 64 * MiB, WS_P = 96 * MiB, WS_Y = 216 * MiB, WS_OG = 240 * MiB, WS_LSE = 264 * MiB,
                 WS_SA = 266 * MiB, WS_SB = 298 * MiB, WS_H8 = 330 * MiB, WS_WTZ8 = 346 * MiB, WS_END = 361 * MiB;

#define LAS __attribute__((address_space(3)))
typedef float f32x4 __attribute__((ext_vector_type(4)));
typedef unsigned v4u __attribute__((ext_vector_type(4)));
constexpr int NWAVES = 8;
constexpr int LDS_BYTES = 147456;

__device__ __forceinline__ float bf2f(bf16_t h) { return __uint_as_float(((unsigned)h) << 16); }
__device__ __forceinline__ unsigned f2bf_u(float f) { unsigned u = __float_as_uint(f); return (u + 0x7fffu + ((u >> 16) & 1u)) >> 16; }
__device__ __forceinline__ bf16_t f2bf(float f) { return (bf16_t)f2bf_u(f); }
__device__ __forceinline__ unsigned pk2(float lo, float hi) { return f2bf_u(lo) | (f2bf_u(hi) << 16); }
__device__ __forceinline__ float wave_sum(float v) {
#pragma unroll
    for (int o = 1; o < 64; o <<= 1) v += __shfl_xor(v, o);
    return v;
}

__device__ __forceinline__ int colmap(int kind, int p) {
    const int bj = p >> 7, wc = (p >> 5) & 3, n = (p >> 4) & 1, fq = (p >> 2) & 3, j = p & 3;
    const int gen = 128 * bj + 32 * wc + 8 * fq + 4 * n + j;
    if (kind == 0) return p;
    if (kind == 1) return gen;
    if (kind == 2) return 128 * bj + 64 * (wc >> 1) + 32 * n + 16 * (wc & 1) + 4 * fq + j;
    return wc == 0 ? p : gen;
}
__device__ __forceinline__ int kind_in(int pn) { return pn < 5 ? 2 : ((pn >= 10 && pn < 22) ? 3 : 1); }

struct TrSrc { const float* W; int N; bf16_t* WT; int ldt, koff, kindsel; unsigned char* wt8; int n8; };
__device__ __forceinline__ void tr_load(const TrSrc& t, int item, int lane, f32x4 (&v)[8]) {
    const int nblk = t.N / 32, kb = item / nblk, nb = item % nblk, k0 = 64 * kb, n0 = 32 * nb;
    const int np = n0 + 4 * (lane & 7), pn = np >> 8;
    const int kind = t.kindsel < 0 ? kind_in(pn) : t.kindsel;
    const float* src = t.W + (size_t)(k0 + (lane >> 3)) * t.N + (pn << 8) + colmap(kind, np & 255);
#pragma unroll
    for (int i = 0; i < 8; ++i) v[i] = __builtin_nontemporal_load((const f32x4*)(src + (size_t)(8 * i) * t.N));
}
__device__ __forceinline__ void tr_store(const TrSrc& t, int item, int lane, const f32x4 (&v)[8], LAS float* scr) {
    const int nblk = t.N / 32, kb = item / nblk, nb = item % nblk, k0 = 64 * kb, n0 = 32 * nb;
    { LAS float* d = scr + (lane >> 3) * 33 + 4 * (lane & 7);
#pragma unroll
      for (int i = 0; i < 8; ++i) { d[i * 264 + 0] = v[i][0]; d[i * 264 + 1] = v[i][1]; d[i * 264 + 2] = v[i][2]; d[i * 264 + 3] = v[i][3]; } }
    asm volatile("s_waitcnt lgkmcnt(0)" ::: "memory");
    const int c = lane & 7;
    const int pn_ = n0 >> 8; const bool is8 = t.wt8 != nullptr && (n0 >= t.n8 || pn_ < 14);
    const int n8row = n0 >= t.n8 ? n0 - t.n8 + 14 * 256 : n0;
    if (is8) {
#pragma unroll
        for (int j = 0; j < 4; ++j) { const int n = (lane >> 3) + 8 * j; const LAS float* sp = scr + (8 * c) * 33 + n;
            int lo = 0, hi = 0;
            lo = __builtin_amdgcn_cvt_pk_fp8_f32(sp[0 * 33] * W8_SCALE, sp[1 * 33] * W8_SCALE, lo, false); lo = __builtin_amdgcn_cvt_pk_fp8_f32(sp[2 * 33] * W8_SCALE, sp[3 * 33] * W8_SCALE, lo, true);
            hi = __builtin_amdgcn_cvt_pk_fp8_f32(sp[4 * 33] * W8_SCALE, sp[5 * 33] * W8_SCALE, hi, false); hi = __builtin_amdgcn_cvt_pk_fp8_f32(sp[6 * 33] * W8_SCALE, sp[7 * 33] * W8_SCALE, hi, true);
            *(unsigned long long*)(t.wt8 + (size_t)(n8row + n) * t.ldt + k0 + 8 * c) = (unsigned long long)(unsigned)lo | ((unsigned long long)(unsigned)hi << 32); }
    } else {
#pragma unroll
    for (int j = 0; j < 4; ++j) { const int n = (lane >> 3) + 8 * j; const LAS float* sp = scr + (8 * c) * 33 + n;
        v4u o; o.x = pk2(sp[0 * 33], sp[1 * 33]); o.y = pk2(sp[2 * 33], sp[3 * 33]); o.z = pk2(sp[4 * 33], sp[5 * 33]); o.w = pk2(sp[6 * 33], sp[7 * 33]);
        *(v4u*)(t.WT + (size_t)(n0 + n) * t.ldt + t.koff + k0 + 8 * c) = o; }
    }
    asm volatile("s_waitcnt lgkmcnt(0)" ::: "memory");
}
__device__ __forceinline__ void tr_matrix(const TrSrc& t, int nitems, int gw, int NGW, int lane, LAS float* scr) {
    f32x4 a[8], b[8];
    int it = gw;
    if (it < nitems) tr_load(t, it, lane, a);
    for (; it < nitems; it += 2 * NGW) {
        const bool hb = it + NGW < nitems;
        if (hb) tr_load(t, it + NGW, lane, b);
        tr_store(t, it, lane, a, scr);
        if (hb) { if (it + 2 * NGW < nitems) tr_load(t, it + 2 * NGW, lane, a); tr_store(t, it + NGW, lane, b, scr); }
    }
}
__device__ __forceinline__ void rms_row_load(const float* xrow, int lane, f32x4 (&v)[8]) {
    const f32x4* xr = (const f32x4*)xrow + lane;
#pragma unroll
    for (int j = 0; j < 8; ++j) v[j] = __builtin_nontemporal_load(xr + 64 * j);
}
__device__ __forceinline__ void rms_row_store(const f32x4 (&v)[8], const float* gain, bf16_t* orow, unsigned char* orow8, int lane) {
    const f32x4* gr = (const f32x4*)gain + lane; float s = 0.f;
#pragma unroll
    for (int j = 0; j < 8; ++j) s += (v[j].x * v[j].x + v[j].y * v[j].y) + (v[j].z * v[j].z + v[j].w * v[j].w);
    const float rs = rsqrtf(wave_sum(s) * (1.f / DM) + EPS);
    unsigned long long* o8 = (unsigned long long*)orow + lane;
    unsigned* q8 = (unsigned*)orow8 + lane;
#pragma unroll
    for (int j = 0; j < 8; ++j) { const f32x4 g = gr[64 * j]; const f32x4 y = v[j] * rs * g;
        o8[64 * j] = (unsigned long long)pk2(y.x, y.y) | ((unsigned long long)pk2(y.z, y.w) << 32);
        int w = 0; w = __builtin_amdgcn_cvt_pk_fp8_f32(y.x * H8_SCALE, y.y * H8_SCALE, w, false); w = __builtin_amdgcn_cvt_pk_fp8_f32(y.z * H8_SCALE, y.w * H8_SCALE, w, true);
        q8[64 * j] = (unsigned)w; }
}
__device__ __forceinline__ void rms_rows(const float* x, const float* gain, bf16_t* H, unsigned char* H8, int m0, int step, int nrows, int lane) {
    f32x4 a[8], b[8];
    int m = m0;
    if (m < nrows) rms_row_load(x + (size_t)m * DM, lane, a);
    for (; m < nrows; m += 2 * step) {
        const bool hb = m + step < nrows;
        if (hb) rms_row_load(x + (size_t)(m + step) * DM, lane, b);
        rms_row_store(a, gain, H + (size_t)m * DM, H8 + (size_t)m * DM, lane);
        if (hb) { if (m + 2 * step < nrows) rms_row_load(x + (size_t)(m + 2 * step) * DM, lane, a); rms_row_store(b, gain, H + (size_t)(m + step) * DM, H8 + (size_t)(m + step) * DM, lane); }
    }
}

#define XB_TMO      128
#define XB_XCNT(j)  (256  + 64 * (j))
#define XB_XSUB(j)  (1280 + 64 * (j))
#define XB_XGEN(j)  (2304 + 64 * (j))
#define XB_TOP      3328
#define XB_TOPGEN   3392
#define XCD_BAR_WORDS 3456
#define XB_SPIN_CAP (1u << 18)

__device__ __forceinline__ unsigned xb_ld(unsigned* p)              { return __hip_atomic_load(p, __ATOMIC_RELAXED, __HIP_MEMORY_SCOPE_AGENT); }
__device__ __forceinline__ unsigned xb_add(unsigned* p, unsigned v) { return __hip_atomic_fetch_add(p, v, __ATOMIC_RELAXED, __HIP_MEMORY_SCOPE_AGENT); }
__device__ __forceinline__ unsigned xb_xcc_id() { return (unsigned)__builtin_amdgcn_s_getreg((3 << 11) | 20) & 0xFu; }
#define XB_SPIN(cond, bar) do { unsigned _sp = 0; while (cond) { __builtin_amdgcn_s_sleep(1); \
    if ((++_sp & 255u) == 0u) { if (xb_ld(&(bar)[XB_TMO])) break; if (_sp > XB_SPIN_CAP) { atomicAdd(&(bar)[XB_TMO], 1u); break; } } } } while (0)

struct XcdBarrier {
    unsigned* bar; unsigned x;
    volatile LAS unsigned* st;
};

__device__ __forceinline__ XcdBarrier xcd_barrier_post(unsigned* bar, volatile LAS unsigned* st) {
    XcdBarrier b; b.bar = bar; b.x = xb_xcc_id(); b.st = st;
    if (threadIdx.x == 0) (void)xb_add(&bar[XB_XCNT(b.x)], 1u);
    return b;
}
__device__ __forceinline__ void xcd_barrier_complete(unsigned* bar, unsigned x, unsigned& nloc, unsigned& nx) {
    const unsigned G = gridDim.x * gridDim.y * gridDim.z;
    unsigned sum, cnt, mine, sp = 0u;
    for (;;) {
        sum = 0u; cnt = 0u; mine = 0u;
#pragma unroll
        for (unsigned j = 0; j < 16; ++j) { const unsigned c = xb_ld(&bar[XB_XCNT(j)]); sum += c; cnt += (c > 0u) ? 1u : 0u; mine = (j == x) ? c : mine; }
        if (sum == G) break;
        __builtin_amdgcn_s_sleep(1);
        if ((++sp & 255u) == 0u) { if (xb_ld(&bar[XB_TMO])) break; if (sp > XB_SPIN_CAP) { atomicAdd(&bar[XB_TMO], 1u); break; } }
    }
    nloc = mine > 0u ? mine : 1u; nx = cnt > 0u ? cnt : 1u;
}

__device__ __forceinline__ void xcd_barrier(const XcdBarrier& b, const int wave_) {
    asm volatile("s_waitcnt vmcnt(0)" ::: "memory");
    __syncthreads();
    if (wave_ == 0 && fresh_lane() == 0) {
        unsigned* bar = b.bar;
        __builtin_amdgcn_s_waitcnt(0);
        unsigned nloc = b.st[0], nx = b.st[1];
        if (nloc == 0u) { xcd_barrier_complete(bar, b.x, nloc, nx); b.st[0] = nloc; b.st[1] = nx; }
        const unsigned old = xb_add(&bar[XB_XSUB(b.x)], 1u);
        const unsigned gen = old / nloc;
        if (old + 1u == (gen + 1u) * nloc) {
            __builtin_amdgcn_fence(__ATOMIC_RELEASE, "agent");
            asm volatile("s_waitcnt vmcnt(0)" ::: "memory");
            const unsigned og = xb_add(&bar[XB_TOP], 1u);
            const unsigned tg = og / nx;
            if (og + 1u == (tg + 1u) * nx) xb_add(&bar[XB_TOPGEN], 1u);
            else XB_SPIN(xb_ld(&bar[XB_TOPGEN]) == tg, bar);
            __builtin_amdgcn_fence(__ATOMIC_ACQUIRE, "agent");
            xb_add(&bar[XB_XGEN(b.x)], 1u);
            asm volatile("s_waitcnt vmcnt(0)" ::: "memory");
        } else {
            XB_SPIN(xb_ld(&bar[XB_XGEN(b.x)]) == gen, bar);
            __builtin_amdgcn_fence(__ATOMIC_ACQUIRE, "agent");
            asm volatile("s_waitcnt vmcnt(0)" ::: "memory");
        }
    }
    __syncthreads();
}

struct Args { const float* in[10]; float* out; unsigned char* ws; int ph_lo, ph_hi; };

__global__ void __launch_bounds__(NWAVES * 64, 2) mk_fwd(Args args) {
    extern __shared__ __attribute__((aligned(16))) unsigned char lds[];
    const int wave = __builtin_amdgcn_readfirstlane((int)threadIdx.x >> 6);
#define TID_LANE const int lane = fresh_lane(); const int tid = wave * 64 + lane; (void)tid; (void)lane;
    const int G = gridDim.x, bx = blockIdx.x;
    const int vcu = (G % 8 == 0) ? (bx % 8) * (G / 8) + bx / 8 : bx;
    unsigned char* ws = args.ws;
    const float* x = args.in[0]; const float* ng = args.in[1]; const float* w_in = args.in[2];
    bf16_t* WT_IN = (bf16_t*)(ws + WS_WTIN); bf16_t* HB = (bf16_t*)(ws + WS_HB); bf16_t* P = (bf16_t*)(ws + WS_P);
    float* COSA = (float*)(ws + WS_TAB); float* SINA = COSA + 2048; float* COSP = COSA + 4096; float* SINP = COSP + 32768;
    bf16_t* OG = (bf16_t*)(ws + WS_OG); float* LSE = (float*)(ws + WS_LSE); unsigned* CTL = (unsigned*)(ws + WS_CTL) + 4096;
    bf16_t* WT_AB = (bf16_t*)(ws + WS_WTAB); bf16_t* WT_O = (bf16_t*)(ws + WS_WTO); bf16_t* Y = (bf16_t*)(ws + WS_Y); bf16_t* MG = HB; unsigned char* H8 = ws + WS_H8; unsigned char* WTZ8 = ws + WS_WTZ8; bf16_t* SA = (bf16_t*)(ws + WS_SA); bf16_t* SB = (bf16_t*)(ws + WS_SB); float* XB = (float*)(ws + WS_XB); unsigned* PCNT = (unsigned*)(ws + WS_CTL) + 8192;
    const int lo = args.ph_lo, hi = args.ph_hi;
    volatile LAS unsigned* MISC = (volatile LAS unsigned*)((LAS unsigned char*)lds + 131072 + 320);
    if (threadIdx.x < 32) MISC[threadIdx.x] = 0u;
    __syncthreads();
    XcdBarrier bar = xcd_barrier_post((unsigned*)(ws + WS_CTL), MISC + 8);
#define GRID_BAR() xcd_barrier(bar, wave)
#define IN(k) (lo <= (k) && (k) < hi)
#define BOTH(k) (IN(k) && IN((k) + 1))
    if (IN(0)) { TID_LANE
        LAS float* scr = (LAS float*)((LAS unsigned char*)lds + wave * 16384);
        const int gw = vcu * NWAVES + wave, NGW = G * NWAVES;
        constexpr int I_IN = (DM / 64) * (NC / 32);
        { const TrSrc t{w_in, NC, WT_IN, DM, 0, -1, WTZ8, 7680}; tr_matrix(t, I_IN, gw, NGW, lane, scr); }
        for (int i = bx * (NWAVES * 64) + tid; i < 2048 + 32768; i += G * NWAVES * 64) {
            if (i < 2048) { const int pos = i >> 5, fi = i & 31; const float a = (float)pos * (1.0f / powf(10000.0f, (float)fi / 32.0f)); COSA[i] = cosf(a); SINA[i] = sinf(a); }
            else { const int k = i - 2048, pos = k >> 4, fi = k & 15; const float a = (float)pos * (1.0f / powf(500000.0f, (float)fi / 16.0f)); COSP[k] = cosf(a); SINP[k] = sinf(a); }
        }
        rms_rows(x, ng, HB, H8, gw, NGW, NTOK, lane);
        if (BOTH(0)) GRID_BAR();
    }
    if (IN(1)) { TID_LANE
        const float dsc = 1.0f / (H8_SCALE * W8_SCALE);
        {
            pg8::Gemm g{HB, WT_IN + (size_t)14 * 256 * DM, NTOK, 16 * 256, DM}; pg8::StaticOrder S; S.init(NTOK, 16 * 256, G, bx, 8);
            pg8::EpiIn<false> E{P, PITCH, COSA, SINA, COSP, SINP, args.in[3], args.in[4], args.in[5], SA, SB, (LAS float*)((LAS unsigned char*)lds + 131072 + 1024), EPS, 1.0f};
            pg8::gemm_phase<pg8::EpiIn<false>, pg8::StaticOrder, true, true>((LAS unsigned char*)lds, g, S, E, wave);
        }
        {
            pg8::Gemm g8{(const bf16_t*)H8, (const bf16_t*)WTZ8, NTOK, 30 * 256, DM / 2}; pg8::StaticOrder S8; S8.init(NTOK, 30 * 256, G, bx, 4);
            pg8::EpiIn<true> E8{P, PITCH, COSA, SINA, COSP, SINP, args.in[3], args.in[4], args.in[5], SA, SB, (LAS float*)((LAS unsigned char*)lds + 131072 + 1024), EPS, dsc};
            pg8::gemm_phase<pg8::EpiIn<true>, pg8::StaticOrder, true, true>((LAS unsigned char*)lds, g8, S8, E8, wave);
        }
        const int nheavy = ((NTOK / 256) * 30) % G;
        {
            const int first = nheavy > 0 ? nheavy : 0, nidle = G - first;
            if (bx >= first) {
                LAS float* scr = (LAS float*)((LAS unsigned char*)lds + wave * 16384);
                const int gw2 = (bx - first) * NWAVES + wave, NGW2 = nidle * NWAVES;
                constexpr int I_A = (1024 / 64) * (DM / 32), I_B = (512 / 64) * (DM / 32), I_O = (DM / 64) * (DM / 32);
                { const TrSrc t{args.in[6], DM, WT_AB, 1536, 0, 1, nullptr, 0}; tr_matrix(t, I_A, gw2, NGW2, lane, scr); }
                { const TrSrc t{args.in[7], DM, WT_AB, 1536, 1024, 1, nullptr, 0}; tr_matrix(t, I_B, gw2, NGW2, lane, scr); }
                { const TrSrc t{args.in[8], DM, WT_O, DM, 0, 0, nullptr, 0}; tr_matrix(t, I_O, gw2, NGW2, lane, scr); }
            }
        }
        if (BOTH(1)) GRID_BAR();
    }
    if (IN(2)) { TID_LANE
        for (int u = bx; u < 384; u += G) {
            const int blk = u & 7, h = (u >> 3) & 3, b = (u >> 5) & 3, g = u >> 7;
            att::attn_band_unit(P, OG, LSE, g, b, h, blk, C_QB, C_KB, C_VB, SEQ, NTOK, (char*)lds, wave);
        }
        asm volatile("s_waitcnt vmcnt(0)" ::: "memory"); __syncthreads();
        if (tid == 0) { __builtin_amdgcn_fence(__ATOMIC_RELEASE, "agent"); asm volatile("s_waitcnt vmcnt(0)" ::: "memory"); __hip_atomic_fetch_add(CTL, 1u, __ATOMIC_RELAXED, __HIP_MEMORY_SCOPE_AGENT); }
        for (int u = bx; u < 256; u += G) {
            const int pair = u & 7, inner = u >> 3, b = pair >> 1, hkv = pair & 1, hq = hkv * 4 + (inner >> 3), qb = inner & 7;
            const size_t row0 = (size_t)b * SEQ + qb * 256;
            att::attn_dense_body(P + row0 * PITCH + C_QA + hq * 128, P + (size_t)b * SEQ * PITCH + C_KA + hkv * 128, P + (size_t)b * SEQ * PITCH + C_VA + hkv * 128,
                                 P + row0 * PITCH + C_GA + hq * 128, Y + row0 * 1536 + hq * 128, SEQ, (char*)lds, wave);
        }
        const int mfirst = (384 - G > 0 && 384 - G < G) ? 384 - G : 0, nmerge = G - mfirst;
        if (bx >= mfirst) {
            if (tid == 0) { unsigned spins = 0; while (__hip_atomic_load(CTL, __ATOMIC_RELAXED, __HIP_MEMORY_SCOPE_AGENT) < (unsigned)G) { __builtin_amdgcn_s_sleep(4); if (++spins > (1u << 24)) break; }
                __builtin_amdgcn_fence(__ATOMIC_ACQUIRE, "agent"); asm volatile("s_waitcnt vmcnt(0)" ::: "memory"); }
            __syncthreads();
            for (int c0 = (bx - mfirst) * (NWAVES * 64) + tid; c0 < NTOK * 64; c0 += 2 * nmerge * NWAVES * 64) {
                v4u a0[2], a1[2], a2[2], gz[2]; float e0[2], e1[2], e2[2]; int tok[2], c8[2]; bool ok[2];
#pragma unroll
                for (int q = 0; q < 2; ++q) { const int ci = c0 + q * nmerge * NWAVES * 64; ok[q] = ci < NTOK * 64; const int cj = ok[q] ? ci : c0; tok[q] = cj >> 6; c8[q] = (cj & 63) * 8; const int h = c8[q] >> 7;
                    e0[q] = LSE[((size_t)0 * NTOK + tok[q]) * 4 + h]; e1[q] = LSE[((size_t)1 * NTOK + tok[q]) * 4 + h]; e2[q] = LSE[((size_t)2 * NTOK + tok[q]) * 4 + h];
                    a0[q] = *(const v4u*)(OG + ((size_t)0 * NTOK + tok[q]) * 512 + c8[q]); a1[q] = *(const v4u*)(OG + ((size_t)1 * NTOK + tok[q]) * 512 + c8[q]); a2[q] = *(const v4u*)(OG + ((size_t)2 * NTOK + tok[q]) * 512 + c8[q]);
                    gz[q] = *(const v4u*)(P + (size_t)tok[q] * PITCH + C_GB + c8[q]); }
#pragma unroll
                for (int q = 0; q < 2; ++q) { const float mx = fmaxf(e0[q], fmaxf(e1[q], e2[q])); float w0 = __expf(e0[q] - mx), w1 = __expf(e1[q] - mx), w2 = __expf(e2[q] - mx); const float inv = 1.f / (w0 + w1 + w2); w0 *= inv; w1 *= inv; w2 *= inv;
                    v4u w;
#pragma unroll
                    for (int e = 0; e < 4; ++e) {
                        const float lo = w0 * __uint_as_float(a0[q][e] << 16) + w1 * __uint_as_float(a1[q][e] << 16) + w2 * __uint_as_float(a2[q][e] << 16);
                        const float hh = w0 * __uint_as_float(a0[q][e] & 0xffff0000u) + w1 * __uint_as_float(a1[q][e] & 0xffff0000u) + w2 * __uint_as_float(a2[q][e] & 0xffff0000u);
                        w[e] = pk2(lo * __uint_as_float(gz[q][e] << 16), hh * __uint_as_float(gz[q][e] & 0xffff0000u)); }
                    if (ok[q]) *(v4u*)(Y + (size_t)tok[q] * 1536 + 1024 + c8[q]) = w; }
            }
        }
        if (BOTH(2)) GRID_BAR();
    }
    if (IN(3)) {
        pg8::Gemm g{Y, WT_AB, NTOK, DM, 1536}; pg8::StaticOrder S; S.init(NTOK, DM, G, bx, 4);
        pg8::EpiMerge2 E{SA, SB, MG, DM};
        pg8::gemm_phase<pg8::EpiMerge2, pg8::StaticOrder, true, true>((LAS unsigned char*)lds, g, S, E, wave);
        if (BOTH(3)) GRID_BAR();
    }
    if (IN(4)) {
        pg8::Gemm g{MG, WT_O, NTOK, DM, DM}; pg8::StaticOrder S; S.init(NTOK, DM, G, bx, 4);
        pg8::EpiResidNorm E{x, args.out, DM, args.in[9], XB, PCNT, 8, EPS};
        if (G == 256) pg8::gemm_phase<pg8::EpiResidNorm, pg8::StaticOrder, false, true>((LAS unsigned char*)lds, g, S, E, wave);
    }
#undef IN
#undef BOTH
}


extern "C" void kernel_launch(void* const* d_in, const int* in_sizes, int n_in, void* d_out, int out_size, void* d_ws, size_t ws_size, hipStream_t stream) {
    static int grid = 0;
    if (grid == 0) {
        if (n_in != 10 || in_sizes[0] != NTOK * DM || out_size != NTOK * DM || ws_size < WS_END) { fprintf(stderr, "kernel_launch: unexpected shapes / workspace (%zu)\n", ws_size); grid = -1; return; }
        int dev = 0, cus = 0, per_cu = 0;
        if (hipGetDevice(&dev) != hipSuccess || hipDeviceGetAttribute(&cus, hipDeviceAttributeMultiprocessorCount, dev) != hipSuccess) { grid = -1; return; }
        if (hipFuncSetAttribute((const void*)mk_fwd, hipFuncAttributeMaxDynamicSharedMemorySize, LDS_BYTES) != hipSuccess) { fprintf(stderr, "kernel_launch: hipFuncSetAttribute failed\n"); grid = -1; return; }
        if (hipOccupancyMaxActiveBlocksPerMultiprocessor(&per_cu, (const void*)mk_fwd, NWAVES * 64, LDS_BYTES) != hipSuccess || per_cu < 1) { fprintf(stderr, "kernel_launch: occupancy query says %d\n", per_cu); grid = -1; return; }
        grid = cus;
    }
    if (grid < 0) return;
    if (hipMemsetAsync((char*)d_ws + WS_CTL, 0, 131072, stream) != hipSuccess) { fprintf(stderr, "kernel_launch: memset failed\n"); return; }
    Args a{};
    for (int i = 0; i < 10; ++i) a.in[i] = (const float*)d_in[i];
    a.out = (float*)d_out; a.ws = (unsigned char*)d_ws; a.ph_lo = 0; a.ph_hi = 5;
    void* kargs[] = {&a};
    hipError_t e = hipLaunchCooperativeKernel((const void*)mk_fwd, dim3(grid), dim3(NWAVES * 64), kargs, LDS_BYTES, stream);
    if (e != hipSuccess) fprintf(stderr, "kernel_launch: cooperative launch failed: %s (grid %d)\n", hipGetErrorString(e), grid);
}
```

```cpp
#include <hip/hip_runtime.h>
#include <cstdio>
#include <cstdint>
#include <cmath>
__device__ __forceinline__ int fresh_lane() { int l; asm volatile("v_mbcnt_lo_u32_b32 %0, -1, 0\n\tv_mbcnt_hi_u32_b32 %0, -1, %0" : "=v"(l)); return l; }
namespace pg8 {
#define PG8_LAS __attribute__((address_space(3)))
typedef unsigned short bf16_t;
typedef short bf16x8 __attribute__((ext_vector_type(8)));
typedef float f32x4 __attribute__((ext_vector_type(4)));
typedef unsigned u32x4 __attribute__((ext_vector_type(4)));
typedef int v4i_t __attribute__((ext_vector_type(4)));
constexpr int BM = 256, BK = 64, HALF = 128, HTB = HALF * BK * 2  , STAGE_BYTES = 8 * HTB, NXCD = 8;

__host__ __device__ __forceinline__ int lds_byte(int r, int c) { const int st = (r >> 4) * 2 + (c >> 5), rr = r & 15, cc = c & 31, ob = rr * 64 + cc * 2; return st * 1024 + (ob ^ (((ob >> 9) & 1) << 5)); }
__host__ __device__ __forceinline__ void stage_rc(int b, int& R, int& C) { const int st = b / 1024, sb = b % 1024, swz = sb ^ (((sb >> 9) & 1) << 5); R = (st >> 1) * 16 + swz / 64; C = (st & 1) * 32 + (swz % 64) / 2; }
__host__ __device__ __forceinline__ int perm32(int rho) { const int n = rho >> 4, i = rho & 15; return 8 * (i >> 2) + 4 * n + (i & 3); }

struct Unit { int pm, pn; };
struct Gemm { const bf16_t* A; const bf16_t* Bt; int M, N, K; };

struct StaticOrder {
    int nM, nN, nwg, G, c, WGM;
    __host__ __device__ void init(int M, int N, int G_, int c_, int wgm = 4) { nM = M / BM; nN = N / BM; nwg = nM * nN; G = G_; c = c_; WGM = wgm; }
    __host__ __device__ bool next(int i, Unit& u) const { const long L = (long)i * G + c; if (L >= nwg) return false; unit_of((int)L, u); return true; }
    __host__ __device__ bool unit_of(int L, Unit& u) const {
        int wgid = L; { const int q = nwg / NXCD, r = nwg % NXCD, xcd = wgid % NXCD, off = wgid / NXCD; wgid = (xcd < r ? xcd * (q + 1) : r * (q + 1) + (xcd - r) * q) + off; }
        const int nig = WGM * nN, gid = wgid / nig, fm = gid * WGM, gsz = (nM - fm) < WGM ? (nM - fm) : WGM;
        u.pm = fm + ((wgid % nig) % gsz); u.pn = (wgid % nig) / gsz; return true;
    }
    __device__ __forceinline__ void a_ready(const Unit&) const {}
    __device__ __forceinline__ void done(const Unit&) const {}
};


typedef float f32x2_cv __attribute__((ext_vector_type(2))); typedef __bf16 bf16x2_cv __attribute__((ext_vector_type(2)));
__device__ __forceinline__ unsigned cvt_pk_bf16(float lo, float hi) { const f32x2_cv v = {lo, hi}; return __builtin_bit_cast(unsigned, __builtin_convertvector(v, bf16x2_cv)); }
typedef float f32x2 __attribute__((ext_vector_type(2)));

template <bool F8> struct EpiIn {
    static constexpr bool PERM = false, AFTER_DRAIN = false, FP8 = F8, INIT_ACC = false; static constexpr int HOOK_T = -1;
    bf16_t* O; int ldc; const float* cosa; const float* sina; const float* cosp; const float* sinp; const float* qg; const float* kg; const float* bias; bf16_t* SA; bf16_t* SB; PG8_LAS float* red; float eps; float sc;
    __device__ __forceinline__ static unsigned long long pk4(const f32x4 v) { return (unsigned long long)cvt_pk_bf16(v[0], v[1]) | ((unsigned long long)cvt_pk_bf16(v[2], v[3]) << 32); }
    __device__ __forceinline__ void operator()(const f32x4 (&acc)[2][2][4][2], const Unit& u, int wr, int wc, int fr_, int fq_) const {
        (void)fr_; (void)fq_; const int ln_ = fresh_lane(), fr = ln_ & 15, fq = ln_ >> 4;
        const int pn = F8 ? (u.pn < 14 ? u.pn : u.pn + 16) : u.pn + 14; const int row0 = u.pm * BM + wr * 64 + fr;
        if (pn < 5) {
#pragma unroll
            for (int ai = 0; ai < 2; ++ai)
#pragma unroll
                for (int m = 0; m < 4; ++m)
#pragma unroll
                    for (int bj = 0; bj < 2; ++bj) { const f32x4 v0 = (acc[ai][bj][m][0] * sc), v1 = (acc[ai][bj][m][1] * sc);
                        float ss = (v0[0] * v0[0] + v0[1] * v0[1]) + (v0[2] * v0[2] + v0[3] * v0[3]) + (v1[0] * v1[0] + v1[1] * v1[1]) + (v1[2] * v1[2] + v1[3] * v1[3]);
                        ss += __shfl_xor(ss, 16); ss += __shfl_xor(ss, 32);
                        if (fq == 0) red[(ai * HALF + wr * 64 + m * 16 + fr) * 8 + bj * 4 + wc] = ss; }
            asm volatile("s_waitcnt lgkmcnt(0)" ::: "memory"); __builtin_amdgcn_s_barrier(); asm volatile("" ::: "memory");
            const int half = wc >> 1, i0 = 16 * (wc & 1) + 4 * fq;
            const float* g = (pn < 4) ? qg : kg;
            const f32x4 g0 = *(const f32x4*)(g + 64 * half + i0), g1 = *(const f32x4*)(g + 64 * half + 32 + i0);
#pragma unroll
            for (int ai = 0; ai < 2; ++ai)
#pragma unroll
                for (int m = 0; m < 4; ++m) { const int row = row0 + ai * HALF + m * 16, sq = row & 2047, pos = half ? (sq & 63) : (sq >> 6);
                    const f32x4 c = *(const f32x4*)(cosa + pos * 32 + i0), sn = *(const f32x4*)(sina + pos * 32 + i0);
#pragma unroll
                    for (int bj = 0; bj < 2; ++bj) { const f32x4 pr = *(const PG8_LAS f32x4*)(red + (ai * HALF + wr * 64 + m * 16 + fr) * 8 + bj * 4);
                        const float rs = rsqrtf(((pr[0] + pr[1]) + (pr[2] + pr[3])) * (1.f / 128.f) + eps);
                        const f32x4 y0 = (acc[ai][bj][m][0] * sc) * rs * g0, y1 = (acc[ai][bj][m][1] * sc) * rs * g1;
                        const f32x4 lo = y0 * c - y1 * sn, hi = y0 * sn + y1 * c;
                        bf16_t* p = O + (size_t)row * ldc + pn * BM + bj * HALF + 64 * half + i0;
                        *(unsigned long long*)p = pk4(lo); *(unsigned long long*)(p + 32) = pk4(hi); } }
        } else if (pn >= 10 && pn < 22 && wc == 0) {
            const int i0 = 4 * fq;
#pragma unroll
            for (int ai = 0; ai < 2; ++ai)
#pragma unroll
                for (int m = 0; m < 4; ++m) { const int row = row0 + ai * HALF + m * 16, sq = row & 2047;
                    const f32x4 c = *(const f32x4*)(cosp + sq * 16 + i0), sn = *(const f32x4*)(sinp + sq * 16 + i0);
#pragma unroll
                    for (int bj = 0; bj < 2; ++bj) { const f32x4 y0 = (acc[ai][bj][m][0] * sc), y1 = (acc[ai][bj][m][1] * sc);
                        const f32x4 lo = y0 * c - y1 * sn, hi = y0 * sn + y1 * c;
                        bf16_t* p = O + (size_t)row * ldc + pn * BM + bj * HALF + i0;
                        *(unsigned long long*)p = pk4(lo); *(unsigned long long*)(p + 16) = pk4(hi); } }
        } else if (pn >= 30) {
            const int which = pn >= 38 ? 1 : 0, pnz = pn - (which ? 38 : 30);
            const float* bs = bias + which * 2048 + pnz * BM + wc * 32 + 8 * fq;
            bf16_t* dst = (which ? SB : SA) + ((((size_t)(u.pm * 8 + pnz) * 8 + (wr * 4 + wc)) * 16) * 64 + (fq * 16 + fr)) * 8;
#pragma unroll
            for (int bj = 0; bj < 2; ++bj) { const f32x4 b0 = *(const f32x4*)(bs + bj * HALF), b1 = *(const f32x4*)(bs + bj * HALF + 4);
#pragma unroll
                for (int ai = 0; ai < 2; ++ai)
#pragma unroll
                    for (int m = 0; m < 4; ++m) { const f32x4 v0 = (acc[ai][bj][m][0] * sc) + b0, v1 = (acc[ai][bj][m][1] * sc) + b1; float sg[8];
#pragma unroll
                        for (int e = 0; e < 4; ++e) { sg[e] = __builtin_amdgcn_rcpf(1.f + __builtin_amdgcn_exp2f(v0[e] * -1.4426950408889634f)); sg[4 + e] = __builtin_amdgcn_rcpf(1.f + __builtin_amdgcn_exp2f(v1[e] * -1.4426950408889634f)); }
                        u32x4 w; w.x = cvt_pk_bf16(sg[0], sg[1]); w.y = cvt_pk_bf16(sg[2], sg[3]); w.z = cvt_pk_bf16(sg[4], sg[5]); w.w = cvt_pk_bf16(sg[6], sg[7]);
                        __builtin_nontemporal_store(w, (u32x4*)(dst + (ai * 8 + bj * 4 + m) * 512)); } }
        } else {
            const bool act = (pn >= 6 && pn < 10) || pn == 28 || pn == 29;
            const int col0 = pn * BM + wc * 32 + 8 * fq;
#pragma unroll
            for (int ai = 0; ai < 2; ++ai)
#pragma unroll
                for (int m = 0; m < 4; ++m) { bf16_t* rowp = O + (size_t)(row0 + ai * HALF + m * 16) * ldc + col0;
#pragma unroll
                    for (int bj = 0; bj < 2; ++bj) { f32x4 v0 = (acc[ai][bj][m][0] * sc), v1 = (acc[ai][bj][m][1] * sc);
                        if (act) {
#pragma unroll
                            for (int e = 0; e < 4; ++e) { v0[e] = v0[e] * __builtin_amdgcn_rcpf(1.f + __builtin_amdgcn_exp2f(v0[e] * -1.4426950408889634f)); v1[e] = v1[e] * __builtin_amdgcn_rcpf(1.f + __builtin_amdgcn_exp2f(v1[e] * -1.4426950408889634f)); } }
                        u32x4 w; w.x = cvt_pk_bf16(v0[0], v0[1]); w.y = cvt_pk_bf16(v0[2], v0[3]); w.z = cvt_pk_bf16(v1[0], v1[1]); w.w = cvt_pk_bf16(v1[2], v1[3]);
                        *(u32x4*)(rowp + bj * HALF) = w; } }
        }
    }
};
struct EpiMerge2 {
    static constexpr bool PERM = false, AFTER_DRAIN = false, FP8 = false; static constexpr int HOOK_T = 16; static constexpr bool INIT_ACC = false;
    const bf16_t* SA; const bf16_t* SB; bf16_t* O; int ldc;
    __device__ __forceinline__ void mid(f32x4 (&acc)[2][2][4][2], const Unit& u, int wr, int wc, int fr, int fq) const {
        int lane = fq * 16 + fr; asm volatile("" : "+v"(lane));
        const size_t base = ((((size_t)(u.pm * 8 + u.pn) * 8 + (wr * 4 + wc)) * 16) * 64 + lane) * 8;
#pragma unroll
        for (int f = 0; f < 16; ++f) { const int ai = f >> 3, bj = (f >> 2) & 1, m = f & 3;
            const u32x4 a = __builtin_nontemporal_load((const u32x4*)(SA + base + f * 512)), b = *(const u32x4*)(SB + base + f * 512);
            f32x4 r0, r1;
#pragma unroll
            for (int e = 0; e < 4; ++e) { const float q_lo = __uint_as_float(a[e] << 16) * __builtin_amdgcn_rcpf(__uint_as_float(b[e] << 16)), q_hi = __uint_as_float(a[e] & 0xffff0000u) * __builtin_amdgcn_rcpf(__uint_as_float(b[e] & 0xffff0000u));
                if (e < 2) { r0[2 * e] = q_lo; r0[2 * e + 1] = q_hi; } else { r1[2 * e - 4] = q_lo; r1[2 * e - 3] = q_hi; } }
            acc[ai][bj][m][0] *= r0; acc[ai][bj][m][1] *= r1; }
    }
    __device__ __forceinline__ void operator()(const f32x4 (&acc)[2][2][4][2], const Unit& u, int wr, int wc, int fr_, int fq_) const {
        (void)fr_; (void)fq_; const int ln_ = fresh_lane(), fr = ln_ & 15, fq = ln_ >> 4;
        const int lane = fq * 16 + fr, row0 = u.pm * BM + wr * 64 + fr, col0 = u.pn * BM + wc * 32 + 8 * fq;
        const size_t base = ((((size_t)(u.pm * 8 + u.pn) * 8 + (wr * 4 + wc)) * 16) * 64 + lane) * 8;
        bf16_t* Oq = O; asm volatile("" : "+s"(Oq));
        const __amdgpu_buffer_rsrc_t rsO = __builtin_amdgcn_make_buffer_rsrc((void*)Oq, 0, 8192 * 2048 * 2, 0x00020000);
#pragma unroll
        for (int f = 0; f < 16; ++f) { const int ai = f >> 3, bj = (f >> 2) & 1, m = f & 3;
            const u32x4 b = __builtin_nontemporal_load((const u32x4*)(SB + base + f * 512));
            const f32x4 v0 = acc[ai][bj][m][0], v1 = acc[ai][bj][m][1];
            u32x4 w; w.x = cvt_pk_bf16(v0[0] * __uint_as_float(b[0] << 16), v0[1] * __uint_as_float(b[0] & 0xffff0000u)); w.y = cvt_pk_bf16(v0[2] * __uint_as_float(b[1] << 16), v0[3] * __uint_as_float(b[1] & 0xffff0000u));
            w.z = cvt_pk_bf16(v1[0] * __uint_as_float(b[2] << 16), v1[1] * __uint_as_float(b[2] & 0xffff0000u)); w.w = cvt_pk_bf16(v1[2] * __uint_as_float(b[3] << 16), v1[3] * __uint_as_float(b[3] & 0xffff0000u));
            __builtin_amdgcn_raw_buffer_store_b128(w, rsO, (int)(((size_t)(row0 + ai * HALF + m * 16) * ldc + col0 + bj * HALF) * 2), 0, 16); }
    }
};
struct EpiResidNorm {
    static constexpr bool PERM = false, AFTER_DRAIN = true, FP8 = false, INIT_ACC = true; static constexpr int HOOK_T = -1;
    const float* base; float* out; int ldc; const float* gain; float* xb; unsigned* cnt; int ntn; float eps;
    __device__ __forceinline__ void init(f32x4 (&acc)[2][2][4][2], const Unit& u, int wr, int wc, int fr, int fq) const {
        const int row0 = u.pm * BM + wr * 64 + fr, col0 = u.pn * BM + wc * 32 + 4 * fq;
#pragma unroll
        for (int ai = 0; ai < 2; ++ai)
#pragma unroll
            for (int m = 0; m < 4; ++m) { const size_t off = (size_t)(row0 + ai * HALF + m * 16) * ldc + col0;
#pragma unroll
                for (int bj = 0; bj < 2; ++bj)
#pragma unroll
                    for (int n = 0; n < 2; ++n) acc[ai][bj][m][n] = __builtin_nontemporal_load((const f32x4*)(base + off + bj * HALF + n * 16)); }
    }
    __device__ __forceinline__ void fused(f32x4 (&acc)[2][2][4][2], const Unit& u, int wr, int wc, int fr_, int fq_, PG8_LAS unsigned char* lds, int wid, int lane) const {
        (void)fr_; (void)fq_; const int ln_ = fresh_lane(), fr = ln_ & 15, fq = ln_ >> 4;
        PG8_LAS float* Pp = (PG8_LAS float*)lds;
        PG8_LAS float* Sr = (PG8_LAS float*)(lds + 4096);
        const int row0 = u.pm * BM + wr * 64 + fr, col0 = u.pn * BM + wc * 32 + 4 * fq;
#pragma unroll
        for (int ai = 0; ai < 2; ++ai)
#pragma unroll
            for (int m = 0; m < 4; ++m) { float ss = 0.f;
#pragma unroll
                for (int bj = 0; bj < 2; ++bj)
#pragma unroll
                    for (int n = 0; n < 2; ++n) { const f32x4 o = acc[ai][bj][m][n];
                        ss += (o[0] * o[0] + o[1] * o[1]) + (o[2] * o[2] + o[3] * o[3]); }
                ss += __shfl_xor(ss, 16); ss += __shfl_xor(ss, 32);
                if (fq == 0) Pp[(ai * HALF + wr * 64 + m * 16 + fr) * 4 + wc] = ss; }
        asm volatile("s_waitcnt lgkmcnt(0)" ::: "memory"); __builtin_amdgcn_s_barrier(); asm volatile("" ::: "memory");
        const int tid = wid * 64 + lane;
        if (tid < 256) { const f32x4 p = *(const PG8_LAS f32x4*)(Pp + tid * 4);
            __hip_atomic_store(xb + (size_t)(u.pm * BM + tid) * 8 + u.pn, (p[0] + p[1]) + (p[2] + p[3]), __ATOMIC_RELAXED, __HIP_MEMORY_SCOPE_AGENT); }
        asm volatile("s_waitcnt vmcnt(0)" ::: "memory"); __builtin_amdgcn_s_barrier(); asm volatile("" ::: "memory");
        if (tid == 0) __hip_atomic_fetch_add(cnt + 64 * u.pm, 1u, __ATOMIC_RELAXED, __HIP_MEMORY_SCOPE_AGENT);
        if (wid == 0) { unsigned spins = 0;
            while ((unsigned)__builtin_amdgcn_readfirstlane(__hip_atomic_load(cnt + 64 * u.pm, __ATOMIC_RELAXED, __HIP_MEMORY_SCOPE_AGENT)) < (unsigned)ntn) { __builtin_amdgcn_s_sleep(2); if (++spins > (1u << 22)) break; }
            __builtin_amdgcn_fence(__ATOMIC_ACQUIRE, "agent"); }
        asm volatile("s_waitcnt vmcnt(0) lgkmcnt(0)" ::: "memory"); __builtin_amdgcn_s_barrier(); asm volatile("" ::: "memory");
        if (tid < 256) { const float* slot = xb + (size_t)(u.pm * BM + tid) * 8; float tot = 0.f;
#pragma unroll
            for (int t = 0; t < 8; ++t) tot += __hip_atomic_load(slot + t, __ATOMIC_RELAXED, __HIP_MEMORY_SCOPE_AGENT);
            Sr[tid] = rsqrtf(tot * (1.0f / 2048.0f) + eps); }
        asm volatile("s_waitcnt lgkmcnt(0)" ::: "memory"); __builtin_amdgcn_s_barrier(); asm volatile("" ::: "memory");
#pragma unroll
        for (int bj = 0; bj < 2; ++bj)
#pragma unroll
            for (int n = 0; n < 2; ++n) { const f32x4 g = *(const f32x4*)(gain + col0 + bj * HALF + n * 16);
#pragma unroll
                for (int ai = 0; ai < 2; ++ai)
#pragma unroll
                    for (int m = 0; m < 4; ++m) { const int rl = ai * HALF + wr * 64 + m * 16 + fr; const float rs = Sr[rl];
                        __builtin_nontemporal_store(acc[ai][bj][m][n] * rs * g, (f32x4*)(out + (size_t)(u.pm * BM + rl) * ldc + col0 + bj * HALF + n * 16)); } }
    }
};

template <class Epi, class Sched, bool ALIGN_EPI = false, bool SP2 = false>
__device__ __forceinline__ void gemm_phase(PG8_LAS unsigned char* lds, const Gemm g, const Sched& S, const Epi& E, const int wave_) {
    const int wid = wave_, lane = fresh_lane(), tid = wid * 64 + lane, wr = wid >> 2, wc = wid & 3, fr = lane & 15, fq = lane >> 4;
    const int K = g.K, nt = K / BK;
    unsigned voffA[2], voffB[2];
#pragma unroll
    for (int i = 0; i < 2; ++i) { int R, C; stage_rc(tid * 16 + i * 8192, R, C); const int Rb = Epi::PERM ? ((R & ~31) + perm32(R & 31)) : R;
        voffA[i] = (unsigned)(R * K + C) * 2u; voffB[i] = (unsigned)(Rb * K + C) * 2u; }
    const unsigned kstep = (unsigned)(BK * 2);
    const unsigned hstep = (unsigned)HALF * (unsigned)K * 2u;
    const unsigned tstep = 2u * hstep;
    const __amdgpu_buffer_rsrc_t rs_voffA = __builtin_amdgcn_make_buffer_rsrc((void*)g.A, 0, (int)((unsigned)g.M * (unsigned)K * 2u), 0x00020000);
    const __amdgpu_buffer_rsrc_t rs_voffB = __builtin_amdgcn_make_buffer_rsrc((void*)g.Bt, 0, (int)((unsigned)g.N * (unsigned)K * 2u), 0x00020000);
    const unsigned ldsw = (unsigned)wid * 1024u;
    const int aoff = lds_byte(wr * 64 + fr, fq * 8), boff = lds_byte(wc * 32 + fr, fq * 8);
#define PG8_SA(b, h) (((b) * 2 + (h)) * HTB)
#define PG8_SB(b, h) ((4 + (b) * 2 + (h)) * HTB)
#define PG8_STAGE(bufoff, goff, voff) do { _Pragma("unroll") for (int _i = 0; _i < 2; ++_i) \
        __builtin_amdgcn_raw_ptr_buffer_load_lds(rs_##voff, (PG8_LAS void*)(lds + (bufoff) + ldsw + _i * 8192), 16, (int)(voff)[_i], (int)(goff), 0, 0); } while (0)
#define PG8_LDA(dst, b, h) do { _Pragma("unroll") for (int m = 0; m < 4; ++m) _Pragma("unroll") for (int k = 0; k < 2; ++k) dst[m][k] = *(const PG8_LAS bf16x8*)(lds + PG8_SA(b, h) + aoff + m * 2048 + k * 1024); } while (0)
#define PG8_LDB(dst, b, h) do { _Pragma("unroll") for (int n = 0; n < 2; ++n) _Pragma("unroll") for (int k = 0; k < 2; ++k) dst[n][k] = *(const PG8_LAS bf16x8*)(lds + PG8_SB(b, h) + boff + n * 2048 + k * 1024); } while (0)
#define PG8_CAT(x, y) __builtin_shufflevector(__builtin_bit_cast(v4i_t, x), __builtin_bit_cast(v4i_t, y), 0, 1, 2, 3, 4, 5, 6, 7)
#define PG8_MMA(ai, bj, At, Bt) do { __builtin_amdgcn_s_setprio(1); _Pragma("unroll") for (int m = 0; m < 4; ++m) _Pragma("unroll") for (int n = 0; n < 2; ++n) { \
        if constexpr (Epi::FP8) acc[ai][bj][m][n] = __builtin_amdgcn_mfma_scale_f32_16x16x128_f8f6f4(PG8_CAT(Bt[n][0], Bt[n][1]), PG8_CAT(At[m][0], At[m][1]), acc[ai][bj][m][n], 0, 0, 0, 0x7f7f7f7f, 0, 0x7f7f7f7f); \
        else { _Pragma("unroll") for (int k = 0; k < 2; ++k) acc[ai][bj][m][n] = __builtin_amdgcn_mfma_f32_16x16x32_bf16(Bt[n][k], At[m][k], acc[ai][bj][m][n], 0, 0, 0); } } \
        __builtin_amdgcn_s_setprio(0); } while (0)
#define PG8_WAIT_V(n) asm volatile("s_waitcnt vmcnt(" #n ")" ::: "memory")
#define PG8_WAIT_L(n) asm volatile("s_waitcnt lgkmcnt(" #n ")" ::: "memory")
#define PG8_BAR __builtin_amdgcn_s_barrier()
#define PG8_SCHED __builtin_amdgcn_sched_barrier(0)
    Unit cur, nxt; int ui = 0;
    if (!S.next(0, cur)) return;
    f32x4 acc[2][2][4][2];
    if constexpr (Epi::INIT_ACC) E.init(acc, cur, wr, wc, fr, fq);
    else {
#pragma unroll
    for (int a = 0; a < 2; ++a)
#pragma unroll
        for (int b = 0; b < 2; ++b)
#pragma unroll
            for (int m = 0; m < 4; ++m)
#pragma unroll
                for (int n = 0; n < 2; ++n) acc[a][b][m][n] = (f32x4){0.f, 0.f, 0.f, 0.f};
    }
    bf16x8 At[4][2], B0[2][2], B1[2][2];
    unsigned cA = (unsigned)cur.pm * tstep, cB = (unsigned)cur.pn * tstep;
    S.a_ready(cur);
    if constexpr (SP2) {
        PG8_STAGE(PG8_SB(0, 0), cB, voffB); PG8_STAGE(PG8_SB(0, 1), cB + hstep, voffB); PG8_STAGE(PG8_SA(0, 0), cA, voffA); PG8_STAGE(PG8_SA(0, 1), cA + hstep, voffA);
        if (wr == 1) PG8_BAR;
        PG8_WAIT_V(2); PG8_BAR;
        PG8_STAGE(PG8_SB(1, 0), cB + kstep, voffB); PG8_STAGE(PG8_SA(1, 0), cA + kstep, voffA); PG8_STAGE(PG8_SB(1, 1), cB + hstep + kstep, voffB);
        PG8_WAIT_V(6); PG8_BAR;
    } else {
        PG8_STAGE(PG8_SB(0, 0), cB, voffB); PG8_STAGE(PG8_SA(0, 0), cA, voffA); PG8_STAGE(PG8_SB(0, 1), cB + hstep, voffB); PG8_STAGE(PG8_SA(0, 1), cA + hstep, voffA);
        if (wr == 1) PG8_BAR;
        PG8_WAIT_V(4); PG8_BAR;
        PG8_STAGE(PG8_SB(1, 0), cB + kstep, voffB); PG8_STAGE(PG8_SA(1, 0), cA + kstep, voffA); PG8_STAGE(PG8_SB(1, 1), cB + hstep + kstep, voffB);
        PG8_WAIT_V(6); PG8_BAR;
    }
    for (;;) {
        const bool has_next = S.next(ui + 1, nxt);
        const unsigned nA = has_next ? (unsigned)nxt.pm * tstep : cA, nB = has_next ? (unsigned)nxt.pn * tstep : cB;
        for (int t = 0; t < nt; t += 2) {
            if constexpr (Epi::HOOK_T >= 0) { if (t == Epi::HOOK_T) E.mid(acc, cur, wr, wc, fr, fq); }
            const bool last = (t == nt - 2);
            const unsigned a1 = cA + (unsigned)(t + 1) * kstep;
            const unsigned a2 = last ? nA : cA + (unsigned)(t + 2) * kstep, b2 = last ? nB : cB + (unsigned)(t + 2) * kstep;
            const unsigned a3 = a2 + kstep, b3 = b2 + kstep;
            if (last && has_next) S.a_ready(nxt);
            if constexpr (SP2) {
            PG8_LDB(B0, 0, 0); PG8_LDB(B1, 0, 1); PG8_SCHED; PG8_LDA(At, 0, 0); PG8_STAGE(PG8_SA(1, 1), a1 + hstep, voffA);
            PG8_WAIT_V(8); PG8_WAIT_L(0); PG8_BAR; PG8_MMA(0, 0, At, B0); PG8_MMA(0, 1, At, B1); PG8_BAR; PG8_SCHED;
            PG8_LDA(At, 0, 1); PG8_STAGE(PG8_SB(0, 0), b2, voffB); PG8_STAGE(PG8_SB(0, 1), b2 + hstep, voffB); PG8_STAGE(PG8_SA(0, 0), a2, voffA);
            PG8_WAIT_V(8); PG8_WAIT_L(0); PG8_BAR; PG8_MMA(1, 0, At, B0); PG8_MMA(1, 1, At, B1); PG8_BAR; PG8_SCHED;
            PG8_LDB(B0, 1, 0); PG8_LDB(B1, 1, 1); PG8_SCHED; PG8_LDA(At, 1, 0); PG8_STAGE(PG8_SA(0, 1), a2 + hstep, voffA);
            PG8_WAIT_V(8); PG8_WAIT_L(0); PG8_BAR; PG8_MMA(0, 0, At, B0); PG8_MMA(0, 1, At, B1); PG8_BAR; PG8_SCHED;
            PG8_LDA(At, 1, 1); PG8_STAGE(PG8_SB(1, 0), b3, voffB); PG8_STAGE(PG8_SB(1, 1), b3 + hstep, voffB); PG8_STAGE(PG8_SA(1, 0), a3, voffA);
            PG8_WAIT_V(8); PG8_WAIT_L(0); PG8_BAR; PG8_MMA(1, 0, At, B0); PG8_MMA(1, 1, At, B1); PG8_BAR; PG8_SCHED;
            } else {
            PG8_LDB(B0, 0, 0); PG8_SCHED; PG8_LDA(At, 0, 0); PG8_STAGE(PG8_SA(1, 1), a1 + hstep, voffA);
            PG8_WAIT_L(8); PG8_BAR; PG8_WAIT_L(0); PG8_MMA(0, 0, At, B0); PG8_BAR; PG8_SCHED;
            PG8_LDB(B1, 0, 1); PG8_STAGE(PG8_SB(0, 0), b2, voffB);
            PG8_BAR; PG8_WAIT_L(0); PG8_MMA(0, 1, At, B1); PG8_BAR;
            PG8_LDA(At, 0, 1); PG8_STAGE(PG8_SA(0, 0), a2, voffA);
            PG8_BAR; PG8_WAIT_L(0); PG8_MMA(1, 0, At, B0); PG8_BAR; PG8_SCHED;
            PG8_STAGE(PG8_SB(0, 1), b2 + hstep, voffB);
            PG8_WAIT_V(6); PG8_BAR; PG8_MMA(1, 1, At, B1); PG8_BAR;
            PG8_LDB(B0, 1, 0); PG8_SCHED; PG8_LDA(At, 1, 0); PG8_STAGE(PG8_SA(0, 1), a2 + hstep, voffA);
            PG8_WAIT_L(8); PG8_BAR; PG8_WAIT_L(0); PG8_MMA(0, 0, At, B0); PG8_BAR; PG8_SCHED;
            PG8_LDB(B1, 1, 1); PG8_STAGE(PG8_SB(1, 0), b3, voffB);
            PG8_BAR; PG8_WAIT_L(0); PG8_MMA(0, 1, At, B1); PG8_BAR;
            PG8_LDA(At, 1, 1); PG8_STAGE(PG8_SA(1, 0), a3, voffA);
            PG8_BAR; PG8_WAIT_L(0); PG8_MMA(1, 0, At, B0); PG8_BAR; PG8_SCHED;
            PG8_STAGE(PG8_SB(1, 1), b3 + hstep, voffB);
            PG8_WAIT_V(6); PG8_BAR; PG8_MMA(1, 1, At, B1); PG8_BAR;
            }
        }
        if constexpr (ALIGN_EPI) { if (wr == 0) PG8_BAR; }
        if constexpr (!Epi::AFTER_DRAIN) { E(acc, cur, wr, wc, fr, fq); S.done(cur); }
        if (!has_next) break;
#pragma unroll
        for (int a = 0; a < 2; ++a)
#pragma unroll
            for (int b = 0; b < 2; ++b)
#pragma unroll
                for (int m = 0; m < 4; ++m)
#pragma unroll
                    for (int n = 0; n < 2; ++n) acc[a][b][m][n] = (f32x4){0.f, 0.f, 0.f, 0.f};
        cur = nxt; cA = nA; cB = nB; ++ui;
        if constexpr (ALIGN_EPI) { if (wr == 1) PG8_BAR; }
    }
    PG8_WAIT_V(0);
    if constexpr (!ALIGN_EPI) { if (wr == 0) PG8_BAR; }
    PG8_BAR;
    if constexpr (Epi::AFTER_DRAIN) { E.fused(acc, cur, wr, wc, fr, fq, lds, wid, lane); S.done(cur); }
#undef PG8_SA
#undef PG8_SB
#undef PG8_STAGE
#undef PG8_LDA
#undef PG8_LDB
#undef PG8_MMA
#undef PG8_CAT
#undef PG8_WAIT_V
#undef PG8_WAIT_L
#undef PG8_BAR
#undef PG8_SCHED
}
}

namespace att {
using bf16 = unsigned short;
constexpr int   D = 128, NW = 8, QBLK = 32, KVBLK = 64;
constexpr float SCALE = 0.088388347648318440f;
constexpr float THR = 8.f;
constexpr int SDEPTH = 2;
constexpr int LDQ = 7680, LDK = 7680;
constexpr int LDY = 1536;
constexpr size_t SHM_V = KVBLK * D * 2, SHM_K = KVBLK * D * 2, SHM_ATTN = 2 * SHM_V + 2 * SHM_K + NW * 64 * 4;
__device__ __forceinline__ float bf2f_(bf16 h) { return __uint_as_float(((unsigned)h) << 16); }
__device__ __forceinline__ bf16 f2bf_(float f) { unsigned u = __float_as_uint(f); return (bf16)((u + 0x7fffu + ((u >> 16) & 1u)) >> 16); }
using bf16x8 = __attribute__((ext_vector_type(8))) short;
using s16x4  = __attribute__((ext_vector_type(4))) short;
using f32x16 = __attribute__((ext_vector_type(16))) float;
using f32x8  = __attribute__((ext_vector_type(8))) float;
using u32x4  = __attribute__((ext_vector_type(4))) unsigned;
using f32x4_ = __attribute__((ext_vector_type(4))) float;
#define KSWZ(row, colB) ((row) * 256 + ((colB) ^ (((row) & 7) << 4)))
#define SBAR() __builtin_amdgcn_sched_barrier(0)
__device__ __forceinline__ int crow(int r, int hi) { return (r & 3) + 8 * (r >> 2) + 4 * hi; }
__device__ __forceinline__ unsigned cvtpk(float lo, float hi) {
  typedef float f32x2_c __attribute__((ext_vector_type(2))); typedef __bf16 bf16x2_c __attribute__((ext_vector_type(2)));
  const f32x2_c v = {lo, hi}; return __builtin_bit_cast(unsigned, __builtin_convertvector(v, bf16x2_c));
}
template <typename TIn> struct Stage;
template <> struct Stage<bf16>  { using T = bf16x8;
  __device__ static __forceinline__ T ld8(const bf16* p) { return *reinterpret_cast<const bf16x8*>(p); }
  __device__ static __forceinline__ bf16x8 tobf(T x) { return x; } };
template <> struct Stage<float> { using T = f32x8;
  __device__ static __forceinline__ T ld8(const float* p) { return *reinterpret_cast<const f32x8*>(p); }
  __device__ static __forceinline__ bf16x8 tobf(T x) {
    u32x4 w = {cvtpk(x[0], x[1]), cvtpk(x[2], x[3]), cvtpk(x[4], x[5]), cvtpk(x[6], x[7])}; return *reinterpret_cast<bf16x8*>(&w); } };

__device__ __forceinline__ void partialSM(f32x16& p0, f32x16& p1, float& m_reg, float& mn, float& alpha) {
  constexpr float C = SCALE * 1.4426950408889634f;
  float pmax = p0[0]; for (int r = 1; r < 16; ++r) pmax = fmaxf(pmax, p0[r]); for (int r = 0; r < 16; ++r) pmax = fmaxf(pmax, p1[r]);
  { auto rr = __builtin_amdgcn_permlane32_swap(__float_as_uint(pmax), __float_as_uint(pmax), false, false);
    pmax = fmaxf(__uint_as_float(rr[0]), __uint_as_float(rr[1])); }
  if (__builtin_expect(__all(pmax - m_reg <= THR / SCALE), 1)) { mn = m_reg; alpha = 1.f; }
  else { mn = fmaxf(m_reg, pmax); alpha = __builtin_amdgcn_exp2f((m_reg - mn) * C); m_reg = mn; }
  float mnC = -mn * C;
  for (int r = 0; r < 16; ++r) p0[r] = fmaf(p0[r], C, mnC); for (int r = 0; r < 16; ++r) p1[r] = fmaf(p1[r], C, mnC);
  for (int r = 0; r < 16; ++r) p0[r] = __builtin_amdgcn_exp2f(p0[r]);
}
__device__ __forceinline__ void finishSM(f32x16& p0, f32x16& p1, float alpha, float& l_reg, bf16x8& pa0, bf16x8& pa1, bf16x8& pa2, bf16x8& pa3) {
  for (int r = 0; r < 16; ++r) p1[r] = __builtin_amdgcn_exp2f(p1[r]);
  float ps = 0; for (int r = 0; r < 16; ++r) ps += p0[r]; for (int r = 0; r < 16; ++r) ps += p1[r];
  { auto rr = __builtin_amdgcn_permlane32_swap(__float_as_uint(ps), __float_as_uint(ps), false, false);
    ps = __uint_as_float(rr[0]) + __uint_as_float(rr[1]); }
  l_reg = l_reg * alpha + ps;
#define PK4(P, BASE, OUT) do { unsigned a0 = cvtpk(P[BASE + 0], P[BASE + 1]), a1 = cvtpk(P[BASE + 2], P[BASE + 3]);   \
    unsigned b0 = cvtpk(P[BASE + 4], P[BASE + 5]), b1 = cvtpk(P[BASE + 6], P[BASE + 7]);                              \
    auto r0 = __builtin_amdgcn_permlane32_swap(a0, b0, false, false); auto r1 = __builtin_amdgcn_permlane32_swap(a1, b1, false, false); \
    u32x4 w = {r0[0], r1[0], r0[1], r1[1]}; OUT = *reinterpret_cast<bf16x8*>(&w); } while (0)
  PK4(p0, 0, pa0); PK4(p0, 8, pa1); PK4(p1, 0, pa2); PK4(p1, 8, pa3);
#undef PK4
}
__device__ __forceinline__ void qkt(f32x16& p0, f32x16& p1, const bf16* Ks, const bf16x8* qr, int r32, int hi) {
  p0 = f32x16{}; p1 = f32x16{};
  for (int d0 = 0; d0 < 8; ++d0) { int cb = (d0 * 16 + hi * 8) * 2;
    bf16x8 b0 = *reinterpret_cast<const bf16x8*>((const char*)Ks + KSWZ(r32, cb));
    bf16x8 b1 = *reinterpret_cast<const bf16x8*>((const char*)Ks + KSWZ(32 + r32, cb));
    p0 = __builtin_amdgcn_mfma_f32_32x32x16_bf16(b0, qr[d0], p0, 0, 0, 0);
    p1 = __builtin_amdgcn_mfma_f32_32x32x16_bf16(b1, qr[d0], p1, 0, 0, 0); }
}
__device__ __forceinline__ int v_st(int k, int c) { const int kk = (k & ~0xC) | ((k & 4) << 1) | ((k & 8) >> 1); return ((kk >> 3) * 4 + (c >> 5)) * 512 + ((kk & 7) * 32 + (c & 31)) * 2; }
__device__ __forceinline__ int v_rd_base(int lane) { return ((lane & 3) << 3) | (((lane >> 2) & 3) << 6) | (((lane >> 4) & 1) << 5) | (((lane >> 5) & 1) << 8); }
constexpr int v_rd_off(int d0, int ks, int half) { return d0 * 512 + ks * 4096 + half * 2048; }
template <int OFF> __device__ __forceinline__ s16x4 tr_read(int vb) {
  s16x4 r; asm volatile("ds_read_b64_tr_b16 %0, %1 offset:%2" : "=&v"(r) : "v"(vb), "i"(OFF) : "memory"); return r;
}
template <int D0> __device__ __forceinline__ void pv_one(f32x16& od, int vb, bf16x8 pa0, bf16x8 pa1, bf16x8 pa2, bf16x8 pa3) {
  const s16x4 l0 = tr_read<v_rd_off(D0, 0, 0)>(vb), h0 = tr_read<v_rd_off(D0, 0, 1)>(vb), l1 = tr_read<v_rd_off(D0, 1, 0)>(vb), h1 = tr_read<v_rd_off(D0, 1, 1)>(vb);
  const s16x4 l2 = tr_read<v_rd_off(D0, 2, 0)>(vb), h2 = tr_read<v_rd_off(D0, 2, 1)>(vb), l3 = tr_read<v_rd_off(D0, 3, 0)>(vb), h3 = tr_read<v_rd_off(D0, 3, 1)>(vb);
  asm volatile("s_waitcnt lgkmcnt(0)" ::: "memory"); SBAR();
#define PK(L, H) (bf16x8){L[0], L[1], L[2], L[3], H[0], H[1], H[2], H[3]}
  od = __builtin_amdgcn_mfma_f32_32x32x16_bf16(pa0, PK(l0, h0), od, 0, 0, 0);
  od = __builtin_amdgcn_mfma_f32_32x32x16_bf16(pa1, PK(l1, h1), od, 0, 0, 0);
  od = __builtin_amdgcn_mfma_f32_32x32x16_bf16(pa2, PK(l2, h2), od, 0, 0, 0);
  od = __builtin_amdgcn_mfma_f32_32x32x16_bf16(pa3, PK(l3, h3), od, 0, 0, 0);
#undef PK
}
__device__ __forceinline__ void pv_d0(f32x16* o, int vb, bf16x8 pa0, bf16x8 pa1, bf16x8 pa2, bf16x8 pa3) {
  pv_one<0>(o[0], vb, pa0, pa1, pa2, pa3); pv_one<1>(o[1], vb, pa0, pa1, pa2, pa3); pv_one<2>(o[2], vb, pa0, pa1, pa2, pa3); pv_one<3>(o[3], vb, pa0, pa1, pa2, pa3);
}

__device__ __forceinline__ void attn_dense_body(const bf16* __restrict__ Qb, const bf16* __restrict__ Kh, const bf16* __restrict__ Vh,
                                                const bf16* __restrict__ Gb, bf16* __restrict__ Yb, int seq, char* lds, const int wave_) {
  using TQ = bf16; using St = Stage<bf16>; using SQ = Stage<TQ>;
  const int wid = wave_, lane = fresh_lane(), tid = wid * 64 + lane, r32 = lane & 31, hi = lane >> 5;
  bf16* V_lds = (bf16*)lds; bf16* K_lds = (bf16*)(lds + 2 * SHM_V);
  float* ws = (float*)(lds + 2 * SHM_V + 2 * SHM_K) + wid * 64; float* li_l = ws; float* al_l = ws + 32;
  float m_reg = -1e30f, l_reg = 0; f32x16 o[4] = {}; bf16x8 qr[8];
  const TQ* Qw = Qb + (long)(wid * QBLK + r32) * LDQ + hi * 8;
#pragma unroll
  for (int d0 = 0; d0 < 8; ++d0) qr[d0] = SQ::tobf(SQ::ld8(Qw + d0 * 16));
  const int sr = tid >> 4, sc = (tid & 15) * 8, vst0 = v_st(sr, sc), vst1 = v_st(32 + sr, sc);
  const unsigned toff = (unsigned)(sr * LDK + sc);
  const int vb0 = (int)(uintptr_t)V_lds + v_rd_base(lane);
  struct { typename St::T vs0, vs1, ks0, ks1; } sr_[SDEPTH];
#define SLOAD(i, k0) do { const bf16* vb_ = Vh + (long)(k0) * LDK; const bf16* kb_ = Kh + (long)(k0) * LDK; \
    sr_[i].vs0 = St::ld8(vb_ + toff); sr_[i].vs1 = St::ld8(vb_ + 32 * LDK + toff); \
    sr_[i].ks0 = St::ld8(kb_ + toff); sr_[i].ks1 = St::ld8(kb_ + 32 * LDK + toff); } while (0)
#define SWRITE(b, i) do { *(bf16x8*)((char*)V_lds + (b) * SHM_V + vst0) = St::tobf(sr_[i].vs0);          \
    *(bf16x8*)((char*)V_lds + (b) * SHM_V + vst1) = St::tobf(sr_[i].vs1); int kc = sc * 2;               \
    *(bf16x8*)((char*)K_lds + (b) * SHM_K + KSWZ(sr, kc)) = St::tobf(sr_[i].ks0);                       \
    *(bf16x8*)((char*)K_lds + (b) * SHM_K + KSWZ(32 + sr, kc)) = St::tobf(sr_[i].ks1); } while (0)
#define SWAIT() do { if constexpr (SDEPTH == 2) asm volatile("s_waitcnt vmcnt(4)" ::: "memory"); else asm volatile("s_waitcnt vmcnt(0)" ::: "memory"); } while (0)
#define RESC(a) do { if (__any((a) < 1.f)) { if (hi == 0) al_l[r32] = (a); asm volatile("s_waitcnt lgkmcnt(0)" ::: "memory"); \
    for (int d = 0; d < 4; ++d) for (int r = 0; r < 16; ++r) o[d][r] *= al_l[crow(r, hi)]; } } while (0)
  f32x16 pA0, pA1, pB0, pB1; float mnA, mnB, alA, alB; bf16x8 pa0, pa1, pa2, pa3; const int NT = seq / KVBLK;
  constexpr int SE = 0, SO = SDEPTH - 1;
  SLOAD(SE, 0); asm volatile("s_waitcnt vmcnt(0)" ::: "memory"); SWRITE(0, SE); __syncthreads();
  qkt(pA0, pA1, K_lds, qr, r32, hi); partialSM(pA0, pA1, m_reg, mnA, alA);
  SLOAD(SO, KVBLK); if constexpr (SDEPTH == 2) { if (2 < NT) SLOAD(SE, 2 * KVBLK); }
  SWAIT(); SWRITE(1, SO); __syncthreads();
  for (int j = 1; j + 1 < NT; j += 2) {
    SBAR(); qkt(pB0, pB1, (bf16*)((char*)K_lds + SHM_K), qr, r32, hi);
    finishSM(pA0, pA1, alA, l_reg, pa0, pa1, pa2, pa3); SBAR();
    SLOAD(SO, (j + SDEPTH) * KVBLK); SBAR();
    pv_d0(o, vb0, pa0, pa1, pa2, pa3); partialSM(pB0, pB1, m_reg, mnB, alB);
    __syncthreads(); SWAIT(); SWRITE(0, SE);
    RESC(alB); __syncthreads();
    SBAR(); qkt(pA0, pA1, K_lds, qr, r32, hi);
    finishSM(pB0, pB1, alB, l_reg, pa0, pa1, pa2, pa3); SBAR();
    if (SDEPTH == 1 || j + 3 < NT) SLOAD(SE, (j + 1 + SDEPTH) * KVBLK); SBAR();
    pv_d0(o, vb0 + (int)SHM_V, pa0, pa1, pa2, pa3); partialSM(pA0, pA1, m_reg, mnA, alA);
    __syncthreads(); SWAIT(); SWRITE(1, SO);
    RESC(alA); __syncthreads();
  }
  SBAR(); qkt(pB0, pB1, (bf16*)((char*)K_lds + SHM_K), qr, r32, hi);
  finishSM(pA0, pA1, alA, l_reg, pa0, pa1, pa2, pa3); SBAR();
  pv_d0(o, vb0, pa0, pa1, pa2, pa3); partialSM(pB0, pB1, m_reg, mnB, alB);
  __syncthreads(); RESC(alB);
  finishSM(pB0, pB1, alB, l_reg, pa0, pa1, pa2, pa3); SBAR();
  pv_d0(o, vb0 + (int)SHM_V, pa0, pa1, pa2, pa3);
  if (hi == 0) li_l[r32] = l_reg; asm volatile("s_waitcnt lgkmcnt(0)" ::: "memory");
  float rli[16];
#pragma unroll
  for (int r = 0; r < 16; ++r) rli[r] = __builtin_amdgcn_rcpf(li_l[crow(r, hi)]);
  __syncthreads();
  { float* stg = (float*)(lds + wid * 16384);
#pragma unroll
    for (int r = 0; r < 16; ++r) { const int orow = crow(r, hi);
#pragma unroll
      for (int d0 = 0; d0 < 4; ++d0) stg[orow * 128 + d0 * 32 + r32] = o[d0][r] * rli[r]; }
    asm volatile("s_waitcnt lgkmcnt(0)" ::: "memory");
    const int ch = lane & 15, rb = lane >> 4;
    const bf16* Gw = Gb + (long)(wid * QBLK + rb) * LDQ + ch * 8; const int yoff = ((wid * QBLK + rb) * LDY + ch * 8) * 2;
    bf16* Yq = Yb; asm volatile("" : "+s"(Yq));
    const __amdgpu_buffer_rsrc_t rsY = __builtin_amdgcn_make_buffer_rsrc((void*)Yq, 0, 0x40000000, 0x00020000);
    u32x4 gq[8];
#pragma unroll
    for (int i = 0; i < 8; ++i) gq[i] = *(const u32x4*)(Gw + (long)(4 * i) * LDQ);
#pragma unroll
    for (int i = 0; i < 8; ++i) { const float* sp = stg + (4 * i + rb) * 128 + ch * 8;
      const f32x4_ a = *(const f32x4_*)sp, b = *(const f32x4_*)(sp + 4); u32x4 w;
      w[0] = cvtpk(a[0] * __uint_as_float(gq[i][0] << 16), a[1] * __uint_as_float(gq[i][0] & 0xffff0000u));
      w[1] = cvtpk(a[2] * __uint_as_float(gq[i][1] << 16), a[3] * __uint_as_float(gq[i][1] & 0xffff0000u));
      w[2] = cvtpk(b[0] * __uint_as_float(gq[i][2] << 16), b[1] * __uint_as_float(gq[i][2] & 0xffff0000u));
      w[3] = cvtpk(b[2] * __uint_as_float(gq[i][3] << 16), b[3] * __uint_as_float(gq[i][3] & 0xffff0000u));
      __builtin_amdgcn_raw_buffer_store_b128(w, rsY, yoff + (4 * i) * LDY * 2, 0, 16); } }
  __syncthreads();
#undef SLOAD
#undef SWRITE
#undef SWAIT
#undef RESC
}

__device__ __forceinline__ void attn_band_unit(const bf16* __restrict__ P, bf16* __restrict__ OG, float* __restrict__ LSE, int g, int b, int h, int blk, int cqb, int ckb, int cvb, int seqlen, int ntok, char* lds, const int wave_) {
  using St = Stage<bf16>;
  const int wid = wave_, lane = fresh_lane(), tid = wid * 64 + lane, r32 = lane & 31, hi = lane >> 5;
  bf16* V_lds = (bf16*)lds; bf16* K_lds = (bf16*)(lds + 2 * SHM_V);
  float* ws = (float*)(lds + 2 * SHM_V + 2 * SHM_K) + wid * 64; float* li_l = ws; float* al_l = ws + 32;
  const int dil = (g == 0) ? 1 : (g == 1 ? 4 : 16), head = g * 4 + h;
  int rq, lq0, ntile, t_lo, res0;
  if (g < 2) { const int kb = (g == 0) ? blk : (blk & 1), nt_all = seqlen / dil / 64; res0 = (g == 0) ? 0 : (blk >> 1);
    rq = res0; lq0 = 256 * kb + 32 * wid; t_lo = (4 * kb - 1 < 0) ? 0 : 4 * kb - 1; const int t_hi = (4 * kb + 5 > nt_all) ? nt_all : 4 * kb + 5; ntile = t_hi - t_lo; }
  else { res0 = 2 * blk; rq = res0 + (wid >> 2); lq0 = 32 * (wid & 3); t_lo = 0; ntile = 4; }
  const long tok0 = (long)b * seqlen;
  const bf16* Pq = P + cqb + head * D; const bf16* Pk = P + ckb + head * D; const bf16* Pv = P + cvb + head * D;
  float m_reg = -1e30f, l_reg = 0; f32x16 o[4] = {}; bf16x8 qr[8];
  { const bf16* Qw = Pq + (tok0 + (long)(lq0 + r32) * dil + rq) * LDQ + hi * 8;
#pragma unroll
    for (int d0 = 0; d0 < 8; ++d0) qr[d0] = St::ld8(Qw + d0 * 16); }
  const int sr = tid >> 4, sc = (tid & 15) * 8, vst0 = v_st(sr, sc), vst1 = v_st(32 + sr, sc);
  const int vb0 = (int)(uintptr_t)V_lds + v_rd_base(lane);
  typename St::T vs0, vs1, ks0, ks1, vt0, vt1, kt0, kt1;
#define TILE_RK(tt) ((g < 2) ? res0 : res0 + ((tt) >> 1))
#define TILE_LK0(tt) ((g < 2) ? 64 * (t_lo + (tt)) : 64 * ((tt) & 1))
#define BLOAD(tt, V0, V1, K0, K1) do { const int rk_ = TILE_RK(tt), lk_ = TILE_LK0(tt); const long ta = (tok0 + (long)(lk_ + sr) * dil + rk_) * LDK + sc, tb = (tok0 + (long)(lk_ + 32 + sr) * dil + rk_) * LDK + sc; \
    V0 = St::ld8(Pv + ta); V1 = St::ld8(Pv + tb); K0 = St::ld8(Pk + ta); K1 = St::ld8(Pk + tb); } while (0)
#define BWRITE(V0, V1, K0, K1) do { *(bf16x8*)((char*)V_lds + vst0) = V0; *(bf16x8*)((char*)V_lds + vst1) = V1; const int kc = sc * 2; \
    *(bf16x8*)((char*)K_lds + KSWZ(sr, kc)) = K0; *(bf16x8*)((char*)K_lds + KSWZ(32 + sr, kc)) = K1; } while (0)
#define BCOMPUTE(tt) do { const int rk = TILE_RK(tt), lk0 = TILE_LK0(tt); \
    const bool need = (rk == rq) && (lk0 + 63 >= lq0 - 64) && (lk0 <= lq0 + 95); \
    if (need) { \
      f32x16 p0, p1; float mn, alpha; bf16x8 pa0, pa1, pa2, pa3; \
      qkt(p0, p1, K_lds, qr, r32, hi); \
      const int dd = lk0 - lq0 - r32 + 4 * hi;                      \
      _Pragma("unroll") for (int r = 0; r < 16; ++r) { const int d0_ = dd + (r & 3) + 8 * (r >> 2), d1_ = d0_ + 32; \
        if (d0_ < -64 || d0_ > 64) p0[r] = -INFINITY; if (d1_ < -64 || d1_ > 64) p1[r] = -INFINITY; } \
      partialSM(p0, p1, m_reg, mn, alpha); \
      if (__any(alpha < 1.f)) { if (hi == 0) al_l[r32] = alpha; asm volatile("s_waitcnt lgkmcnt(0)" ::: "memory"); \
        _Pragma("unroll") for (int d = 0; d < 4; ++d) _Pragma("unroll") for (int r = 0; r < 16; ++r) o[d][r] *= al_l[crow(r, hi)]; } \
      finishSM(p0, p1, alpha, l_reg, pa0, pa1, pa2, pa3); SBAR(); \
      pv_d0(o, vb0, pa0, pa1, pa2, pa3); \
    } } while (0)
  BLOAD(0, vs0, vs1, ks0, ks1); if (ntile > 1) BLOAD(1, vt0, vt1, kt0, kt1);
  for (int tt = 0; tt < ntile; tt += 2) {
    __syncthreads();
    BWRITE(vs0, vs1, ks0, ks1);
    __syncthreads();
    if (tt + 2 < ntile) BLOAD(tt + 2, vs0, vs1, ks0, ks1);
    BCOMPUTE(tt);
    if (tt + 1 < ntile) {
      __syncthreads();
      BWRITE(vt0, vt1, kt0, kt1);
      __syncthreads();
      if (tt + 3 < ntile) BLOAD(tt + 3, vt0, vt1, kt0, kt1);
      BCOMPUTE(tt + 1);
    }
  }
#undef BWRITE
#undef BCOMPUTE
#undef BLOAD
#undef TILE_RK
#undef TILE_LK0
  if (hi == 0) li_l[r32] = l_reg; asm volatile("s_waitcnt lgkmcnt(0)" ::: "memory");
  float rli[16];
#pragma unroll
  for (int r = 0; r < 16; ++r) rli[r] = __builtin_amdgcn_rcpf(li_l[crow(r, hi)]);
  __syncthreads();
  { float* stg = (float*)(lds + wid * 16384);
#pragma unroll
    for (int r = 0; r < 16; ++r) { const int orow = crow(r, hi);
#pragma unroll
      for (int d0 = 0; d0 < 4; ++d0) stg[orow * 128 + d0 * 32 + r32] = o[d0][r] * rli[r]; }
    asm volatile("s_waitcnt lgkmcnt(0)" ::: "memory");
    const int ch = lane & 15, rb = lane >> 4;
    bf16* Og = OG + (long)g * ntok * 512 + h * D + ch * 8;
#pragma unroll
    for (int i = 0; i < 8; ++i) { const int row = 4 * i + rb; const float* sp = stg + row * 128 + ch * 8;
      const f32x4_ a = *(const f32x4_*)sp, b = *(const f32x4_*)(sp + 4); u32x4 w;
      w[0] = cvtpk(a[0], a[1]); w[1] = cvtpk(a[2], a[3]); w[2] = cvtpk(b[0], b[1]); w[3] = cvtpk(b[2], b[3]);
      *(u32x4*)(Og + (tok0 + (long)(lq0 + row) * dil + rq) * 512) = w; } }
  if (hi == 0) LSE[((long)g * ntok + tok0 + (long)(lq0 + r32) * dil + rq) * 4 + h] = m_reg * SCALE + __logf(l_reg);
  __syncthreads();
}
}

typedef unsigned short bf16_t;
constexpr int BATCH = 4, SEQ = 2048, DM = 2048, NTOK = BATCH * SEQ, NC = 11776;
constexpr int C_QA = 0, C_KA = 1024, C_VA = 1280, C_GA = 1536, C_QB = 2560, C_KB = 4096, C_VB = 5632, C_GB = 7168, C_ZA = 7680, C_ZB = 9728;
constexpr float EPS = 1e-6f;
constexpr float H8_SCALE = 4.0f, W8_SCALE = 64.0f;
constexpr size_t MiB = 1u << 20;
constexpr int PITCH = 7680;
constexpr size_t WS_CTL = 0, WS_TAB = 1 * MiB, WS_XB = 1 * MiB + 512 * 1024, WS_WTIN = 2 * MiB, WS_WTAB = 48 * MiB, WS_WTO = 54 * MiB, WS_HB = 64 * MiB, WS_P = 96 * MiB, WS_Y = 216 * MiB, WS_OG = 240 * MiB, WS_LSE = 264 * MiB,
                 WS_SA = 266 * MiB, WS_SB = 298 * MiB, WS_H8 = 330 * MiB, WS_WTZ8 = 346 * MiB, WS_END = 361 * MiB;

#define LAS __attribute__((address_space(3)))
typedef float f32x4 __attribute__((ext_vector_type(4)));
typedef unsigned v4u __attribute__((ext_vector_type(4)));
constexpr int NWAVES = 8;
constexpr int LDS_BYTES = 147456;

__device__ __forceinline__ float bf2f(bf16_t h) { return __uint_as_float(((unsigned)h) << 16); }
__device__ __forceinline__ unsigned f2bf_u(float f) { unsigned u = __float_as_uint(f); return (u + 0x7fffu + ((u >> 16) & 1u)) >> 16; }
__device__ __forceinline__ bf16_t f2bf(float f) { return (bf16_t)f2bf_u(f); }
__device__ __forceinline__ unsigned pk2(float lo, float hi) { return f2bf_u(lo) | (f2bf_u(hi) << 16); }
__device__ __forceinline__ float wave_sum(float v) {
#pragma unroll
    for (int o = 1; o < 64; o <<= 1) v += __shfl_xor(v, o);
    return v;
}

__device__ __forceinline__ int colmap(int kind, int p) {
    const int bj = p >> 7, wc = (p >> 5) & 3, n = (p >> 4) & 1, fq = (p >> 2) & 3, j = p & 3;
    const int gen = 128 * bj + 32 * wc + 8 * fq + 4 * n + j;
    if (kind == 0) return p;
    if (kind == 1) return gen;
    if (kind == 2) return 128 * bj + 64 * (wc >> 1) + 32 * n + 16 * (wc & 1) + 4 * fq + j;
    return wc == 0 ? p : gen;
}
__device__ __forceinline__ int kind_in(int pn) { return pn < 5 ? 2 : ((pn >= 10 && pn < 22) ? 3 : 1); }

struct TrSrc { const float* W; int N; bf16_t* WT; int ldt, koff, kindsel; unsigned char* wt8; int n8; };
__device__ __forceinline__ void tr_load(const TrSrc& t, int item, int lane, f32x4 (&v)[8]) {
    const int nblk = t.N / 32, kb = item / nblk, nb = item % nblk, k0 = 64 * kb, n0 = 32 * nb;
    const int np = n0 + 4 * (lane & 7), pn = np >> 8;
    const int kind = t.kindsel < 0 ? kind_in(pn) : t.kindsel;
    const float* src = t.W + (size_t)(k0 + (lane >> 3)) * t.N + (pn << 8) + colmap(kind, np & 255);
#pragma unroll
    for (int i = 0; i < 8; ++i) v[i] = __builtin_nontemporal_load((const f32x4*)(src + (size_t)(8 * i) * t.N));
}
__device__ __forceinline__ void tr_store(const TrSrc& t, int item, int lane, const f32x4 (&v)[8], LAS float* scr) {
    const int nblk = t.N / 32, kb = item / nblk, nb = item % nblk, k0 = 64 * kb, n0 = 32 * nb;
    { LAS float* d = scr + (lane >> 3) * 33 + 4 * (lane & 7);
#pragma unroll
      for (int i = 0; i < 8; ++i) { d[i * 264 + 0] = v[i][0]; d[i * 264 + 1] = v[i][1]; d[i * 264 + 2] = v[i][2]; d[i * 264 + 3] = v[i][3]; } }
    asm volatile("s_waitcnt lgkmcnt(0)" ::: "memory");
    const int c = lane & 7;
    const int pn_ = n0 >> 8; const bool is8 = t.wt8 != nullptr && (n0 >= t.n8 || pn_ < 14);
    const int n8row = n0 >= t.n8 ? n0 - t.n8 + 14 * 256 : n0;
    if (is8) {
#pragma unroll
        for (int j = 0; j < 4; ++j) { const int n = (lane >> 3) + 8 * j; const LAS float* sp = scr + (8 * c) * 33 + n;
            int lo = 0, hi = 0;
            lo = __builtin_amdgcn_cvt_pk_fp8_f32(sp[0 * 33] * W8_SCALE, sp[1 * 33] * W8_SCALE, lo, false); lo = __builtin_amdgcn_cvt_pk_fp8_f32(sp[2 * 33] * W8_SCALE, sp[3 * 33] * W8_SCALE, lo, true);
            hi = __builtin_amdgcn_cvt_pk_fp8_f32(sp[4 * 33] * W8_SCALE, sp[5 * 33] * W8_SCALE, hi, false); hi = __builtin_amdgcn_cvt_pk_fp8_f32(sp[6 * 33] * W8_SCALE, sp[7 * 33] * W8_SCALE, hi, true);
            *(unsigned long long*)(t.wt8 + (size_t)(n8row + n) * t.ldt + k0 + 8 * c) = (unsigned long long)(unsigned)lo | ((unsigned long long)(unsigned)hi << 32); }
    } else {
#pragma unroll
    for (int j = 0; j < 4; ++j) { const int n = (lane >> 3) + 8 * j; const LAS float* sp = scr + (8 * c) * 33 + n;
        v4u o; o.x = pk2(sp[0 * 33], sp[1 * 33]); o.y = pk2(sp[2 * 33], sp[3 * 33]); o.z = pk2(sp[4 * 33], sp[5 * 33]); o.w = pk2(sp[6 * 33], sp[7 * 33]);
        *(v4u*)(t.WT + (size_t)(n0 + n) * t.ldt + t.koff + k0 + 8 * c) = o; }
    }
    asm volatile("s_waitcnt lgkmcnt(0)" ::: "memory");
}
__device__ __forceinline__ void tr_matrix(const TrSrc& t, int nitems, int gw, int NGW, int lane, LAS float* scr) {
    f32x4 a[8], b[8];
    int it = gw;
    if (it < nitems) tr_load(t, it, lane, a);
    for (; it < nitems; it += 2 * NGW) {
        const bool hb = it + NGW < nitems;
        if (hb) tr_load(t, it + NGW, lane, b);
        tr_store(t, it, lane, a, scr);
        if (hb) { if (it + 2 * NGW < nitems) tr_load(t, it + 2 * NGW, lane, a); tr_store(t, it + NGW, lane, b, scr); }
    }
}
__device__ __forceinline__ void rms_row_load(const float* xrow, int lane, f32x4 (&v)[8]) {
    const f32x4* xr = (const f32x4*)xrow + lane;
#pragma unroll
    for (int j = 0; j < 8; ++j) v[j] = __builtin_nontemporal_load(xr + 64 * j);
}
__device__ __forceinline__ void rms_row_store(const f32x4 (&v)[8], const float* gain, bf16_t* orow, unsigned char* orow8, int lane) {
    const f32x4* gr = (const f32x4*)gain + lane; float s = 0.f;
#pragma unroll
    for (int j = 0; j < 8; ++j) s += (v[j].x * v[j].x + v[j].y * v[j].y) + (v[j].z * v[j].z + v[j].w * v[j].w);
    const float rs = rsqrtf(wave_sum(s) * (1.f / DM) + EPS);
    unsigned long long* o8 = (unsigned long long*)orow + lane;
    unsigned* q8 = (unsigned*)orow8 + lane;
#pragma unroll
    for (int j = 0; j < 8; ++j) { const f32x4 g = gr[64 * j]; const f32x4 y = v[j] * rs * g;
        o8[64 * j] = (unsigned long long)pk2(y.x, y.y) | ((unsigned long long)pk2(y.z, y.w) << 32);
        int w = 0; w = __builtin_amdgcn_cvt_pk_fp8_f32(y.x * H8_SCALE, y.y * H8_SCALE, w, false); w = __builtin_amdgcn_cvt_pk_fp8_f32(y.z * H8_SCALE, y.w * H8_SCALE, w, true);
        q8[64 * j] = (unsigned)w; }
}
__device__ __forceinline__ void rms_rows(const float* x, const float* gain, bf16_t* H, unsigned char* H8, int m0, int step, int nrows, int lane) {
    f32x4 a[8], b[8];
    int m = m0;
    if (m < nrows) rms_row_load(x + (size_t)m * DM, lane, a);
    for (; m < nrows; m += 2 * step) {
        const bool hb = m + step < nrows;
        if (hb) rms_row_load(x + (size_t)(m + step) * DM, lane, b);
        rms_row_store(a, gain, H + (size_t)m * DM, H8 + (size_t)m * DM, lane);
        if (hb) { if (m + 2 * step < nrows) rms_row_load(x + (size_t)(m + 2 * step) * DM, lane, a); rms_row_store(b, gain, H + (size_t)(m + step) * DM, H8 + (size_t)(m + step) * DM, lane); }
    }
}

#define XB_TMO      128
#define XB_XCNT(j)  (256  + 64 * (j))
#define XB_XSUB(j)  (1280 + 64 * (j))
#define XB_XGEN(j)  (2304 + 64 * (j))
#define XB_TOP      3328
#define XB_TOPGEN   3392
#define XCD_BAR_WORDS 3456
#define XB_SPIN_CAP (1u << 18)

__device__ __forceinline__ unsigned xb_ld(unsigned* p)              { return __hip_atomic_load(p, __ATOMIC_RELAXED, __HIP_MEMORY_SCOPE_AGENT); }
__device__ __forceinline__ unsigned xb_add(unsigned* p, unsigned v) { return __hip_atomic_fetch_add(p, v, __ATOMIC_RELAXED, __HIP_MEMORY_SCOPE_AGENT); }
__device__ __forceinline__ unsigned xb_xcc_id() { return (unsigned)__builtin_amdgcn_s_getreg((3 << 11) | 20) & 0xFu; }
#define XB_SPIN(cond, bar) do { unsigned _sp = 0; while (cond) { __builtin_amdgcn_s_sleep(1); \
    if ((++_sp & 255u) == 0u) { if (xb_ld(&(bar)[XB_TMO])) break; if (_sp > XB_SPIN_CAP) { atomicAdd(&(bar)[XB_TMO], 1u); break; } } } } while (0)

struct XcdBarrier {
    unsigned* bar; unsigned x;
    volatile LAS unsigned* st;
};

__device__ __forceinline__ XcdBarrier xcd_barrier_post(unsigned* bar, volatile LAS unsigned* st) {
    XcdBarrier b; b.bar = bar; b.x = xb_xcc_id(); b.st = st;
    if (threadIdx.x == 0) (void)xb_add(&bar[XB_XCNT(b.x)], 1u);
    return b;
}
__device__ __forceinline__ void xcd_barrier_complete(unsigned* bar, unsigned x, unsigned& nloc, unsigned& nx) {
    const unsigned G = gridDim.x * gridDim.y * gridDim.z;
    unsigned sum, cnt, mine, sp = 0u;
    for (;;) {
        sum = 0u; cnt = 0u; mine = 0u;
#pragma unroll
        for (unsigned j = 0; j < 16; ++j) { const unsigned c = xb_ld(&bar[XB_XCNT(j)]); sum += c; cnt += (c > 0u) ? 1u : 0u; mine = (j == x) ? c : mine; }
        if (sum == G) break;
        __builtin_amdgcn_s_sleep(1);
        if ((++sp & 255u) == 0u) { if (xb_ld(&bar[XB_TMO])) break; if (sp > XB_SPIN_CAP) { atomicAdd(&bar[XB_TMO], 1u); break; } }
    }
    nloc = mine > 0u ? mine : 1u; nx = cnt > 0u ? cnt : 1u;
}

__device__ __forceinline__ void xcd_barrier(const XcdBarrier& b, const int wave_) {
    asm volatile("s_waitcnt vmcnt(0)" ::: "memory");
    __syncthreads();
    if (wave_ == 0 && fresh_lane() == 0) {
        unsigned* bar = b.bar;
        __builtin_amdgcn_s_waitcnt(0);
        unsigned nloc = b.st[0], nx = b.st[1];
        if (nloc == 0u) { xcd_barrier_complete(bar, b.x, nloc, nx); b.st[0] = nloc; b.st[1] = nx; }
        const unsigned old = xb_add(&bar[XB_XSUB(b.x)], 1u);
        const unsigned gen = old / nloc;
        if (old + 1u == (gen + 1u) * nloc) {
            __builtin_amdgcn_fence(__ATOMIC_RELEASE, "agent");
            asm volatile("s_waitcnt vmcnt(0)" ::: "memory");
            const unsigned og = xb_add(&bar[XB_TOP], 1u);
            const unsigned tg = og / nx;
            if (og + 1u == (tg + 1u) * nx) xb_add(&bar[XB_TOPGEN], 1u);
            else XB_SPIN(xb_ld(&bar[XB_TOPGEN]) == tg, bar);
            __builtin_amdgcn_fence(__ATOMIC_ACQUIRE, "agent");
            xb_add(&bar[XB_XGEN(b.x)], 1u);
            asm volatile("s_waitcnt vmcnt(0)" ::: "memory");
        } else {
            XB_SPIN(xb_ld(&bar[XB_XGEN(b.x)]) == gen, bar);
            __builtin_amdgcn_fence(__ATOMIC_ACQUIRE, "agent");
            asm volatile("s_waitcnt vmcnt(0)" ::: "memory");
        }
    }
    __syncthreads();
}

struct Args { const float* in[10]; float* out; unsigned char* ws; int ph_lo, ph_hi; };

__global__ void __launch_bounds__(NWAVES * 64, 2) mk_fwd(Args args) {
    extern __shared__ __attribute__((aligned(16))) unsigned char lds[];
    const int wave = __builtin_amdgcn_readfirstlane((int)threadIdx.x >> 6);
#define TID_LANE const int lane = fresh_lane(); const int tid = wave * 64 + lane; (void)tid; (void)lane;
    const int G = gridDim.x, bx = blockIdx.x;
    const int vcu = (G % 8 == 0) ? (bx % 8) * (G / 8) + bx / 8 : bx;
    unsigned char* ws = args.ws;
    const float* x = args.in[0]; const float* ng = args.in[1]; const float* w_in = args.in[2];
    bf16_t* WT_IN = (bf16_t*)(ws + WS_WTIN); bf16_t* HB = (bf16_t*)(ws + WS_HB); bf16_t* P = (bf16_t*)(ws + WS_P);
    float* COSA = (float*)(ws + WS_TAB); float* SINA = COSA + 2048; float* COSP = COSA + 4096; float* SINP = COSP + 32768;
    bf16_t* OG = (bf16_t*)(ws + WS_OG); float* LSE = (float*)(ws + WS_LSE); unsigned* CTL = (unsigned*)(ws + WS_CTL) + 4096;
    bf16_t* WT_AB = (bf16_t*)(ws + WS_WTAB); bf16_t* WT_O = (bf16_t*)(ws + WS_WTO); bf16_t* Y = (bf16_t*)(ws + WS_Y); bf16_t* MG = HB; unsigned char* H8 = ws + WS_H8; unsigned char* WTZ8 = ws + WS_WTZ8; bf16_t* SA = (bf16_t*)(ws + WS_SA); bf16_t* SB = (bf16_t*)(ws + WS_SB); float* XB = (float*)(ws + WS_XB); unsigned* PCNT = (unsigned*)(ws + WS_CTL) + 8192; unsigned* PC2 = (unsigned*)(ws + WS_CTL) + 10240;
    const int lo = args.ph_lo, hi = args.ph_hi;
    volatile LAS unsigned* MISC = (volatile LAS unsigned*)((LAS unsigned char*)lds + 131072 + 320);
    if (threadIdx.x < 32) MISC[threadIdx.x] = 0u;
    __syncthreads();
    XcdBarrier bar = xcd_barrier_post((unsigned*)(ws + WS_CTL), MISC + 8);
#define GRID_BAR() xcd_barrier(bar, wave)
#define IN(k) (lo <= (k) && (k) < hi)
#define BOTH(k) (IN(k) && IN((k) + 1))
    if (IN(0)) { TID_LANE
        LAS float* scr = (LAS float*)((LAS unsigned char*)lds + wave * 16384);
        const int gw = vcu * NWAVES + wave, NGW = G * NWAVES;
        constexpr int I_IN = (DM / 64) * (NC / 32);
        { const TrSrc t{w_in, NC, WT_IN, DM, 0, -1, WTZ8, 7680}; tr_matrix(t, I_IN, gw, NGW, lane, scr); }
        for (int i = bx * (NWAVES * 64) + tid; i < 2048 + 32768; i += G * NWAVES * 64) {
            if (i < 2048) { const int pos = i >> 5, fi = i & 31; const float a = (float)pos * (1.0f / powf(10000.0f, (float)fi / 32.0f)); COSA[i] = cosf(a); SINA[i] = sinf(a); }
            else { const int k = i - 2048, pos = k >> 4, fi = k & 15; const float a = (float)pos * (1.0f / powf(500000.0f, (float)fi / 16.0f)); COSP[k] = cosf(a); SINP[k] = sinf(a); }
        }
        rms_rows(x, ng, HB, H8, gw, NGW, NTOK, lane);
        if (BOTH(0)) GRID_BAR();
    }
    if (IN(1)) { TID_LANE
        const float dsc = 1.0f / (H8_SCALE * W8_SCALE);
        {
            pg8::Gemm g{HB, WT_IN + (size_t)14 * 256 * DM, NTOK, 16 * 256, DM}; pg8::StaticOrder S; S.init(NTOK, 16 * 256, G, bx, 8);
            pg8::EpiIn<false> E{P, PITCH, COSA, SINA, COSP, SINP, args.in[3], args.in[4], args.in[5], SA, SB, (LAS float*)((LAS unsigned char*)lds + 131072 + 1024), EPS, 1.0f};
            pg8::gemm_phase<pg8::EpiIn<false>, pg8::StaticOrder, true, true>((LAS unsigned char*)lds, g, S, E, wave);
        }
        {
            pg8::Gemm g8{(const bf16_t*)H8, (const bf16_t*)WTZ8, NTOK, 30 * 256, DM / 2}; pg8::StaticOrder S8; S8.init(NTOK, 30 * 256, G, bx, 4);
            pg8::EpiIn<true> E8{P, PITCH, COSA, SINA, COSP, SINP, args.in[3], args.in[4], args.in[5], SA, SB, (LAS float*)((LAS unsigned char*)lds + 131072 + 1024), EPS, dsc};
            pg8::gemm_phase<pg8::EpiIn<true>, pg8::StaticOrder, true, true>((LAS unsigned char*)lds, g8, S8, E8, wave);
        }
        const int nheavy = ((NTOK / 256) * 30) % G;
        {
            const int first = nheavy > 0 ? nheavy : 0, nidle = G - first;
            if (bx >= first) {
                LAS float* scr = (LAS float*)((LAS unsigned char*)lds + wave * 16384);
                const int gw2 = (bx - first) * NWAVES + wave, NGW2 = nidle * NWAVES;
                constexpr int I_A = (1024 / 64) * (DM / 32), I_B = (512 / 64) * (DM / 32), I_O = (DM / 64) * (DM / 32);
                { const TrSrc t{args.in[6], DM, WT_AB, 1536, 0, 1, nullptr, 0}; tr_matrix(t, I_A, gw2, NGW2, lane, scr); }
                { const TrSrc t{args.in[7], DM, WT_AB, 1536, 1024, 1, nullptr, 0}; tr_matrix(t, I_B, gw2, NGW2, lane, scr); }
                { const TrSrc t{args.in[8], DM, WT_O, DM, 0, 0, nullptr, 0}; tr_matrix(t, I_O, gw2, NGW2, lane, scr); }
            }
        }
        if (BOTH(1)) GRID_BAR();
    }
    if (IN(2)) { TID_LANE
        for (int u = bx; u < 384; u += G) {
            const int blk = u & 7, h = (u >> 3) & 3, b = (u >> 5) & 3, g = u >> 7;
            att::attn_band_unit(P, OG, LSE, g, b, h, blk, C_QB, C_KB, C_VB, SEQ, NTOK, (char*)lds, wave);
        }
        asm volatile("s_waitcnt vmcnt(0)" ::: "memory"); __syncthreads();
        if (tid == 0) { __builtin_amdgcn_fence(__ATOMIC_RELEASE, "agent"); asm volatile("s_waitcnt vmcnt(0)" ::: "memory"); __hip_atomic_fetch_add(CTL, 1u, __ATOMIC_RELAXED, __HIP_MEMORY_SCOPE_AGENT); }
        for (int u = bx; u < 256; u += G) {
            const int pair = u & 7, inner = u >> 3, b = pair >> 1, hkv = pair & 1, hq = hkv * 4 + (inner >> 3), qb = inner & 7;
            const size_t row0 = (size_t)b * SEQ + qb * 256;
            att::attn_dense_body(P + row0 * PITCH + C_QA + hq * 128, P + (size_t)b * SEQ * PITCH + C_KA + hkv * 128, P + (size_t)b * SEQ * PITCH + C_VA + hkv * 128,
                                 P + row0 * PITCH + C_GA + hq * 128, Y + row0 * 1536 + hq * 128, SEQ, (char*)lds, wave);
            if (G == 256) { asm volatile("s_waitcnt vmcnt(0)" ::: "memory"); __syncthreads();
                if (tid == 0) __hip_atomic_fetch_add(PC2 + 64 * (b * 8 + qb), 1u, __ATOMIC_RELAXED, __HIP_MEMORY_SCOPE_AGENT); }
        }
        const int mfirst = (384 - G > 0 && 384 - G < G) ? 384 - G : 0, nmerge = G - mfirst;
        if (bx >= mfirst) {
            if (tid == 0) { unsigned spins = 0; while (__hip_atomic_load(CTL, __ATOMIC_RELAXED, __HIP_MEMORY_SCOPE_AGENT) < (unsigned)G) { __builtin_amdgcn_s_sleep(4); if (++spins > (1u << 24)) break; }
                __builtin_amdgcn_fence(__ATOMIC_ACQUIRE, "agent"); asm volatile("s_waitcnt vmcnt(0)" ::: "memory"); }
            __syncthreads();
            const int mj = bx - mfirst, mbase = (G == 256) ? (256 * (mj >> 2) + 64 * (mj & 3)) * 64 : mj * (NWAVES * 64), mend = (G == 256) ? mbase + 64 * 64 : NTOK * 64, mstep = (G == 256) ? NWAVES * 64 : nmerge * NWAVES * 64;
            const __amdgpu_buffer_rsrc_t rsYm = __builtin_amdgcn_make_buffer_rsrc((void*)Y, 0, NTOK * 1536 * 2, 0x00020000);
            for (int c0 = mbase + tid; c0 < mend; c0 += 2 * mstep) {
                v4u a0[2], a1[2], a2[2], gz[2]; float e0[2], e1[2], e2[2]; int tok[2], c8[2]; bool ok[2];
#pragma unroll
                for (int q = 0; q < 2; ++q) { const int ci = c0 + q * mstep; ok[q] = ci < mend; const int cj = ok[q] ? ci : c0; tok[q] = cj >> 6; c8[q] = (cj & 63) * 8; const int h = c8[q] >> 7;
                    e0[q] = LSE[((size_t)0 * NTOK + tok[q]) * 4 + h]; e1[q] = LSE[((size_t)1 * NTOK + tok[q]) * 4 + h]; e2[q] = LSE[((size_t)2 * NTOK + tok[q]) * 4 + h];
                    a0[q] = *(const v4u*)(OG + ((size_t)0 * NTOK + tok[q]) * 512 + c8[q]); a1[q] = *(const v4u*)(OG + ((size_t)1 * NTOK + tok[q]) * 512 + c8[q]); a2[q] = *(const v4u*)(OG + ((size_t)2 * NTOK + tok[q]) * 512 + c8[q]);
                    gz[q] = *(const v4u*)(P + (size_t)tok[q] * PITCH + C_GB + c8[q]); }
#pragma unroll
                for (int q = 0; q < 2; ++q) { const float mx = fmaxf(e0[q], fmaxf(e1[q], e2[q])); float w0 = __expf(e0[q] - mx), w1 = __expf(e1[q] - mx), w2 = __expf(e2[q] - mx); const float inv = 1.f / (w0 + w1 + w2); w0 *= inv; w1 *= inv; w2 *= inv;
                    v4u w;
#pragma unroll
                    for (int e = 0; e < 4; ++e) {
                        const float lo = w0 * __uint_as_float(a0[q][e] << 16) + w1 * __uint_as_float(a1[q][e] << 16) + w2 * __uint_as_float(a2[q][e] << 16);
                        const float hh = w0 * __uint_as_float(a0[q][e] & 0xffff0000u) + w1 * __uint_as_float(a1[q][e] & 0xffff0000u) + w2 * __uint_as_float(a2[q][e] & 0xffff0000u);
                        w[e] = pk2(lo * __uint_as_float(gz[q][e] << 16), hh * __uint_as_float(gz[q][e] & 0xffff0000u)); }
                    if (ok[q]) __builtin_amdgcn_raw_buffer_store_b128(w, rsYm, (int)(((size_t)tok[q] * 1536 + 1024 + c8[q]) * 2), 0, 16); }
            }
            if (G == 256) { asm volatile("s_waitcnt vmcnt(0)" ::: "memory"); __syncthreads(); if (tid == 0) __hip_atomic_fetch_add(PC2 + 64 * (mj >> 2), 1u, __ATOMIC_RELAXED, __HIP_MEMORY_SCOPE_AGENT); }
        }
        if (BOTH(2) && G != 256) GRID_BAR();
    }
    if (IN(3)) {
        pg8::Gemm g{Y, WT_AB, NTOK, DM, 1536}; pg8::StaticOrder S; S.init(NTOK, DM, G, bx, 4);
        if (G == 256 && IN(2)) {
            pg8::Unit u2; if (S.next(0, u2)) {
                unsigned* pc2 = PC2 + 64 * u2.pm;
                if (wave == 0 && fresh_lane() == 0) { unsigned spins = 0; while (__hip_atomic_load(pc2, __ATOMIC_RELAXED, __HIP_MEMORY_SCOPE_AGENT) < 12u) { __builtin_amdgcn_s_sleep(2); if (++spins > (1u << 22)) break; }
                    __builtin_amdgcn_fence(__ATOMIC_ACQUIRE, "agent"); asm volatile("s_waitcnt vmcnt(0)" ::: "memory"); }
                __syncthreads(); } }
        pg8::EpiMerge2 E{SA, SB, MG, DM};
        pg8::gemm_phase<pg8::EpiMerge2, pg8::StaticOrder, true, true>((LAS unsigned char*)lds, g, S, E, wave);
        if (BOTH(3)) {
            pg8::Unit u3; const bool has = S.next(0, u3);
            if (G == 256 && has) {
                unsigned* pc3 = (unsigned*)(ws + WS_CTL) + 5120 + 64 * u3.pm;
                asm volatile("s_waitcnt vmcnt(0)" ::: "memory"); __syncthreads();
                if (wave == 0 && fresh_lane() == 0) {
                    __hip_atomic_fetch_add(pc3, 1u, __ATOMIC_RELAXED, __HIP_MEMORY_SCOPE_AGENT);
                    unsigned spins = 0; while (__hip_atomic_load(pc3, __ATOMIC_RELAXED, __HIP_MEMORY_SCOPE_AGENT) < 8u) { __builtin_amdgcn_s_sleep(2); if (++spins > (1u << 22)) break; }
                    __builtin_amdgcn_fence(__ATOMIC_ACQUIRE, "agent"); asm volatile("s_waitcnt vmcnt(0)" ::: "memory"); }
                __syncthreads();
            } else GRID_BAR();
        }
    }
    if (IN(4)) {
        pg8::Gemm g{MG, WT_O, NTOK, DM, DM}; pg8::StaticOrder S; S.init(NTOK, DM, G, bx, 4);
        pg8::EpiResidNorm E{x, args.out, DM, args.in[9], XB, PCNT, 8, EPS};
        if (G == 256) pg8::gemm_phase<pg8::EpiResidNorm, pg8::StaticOrder, false, true>((LAS unsigned char*)lds, g, S, E, wave);
    }
#undef IN
#undef BOTH
}


extern "C" void kernel_launch(void* const* d_in, const int* in_sizes, int n_in, void* d_out, int out_size, void* d_ws, size_t ws_size, hipStream_t stream) {
    static int grid = 0;
    if (grid == 0) {
        if (n_in != 10 || in_sizes[0] != NTOK * DM || out_size != NTOK * DM || ws_size < WS_END) { fprintf(stderr, "kernel_launch: unexpected shapes / workspace (%zu)\n", ws_size); grid = -1; return; }
        int dev = 0, cus = 0, per_cu = 0;
        if (hipGetDevice(&dev) != hipSuccess || hipDeviceGetAttribute(&cus, hipDeviceAttributeMultiprocessorCount, dev) != hipSuccess) { grid = -1; return; }
        if (hipFuncSetAttribute((const void*)mk_fwd, hipFuncAttributeMaxDynamicSharedMemorySize, LDS_BYTES) != hipSuccess) { fprintf(stderr, "kernel_launch: hipFuncSetAttribute failed\n"); grid = -1; return; }
        if (hipOccupancyMaxActiveBlocksPerMultiprocessor(&per_cu, (const void*)mk_fwd, NWAVES * 64, LDS_BYTES) != hipSuccess || per_cu < 1) { fprintf(stderr, "kernel_launch: occupancy query says %d\n", per_cu); grid = -1; return; }
        grid = cus;
    }
    if (grid < 0) return;
    if (hipMemsetAsync((char*)d_ws + WS_CTL, 0, 131072, stream) != hipSuccess) { fprintf(stderr, "kernel_launch: memset failed\n"); return; }
    Args a{};
    for (int i = 0; i < 10; ++i) a.in[i] = (const float*)d_in[i];
    a.out = (float*)d_out; a.ws = (unsigned char*)d_ws; a.ph_lo = 0; a.ph_hi = 5;
    void* kargs[] = {&a};
    hipError_t e = hipLaunchCooperativeKernel((const void*)mk_fwd, dim3(grid), dim3(NWAVES * 64), kargs, LDS_BYTES, stream);
    if (e != hipSuccess) fprintf(stderr, "kernel_launch: cooperative launch failed: %s (grid %d)\n", hipGetErrorString(e), grid);
}
```

```cpp
#include <hip/hip_runtime.h>
#include <cstdio>
#include <cstdint>
#include <cmath>
__device__ __forceinline__ int fresh_lane() { int l; asm volatile("v_mbcnt_lo_u32_b32 %0, -1, 0\n\tv_mbcnt_hi_u32_b32 %0, -1, %0" : "=v"(l)); return l; }
namespace pg8 {
#define PG8_LAS __attribute__((address_space(3)))
typedef unsigned short bf16_t;
typedef short bf16x8 __attribute__((ext_vector_type(8)));
typedef float f32x4 __attribute__((ext_vector_type(4)));
typedef unsigned u32x4 __attribute__((ext_vector_type(4)));
typedef int v4i_t __attribute__((ext_vector_type(4)));
constexpr int BM = 256, BK = 64, HALF = 128, HTB = HALF * BK * 2  , STAGE_BYTES = 8 * HTB, NXCD = 8;

__host__ __device__ __forceinline__ int lds_byte(int r, int c) { const int st = (r >> 4) * 2 + (c >> 5), rr = r & 15, cc = c & 31, ob = rr * 64 + cc * 2; return st * 1024 + (ob ^ (((ob >> 9) & 1) << 5)); }
__host__ __device__ __forceinline__ void stage_rc(int b, int& R, int& C) { const int st = b / 1024, sb = b % 1024, swz = sb ^ (((sb >> 9) & 1) << 5); R = (st >> 1) * 16 + swz / 64; C = (st & 1) * 32 + (swz % 64) / 2; }
__host__ __device__ __forceinline__ int perm32(int rho) { const int n = rho >> 4, i = rho & 15; return 8 * (i >> 2) + 4 * n + (i & 3); }

struct Unit { int pm, pn; };
struct Gemm { const bf16_t* A; const bf16_t* Bt; int M, N, K; };

struct StaticOrder {
    int nM, nN, nwg, G, c, WGM;
    __host__ __device__ void init(int M, int N, int G_, int c_, int wgm = 4) { nM = M / BM; nN = N / BM; nwg = nM * nN; G = G_; c = c_; WGM = wgm; }
    __host__ __device__ bool next(int i, Unit& u) const { const long L = (long)i * G + c; if (L >= nwg) return false; unit_of((int)L, u); return true; }
    __host__ __device__ bool unit_of(int L, Unit& u) const {
        int wgid = L; { const int q = nwg / NXCD, r = nwg % NXCD, xcd = wgid % NXCD, off = wgid / NXCD; wgid = (xcd < r ? xcd * (q + 1) : r * (q + 1) + (xcd - r) * q) + off; }
        const int nig = WGM * nN, gid = wgid / nig, fm = gid * WGM, gsz = (nM - fm) < WGM ? (nM - fm) : WGM;
        u.pm = fm + ((wgid % nig) % gsz); u.pn = (wgid % nig) / gsz; return true;
    }
    __device__ __forceinline__ void a_ready(const Unit&) const {}
    __device__ __forceinline__ void done(const Unit&) const {}
};


typedef float f32x2_cv __attribute__((ext_vector_type(2))); typedef __bf16 bf16x2_cv __attribute__((ext_vector_type(2)));
__device__ __forceinline__ unsigned cvt_pk_bf16(float lo, float hi) { const f32x2_cv v = {lo, hi}; return __builtin_bit_cast(unsigned, __builtin_convertvector(v, bf16x2_cv)); }
typedef float f32x2 __attribute__((ext_vector_type(2)));

template <bool F8> struct EpiIn {
    static constexpr bool PERM = false, AFTER_DRAIN = false, FP8 = F8, INIT_ACC = false; static constexpr int HOOK_T = -1;
    bf16_t* O; int ldc; const float* cosa; const float* sina; const float* cosp; const float* sinp; const float* qg; const float* kg; const float* bias; bf16_t* SA; bf16_t* SB; PG8_LAS float* red; float eps; float sc;
    __device__ __forceinline__ static unsigned long long pk4(const f32x4 v) { return (unsigned long long)cvt_pk_bf16(v[0], v[1]) | ((unsigned long long)cvt_pk_bf16(v[2], v[3]) << 32); }
    __device__ __forceinline__ void operator()(const f32x4 (&acc)[2][2][4][2], const Unit& u, int wr, int wc, int fr_, int fq_) const {
        (void)fr_; (void)fq_; const int ln_ = fresh_lane(), fr = ln_ & 15, fq = ln_ >> 4;
        const int pn = F8 ? (u.pn < 14 ? u.pn : u.pn + 16) : u.pn + 14; const int row0 = u.pm * BM + wr * 64 + fr;
        if (pn < 5) {
#pragma unroll
            for (int ai = 0; ai < 2; ++ai)
#pragma unroll
                for (int m = 0; m < 4; ++m)
#pragma unroll
                    for (int bj = 0; bj < 2; ++bj) { const f32x4 v0 = (acc[ai][bj][m][0] * sc), v1 = (acc[ai][bj][m][1] * sc);
                        float ss = (v0[0] * v0[0] + v0[1] * v0[1]) + (v0[2] * v0[2] + v0[3] * v0[3]) + (v1[0] * v1[0] + v1[1] * v1[1]) + (v1[2] * v1[2] + v1[3] * v1[3]);
                        ss += __shfl_xor(ss, 16); ss += __shfl_xor(ss, 32);
                        if (fq == 0) red[(ai * HALF + wr * 64 + m * 16 + fr) * 8 + bj * 4 + wc] = ss; }
            asm volatile("s_waitcnt lgkmcnt(0)" ::: "memory"); __builtin_amdgcn_s_barrier(); asm volatile("" ::: "memory");
            const int half = wc >> 1, i0 = 16 * (wc & 1) + 4 * fq;
            const float* g = (pn < 4) ? qg : kg;
            const f32x4 g0 = *(const f32x4*)(g + 64 * half + i0), g1 = *(const f32x4*)(g + 64 * half + 32 + i0);
#pragma unroll
            for (int ai = 0; ai < 2; ++ai)
#pragma unroll
                for (int m = 0; m < 4; ++m) { const int row = row0 + ai * HALF + m * 16, sq = row & 2047, pos = half ? (sq & 63) : (sq >> 6);
                    const f32x4 c = *(const f32x4*)(cosa + pos * 32 + i0), sn = *(const f32x4*)(sina + pos * 32 + i0);
#pragma unroll
                    for (int bj = 0; bj < 2; ++bj) { const f32x4 pr = *(const PG8_LAS f32x4*)(red + (ai * HALF + wr * 64 + m * 16 + fr) * 8 + bj * 4);
                        const float rs = rsqrtf(((pr[0] + pr[1]) + (pr[2] + pr[3])) * (1.f / 128.f) + eps);
                        const f32x4 y0 = (acc[ai][bj][m][0] * sc) * rs * g0, y1 = (acc[ai][bj][m][1] * sc) * rs * g1;
                        const f32x4 lo = y0 * c - y1 * sn, hi = y0 * sn + y1 * c;
                        bf16_t* p = O + (size_t)row * ldc + pn * BM + bj * HALF + 64 * half + i0;
                        *(unsigned long long*)p = pk4(lo); *(unsigned long long*)(p + 32) = pk4(hi); } }
        } else if (pn >= 10 && pn < 22 && wc == 0) {
            const int i0 = 4 * fq;
#pragma unroll
            for (int ai = 0; ai < 2; ++ai)
#pragma unroll
                for (int m = 0; m < 4; ++m) { const int row = row0 + ai * HALF + m * 16, sq = row & 2047;
                    const f32x4 c = *(const f32x4*)(cosp + sq * 16 + i0), sn = *(const f32x4*)(sinp + sq * 16 + i0);
#pragma unroll
                    for (int bj = 0; bj < 2; ++bj) { const f32x4 y0 = (acc[ai][bj][m][0] * sc), y1 = (acc[ai][bj][m][1] * sc);
                        const f32x4 lo = y0 * c - y1 * sn, hi = y0 * sn + y1 * c;
                        bf16_t* p = O + (size_t)row * ldc + pn * BM + bj * HALF + i0;
                        *(unsigned long long*)p = pk4(lo); *(unsigned long long*)(p + 16) = pk4(hi); } }
        } else if (pn >= 30) {
            const int which = pn >= 38 ? 1 : 0, pnz = pn - (which ? 38 : 30);
            const float* bs = bias + which * 2048 + pnz * BM + wc * 32 + 8 * fq;
            bf16_t* dst = (which ? SB : SA) + ((((size_t)(u.pm * 8 + pnz) * 8 + (wr * 4 + wc)) * 16) * 64 + (fq * 16 + fr)) * 8;
#pragma unroll
            for (int bj = 0; bj < 2; ++bj) { const f32x4 b0 = *(const f32x4*)(bs + bj * HALF), b1 = *(const f32x4*)(bs + bj * HALF + 4);
#pragma unroll
                for (int ai = 0; ai < 2; ++ai)
#pragma unroll
                    for (int m = 0; m < 4; ++m) { const f32x4 v0 = (acc[ai][bj][m][0] * sc) + b0, v1 = (acc[ai][bj][m][1] * sc) + b1; float sg[8];
#pragma unroll
                        for (int e = 0; e < 4; ++e) { sg[e] = __builtin_amdgcn_rcpf(1.f + __builtin_amdgcn_exp2f(v0[e] * -1.4426950408889634f)); sg[4 + e] = __builtin_amdgcn_rcpf(1.f + __builtin_amdgcn_exp2f(v1[e] * -1.4426950408889634f)); }
                        u32x4 w; w.x = cvt_pk_bf16(sg[0], sg[1]); w.y = cvt_pk_bf16(sg[2], sg[3]); w.z = cvt_pk_bf16(sg[4], sg[5]); w.w = cvt_pk_bf16(sg[6], sg[7]);
                        __builtin_nontemporal_store(w, (u32x4*)(dst + (ai * 8 + bj * 4 + m) * 512)); } }
        } else {
            const bool act = (pn >= 6 && pn < 10) || pn == 28 || pn == 29;
            const int col0 = pn * BM + wc * 32 + 8 * fq;
#pragma unroll
            for (int ai = 0; ai < 2; ++ai)
#pragma unroll
                for (int m = 0; m < 4; ++m) { bf16_t* rowp = O + (size_t)(row0 + ai * HALF + m * 16) * ldc + col0;
#pragma unroll
                    for (int bj = 0; bj < 2; ++bj) { f32x4 v0 = (acc[ai][bj][m][0] * sc), v1 = (acc[ai][bj][m][1] * sc);
                        if (act) {
#pragma unroll
                            for (int e = 0; e < 4; ++e) { v0[e] = v0[e] * __builtin_amdgcn_rcpf(1.f + __builtin_amdgcn_exp2f(v0[e] * -1.4426950408889634f)); v1[e] = v1[e] * __builtin_amdgcn_rcpf(1.f + __builtin_amdgcn_exp2f(v1[e] * -1.4426950408889634f)); } }
                        u32x4 w; w.x = cvt_pk_bf16(v0[0], v0[1]); w.y = cvt_pk_bf16(v0[2], v0[3]); w.z = cvt_pk_bf16(v1[0], v1[1]); w.w = cvt_pk_bf16(v1[2], v1[3]);
                        *(u32x4*)(rowp + bj * HALF) = w; } }
        }
    }
};
struct EpiMerge2 {
    static constexpr bool PERM = false, AFTER_DRAIN = false, FP8 = false; static constexpr int HOOK_T = 16; static constexpr bool INIT_ACC = false;
    const bf16_t* SA; const bf16_t* SB; bf16_t* O; int ldc;
    __device__ __forceinline__ void mid(f32x4 (&acc)[2][2][4][2], const Unit& u, int wr, int wc, int fr, int fq) const {
        int lane = fq * 16 + fr; asm volatile("" : "+v"(lane));
        const size_t base = ((((size_t)(u.pm * 8 + u.pn) * 8 + (wr * 4 + wc)) * 16) * 64 + lane) * 8;
#pragma unroll
        for (int f = 0; f < 16; ++f) { const int ai = f >> 3, bj = (f >> 2) & 1, m = f & 3;
            const u32x4 a = __builtin_nontemporal_load((const u32x4*)(SA + base + f * 512)), b = *(const u32x4*)(SB + base + f * 512);
            f32x4 r0, r1;
#pragma unroll
            for (int e = 0; e < 4; ++e) { const float q_lo = __uint_as_float(a[e] << 16) * __builtin_amdgcn_rcpf(__uint_as_float(b[e] << 16)), q_hi = __uint_as_float(a[e] & 0xffff0000u) * __builtin_amdgcn_rcpf(__uint_as_float(b[e] & 0xffff0000u));
                if (e < 2) { r0[2 * e] = q_lo; r0[2 * e + 1] = q_hi; } else { r1[2 * e - 4] = q_lo; r1[2 * e - 3] = q_hi; } }
            acc[ai][bj][m][0] *= r0; acc[ai][bj][m][1] *= r1; }
    }
    __device__ __forceinline__ void operator()(const f32x4 (&acc)[2][2][4][2], const Unit& u, int wr, int wc, int fr_, int fq_) const {
        (void)fr_; (void)fq_; const int ln_ = fresh_lane(), fr = ln_ & 15, fq = ln_ >> 4;
        const int lane = fq * 16 + fr, row0 = u.pm * BM + wr * 64 + fr, col0 = u.pn * BM + wc * 32 + 8 * fq;
        const size_t base = ((((size_t)(u.pm * 8 + u.pn) * 8 + (wr * 4 + wc)) * 16) * 64 + lane) * 8;
        bf16_t* Oq = O; asm volatile("" : "+s"(Oq));
        const __amdgpu_buffer_rsrc_t rsO = __builtin_amdgcn_make_buffer_rsrc((void*)Oq, 0, 8192 * 2048 * 2, 0x00020000);
#pragma unroll
        for (int f = 0; f < 16; ++f) { const int ai = f >> 3, bj = (f >> 2) & 1, m = f & 3;
            const u32x4 b = __builtin_nontemporal_load((const u32x4*)(SB + base + f * 512));
            const f32x4 v0 = acc[ai][bj][m][0], v1 = acc[ai][bj][m][1];
            u32x4 w; w.x = cvt_pk_bf16(v0[0] * __uint_as_float(b[0] << 16), v0[1] * __uint_as_float(b[0] & 0xffff0000u)); w.y = cvt_pk_bf16(v0[2] * __uint_as_float(b[1] << 16), v0[3] * __uint_as_float(b[1] & 0xffff0000u));
            w.z = cvt_pk_bf16(v1[0] * __uint_as_float(b[2] << 16), v1[1] * __uint_as_float(b[2] & 0xffff0000u)); w.w = cvt_pk_bf16(v1[2] * __uint_as_float(b[3] << 16), v1[3] * __uint_as_float(b[3] & 0xffff0000u));
            __builtin_amdgcn_raw_buffer_store_b128(w, rsO, (int)(((size_t)(row0 + ai * HALF + m * 16) * ldc + col0 + bj * HALF) * 2), 0, 16); }
    }
};
struct EpiResidNorm {
    static constexpr bool PERM = false, AFTER_DRAIN = true, FP8 = false, INIT_ACC = true; static constexpr int HOOK_T = -1;
    const float* base; float* out; int ldc; const float* gain; float* xb; unsigned* cnt; int ntn; float eps;
    __device__ __forceinline__ void init(f32x4 (&acc)[2][2][4][2], const Unit& u, int wr, int wc, int fr, int fq) const {
        const int row0 = u.pm * BM + wr * 64 + fr, col0 = u.pn * BM + wc * 32 + 4 * fq;
#pragma unroll
        for (int ai = 0; ai < 2; ++ai)
#pragma unroll
            for (int m = 0; m < 4; ++m) { const size_t off = (size_t)(row0 + ai * HALF + m * 16) * ldc + col0;
#pragma unroll
                for (int bj = 0; bj < 2; ++bj)
#pragma unroll
                    for (int n = 0; n < 2; ++n) acc[ai][bj][m][n] = __builtin_nontemporal_load((const f32x4*)(base + off + bj * HALF + n * 16)); }
    }
    __device__ __forceinline__ void fused(f32x4 (&acc)[2][2][4][2], const Unit& u, int wr, int wc, int fr_, int fq_, PG8_LAS unsigned char* lds, int wid, int lane) const {
        (void)fr_; (void)fq_; const int ln_ = fresh_lane(), fr = ln_ & 15, fq = ln_ >> 4;
        PG8_LAS float* Pp = (PG8_LAS float*)lds;
        PG8_LAS float* Sr = (PG8_LAS float*)(lds + 4096);
        const int row0 = u.pm * BM + wr * 64 + fr, col0 = u.pn * BM + wc * 32 + 4 * fq;
#pragma unroll
        for (int ai = 0; ai < 2; ++ai)
#pragma unroll
            for (int m = 0; m < 4; ++m) { float ss = 0.f;
#pragma unroll
                for (int bj = 0; bj < 2; ++bj)
#pragma unroll
                    for (int n = 0; n < 2; ++n) { const f32x4 o = acc[ai][bj][m][n];
                        ss += (o[0] * o[0] + o[1] * o[1]) + (o[2] * o[2] + o[3] * o[3]); }
                ss += __shfl_xor(ss, 16); ss += __shfl_xor(ss, 32);
                if (fq == 0) Pp[(ai * HALF + wr * 64 + m * 16 + fr) * 4 + wc] = ss; }
        asm volatile("s_waitcnt lgkmcnt(0)" ::: "memory"); __builtin_amdgcn_s_barrier(); asm volatile("" ::: "memory");
        const int tid = wid * 64 + lane;
        if (tid < 256) { const f32x4 p = *(const PG8_LAS f32x4*)(Pp + tid * 4);
            __hip_atomic_store(xb + (size_t)(u.pm * BM + tid) * 8 + u.pn, (p[0] + p[1]) + (p[2] + p[3]), __ATOMIC_RELAXED, __HIP_MEMORY_SCOPE_AGENT); }
        asm volatile("s_waitcnt vmcnt(0)" ::: "memory"); __builtin_amdgcn_s_barrier(); asm volatile("" ::: "memory");
        if (tid == 0) __hip_atomic_fetch_add(cnt + 64 * u.pm, 1u, __ATOMIC_RELAXED, __HIP_MEMORY_SCOPE_AGENT);
        if (wid == 0) { unsigned spins = 0;
            while ((unsigned)__builtin_amdgcn_readfirstlane(__hip_atomic_load(cnt + 64 * u.pm, __ATOMIC_RELAXED, __HIP_MEMORY_SCOPE_AGENT)) < (unsigned)ntn) { __builtin_amdgcn_s_sleep(2); if (++spins > (1u << 22)) break; }
            __builtin_amdgcn_fence(__ATOMIC_ACQUIRE, "agent"); }
        asm volatile("s_waitcnt vmcnt(0) lgkmcnt(0)" ::: "memory"); __builtin_amdgcn_s_barrier(); asm volatile("" ::: "memory");
        if (tid < 256) { const float* slot = xb + (size_t)(u.pm * BM + tid) * 8; float tot = 0.f;
#pragma unroll
            for (int t = 0; t < 8; ++t) tot += __hip_atomic_load(slot + t, __ATOMIC_RELAXED, __HIP_MEMORY_SCOPE_AGENT);
            Sr[tid] = rsqrtf(tot * (1.0f / 2048.0f) + eps); }
        asm volatile("s_waitcnt lgkmcnt(0)" ::: "memory"); __builtin_amdgcn_s_barrier(); asm volatile("" ::: "memory");
#pragma unroll
        for (int bj = 0; bj < 2; ++bj)
#pragma unroll
            for (int n = 0; n < 2; ++n) { const f32x4 g = *(const f32x4*)(gain + col0 + bj * HALF + n * 16);
#pragma unroll
                for (int ai = 0; ai < 2; ++ai)
#pragma unroll
                    for (int m = 0; m < 4; ++m) { const int rl = ai * HALF + wr * 64 + m * 16 + fr; const float rs = Sr[rl];
                        __builtin_nontemporal_store(acc[ai][bj][m][n] * rs * g, (f32x4*)(out + (size_t)(u.pm * BM + rl) * ldc + col0 + bj * HALF + n * 16)); } }
    }
};

template <class Epi, class Sched, bool ALIGN_EPI = false, bool SP2 = false>
__device__ __forceinline__ void gemm_phase(PG8_LAS unsigned char* lds, const Gemm g, const Sched& S, const Epi& E, const int wave_) {
    const int wid = wave_, lane = fresh_lane(), tid = wid * 64 + lane, wr = wid >> 2, wc = wid & 3, fr = lane & 15, fq = lane >> 4;
    const int K = g.K, nt = K / BK;
    unsigned voffA[2], voffB[2];
#pragma unroll
    for (int i = 0; i < 2; ++i) { int R, C; stage_rc(tid * 16 + i * 8192, R, C); const int Rb = Epi::PERM ? ((R & ~31) + perm32(R & 31)) : R;
        voffA[i] = (unsigned)(R * K + C) * 2u; voffB[i] = (unsigned)(Rb * K + C) * 2u; }
    const unsigned kstep = (unsigned)(BK * 2);
    const unsigned hstep = (unsigned)HALF * (unsigned)K * 2u;
    const unsigned tstep = 2u * hstep;
    const __amdgpu_buffer_rsrc_t rs_voffA = __builtin_amdgcn_make_buffer_rsrc((void*)g.A, 0, (int)((unsigned)g.M * (unsigned)K * 2u), 0x00020000);
    const __amdgpu_buffer_rsrc_t rs_voffB = __builtin_amdgcn_make_buffer_rsrc((void*)g.Bt, 0, (int)((unsigned)g.N * (unsigned)K * 2u), 0x00020000);
    const unsigned ldsw = (unsigned)wid * 1024u;
    const int aoff = lds_byte(wr * 64 + fr, fq * 8), boff = lds_byte(wc * 32 + fr, fq * 8);
#define PG8_SA(b, h) (((b) * 2 + (h)) * HTB)
#define PG8_SB(b, h) ((4 + (b) * 2 + (h)) * HTB)
#define PG8_STAGE(bufoff, goff, voff) do { _Pragma("unroll") for (int _i = 0; _i < 2; ++_i) \
        __builtin_amdgcn_raw_ptr_buffer_load_lds(rs_##voff, (PG8_LAS void*)(lds + (bufoff) + ldsw + _i * 8192), 16, (int)(voff)[_i], (int)(goff), 0, 0); } while (0)
#define PG8_LDA(dst, b, h) do { _Pragma("unroll") for (int m = 0; m < 4; ++m) _Pragma("unroll") for (int k = 0; k < 2; ++k) dst[m][k] = *(const PG8_LAS bf16x8*)(lds + PG8_SA(b, h) + aoff + m * 2048 + k * 1024); } while (0)
#define PG8_LDB(dst, b, h) do { _Pragma("unroll") for (int n = 0; n < 2; ++n) _Pragma("unroll") for (int k = 0; k < 2; ++k) dst[n][k] = *(const PG8_LAS bf16x8*)(lds + PG8_SB(b, h) + boff + n * 2048 + k * 1024); } while (0)
#define PG8_CAT(x, y) __builtin_shufflevector(__builtin_bit_cast(v4i_t, x), __builtin_bit_cast(v4i_t, y), 0, 1, 2, 3, 4, 5, 6, 7)
#define PG8_MMA(ai, bj, At, Bt) do { __builtin_amdgcn_s_setprio(1); _Pragma("unroll") for (int m = 0; m < 4; ++m) _Pragma("unroll") for (int n = 0; n < 2; ++n) { \
        if constexpr (Epi::FP8) acc[ai][bj][m][n] = __builtin_amdgcn_mfma_scale_f32_16x16x128_f8f6f4(PG8_CAT(Bt[n][0], Bt[n][1]), PG8_CAT(At[m][0], At[m][1]), acc[ai][bj][m][n], 0, 0, 0, 0x7f7f7f7f, 0, 0x7f7f7f7f); \
        else { _Pragma("unroll") for (int k = 0; k < 2; ++k) acc[ai][bj][m][n] = __builtin_amdgcn_mfma_f32_16x16x32_bf16(Bt[n][k], At[m][k], acc[ai][bj][m][n], 0, 0, 0); } } \
        __builtin_amdgcn_s_setprio(0); } while (0)
#define PG8_WAIT_V(n) asm volatile("s_waitcnt vmcnt(" #n ")" ::: "memory")
#define PG8_WAIT_L(n) asm volatile("s_waitcnt lgkmcnt(" #n ")" ::: "memory")
#define PG8_BAR __builtin_amdgcn_s_barrier()
#define PG8_SCHED __builtin_amdgcn_sched_barrier(0)
    Unit cur, nxt; int ui = 0;
    if (!S.next(0, cur)) return;
    f32x4 acc[2][2][4][2];
    if constexpr (Epi::INIT_ACC) E.init(acc, cur, wr, wc, fr, fq);
    else {
#pragma unroll
    for (int a = 0; a < 2; ++a)
#pragma unroll
        for (int b = 0; b < 2; ++b)
#pragma unroll
            for (int m = 0; m < 4; ++m)
#pragma unroll
                for (int n = 0; n < 2; ++n) acc[a][b][m][n] = (f32x4){0.f, 0.f, 0.f, 0.f};
    }
    bf16x8 At[4][2], B0[2][2], B1[2][2];
    unsigned cA = (unsigned)cur.pm * tstep, cB = (unsigned)cur.pn * tstep;
    S.a_ready(cur);
    if constexpr (SP2) {
        PG8_STAGE(PG8_SB(0, 0), cB, voffB); PG8_STAGE(PG8_SB(0, 1), cB + hstep, voffB); PG8_STAGE(PG8_SA(0, 0), cA, voffA); PG8_STAGE(PG8_SA(0, 1), cA + hstep, voffA);
        if (wr == 1) PG8_BAR;
        PG8_WAIT_V(2); PG8_BAR;
        PG8_STAGE(PG8_SB(1, 0), cB + kstep, voffB); PG8_STAGE(PG8_SA(1, 0), cA + kstep, voffA); PG8_STAGE(PG8_SB(1, 1), cB + hstep + kstep, voffB);
        PG8_WAIT_V(6); PG8_BAR;
    } else {
        PG8_STAGE(PG8_SB(0, 0), cB, voffB); PG8_STAGE(PG8_SA(0, 0), cA, voffA); PG8_STAGE(PG8_SB(0, 1), cB + hstep, voffB); PG8_STAGE(PG8_SA(0, 1), cA + hstep, voffA);
        if (wr == 1) PG8_BAR;
        PG8_WAIT_V(4); PG8_BAR;
        PG8_STAGE(PG8_SB(1, 0), cB + kstep, voffB); PG8_STAGE(PG8_SA(1, 0), cA + kstep, voffA); PG8_STAGE(PG8_SB(1, 1), cB + hstep + kstep, voffB);
        PG8_WAIT_V(6); PG8_BAR;
    }
    for (;;) {
        const bool has_next = S.next(ui + 1, nxt);
        const unsigned nA = has_next ? (unsigned)nxt.pm * tstep : cA, nB = has_next ? (unsigned)nxt.pn * tstep : cB;
        for (int t = 0; t < nt; t += 2) {
            if constexpr (Epi::HOOK_T >= 0) { if (t == Epi::HOOK_T) E.mid(acc, cur, wr, wc, fr, fq); }
            const bool last = (t == nt - 2);
            const unsigned a1 = cA + (unsigned)(t + 1) * kstep;
            const unsigned a2 = last ? nA : cA + (unsigned)(t + 2) * kstep, b2 = last ? nB : cB + (unsigned)(t + 2) * kstep;
            const unsigned a3 = a2 + kstep, b3 = b2 + kstep;
            if (last && has_next) S.a_ready(nxt);
            if constexpr (SP2) {
            PG8_LDB(B0, 0, 0); PG8_LDB(B1, 0, 1); PG8_SCHED; PG8_LDA(At, 0, 0); PG8_STAGE(PG8_SA(1, 1), a1 + hstep, voffA);
            PG8_WAIT_V(8); PG8_WAIT_L(0); PG8_BAR; PG8_MMA(0, 0, At, B0); PG8_MMA(0, 1, At, B1); PG8_BAR; PG8_SCHED;
            PG8_LDA(At, 0, 1); PG8_STAGE(PG8_SB(0, 0), b2, voffB); PG8_STAGE(PG8_SB(0, 1), b2 + hstep, voffB); PG8_STAGE(PG8_SA(0, 0), a2, voffA);
            PG8_WAIT_V(8); PG8_WAIT_L(0); PG8_BAR; PG8_MMA(1, 0, At, B0); PG8_MMA(1, 1, At, B1); PG8_BAR; PG8_SCHED;
            PG8_LDB(B0, 1, 0); PG8_LDB(B1, 1, 1); PG8_SCHED; PG8_LDA(At, 1, 0); PG8_STAGE(PG8_SA(0, 1), a2 + hstep, voffA);
            PG8_WAIT_V(8); PG8_WAIT_L(0); PG8_BAR; PG8_MMA(0, 0, At, B0); PG8_MMA(0, 1, At, B1); PG8_BAR; PG8_SCHED;
            PG8_LDA(At, 1, 1); PG8_STAGE(PG8_SB(1, 0), b3, voffB); PG8_STAGE(PG8_SB(1, 1), b3 + hstep, voffB); PG8_STAGE(PG8_SA(1, 0), a3, voffA);
            PG8_WAIT_V(8); PG8_WAIT_L(0); PG8_BAR; PG8_MMA(1, 0, At, B0); PG8_MMA(1, 1, At, B1); PG8_BAR; PG8_SCHED;
            } else {
            PG8_LDB(B0, 0, 0); PG8_SCHED; PG8_LDA(At, 0, 0); PG8_STAGE(PG8_SA(1, 1), a1 + hstep, voffA);
            PG8_WAIT_L(8); PG8_BAR; PG8_WAIT_L(0); PG8_MMA(0, 0, At, B0); PG8_BAR; PG8_SCHED;
            PG8_LDB(B1, 0, 1); PG8_STAGE(PG8_SB(0, 0), b2, voffB);
            PG8_BAR; PG8_WAIT_L(0); PG8_MMA(0, 1, At, B1); PG8_BAR;
            PG8_LDA(At, 0, 1); PG8_STAGE(PG8_SA(0, 0), a2, voffA);
            PG8_BAR; PG8_WAIT_L(0); PG8_MMA(1, 0, At, B0); PG8_BAR; PG8_SCHED;
            PG8_STAGE(PG8_SB(0, 1), b2 + hstep, voffB);
            PG8_WAIT_V(6); PG8_BAR; PG8_MMA(1, 1, At, B1); PG8_BAR;
            PG8_LDB(B0, 1, 0); PG8_SCHED; PG8_LDA(At, 1, 0); PG8_STAGE(PG8_SA(0, 1), a2 + hstep, voffA);
            PG8_WAIT_L(8); PG8_BAR; PG8_WAIT_L(0); PG8_MMA(0, 0, At, B0); PG8_BAR; PG8_SCHED;
            PG8_LDB(B1, 1, 1); PG8_STAGE(PG8_SB(1, 0), b3, voffB);
            PG8_BAR; PG8_WAIT_L(0); PG8_MMA(0, 1, At, B1); PG8_BAR;
            PG8_LDA(At, 1, 1); PG8_STAGE(PG8_SA(1, 0), a3, voffA);
            PG8_BAR; PG8_WAIT_L(0); PG8_MMA(1, 0, At, B0); PG8_BAR; PG8_SCHED;
            PG8_STAGE(PG8_SB(1, 1), b3 + hstep, voffB);
            PG8_WAIT_V(6); PG8_BAR; PG8_MMA(1, 1, At, B1); PG8_BAR;
            }
        }
        if constexpr (ALIGN_EPI) { if (wr == 0) PG8_BAR; }
        if constexpr (!Epi::AFTER_DRAIN) { E(acc, cur, wr, wc, fr, fq); S.done(cur); }
        if (!has_next) break;
#pragma unroll
        for (int a = 0; a < 2; ++a)
#pragma unroll
            for (int b = 0; b < 2; ++b)
#pragma unroll
                for (int m = 0; m < 4; ++m)
#pragma unroll
                    for (int n = 0; n < 2; ++n) acc[a][b][m][n] = (f32x4){0.f, 0.f, 0.f, 0.f};
        cur = nxt; cA = nA; cB = nB; ++ui;
        if constexpr (ALIGN_EPI) { if (wr == 1) PG8_BAR; }
    }
    PG8_WAIT_V(0);
    if constexpr (!ALIGN_EPI) { if (wr == 0) PG8_BAR; }
    PG8_BAR;
    if constexpr (Epi::AFTER_DRAIN) { E.fused(acc, cur, wr, wc, fr, fq, lds, wid, lane); S.done(cur); }
#undef PG8_SA
#undef PG8_SB
#undef PG8_STAGE
#undef PG8_LDA
#undef PG8_LDB
#undef PG8_MMA
#undef PG8_CAT
#undef PG8_WAIT_V
#undef PG8_WAIT_L
#undef PG8_BAR
#undef PG8_SCHED
}
}

namespace att {
using bf16 = unsigned short;
constexpr int   D = 128, NW = 8, QBLK = 32, KVBLK = 64;
constexpr float SCALE = 0.088388347648318440f;
constexpr float THR = 8.f;
constexpr int SDEPTH = 2;
constexpr int LDQ = 7680, LDK = 7680;
constexpr int LDY = 1536;
constexpr size_t SHM_V = KVBLK * D * 2, SHM_K = KVBLK * D * 2, SHM_ATTN = 2 * SHM_V + 2 * SHM_K + NW * 64 * 4;
__device__ __forceinline__ float bf2f_(bf16 h) { return __uint_as_float(((unsigned)h) << 16); }
__device__ __forceinline__ bf16 f2bf_(float f) { unsigned u = __float_as_uint(f); return (bf16)((u + 0x7fffu + ((u >> 16) & 1u)) >> 16); }
using bf16x8 = __attribute__((ext_vector_type(8))) short;
using s16x4  = __attribute__((ext_vector_type(4))) short;
using f32x16 = __attribute__((ext_vector_type(16))) float;
using f32x8  = __attribute__((ext_vector_type(8))) float;
using u32x4  = __attribute__((ext_vector_type(4))) unsigned;
using f32x4_ = __attribute__((ext_vector_type(4))) float;
#define KSWZ(row, colB) ((row) * 256 + ((colB) ^ (((row) & 7) << 4)))
#define SBAR() __builtin_amdgcn_sched_barrier(0)
__device__ __forceinline__ int crow(int r, int hi) { return (r & 3) + 8 * (r >> 2) + 4 * hi; }
__device__ __forceinline__ unsigned cvtpk(float lo, float hi) {
  typedef float f32x2_c __attribute__((ext_vector_type(2))); typedef __bf16 bf16x2_c __attribute__((ext_vector_type(2)));
  const f32x2_c v = {lo, hi}; return __builtin_bit_cast(unsigned, __builtin_convertvector(v, bf16x2_c));
}
template <typename TIn> struct Stage;
template <> struct Stage<bf16>  { using T = bf16x8;
  __device__ static __forceinline__ T ld8(const bf16* p) { return *reinterpret_cast<const bf16x8*>(p); }
  __device__ static __forceinline__ bf16x8 tobf(T x) { return x; } };
template <> struct Stage<float> { using T = f32x8;
  __device__ static __forceinline__ T ld8(const float* p) { return *reinterpret_cast<const f32x8*>(p); }
  __device__ static __forceinline__ bf16x8 tobf(T x) {
    u32x4 w = {cvtpk(x[0], x[1]), cvtpk(x[2], x[3]), cvtpk(x[4], x[5]), cvtpk(x[6], x[7])}; return *reinterpret_cast<bf16x8*>(&w); } };

__device__ __forceinline__ void partialSM(f32x16& p0, f32x16& p1, float& m_reg, float& mn, float& alpha) {
  constexpr float C = SCALE * 1.4426950408889634f;
  float pmax = p0[0]; for (int r = 1; r < 16; ++r) pmax = fmaxf(pmax, p0[r]); for (int r = 0; r < 16; ++r) pmax = fmaxf(pmax, p1[r]);
  { auto rr = __builtin_amdgcn_permlane32_swap(__float_as_uint(pmax), __float_as_uint(pmax), false, false);
    pmax = fmaxf(__uint_as_float(rr[0]), __uint_as_float(rr[1])); }
  if (__builtin_expect(__all(pmax - m_reg <= THR / SCALE), 1)) { mn = m_reg; alpha = 1.f; }
  else { mn = fmaxf(m_reg, pmax); alpha = __builtin_amdgcn_exp2f((m_reg - mn) * C); m_reg = mn; }
  float mnC = -mn * C;
  for (int r = 0; r < 16; ++r) p0[r] = fmaf(p0[r], C, mnC); for (int r = 0; r < 16; ++r) p1[r] = fmaf(p1[r], C, mnC);
  for (int r = 0; r < 16; ++r) p0[r] = __builtin_amdgcn_exp2f(p0[r]);
}
__device__ __forceinline__ void finishSM(f32x16& p0, f32x16& p1, float alpha, float& l_reg, bf16x8& pa0, bf16x8& pa1, bf16x8& pa2, bf16x8& pa3) {
  for (int r = 0; r < 16; ++r) p1[r] = __builtin_amdgcn_exp2f(p1[r]);
  float ps = 0; for (int r = 0; r < 16; ++r) ps += p0[r]; for (int r = 0; r < 16; ++r) ps += p1[r];
  { auto rr = __builtin_amdgcn_permlane32_swap(__float_as_uint(ps), __float_as_uint(ps), false, false);
    ps = __uint_as_float(rr[0]) + __uint_as_float(rr[1]); }
  l_reg = l_reg * alpha + ps;
#define PK4(P, BASE, OUT) do { unsigned a0 = cvtpk(P[BASE + 0], P[BASE + 1]), a1 = cvtpk(P[BASE + 2], P[BASE + 3]);   \
    unsigned b0 = cvtpk(P[BASE + 4], P[BASE + 5]), b1 = cvtpk(P[BASE + 6], P[BASE + 7]);                              \
    auto r0 = __builtin_amdgcn_permlane32_swap(a0, b0, false, false); auto r1 = __builtin_amdgcn_permlane32_swap(a1, b1, false, false); \
    u32x4 w = {r0[0], r1[0], r0[1], r1[1]}; OUT = *reinterpret_cast<bf16x8*>(&w); } while (0)
  PK4(p0, 0, pa0); PK4(p0, 8, pa1); PK4(p1, 0, pa2); PK4(p1, 8, pa3);
#undef PK4
}
__device__ __forceinline__ void qkt(f32x16& p0, f32x16& p1, const bf16* Ks, const bf16x8* qr, int r32, int hi) {
  p0 = f32x16{}; p1 = f32x16{};
  for (int d0 = 0; d0 < 8; ++d0) { int cb = (d0 * 16 + hi * 8) * 2;
    bf16x8 b0 = *reinterpret_cast<const bf16x8*>((const char*)Ks + KSWZ(r32, cb));
    bf16x8 b1 = *reinterpret_cast<const bf16x8*>((const char*)Ks + KSWZ(32 + r32, cb));
    p0 = __builtin_amdgcn_mfma_f32_32x32x16_bf16(b0, qr[d0], p0, 0, 0, 0);
    p1 = __builtin_amdgcn_mfma_f32_32x32x16_bf16(b1, qr[d0], p1, 0, 0, 0); }
}
__device__ __forceinline__ int v_st(int k, int c) { const int kk = (k & ~0xC) | ((k & 4) << 1) | ((k & 8) >> 1); return ((kk >> 3) * 4 + (c >> 5)) * 512 + ((kk & 7) * 32 + (c & 31)) * 2; }
__device__ __forceinline__ int v_rd_base(int lane) { return ((lane & 3) << 3) | (((lane >> 2) & 3) << 6) | (((lane >> 4) & 1) << 5) | (((lane >> 5) & 1) << 8); }
constexpr int v_rd_off(int d0, int ks, int half) { return d0 * 512 + ks * 4096 + half * 2048; }
template <int OFF> __device__ __forceinline__ s16x4 tr_read(int vb) {
  s16x4 r; asm volatile("ds_read_b64_tr_b16 %0, %1 offset:%2" : "=&v"(r) : "v"(vb), "i"(OFF) : "memory"); return r;
}
template <int D0> __device__ __forceinline__ void pv_one(f32x16& od, int vb, bf16x8 pa0, bf16x8 pa1, bf16x8 pa2, bf16x8 pa3) {
  const s16x4 l0 = tr_read<v_rd_off(D0, 0, 0)>(vb), h0 = tr_read<v_rd_off(D0, 0, 1)>(vb), l1 = tr_read<v_rd_off(D0, 1, 0)>(vb), h1 = tr_read<v_rd_off(D0, 1, 1)>(vb);
  const s16x4 l2 = tr_read<v_rd_off(D0, 2, 0)>(vb), h2 = tr_read<v_rd_off(D0, 2, 1)>(vb), l3 = tr_read<v_rd_off(D0, 3, 0)>(vb), h3 = tr_read<v_rd_off(D0, 3, 1)>(vb);
  asm volatile("s_waitcnt lgkmcnt(0)" ::: "memory"); SBAR();
#define PK(L, H) (bf16x8){L[0], L[1], L[2], L[3], H[0], H[1], H[2], H[3]}
  od = __builtin_amdgcn_mfma_f32_32x32x16_bf16(pa0, PK(l0, h0), od, 0, 0, 0);
  od = __builtin_amdgcn_mfma_f32_32x32x16_bf16(pa1, PK(l1, h1), od, 0, 0, 0);
  od = __builtin_amdgcn_mfma_f32_32x32x16_bf16(pa2, PK(l2, h2), od, 0, 0, 0);
  od = __builtin_amdgcn_mfma_f32_32x32x16_bf16(pa3, PK(l3, h3), od, 0, 0, 0);
#undef PK
}
__device__ __forceinline__ void pv_d0(f32x16* o, int vb, bf16x8 pa0, bf16x8 pa1, bf16x8 pa2, bf16x8 pa3) {
  pv_one<0>(o[0], vb, pa0, pa1, pa2, pa3); pv_one<1>(o[1], vb, pa0, pa1, pa2, pa3); pv_one<2>(o[2], vb, pa0, pa1, pa2, pa3); pv_one<3>(o[3], vb, pa0, pa1, pa2, pa3);
}

__device__ __forceinline__ void attn_dense_body(const bf16* __restrict__ Qb, const bf16* __restrict__ Kh, const bf16* __restrict__ Vh,
                                                const bf16* __restrict__ Gb, bf16* __restrict__ Yb, int seq, char* lds, const int wave_) {
  using TQ = bf16; using St = Stage<bf16>; using SQ = Stage<TQ>;
  const int wid = wave_, lane = fresh_lane(), tid = wid * 64 + lane, r32 = lane & 31, hi = lane >> 5;
  bf16* V_lds = (bf16*)lds; bf16* K_lds = (bf16*)(lds + 2 * SHM_V);
  float* ws = (float*)(lds + 2 * SHM_V + 2 * SHM_K) + wid * 64; float* li_l = ws; float* al_l = ws + 32;
  float m_reg = -1e30f, l_reg = 0; f32x16 o[4] = {}; bf16x8 qr[8];
  const TQ* Qw = Qb + (long)(wid * QBLK + r32) * LDQ + hi * 8;
#pragma unroll
  for (int d0 = 0; d0 < 8; ++d0) qr[d0] = SQ::tobf(SQ::ld8(Qw + d0 * 16));
  const int sr = tid >> 4, sc = (tid & 15) * 8, vst0 = v_st(sr, sc), vst1 = v_st(32 + sr, sc);
  const unsigned toff = (unsigned)(sr * LDK + sc);
  const int vb0 = (int)(uintptr_t)V_lds + v_rd_base(lane);
  struct { typename St::T vs0, vs1, ks0, ks1; } sr_[SDEPTH];
#define SLOAD(i, k0) do { const bf16* vb_ = Vh + (long)(k0) * LDK; const bf16* kb_ = Kh + (long)(k0) * LDK; \
    sr_[i].vs0 = St::ld8(vb_ + toff); sr_[i].vs1 = St::ld8(vb_ + 32 * LDK + toff); \
    sr_[i].ks0 = St::ld8(kb_ + toff); sr_[i].ks1 = St::ld8(kb_ + 32 * LDK + toff); } while (0)
#define SWRITE(b, i) do { *(bf16x8*)((char*)V_lds + (b) * SHM_V + vst0) = St::tobf(sr_[i].vs0);          \
    *(bf16x8*)((char*)V_lds + (b) * SHM_V + vst1) = St::tobf(sr_[i].vs1); int kc = sc * 2;               \
    *(bf16x8*)((char*)K_lds + (b) * SHM_K + KSWZ(sr, kc)) = St::tobf(sr_[i].ks0);                       \
    *(bf16x8*)((char*)K_lds + (b) * SHM_K + KSWZ(32 + sr, kc)) = St::tobf(sr_[i].ks1); } while (0)
#define SWAIT() do { if constexpr (SDEPTH == 2) asm volatile("s_waitcnt vmcnt(4)" ::: "memory"); else asm volatile("s_waitcnt vmcnt(0)" ::: "memory"); } while (0)
#define RESC(a) do { if (__any((a) < 1.f)) { if (hi == 0) al_l[r32] = (a); asm volatile("s_waitcnt lgkmcnt(0)" ::: "memory"); \
    for (int d = 0; d < 4; ++d) for (int r = 0; r < 16; ++r) o[d][r] *= al_l[crow(r, hi)]; } } while (0)
  f32x16 pA0, pA1, pB0, pB1; float mnA, mnB, alA, alB; bf16x8 pa0, pa1, pa2, pa3; const int NT = seq / KVBLK;
  constexpr int SE = 0, SO = SDEPTH - 1;
  SLOAD(SE, 0); asm volatile("s_waitcnt vmcnt(0)" ::: "memory"); SWRITE(0, SE); __syncthreads();
  qkt(pA0, pA1, K_lds, qr, r32, hi); partialSM(pA0, pA1, m_reg, mnA, alA);
  SLOAD(SO, KVBLK); if constexpr (SDEPTH == 2) { if (2 < NT) SLOAD(SE, 2 * KVBLK); }
  SWAIT(); SWRITE(1, SO); __syncthreads();
  for (int j = 1; j + 1 < NT; j += 2) {
    SBAR(); qkt(pB0, pB1, (bf16*)((char*)K_lds + SHM_K), qr, r32, hi);
    finishSM(pA0, pA1, alA, l_reg, pa0, pa1, pa2, pa3); SBAR();
    SLOAD(SO, (j + SDEPTH) * KVBLK); SBAR();
    pv_d0(o, vb0, pa0, pa1, pa2, pa3); partialSM(pB0, pB1, m_reg, mnB, alB);
    __syncthreads(); SWAIT(); SWRITE(0, SE);
    RESC(alB); __syncthreads();
    SBAR(); qkt(pA0, pA1, K_lds, qr, r32, hi);
    finishSM(pB0, pB1, alB, l_reg, pa0, pa1, pa2, pa3); SBAR();
    if (SDEPTH == 1 || j + 3 < NT) SLOAD(SE, (j + 1 + SDEPTH) * KVBLK); SBAR();
    pv_d0(o, vb0 + (int)SHM_V, pa0, pa1, pa2, pa3); partialSM(pA0, pA1, m_reg, mnA, alA);
    __syncthreads(); SWAIT(); SWRITE(1, SO);
    RESC(alA); __syncthreads();
  }
  SBAR(); qkt(pB0, pB1, (bf16*)((char*)K_lds + SHM_K), qr, r32, hi);
  finishSM(pA0, pA1, alA, l_reg, pa0, pa1, pa2, pa3); SBAR();
  pv_d0(o, vb0, pa0, pa1, pa2, pa3); partialSM(pB0, pB1, m_reg, mnB, alB);
  __syncthreads(); RESC(alB);
  finishSM(pB0, pB1, alB, l_reg, pa0, pa1, pa2, pa3); SBAR();
  pv_d0(o, vb0 + (int)SHM_V, pa0, pa1, pa2, pa3);
  if (hi == 0) li_l[r32] = l_reg; asm volatile("s_waitcnt lgkmcnt(0)" ::: "memory");
  float rli[16];
#pragma unroll
  for (int r = 0; r < 16; ++r) rli[r] = __builtin_amdgcn_rcpf(li_l[crow(r, hi)]);
  __syncthreads();
  { float* stg = (float*)(lds + wid * 16384);
#pragma unroll
    for (int r = 0; r < 16; ++r) { const int orow = crow(r, hi);
#pragma unroll
      for (int d0 = 0; d0 < 4; ++d0) stg[orow * 128 + d0 * 32 + r32] = o[d0][r] * rli[r]; }
    asm volatile("s_waitcnt lgkmcnt(0)" ::: "memory");
    const int ch = lane & 15, rb = lane >> 4;
    const bf16* Gw = Gb + (long)(wid * QBLK + rb) * LDQ + ch * 8; const int yoff = ((wid * QBLK + rb) * LDY + ch * 8) * 2;
    bf16* Yq = Yb; asm volatile("" : "+s"(Yq));
    const __amdgpu_buffer_rsrc_t rsY = __builtin_amdgcn_make_buffer_rsrc((void*)Yq, 0, 0x40000000, 0x00020000);
    u32x4 gq[8];
#pragma unroll
    for (int i = 0; i < 8; ++i) gq[i] = *(const u32x4*)(Gw + (long)(4 * i) * LDQ);
#pragma unroll
    for (int i = 0; i < 8; ++i) { const float* sp = stg + (4 * i + rb) * 128 + ch * 8;
      const f32x4_ a = *(const f32x4_*)sp, b = *(const f32x4_*)(sp + 4); u32x4 w;
      w[0] = cvtpk(a[0] * __uint_as_float(gq[i][0] << 16), a[1] * __uint_as_float(gq[i][0] & 0xffff0000u));
      w[1] = cvtpk(a[2] * __uint_as_float(gq[i][1] << 16), a[3] * __uint_as_float(gq[i][1] & 0xffff0000u));
      w[2] = cvtpk(b[0] * __uint_as_float(gq[i][2] << 16), b[1] * __uint_as_float(gq[i][2] & 0xffff0000u));
      w[3] = cvtpk(b[2] * __uint_as_float(gq[i][3] << 16), b[3] * __uint_as_float(gq[i][3] & 0xffff0000u));
      __builtin_amdgcn_raw_buffer_store_b128(w, rsY, yoff + (4 * i) * LDY * 2, 0, 16); } }
  __syncthreads();
#undef SLOAD
#undef SWRITE
#undef SWAIT
#undef RESC
}

__device__ __forceinline__ void attn_band_unit(const bf16* __restrict__ P, bf16* __restrict__ OG, float* __restrict__ LSE, int g, int b, int h, int blk, int cqb, int ckb, int cvb, int seqlen, int ntok, char* lds, const int wave_) {
  using St = Stage<bf16>;
  const int wid = wave_, lane = fresh_lane(), tid = wid * 64 + lane, r32 = lane & 31, hi = lane >> 5;
  bf16* V_lds = (bf16*)lds; bf16* K_lds = (bf16*)(lds + 2 * SHM_V);
  float* ws = (float*)(lds + 2 * SHM_V + 2 * SHM_K) + wid * 64; float* li_l = ws; float* al_l = ws + 32;
  const int dil = (g == 0) ? 1 : (g == 1 ? 4 : 16), head = g * 4 + h;
  int rq, lq0, ntile, t_lo, res0;
  if (g < 2) { const int kb = (g == 0) ? blk : (blk & 1), nt_all = seqlen / dil / 64; res0 = (g == 0) ? 0 : (blk >> 1);
    rq = res0; lq0 = 256 * kb + 32 * wid; t_lo = (4 * kb - 1 < 0) ? 0 : 4 * kb - 1; const int t_hi = (4 * kb + 5 > nt_all) ? nt_all : 4 * kb + 5; ntile = t_hi - t_lo; }
  else { res0 = 2 * blk; rq = res0 + (wid >> 2); lq0 = 32 * (wid & 3); t_lo = 0; ntile = 4; }
  const long tok0 = (long)b * seqlen;
  const bf16* Pq = P + cqb + head * D; const bf16* Pk = P + ckb + head * D; const bf16* Pv = P + cvb + head * D;
  float m_reg = -1e30f, l_reg = 0; f32x16 o[4] = {}; bf16x8 qr[8];
  { const bf16* Qw = Pq + (tok0 + (long)(lq0 + r32) * dil + rq) * LDQ + hi * 8;
#pragma unroll
    for (int d0 = 0; d0 < 8; ++d0) qr[d0] = St::ld8(Qw + d0 * 16); }
  const int sr = tid >> 4, sc = (tid & 15) * 8, vst0 = v_st(sr, sc), vst1 = v_st(32 + sr, sc);
  const int vb0 = (int)(uintptr_t)V_lds + v_rd_base(lane);
  typename St::T vs0, vs1, ks0, ks1, vt0, vt1, kt0, kt1;
#define TILE_RK(tt) ((g < 2) ? res0 : res0 + ((tt) >> 1))
#define TILE_LK0(tt) ((g < 2) ? 64 * (t_lo + (tt)) : 64 * ((tt) & 1))
#define BLOAD(tt, V0, V1, K0, K1) do { const int rk_ = TILE_RK(tt), lk_ = TILE_LK0(tt); const long ta = (tok0 + (long)(lk_ + sr) * dil + rk_) * LDK + sc, tb = (tok0 + (long)(lk_ + 32 + sr) * dil + rk_) * LDK + sc; \
    V0 = St::ld8(Pv + ta); V1 = St::ld8(Pv + tb); K0 = St::ld8(Pk + ta); K1 = St::ld8(Pk + tb); } while (0)
#define BWRITE(V0, V1, K0, K1) do { *(bf16x8*)((char*)V_lds + vst0) = V0; *(bf16x8*)((char*)V_lds + vst1) = V1; const int kc = sc * 2; \
    *(bf16x8*)((char*)K_lds + KSWZ(sr, kc)) = K0; *(bf16x8*)((char*)K_lds + KSWZ(32 + sr, kc)) = K1; } while (0)
#define BCOMPUTE(tt) do { const int rk = TILE_RK(tt), lk0 = TILE_LK0(tt); \
    const bool need = (rk == rq) && (lk0 + 63 >= lq0 - 64) && (lk0 <= lq0 + 95); \
    if (need) { \
      f32x16 p0, p1; float mn, alpha; bf16x8 pa0, pa1, pa2, pa3; \
      qkt(p0, p1, K_lds, qr, r32, hi); \
      const int dd = lk0 - lq0 - r32 + 4 * hi;                      \
      _Pragma("unroll") for (int r = 0; r < 16; ++r) { const int d0_ = dd + (r & 3) + 8 * (r >> 2), d1_ = d0_ + 32; \
        if (d0_ < -64 || d0_ > 64) p0[r] = -INFINITY; if (d1_ < -64 || d1_ > 64) p1[r] = -INFINITY; } \
      partialSM(p0, p1, m_reg, mn, alpha); \
      if (__any(alpha < 1.f)) { if (hi == 0) al_l[r32] = alpha; asm volatile("s_waitcnt lgkmcnt(0)" ::: "memory"); \
        _Pragma("unroll") for (int d = 0; d < 4; ++d) _Pragma("unroll") for (int r = 0; r < 16; ++r) o[d][r] *= al_l[crow(r, hi)]; } \
      finishSM(p0, p1, alpha, l_reg, pa0, pa1, pa2, pa3); SBAR(); \
      pv_d0(o, vb0, pa0, pa1, pa2, pa3); \
    } } while (0)
  BLOAD(0, vs0, vs1, ks0, ks1); if (ntile > 1) BLOAD(1, vt0, vt1, kt0, kt1);
  for (int tt = 0; tt < ntile; tt += 2) {
    __syncthreads();
    BWRITE(vs0, vs1, ks0, ks1);
    __syncthreads();
    if (tt + 2 < ntile) BLOAD(tt + 2, vs0, vs1, ks0, ks1);
    BCOMPUTE(tt);
    if (tt + 1 < ntile) {
      __syncthreads();
      BWRITE(vt0, vt1, kt0, kt1);
      __syncthreads();
      if (tt + 3 < ntile) BLOAD(tt + 3, vt0, vt1, kt0, kt1);
      BCOMPUTE(tt + 1);
    }
  }
#undef BWRITE
#undef BCOMPUTE
#undef BLOAD
#undef TILE_RK
#undef TILE_LK0
  if (hi == 0) li_l[r32] = l_reg; asm volatile("s_waitcnt lgkmcnt(0)" ::: "memory");
  float rli[16];
#pragma unroll
  for (int r = 0; r < 16; ++r) rli[r] = __builtin_amdgcn_rcpf(li_l[crow(r, hi)]);
  __syncthreads();
  { float* stg = (float*)(lds + wid * 16384);
#pragma unroll
    for (int r = 0; r < 16; ++r) { const int orow = crow(r, hi);
#pragma unroll
      for (int d0 = 0; d0 < 4; ++d0) stg[orow * 128 + d0 * 32 + r32] = o[d0][r] * rli[r]; }
    asm volatile("s_waitcnt lgkmcnt(0)" ::: "memory");
    const int ch = lane & 15, rb = lane >> 4;
    bf16* OGq = OG; asm volatile("" : "+s"(OGq));
    const __amdgpu_buffer_rsrc_t rsOG = __builtin_amdgcn_make_buffer_rsrc((void*)OGq, 0, 3 * 8192 * 512 * 2, 0x00020000);
#pragma unroll
    for (int i = 0; i < 8; ++i) { const int row = 4 * i + rb; const float* sp = stg + row * 128 + ch * 8;
      const f32x4_ a = *(const f32x4_*)sp, b = *(const f32x4_*)(sp + 4); u32x4 w;
      w[0] = cvtpk(a[0], a[1]); w[1] = cvtpk(a[2], a[3]); w[2] = cvtpk(b[0], b[1]); w[3] = cvtpk(b[2], b[3]);
      __builtin_amdgcn_raw_buffer_store_b128(w, rsOG, (int)(((long)g * ntok * 512 + h * D + ch * 8 + (tok0 + (long)(lq0 + row) * dil + rq) * 512) * 2), 0, 16); } }
  if (hi == 0) __hip_atomic_store(LSE + ((long)g * ntok + tok0 + (long)(lq0 + r32) * dil + rq) * 4 + h, m_reg * SCALE + __logf(l_reg), __ATOMIC_RELAXED, __HIP_MEMORY_SCOPE_AGENT);
  __syncthreads();
}
}

typedef unsigned short bf16_t;
constexpr int BATCH = 4, SEQ = 2048, DM = 2048, NTOK = BATCH * SEQ, NC = 11776;
constexpr int C_QA = 0, C_KA = 1024, C_VA = 1280, C_GA = 1536, C_QB = 2560, C_KB = 4096, C_VB = 5632, C_GB = 7168, C_ZA = 7680, C_ZB = 9728;
constexpr float EPS = 1e-6f;
constexpr float H8_SCALE = 4.0f, W8_SCALE = 64.0f;
constexpr size_t MiB = 1u << 20;
constexpr int PITCH = 7680;
constexpr size_t WS_CTL = 0, WS_TAB = 1 * MiB, WS_XB = 1 * MiB + 512 * 1024, WS_WTIN = 2 * MiB, WS_WTAB = 48 * MiB, WS_WTO = 54 * MiB, WS_HB = 64 * MiB, WS_P = 96 * MiB, WS_Y = 216 * MiB, WS_OG = 240 * MiB, WS_LSE = 264 * MiB,
                 WS_SA = 266 * MiB, WS_SB = 298 * MiB, WS_H8 = 330 * MiB, WS_WTZ8 = 346 * MiB, WS_END = 361 * MiB;

#define LAS __attribute__((address_space(3)))
typedef float f32x4 __attribute__((ext_vector_type(4)));
typedef unsigned v4u __attribute__((ext_vector_type(4)));
constexpr int NWAVES = 8;
constexpr int LDS_BYTES = 147456;

__device__ __forceinline__ float bf2f(bf16_t h) { return __uint_as_float(((unsigned)h) << 16); }
__device__ __forceinline__ unsigned f2bf_u(float f) { unsigned u = __float_as_uint(f); return (u + 0x7fffu + ((u >> 16) & 1u)) >> 16; }
__device__ __forceinline__ bf16_t f2bf(float f) { return (bf16_t)f2bf_u(f); }
__device__ __forceinline__ unsigned pk2(float lo, float hi) { return f2bf_u(lo) | (f2bf_u(hi) << 16); }
__device__ __forceinline__ float wave_sum(float v) {
#pragma unroll
    for (int o = 1; o < 64; o <<= 1) v += __shfl_xor(v, o);
    return v;
}

__device__ __forceinline__ int colmap(int kind, int p) {
    const int bj = p >> 7, wc = (p >> 5) & 3, n = (p >> 4) & 1, fq = (p >> 2) & 3, j = p & 3;
    const int gen = 128 * bj + 32 * wc + 8 * fq + 4 * n + j;
    if (kind == 0) return p;
    if (kind == 1) return gen;
    if (kind == 2) return 128 * bj + 64 * (wc >> 1) + 32 * n + 16 * (wc & 1) + 4 * fq + j;
    return wc == 0 ? p : gen;
}
__device__ __forceinline__ int kind_in(int pn) { return pn < 5 ? 2 : ((pn >= 10 && pn < 22) ? 3 : 1); }

struct TrSrc { const float* W; int N; bf16_t* WT; int ldt, koff, kindsel; unsigned char* wt8; int n8; };
__device__ __forceinline__ void tr_load(const TrSrc& t, int item, int lane, f32x4 (&v)[8]) {
    const int nblk = t.N / 32, kb = item / nblk, nb = item % nblk, k0 = 64 * kb, n0 = 32 * nb;
    const int np = n0 + 4 * (lane & 7), pn = np >> 8;
    const int kind = t.kindsel < 0 ? kind_in(pn) : t.kindsel;
    const float* src = t.W + (size_t)(k0 + (lane >> 3)) * t.N + (pn << 8) + colmap(kind, np & 255);
#pragma unroll
    for (int i = 0; i < 8; ++i) v[i] = __builtin_nontemporal_load((const f32x4*)(src + (size_t)(8 * i) * t.N));
}
__device__ __forceinline__ void tr_store(const TrSrc& t, int item, int lane, const f32x4 (&v)[8], LAS float* scr) {
    const int nblk = t.N / 32, kb = item / nblk, nb = item % nblk, k0 = 64 * kb, n0 = 32 * nb;
    { LAS float* d = scr + (lane >> 3) * 33 + 4 * (lane & 7);
#pragma unroll
      for (int i = 0; i < 8; ++i) { d[i * 264 + 0] = v[i][0]; d[i * 264 + 1] = v[i][1]; d[i * 264 + 2] = v[i][2]; d[i * 264 + 3] = v[i][3]; } }
    asm volatile("s_waitcnt lgkmcnt(0)" ::: "memory");
    const int c = lane & 7;
    const int pn_ = n0 >> 8; const bool is8 = t.wt8 != nullptr && (n0 >= t.n8 || pn_ < 14);
    const int n8row = n0 >= t.n8 ? n0 - t.n8 + 14 * 256 : n0;
    if (is8) {
#pragma unroll
        for (int j = 0; j < 4; ++j) { const int n = (lane >> 3) + 8 * j; const LAS float* sp = scr + (8 * c) * 33 + n;
            int lo = 0, hi = 0;
            lo = __builtin_amdgcn_cvt_pk_fp8_f32(sp[0 * 33] * W8_SCALE, sp[1 * 33] * W8_SCALE, lo, false); lo = __builtin_amdgcn_cvt_pk_fp8_f32(sp[2 * 33] * W8_SCALE, sp[3 * 33] * W8_SCALE, lo, true);
            hi = __builtin_amdgcn_cvt_pk_fp8_f32(sp[4 * 33] * W8_SCALE, sp[5 * 33] * W8_SCALE, hi, false); hi = __builtin_amdgcn_cvt_pk_fp8_f32(sp[6 * 33] * W8_SCALE, sp[7 * 33] * W8_SCALE, hi, true);
            *(unsigned long long*)(t.wt8 + (size_t)(n8row + n) * t.ldt + k0 + 8 * c) = (unsigned long long)(unsigned)lo | ((unsigned long long)(unsigned)hi << 32); }
    } else {
#pragma unroll
    for (int j = 0; j < 4; ++j) { const int n = (lane >> 3) + 8 * j; const LAS float* sp = scr + (8 * c) * 33 + n;
        v4u o; o.x = pk2(sp[0 * 33], sp[1 * 33]); o.y = pk2(sp[2 * 33], sp[3 * 33]); o.z = pk2(sp[4 * 33], sp[5 * 33]); o.w = pk2(sp[6 * 33], sp[7 * 33]);
        *(v4u*)(t.WT + (size_t)(n0 + n) * t.ldt + t.koff + k0 + 8 * c) = o; }
    }
    asm volatile("s_waitcnt lgkmcnt(0)" ::: "memory");
}
__device__ __forceinline__ void tr_matrix(const TrSrc& t, int nitems, int gw, int NGW, int lane, LAS float* scr) {
    f32x4 a[8], b[8];
    int it = gw;
    if (it < nitems) tr_load(t, it, lane, a);
    for (; it < nitems; it += 2 * NGW) {
        const bool hb = it + NGW < nitems;
        if (hb) tr_load(t, it + NGW, lane, b);
        tr_store(t, it, lane, a, scr);
        if (hb) { if (it + 2 * NGW < nitems) tr_load(t, it + 2 * NGW, lane, a); tr_store(t, it + NGW, lane, b, scr); }
    }
}
__device__ __forceinline__ void rms_row_load(const float* xrow, int lane, f32x4 (&v)[8]) {
    const f32x4* xr = (const f32x4*)xrow + lane;
#pragma unroll
    for (int j = 0; j < 8; ++j) v[j] = __builtin_nontemporal_load(xr + 64 * j);
}
__device__ __forceinline__ void rms_row_store(const f32x4 (&v)[8], const float* gain, bf16_t* orow, unsigned char* orow8, int lane) {
    const f32x4* gr = (const f32x4*)gain + lane; float s = 0.f;
#pragma unroll
    for (int j = 0; j < 8; ++j) s += (v[j].x * v[j].x + v[j].y * v[j].y) + (v[j].z * v[j].z + v[j].w * v[j].w);
    const float rs = rsqrtf(wave_sum(s) * (1.f / DM) + EPS);
    unsigned long long* o8 = (unsigned long long*)orow + lane;
    unsigned* q8 = (unsigned*)orow8 + lane;
#pragma unroll
    for (int j = 0; j < 8; ++j) { const f32x4 g = gr[64 * j]; const f32x4 y = v[j] * rs * g;
        o8[64 * j] = (unsigned long long)pk2(y.x, y.y) | ((unsigned long long)pk2(y.z, y.w) << 32);
        int w = 0; w = __builtin_amdgcn_cvt_pk_fp8_f32(y.x * H8_SCALE, y.y * H8_SCALE, w, false); w = __builtin_amdgcn_cvt_pk_fp8_f32(y.z * H8_SCALE, y.w * H8_SCALE, w, true);
        q8[64 * j] = (unsigned)w; }
}
__device__ __forceinline__ void rms_rows(const float* x, const float* gain, bf16_t* H, unsigned char* H8, int m0, int step, int nrows, int lane) {
    f32x4 a[8], b[8];
    int m = m0;
    if (m < nrows) rms_row_load(x + (size_t)m * DM, lane, a);
    for (; m < nrows; m += 2 * step) {
        const bool hb = m + step < nrows;
        if (hb) rms_row_load(x + (size_t)(m + step) * DM, lane, b);
        rms_row_store(a, gain, H + (size_t)m * DM, H8 + (size_t)m * DM, lane);
        if (hb) { if (m + 2 * step < nrows) rms_row_load(x + (size_t)(m + 2 * step) * DM, lane, a); rms_row_store(b, gain, H + (size_t)(m + step) * DM, H8 + (size_t)(m + step) * DM, lane); }
    }
}

#define XB_TMO      128
#define XB_XCNT(j)  (256  + 64 * (j))
#define XB_XSUB(j)  (1280 + 64 * (j))
#define XB_XGEN(j)  (2304 + 64 * (j))
#define XB_TOP      3328
#define XB_TOPGEN   3392
#define XCD_BAR_WORDS 3456
#define XB_SPIN_CAP (1u << 18)

__device__ __forceinline__ unsigned xb_ld(unsigned* p)              { return __hip_atomic_load(p, __ATOMIC_RELAXED, __HIP_MEMORY_SCOPE_AGENT); }
__device__ __forceinline__ unsigned xb_add(unsigned* p, unsigned v) { return __hip_atomic_fetch_add(p, v, __ATOMIC_RELAXED, __HIP_MEMORY_SCOPE_AGENT); }
__device__ __forceinline__ unsigned xb_xcc_id() { return (unsigned)__builtin_amdgcn_s_getreg((3 << 11) | 20) & 0xFu; }
#define XB_SPIN(cond, bar) do { unsigned _sp = 0; while (cond) { __builtin_amdgcn_s_sleep(1); \
    if ((++_sp & 255u) == 0u) { if (xb_ld(&(bar)[XB_TMO])) break; if (_sp > XB_SPIN_CAP) { atomicAdd(&(bar)[XB_TMO], 1u); break; } } } } while (0)

struct XcdBarrier {
    unsigned* bar; unsigned x;
    volatile LAS unsigned* st;
};

__device__ __forceinline__ XcdBarrier xcd_barrier_post(unsigned* bar, volatile LAS unsigned* st) {
    XcdBarrier b; b.bar = bar; b.x = xb_xcc_id(); b.st = st;
    if (threadIdx.x == 0) (void)xb_add(&bar[XB_XCNT(b.x)], 1u);
    return b;
}
__device__ __forceinline__ void xcd_barrier_complete(unsigned* bar, unsigned x, unsigned& nloc, unsigned& nx) {
    const unsigned G = gridDim.x * gridDim.y * gridDim.z;
    unsigned sum, cnt, mine, sp = 0u;
    for (;;) {
        sum = 0u; cnt = 0u; mine = 0u;
#pragma unroll
        for (unsigned j = 0; j < 16; ++j) { const unsigned c = xb_ld(&bar[XB_XCNT(j)]); sum += c; cnt += (c > 0u) ? 1u : 0u; mine = (j == x) ? c : mine; }
        if (sum == G) break;
        __builtin_amdgcn_s_sleep(1);
        if ((++sp & 255u) == 0u) { if (xb_ld(&bar[XB_TMO])) break; if (sp > XB_SPIN_CAP) { atomicAdd(&bar[XB_TMO], 1u); break; } }
    }
    nloc = mine > 0u ? mine : 1u; nx = cnt > 0u ? cnt : 1u;
}

__device__ __forceinline__ void xcd_barrier(const XcdBarrier& b, const int wave_) {
    asm volatile("s_waitcnt vmcnt(0)" ::: "memory");
    __syncthreads();
    if (wave_ == 0 && fresh_lane() == 0) {
        unsigned* bar = b.bar;
        __builtin_amdgcn_s_waitcnt(0);
        unsigned nloc = b.st[0], nx = b.st[1];
        if (nloc == 0u) { xcd_barrier_complete(bar, b.x, nloc, nx); b.st[0] = nloc; b.st[1] = nx; }
        const unsigned old = xb_add(&bar[XB_XSUB(b.x)], 1u);
        const unsigned gen = old / nloc;
        if (old + 1u == (gen + 1u) * nloc) {
            __builtin_amdgcn_fence(__ATOMIC_RELEASE, "agent");
            asm volatile("s_waitcnt vmcnt(0)" ::: "memory");
            const unsigned og = xb_add(&bar[XB_TOP], 1u);
            const unsigned tg = og / nx;
            if (og + 1u == (tg + 1u) * nx) xb_add(&bar[XB_TOPGEN], 1u);
            else XB_SPIN(xb_ld(&bar[XB_TOPGEN]) == tg, bar);
            __builtin_amdgcn_fence(__ATOMIC_ACQUIRE, "agent");
            xb_add(&bar[XB_XGEN(b.x)], 1u);
            asm volatile("s_waitcnt vmcnt(0)" ::: "memory");
        } else {
            XB_SPIN(xb_ld(&bar[XB_XGEN(b.x)]) == gen, bar);
            __builtin_amdgcn_fence(__ATOMIC_ACQUIRE, "agent");
            asm volatile("s_waitcnt vmcnt(0)" ::: "memory");
        }
    }
    __syncthreads();
}

struct Args { const float* in[10]; float* out; unsigned char* ws; int ph_lo, ph_hi; };

__global__ void __launch_bounds__(NWAVES * 64, 2) mk_fwd(Args args) {
    extern __shared__ __attribute__((aligned(16))) unsigned char lds[];
    const int wave = __builtin_amdgcn_readfirstlane((int)threadIdx.x >> 6);
#define TID_LANE const int lane = fresh_lane(); const int tid = wave * 64 + lane; (void)tid; (void)lane;
    const int G = gridDim.x, bx = blockIdx.x;
    const int vcu = (G % 8 == 0) ? (bx % 8) * (G / 8) + bx / 8 : bx;
    unsigned char* ws = args.ws;
    const float* x = args.in[0]; const float* ng = args.in[1]; const float* w_in = args.in[2];
    bf16_t* WT_IN = (bf16_t*)(ws + WS_WTIN); bf16_t* HB = (bf16_t*)(ws + WS_HB); bf16_t* P = (bf16_t*)(ws + WS_P);
    float* COSA = (float*)(ws + WS_TAB); float* SINA = COSA + 2048; float* COSP = COSA + 4096; float* SINP = COSP + 32768;
    bf16_t* OG = (bf16_t*)(ws + WS_OG); float* LSE = (float*)(ws + WS_LSE); unsigned* CTL = (unsigned*)(ws + WS_CTL) + 4096;
    bf16_t* WT_AB = (bf16_t*)(ws + WS_WTAB); bf16_t* WT_O = (bf16_t*)(ws + WS_WTO); bf16_t* Y = (bf16_t*)(ws + WS_Y); bf16_t* MG = HB; unsigned char* H8 = ws + WS_H8; unsigned char* WTZ8 = ws + WS_WTZ8; bf16_t* SA = (bf16_t*)(ws + WS_SA); bf16_t* SB = (bf16_t*)(ws + WS_SB); float* XB = (float*)(ws + WS_XB); unsigned* PCNT = (unsigned*)(ws + WS_CTL) + 8192; unsigned* PC2 = (unsigned*)(ws + WS_CTL) + 10240;
    const int lo = args.ph_lo, hi = args.ph_hi;
    volatile LAS unsigned* MISC = (volatile LAS unsigned*)((LAS unsigned char*)lds + 131072 + 320);
    if (threadIdx.x < 32) MISC[threadIdx.x] = 0u;
    __syncthreads();
    XcdBarrier bar = xcd_barrier_post((unsigned*)(ws + WS_CTL), MISC + 8);
#define GRID_BAR() xcd_barrier(bar, wave)
#define IN(k) (lo <= (k) && (k) < hi)
#define BOTH(k) (IN(k) && IN((k) + 1))
    if (IN(0)) { TID_LANE
        LAS float* scr = (LAS float*)((LAS unsigned char*)lds + wave * 16384);
        const int gw = vcu * NWAVES + wave, NGW = G * NWAVES;
        constexpr int I_IN = (DM / 64) * (NC / 32);
        { const TrSrc t{w_in, NC, WT_IN, DM, 0, -1, WTZ8, 7680}; tr_matrix(t, I_IN, gw, NGW, lane, scr); }
        for (int i = bx * (NWAVES * 64) + tid; i < 2048 + 32768; i += G * NWAVES * 64) {
            if (i < 2048) { const int pos = i >> 5, fi = i & 31; const float a = (float)pos * (1.0f / powf(10000.0f, (float)fi / 32.0f)); COSA[i] = cosf(a); SINA[i] = sinf(a); }
            else { const int k = i - 2048, pos = k >> 4, fi = k & 15; const float a = (float)pos * (1.0f / powf(500000.0f, (float)fi / 16.0f)); COSP[k] = cosf(a); SINP[k] = sinf(a); }
        }
        rms_rows(x, ng, HB, H8, gw, NGW, NTOK, lane);
        if (BOTH(0)) GRID_BAR();
    }
    if (IN(1)) { TID_LANE
        const float dsc = 1.0f / (H8_SCALE * W8_SCALE);
        {
            pg8::Gemm g{HB, WT_IN + (size_t)14 * 256 * DM, NTOK, 16 * 256, DM}; pg8::StaticOrder S; S.init(NTOK, 16 * 256, G, bx, 8);
            pg8::EpiIn<false> E{P, PITCH, COSA, SINA, COSP, SINP, args.in[3], args.in[4], args.in[5], SA, SB, (LAS float*)((LAS unsigned char*)lds + 131072 + 1024), EPS, 1.0f};
            pg8::gemm_phase<pg8::EpiIn<false>, pg8::StaticOrder, true, true>((LAS unsigned char*)lds, g, S, E, wave);
        }
        {
            pg8::Gemm g8{(const bf16_t*)H8, (const bf16_t*)WTZ8, NTOK, 30 * 256, DM / 2}; pg8::StaticOrder S8; S8.init(NTOK, 30 * 256, G, bx, 4);
            pg8::EpiIn<true> E8{P, PITCH, COSA, SINA, COSP, SINP, args.in[3], args.in[4], args.in[5], SA, SB, (LAS float*)((LAS unsigned char*)lds + 131072 + 1024), EPS, dsc};
            pg8::gemm_phase<pg8::EpiIn<true>, pg8::StaticOrder, true, true>((LAS unsigned char*)lds, g8, S8, E8, wave);
        }
        const int nheavy = ((NTOK / 256) * 30) % G;
        {
            const int first = nheavy > 0 ? nheavy : 0, nidle = G - first;
            if (bx >= first) {
                LAS float* scr = (LAS float*)((LAS unsigned char*)lds + wave * 16384);
                const int gw2 = (bx - first) * NWAVES + wave, NGW2 = nidle * NWAVES;
                constexpr int I_A = (1024 / 64) * (DM / 32), I_B = (512 / 64) * (DM / 32), I_O = (DM / 64) * (DM / 32);
                { const TrSrc t{args.in[6], DM, WT_AB, 1536, 0, 1, nullptr, 0}; tr_matrix(t, I_A, gw2, NGW2, lane, scr); }
                { const TrSrc t{args.in[7], DM, WT_AB, 1536, 1024, 1, nullptr, 0}; tr_matrix(t, I_B, gw2, NGW2, lane, scr); }
                { const TrSrc t{args.in[8], DM, WT_O, DM, 0, 0, nullptr, 0}; tr_matrix(t, I_O, gw2, NGW2, lane, scr); }
            }
        }
        if (BOTH(1)) GRID_BAR();
    }
    if (IN(2)) { TID_LANE
        for (int u = bx; u < 384; u += G) {
            const int blk = u & 7, h = (u >> 3) & 3, b = (u >> 5) & 3, g = u >> 7;
            att::attn_band_unit(P, OG, LSE, g, b, h, blk, C_QB, C_KB, C_VB, SEQ, NTOK, (char*)lds, wave);
        }
        asm volatile("s_waitcnt vmcnt(0)" ::: "memory"); __syncthreads();
        if (tid == 0) __hip_atomic_fetch_add(CTL, 1u, __ATOMIC_RELAXED, __HIP_MEMORY_SCOPE_AGENT);
        for (int u = bx; u < 256; u += G) {
            const int pair = u & 7, inner = u >> 3, b = pair >> 1, hkv = pair & 1, hq = hkv * 4 + (inner >> 3), qb = inner & 7;
            const size_t row0 = (size_t)b * SEQ + qb * 256;
            att::attn_dense_body(P + row0 * PITCH + C_QA + hq * 128, P + (size_t)b * SEQ * PITCH + C_KA + hkv * 128, P + (size_t)b * SEQ * PITCH + C_VA + hkv * 128,
                                 P + row0 * PITCH + C_GA + hq * 128, Y + row0 * 1536 + hq * 128, SEQ, (char*)lds, wave);
            if (G == 256) { asm volatile("s_waitcnt vmcnt(0)" ::: "memory"); __syncthreads();
                if (tid == 0) __hip_atomic_fetch_add(PC2 + 64 * (b * 8 + qb), 1u, __ATOMIC_RELAXED, __HIP_MEMORY_SCOPE_AGENT); }
        }
        const int mfirst = (384 - G > 0 && 384 - G < G) ? 384 - G : 0, nmerge = G - mfirst;
        if (bx >= mfirst) {
            if (tid == 0) { unsigned spins = 0; while (__hip_atomic_load(CTL, __ATOMIC_RELAXED, __HIP_MEMORY_SCOPE_AGENT) < (unsigned)G) { __builtin_amdgcn_s_sleep(4); if (++spins > (1u << 24)) break; }
                __builtin_amdgcn_fence(__ATOMIC_ACQUIRE, "agent"); asm volatile("s_waitcnt vmcnt(0)" ::: "memory"); }
            __syncthreads();
            const int mj = bx - mfirst, mbase = (G == 256) ? (256 * (mj >> 2) + 64 * (mj & 3)) * 64 : mj * (NWAVES * 64), mend = (G == 256) ? mbase + 64 * 64 : NTOK * 64, mstep = (G == 256) ? NWAVES * 64 : nmerge * NWAVES * 64;
            const __amdgpu_buffer_rsrc_t rsYm = __builtin_amdgcn_make_buffer_rsrc((void*)Y, 0, NTOK * 1536 * 2, 0x00020000);
            for (int c0 = mbase + tid; c0 < mend; c0 += 2 * mstep) {
                v4u a0[2], a1[2], a2[2], gz[2]; float e0[2], e1[2], e2[2]; int tok[2], c8[2]; bool ok[2];
#pragma unroll
                for (int q = 0; q < 2; ++q) { const int ci = c0 + q * mstep; ok[q] = ci < mend; const int cj = ok[q] ? ci : c0; tok[q] = cj >> 6; c8[q] = (cj & 63) * 8; const int h = c8[q] >> 7;
                    e0[q] = LSE[((size_t)0 * NTOK + tok[q]) * 4 + h]; e1[q] = LSE[((size_t)1 * NTOK + tok[q]) * 4 + h]; e2[q] = LSE[((size_t)2 * NTOK + tok[q]) * 4 + h];
                    a0[q] = *(const v4u*)(OG + ((size_t)0 * NTOK + tok[q]) * 512 + c8[q]); a1[q] = *(const v4u*)(OG + ((size_t)1 * NTOK + tok[q]) * 512 + c8[q]); a2[q] = *(const v4u*)(OG + ((size_t)2 * NTOK + tok[q]) * 512 + c8[q]);
                    gz[q] = *(const v4u*)(P + (size_t)tok[q] * PITCH + C_GB + c8[q]); }
#pragma unroll
                for (int q = 0; q < 2; ++q) { const float mx = fmaxf(e0[q], fmaxf(e1[q], e2[q])); float w0 = __expf(e0[q] - mx), w1 = __expf(e1[q] - mx), w2 = __expf(e2[q] - mx); const float inv = 1.f / (w0 + w1 + w2); w0 *= inv; w1 *= inv; w2 *= inv;
                    v4u w;
#pragma unroll
                    for (int e = 0; e < 4; ++e) {
                        const float lo = w0 * __uint_as_float(a0[q][e] << 16) + w1 * __uint_as_float(a1[q][e] << 16) + w2 * __uint_as_float(a2[q][e] << 16);
                        const float hh = w0 * __uint_as_float(a0[q][e] & 0xffff0000u) + w1 * __uint_as_float(a1[q][e] & 0xffff0000u) + w2 * __uint_as_float(a2[q][e] & 0xffff0000u);
                        w[e] = pk2(lo * __uint_as_float(gz[q][e] << 16), hh * __uint_as_float(gz[q][e] & 0xffff0000u)); }
                    if (ok[q]) __builtin_amdgcn_raw_buffer_store_b128(w, rsYm, (int)(((size_t)tok[q] * 1536 + 1024 + c8[q]) * 2), 0, 16); }
            }
            if (G == 256) { asm volatile("s_waitcnt vmcnt(0)" ::: "memory"); __syncthreads(); if (tid == 0) __hip_atomic_fetch_add(PC2 + 64 * (mj >> 2), 1u, __ATOMIC_RELAXED, __HIP_MEMORY_SCOPE_AGENT); }
        }
        if (BOTH(2) && G != 256) GRID_BAR();
    }
    if (IN(3)) {
        pg8::Gemm g{Y, WT_AB, NTOK, DM, 1536}; pg8::StaticOrder S; S.init(NTOK, DM, G, bx, 4);
        if (G == 256 && IN(2)) {
            pg8::Unit u2; if (S.next(0, u2)) {
                unsigned* pc2 = PC2 + 64 * u2.pm;
                if (wave == 0 && fresh_lane() == 0) { unsigned spins = 0; while (__hip_atomic_load(pc2, __ATOMIC_RELAXED, __HIP_MEMORY_SCOPE_AGENT) < 12u) { __builtin_amdgcn_s_sleep(2); if (++spins > (1u << 22)) break; }
                    __builtin_amdgcn_fence(__ATOMIC_ACQUIRE, "agent"); asm volatile("s_waitcnt vmcnt(0)" ::: "memory"); }
                __syncthreads(); } }
        pg8::EpiMerge2 E{SA, SB, MG, DM};
        pg8::gemm_phase<pg8::EpiMerge2, pg8::StaticOrder, true, true>((LAS unsigned char*)lds, g, S, E, wave);
        if (BOTH(3)) {
            pg8::Unit u3; const bool has = S.next(0, u3);
            if (G == 256 && has) {
                unsigned* pc3 = (unsigned*)(ws + WS_CTL) + 5120 + 64 * u3.pm;
                asm volatile("s_waitcnt vmcnt(0)" ::: "memory"); __syncthreads();
                if (wave == 0 && fresh_lane() == 0) {
                    __hip_atomic_fetch_add(pc3, 1u, __ATOMIC_RELAXED, __HIP_MEMORY_SCOPE_AGENT);
                    unsigned spins = 0; while (__hip_atomic_load(pc3, __ATOMIC_RELAXED, __HIP_MEMORY_SCOPE_AGENT) < 8u) { __builtin_amdgcn_s_sleep(2); if (++spins > (1u << 22)) break; }
                    __builtin_amdgcn_fence(__ATOMIC_ACQUIRE, "agent"); asm volatile("s_waitcnt vmcnt(0)" ::: "memory"); }
                __syncthreads();
            } else GRID_BAR();
        }
    }
    if (IN(4)) {
        pg8::Gemm g{MG, WT_O, NTOK, DM, DM}; pg8::StaticOrder S; S.init(NTOK, DM, G, bx, 4);
        pg8::EpiResidNorm E{x, args.out, DM, args.in[9], XB, PCNT, 8, EPS};
        if (G == 256) pg8::gemm_phase<pg8::EpiResidNorm, pg8::StaticOrder, false, true>((LAS unsigned char*)lds, g, S, E, wave);
    }
#undef IN
#undef BOTH
}


extern "C" void kernel_launch(void* const* d_in, const int* in_sizes, int n_in, void* d_out, int out_size, void* d_ws, size_t ws_size, hipStream_t stream) {
    static int grid = 0;
    if (grid == 0) {
        if (n_in != 10 || in_sizes[0] != NTOK * DM || out_size != NTOK * DM || ws_size < WS_END) { fprintf(stderr, "kernel_launch: unexpected shapes / workspace (%zu)\n", ws_size); grid = -1; return; }
        int dev = 0, cus = 0, per_cu = 0;
        if (hipGetDevice(&dev) != hipSuccess || hipDeviceGetAttribute(&cus, hipDeviceAttributeMultiprocessorCount, dev) != hipSuccess) { grid = -1; return; }
        if (hipFuncSetAttribute((const void*)mk_fwd, hipFuncAttributeMaxDynamicSharedMemorySize, LDS_BYTES) != hipSuccess) { fprintf(stderr, "kernel_launch: hipFuncSetAttribute failed\n"); grid = -1; return; }
        if (hipOccupancyMaxActiveBlocksPerMultiprocessor(&per_cu, (const void*)mk_fwd, NWAVES * 64, LDS_BYTES) != hipSuccess || per_cu < 1) { fprintf(stderr, "kernel_launch: occupancy query says %d\n", per_cu); grid = -1; return; }
        grid = cus;
    }
    if (grid < 0) return;
    if (hipMemsetAsync((char*)d_ws + WS_CTL, 0, 131072, stream) != hipSuccess) { fprintf(stderr, "kernel_launch: memset failed\n"); return; }
    Args a{};
    for (int i = 0; i < 10; ++i) a.in[i] = (const float*)d_in[i];
    a.out = (float*)d_out; a.ws = (unsigned char*)d_ws; a.ph_lo = 0; a.ph_hi = 5;
    void* kargs[] = {&a};
    hipError_t e = hipLaunchCooperativeKernel((const void*)mk_fwd, dim3(grid), dim3(NWAVES * 64), kargs, LDS_BYTES, stream);
    if (e != hipSuccess) fprintf(stderr, "kernel_launch: cooperative launch failed: %s (grid %d)\n", hipGetErrorString(e), grid);
}
```

```cpp
#include <hip/hip_runtime.h>
#include <cstdio>
#include <cstdint>
#include <cmath>
__device__ __forceinline__ int fresh_lane() { int l; asm volatile("v_mbcnt_lo_u32_b32 %0, -1, 0\n\tv_mbcnt_hi_u32_b32 %0, -1, %0" : "=v"(l)); return l; }
namespace pg8 {
#define PG8_LAS __attribute__((address_space(3)))
typedef unsigned short bf16_t;
typedef short bf16x8 __attribute__((ext_vector_type(8)));
typedef float f32x4 __attribute__((ext_vector_type(4)));
typedef unsigned u32x4 __attribute__((ext_vector_type(4)));
typedef int v4i_t __attribute__((ext_vector_type(4)));
constexpr int BM = 256, BK = 64, HALF = 128, HTB = HALF * BK * 2  , STAGE_BYTES = 8 * HTB, NXCD = 8;

__host__ __device__ __forceinline__ int lds_byte(int r, int c) { const int st = (r >> 4) * 2 + (c >> 5), rr = r & 15, cc = c & 31, ob = rr * 64 + cc * 2; return st * 1024 + (ob ^ (((ob >> 9) & 1) << 5)); }
__host__ __device__ __forceinline__ void stage_rc(int b, int& R, int& C) { const int st = b / 1024, sb = b % 1024, swz = sb ^ (((sb >> 9) & 1) << 5); R = (st >> 1) * 16 + swz / 64; C = (st & 1) * 32 + (swz % 64) / 2; }
__host__ __device__ __forceinline__ int perm32(int rho) { const int n = rho >> 4, i = rho & 15; return 8 * (i >> 2) + 4 * n + (i & 3); }

struct Unit { int pm, pn; };
struct Gemm { const bf16_t* A; const bf16_t* Bt; int M, N, K; };

struct StaticOrder {
    int nM, nN, nwg, G, c, WGM;
    __host__ __device__ void init(int M, int N, int G_, int c_, int wgm = 4) { nM = M / BM; nN = N / BM; nwg = nM * nN; G = G_; c = c_; WGM = wgm; }
    __host__ __device__ bool next(int i, Unit& u) const { const long L = (long)i * G + c; if (L >= nwg) return false; unit_of((int)L, u); return true; }
    __host__ __device__ bool unit_of(int L, Unit& u) const {
        int wgid = L; { const int q = nwg / NXCD, r = nwg % NXCD, xcd = wgid % NXCD, off = wgid / NXCD; wgid = (xcd < r ? xcd * (q + 1) : r * (q + 1) + (xcd - r) * q) + off; }
        const int nig = WGM * nN, gid = wgid / nig, fm = gid * WGM, gsz = (nM - fm) < WGM ? (nM - fm) : WGM;
        u.pm = fm + ((wgid % nig) % gsz); u.pn = (wgid % nig) / gsz; return true;
    }
    __device__ __forceinline__ void a_ready(const Unit&) const {}
    __device__ __forceinline__ void done(const Unit&) const {}
};


typedef float f32x2_cv __attribute__((ext_vector_type(2))); typedef __bf16 bf16x2_cv __attribute__((ext_vector_type(2)));
__device__ __forceinline__ unsigned cvt_pk_bf16(float lo, float hi) { const f32x2_cv v = {lo, hi}; return __builtin_bit_cast(unsigned, __builtin_convertvector(v, bf16x2_cv)); }
typedef float f32x2 __attribute__((ext_vector_type(2)));

template <bool F8> struct EpiIn {
    static constexpr bool PERM = false, AFTER_DRAIN = false, FP8 = F8, INIT_ACC = false; static constexpr int HOOK_T = -1;
    bf16_t* O; int ldc; const float* cosa; const float* sina; const float* cosp; const float* sinp; const float* qg; const float* kg; const float* bias; bf16_t* SA; bf16_t* SB; PG8_LAS float* red; float eps; float sc;
    __device__ __forceinline__ static unsigned long long pk4(const f32x4 v) { return (unsigned long long)cvt_pk_bf16(v[0], v[1]) | ((unsigned long long)cvt_pk_bf16(v[2], v[3]) << 32); }
    __device__ __forceinline__ void operator()(const f32x4 (&acc)[2][2][4][2], const Unit& u, int wr, int wc, int fr_, int fq_) const {
        (void)fr_; (void)fq_; const int ln_ = fresh_lane(), fr = ln_ & 15, fq = ln_ >> 4;
        const int pn = F8 ? (u.pn < 14 ? u.pn : u.pn + 16) : u.pn + 14; const int row0 = u.pm * BM + wr * 64 + fr;
        if (pn < 5) {
#pragma unroll
            for (int ai = 0; ai < 2; ++ai)
#pragma unroll
                for (int m = 0; m < 4; ++m)
#pragma unroll
                    for (int bj = 0; bj < 2; ++bj) { const f32x4 v0 = (acc[ai][bj][m][0] * sc), v1 = (acc[ai][bj][m][1] * sc);
                        float ss = (v0[0] * v0[0] + v0[1] * v0[1]) + (v0[2] * v0[2] + v0[3] * v0[3]) + (v1[0] * v1[0] + v1[1] * v1[1]) + (v1[2] * v1[2] + v1[3] * v1[3]);
                        ss += __shfl_xor(ss, 16); ss += __shfl_xor(ss, 32);
                        if (fq == 0) red[(ai * HALF + wr * 64 + m * 16 + fr) * 8 + bj * 4 + wc] = ss; }
            asm volatile("s_waitcnt lgkmcnt(0)" ::: "memory"); __builtin_amdgcn_s_barrier(); asm volatile("" ::: "memory");
            const int half = wc >> 1, i0 = 16 * (wc & 1) + 4 * fq;
            const float* g = (pn < 4) ? qg : kg;
            const f32x4 g0 = *(const f32x4*)(g + 64 * half + i0), g1 = *(const f32x4*)(g + 64 * half + 32 + i0);
#pragma unroll
            for (int ai = 0; ai < 2; ++ai)
#pragma unroll
                for (int m = 0; m < 4; ++m) { const int row = row0 + ai * HALF + m * 16, sq = row & 2047, pos = half ? (sq & 63) : (sq >> 6);
                    const f32x4 c = *(const f32x4*)(cosa + pos * 32 + i0), sn = *(const f32x4*)(sina + pos * 32 + i0);
#pragma unroll
                    for (int bj = 0; bj < 2; ++bj) { const f32x4 pr = *(const PG8_LAS f32x4*)(red + (ai * HALF + wr * 64 + m * 16 + fr) * 8 + bj * 4);
                        const float rs = rsqrtf(((pr[0] + pr[1]) + (pr[2] + pr[3])) * (1.f / 128.f) + eps);
                        const f32x4 y0 = (acc[ai][bj][m][0] * sc) * rs * g0, y1 = (acc[ai][bj][m][1] * sc) * rs * g1;
                        const f32x4 lo = y0 * c - y1 * sn, hi = y0 * sn + y1 * c;
                        bf16_t* p = O + (size_t)row * ldc + pn * BM + bj * HALF + 64 * half + i0;
                        *(unsigned long long*)p = pk4(lo); *(unsigned long long*)(p + 32) = pk4(hi); } }
        } else if (pn >= 10 && pn < 22 && wc == 0) {
            const int i0 = 4 * fq;
#pragma unroll
            for (int ai = 0; ai < 2; ++ai)
#pragma unroll
                for (int m = 0; m < 4; ++m) { const int row = row0 + ai * HALF + m * 16, sq = row & 2047;
                    const f32x4 c = *(const f32x4*)(cosp + sq * 16 + i0), sn = *(const f32x4*)(sinp + sq * 16 + i0);
#pragma unroll
                    for (int bj = 0; bj < 2; ++bj) { const f32x4 y0 = (acc[ai][bj][m][0] * sc), y1 = (acc[ai][bj][m][1] * sc);
                        const f32x4 lo = y0 * c - y1 * sn, hi = y0 * sn + y1 * c;
                        bf16_t* p = O + (size_t)row * ldc + pn * BM + bj * HALF + i0;
                        *(unsigned long long*)p = pk4(lo); *(unsigned long long*)(p + 16) = pk4(hi); } }
        } else if (pn >= 30) {
            const int gq = pn - 30;
            const float* bs = bias + gq * HALF + wc * 32 + 8 * fq;
            const f32x4 a0 = *(const f32x4*)bs, a1 = *(const f32x4*)(bs + 4), b0 = *(const f32x4*)(bs + 2048), b1 = *(const f32x4*)(bs + 2048 + 4);
            const size_t fo = ((((size_t)(u.pm * 8 + (gq >> 1)) * 8 + (wr * 4 + wc)) * 16 + (gq & 1) * 4) * 64 + (fq * 16 + fr)) * 8;
#pragma unroll
            for (int ai = 0; ai < 2; ++ai)
#pragma unroll
                for (int m = 0; m < 4; ++m) { const f32x4 za0 = (acc[ai][0][m][0] * sc) + a0, za1 = (acc[ai][0][m][1] * sc) + a1, zb0 = (acc[ai][1][m][0] * sc) + b0, zb1 = (acc[ai][1][m][1] * sc) + b1;
                    float rr[8], ss[8];
#pragma unroll
                    for (int e = 0; e < 4; ++e) { const float ea0 = 1.f + __builtin_amdgcn_exp2f(za0[e] * -1.4426950408889634f), ea1 = 1.f + __builtin_amdgcn_exp2f(za1[e] * -1.4426950408889634f);
                        const float eb0 = 1.f + __builtin_amdgcn_exp2f(zb0[e] * -1.4426950408889634f), eb1 = 1.f + __builtin_amdgcn_exp2f(zb1[e] * -1.4426950408889634f);
                        rr[e] = eb0 * __builtin_amdgcn_rcpf(ea0); rr[4 + e] = eb1 * __builtin_amdgcn_rcpf(ea1); ss[e] = __builtin_amdgcn_rcpf(eb0); ss[4 + e] = __builtin_amdgcn_rcpf(eb1); }
                    u32x4 w; w.x = cvt_pk_bf16(rr[0], rr[1]); w.y = cvt_pk_bf16(rr[2], rr[3]); w.z = cvt_pk_bf16(rr[4], rr[5]); w.w = cvt_pk_bf16(rr[6], rr[7]);
                    __builtin_nontemporal_store(w, (u32x4*)(SA + fo + (ai * 8 + m) * 512));
                    w.x = cvt_pk_bf16(ss[0], ss[1]); w.y = cvt_pk_bf16(ss[2], ss[3]); w.z = cvt_pk_bf16(ss[4], ss[5]); w.w = cvt_pk_bf16(ss[6], ss[7]);
                    __builtin_nontemporal_store(w, (u32x4*)(SB + fo + (ai * 8 + m) * 512)); }
        } else {
            const bool act = (pn >= 6 && pn < 10) || pn == 28 || pn == 29;
            const int col0 = pn * BM + wc * 32 + 8 * fq;
#pragma unroll
            for (int ai = 0; ai < 2; ++ai)
#pragma unroll
                for (int m = 0; m < 4; ++m) { bf16_t* rowp = O + (size_t)(row0 + ai * HALF + m * 16) * ldc + col0;
#pragma unroll
                    for (int bj = 0; bj < 2; ++bj) { f32x4 v0 = (acc[ai][bj][m][0] * sc), v1 = (acc[ai][bj][m][1] * sc);
                        if (act) {
#pragma unroll
                            for (int e = 0; e < 4; ++e) { v0[e] = v0[e] * __builtin_amdgcn_rcpf(1.f + __builtin_amdgcn_exp2f(v0[e] * -1.4426950408889634f)); v1[e] = v1[e] * __builtin_amdgcn_rcpf(1.f + __builtin_amdgcn_exp2f(v1[e] * -1.4426950408889634f)); } }
                        u32x4 w; w.x = cvt_pk_bf16(v0[0], v0[1]); w.y = cvt_pk_bf16(v0[2], v0[3]); w.z = cvt_pk_bf16(v1[0], v1[1]); w.w = cvt_pk_bf16(v1[2], v1[3]);
                        *(u32x4*)(rowp + bj * HALF) = w; } }
        }
    }
};
struct EpiMerge2 {
    static constexpr bool PERM = false, AFTER_DRAIN = false, FP8 = false; static constexpr int HOOK_T = 16; static constexpr bool INIT_ACC = false;
    const bf16_t* SA; const bf16_t* SB; bf16_t* O; int ldc;
    __device__ __forceinline__ void mid(f32x4 (&acc)[2][2][4][2], const Unit& u, int wr, int wc, int fr, int fq) const {
        int lane = fq * 16 + fr; asm volatile("" : "+v"(lane));
        const size_t base = ((((size_t)(u.pm * 8 + u.pn) * 8 + (wr * 4 + wc)) * 16) * 64 + lane) * 8;
#pragma unroll
        for (int f = 0; f < 16; ++f) { const int ai = f >> 3, bj = (f >> 2) & 1, m = f & 3;
            const u32x4 a = __builtin_nontemporal_load((const u32x4*)(SA + base + f * 512));
            f32x4 r0, r1;
#pragma unroll
            for (int e = 0; e < 4; ++e) { const float q_lo = __uint_as_float(a[e] << 16), q_hi = __uint_as_float(a[e] & 0xffff0000u);
                if (e < 2) { r0[2 * e] = q_lo; r0[2 * e + 1] = q_hi; } else { r1[2 * e - 4] = q_lo; r1[2 * e - 3] = q_hi; } }
            acc[ai][bj][m][0] *= r0; acc[ai][bj][m][1] *= r1; }
    }
    __device__ __forceinline__ void operator()(const f32x4 (&acc)[2][2][4][2], const Unit& u, int wr, int wc, int fr_, int fq_) const {
        (void)fr_; (void)fq_; const int ln_ = fresh_lane(), fr = ln_ & 15, fq = ln_ >> 4;
        const int lane = fq * 16 + fr, row0 = u.pm * BM + wr * 64 + fr, col0 = u.pn * BM + wc * 32 + 8 * fq;
        const size_t base = ((((size_t)(u.pm * 8 + u.pn) * 8 + (wr * 4 + wc)) * 16) * 64 + lane) * 8;
        bf16_t* Oq = O; asm volatile("" : "+s"(Oq));
        const __amdgpu_buffer_rsrc_t rsO = __builtin_amdgcn_make_buffer_rsrc((void*)Oq, 0, 8192 * 2048 * 2, 0x00020000);
#pragma unroll
        for (int f = 0; f < 16; ++f) { const int ai = f >> 3, bj = (f >> 2) & 1, m = f & 3;
            const u32x4 b = __builtin_nontemporal_load((const u32x4*)(SB + base + f * 512));
            const f32x4 v0 = acc[ai][bj][m][0], v1 = acc[ai][bj][m][1];
            u32x4 w; w.x = cvt_pk_bf16(v0[0] * __uint_as_float(b[0] << 16), v0[1] * __uint_as_float(b[0] & 0xffff0000u)); w.y = cvt_pk_bf16(v0[2] * __uint_as_float(b[1] << 16), v0[3] * __uint_as_float(b[1] & 0xffff0000u));
            w.z = cvt_pk_bf16(v1[0] * __uint_as_float(b[2] << 16), v1[1] * __uint_as_float(b[2] & 0xffff0000u)); w.w = cvt_pk_bf16(v1[2] * __uint_as_float(b[3] << 16), v1[3] * __uint_as_float(b[3] & 0xffff0000u));
            __builtin_amdgcn_raw_buffer_store_b128(w, rsO, (int)(((size_t)(row0 + ai * HALF + m * 16) * ldc + col0 + bj * HALF) * 2), 0, 16); }
    }
};
struct EpiResidNorm {
    static constexpr bool PERM = false, AFTER_DRAIN = true, FP8 = false, INIT_ACC = true; static constexpr int HOOK_T = -1;
    const float* base; float* out; int ldc; const float* gain; float* xb; unsigned* cnt; int ntn; float eps;
    __device__ __forceinline__ void init(f32x4 (&acc)[2][2][4][2], const Unit& u, int wr, int wc, int fr, int fq) const {
        const int row0 = u.pm * BM + wr * 64 + fr, col0 = u.pn * BM + wc * 32 + 4 * fq;
#pragma unroll
        for (int ai = 0; ai < 2; ++ai)
#pragma unroll
            for (int m = 0; m < 4; ++m) { const size_t off = (size_t)(row0 + ai * HALF + m * 16) * ldc + col0;
#pragma unroll
                for (int bj = 0; bj < 2; ++bj)
#pragma unroll
                    for (int n = 0; n < 2; ++n) acc[ai][bj][m][n] = __builtin_nontemporal_load((const f32x4*)(base + off + bj * HALF + n * 16)); }
    }
    __device__ __forceinline__ void fused(f32x4 (&acc)[2][2][4][2], const Unit& u, int wr, int wc, int fr_, int fq_, PG8_LAS unsigned char* lds, int wid, int lane) const {
        (void)fr_; (void)fq_; const int ln_ = fresh_lane(), fr = ln_ & 15, fq = ln_ >> 4;
        PG8_LAS float* Pp = (PG8_LAS float*)lds;
        PG8_LAS float* Sr = (PG8_LAS float*)(lds + 4096);
        const int row0 = u.pm * BM + wr * 64 + fr, col0 = u.pn * BM + wc * 32 + 4 * fq;
#pragma unroll
        for (int ai = 0; ai < 2; ++ai)
#pragma unroll
            for (int m = 0; m < 4; ++m) { float ss = 0.f;
#pragma unroll
                for (int bj = 0; bj < 2; ++bj)
#pragma unroll
                    for (int n = 0; n < 2; ++n) { const f32x4 o = acc[ai][bj][m][n];
                        ss += (o[0] * o[0] + o[1] * o[1]) + (o[2] * o[2] + o[3] * o[3]); }
                ss += __shfl_xor(ss, 16); ss += __shfl_xor(ss, 32);
                if (fq == 0) Pp[(ai * HALF + wr * 64 + m * 16 + fr) * 4 + wc] = ss; }
        asm volatile("s_waitcnt lgkmcnt(0)" ::: "memory"); __builtin_amdgcn_s_barrier(); asm volatile("" ::: "memory");
        const int tid = wid * 64 + lane;
        if (tid < 256) { const f32x4 p = *(const PG8_LAS f32x4*)(Pp + tid * 4);
            __hip_atomic_store(xb + (size_t)(u.pm * BM + tid) * 8 + u.pn, (p[0] + p[1]) + (p[2] + p[3]), __ATOMIC_RELAXED, __HIP_MEMORY_SCOPE_AGENT); }
        asm volatile("s_waitcnt vmcnt(0)" ::: "memory"); __builtin_amdgcn_s_barrier(); asm volatile("" ::: "memory");
        if (tid == 0) __hip_atomic_fetch_add(cnt + 64 * u.pm, 1u, __ATOMIC_RELAXED, __HIP_MEMORY_SCOPE_AGENT);
        if (wid == 0) { unsigned spins = 0;
            while ((unsigned)__builtin_amdgcn_readfirstlane(__hip_atomic_load(cnt + 64 * u.pm, __ATOMIC_RELAXED, __HIP_MEMORY_SCOPE_AGENT)) < (unsigned)ntn) { __builtin_amdgcn_s_sleep(2); if (++spins > (1u << 22)) break; }
            __builtin_amdgcn_fence(__ATOMIC_ACQUIRE, "agent"); }
        asm volatile("s_waitcnt vmcnt(0) lgkmcnt(0)" ::: "memory"); __builtin_amdgcn_s_barrier(); asm volatile("" ::: "memory");
        if (tid < 256) { const float* slot = xb + (size_t)(u.pm * BM + tid) * 8; float tot = 0.f;
#pragma unroll
            for (int t = 0; t < 8; ++t) tot += __hip_atomic_load(slot + t, __ATOMIC_RELAXED, __HIP_MEMORY_SCOPE_AGENT);
            Sr[tid] = rsqrtf(tot * (1.0f / 2048.0f) + eps); }
        asm volatile("s_waitcnt lgkmcnt(0)" ::: "memory"); __builtin_amdgcn_s_barrier(); asm volatile("" ::: "memory");
#pragma unroll
        for (int bj = 0; bj < 2; ++bj)
#pragma unroll
            for (int n = 0; n < 2; ++n) { const f32x4 g = *(const f32x4*)(gain + col0 + bj * HALF + n * 16);
#pragma unroll
                for (int ai = 0; ai < 2; ++ai)
#pragma unroll
                    for (int m = 0; m < 4; ++m) { const int rl = ai * HALF + wr * 64 + m * 16 + fr; const float rs = Sr[rl];
                        __builtin_nontemporal_store(acc[ai][bj][m][n] * rs * g, (f32x4*)(out + (size_t)(u.pm * BM + rl) * ldc + col0 + bj * HALF + n * 16)); } }
    }
};

template <class Epi, class Sched, bool ALIGN_EPI = false, bool SP2 = false>
__device__ __forceinline__ void gemm_phase(PG8_LAS unsigned char* lds, const Gemm g, const Sched& S, const Epi& E, const int wave_) {
    const int wid = wave_, lane = fresh_lane(), tid = wid * 64 + lane, wr = wid >> 2, wc = wid & 3, fr = lane & 15, fq = lane >> 4;
    const int K = g.K, nt = K / BK;
    unsigned voffA[2], voffB[2];
#pragma unroll
    for (int i = 0; i < 2; ++i) { int R, C; stage_rc(tid * 16 + i * 8192, R, C); const int Rb = Epi::PERM ? ((R & ~31) + perm32(R & 31)) : R;
        voffA[i] = (unsigned)(R * K + C) * 2u; voffB[i] = (unsigned)(Rb * K + C) * 2u; }
    const unsigned kstep = (unsigned)(BK * 2);
    const unsigned hstep = (unsigned)HALF * (unsigned)K * 2u;
    const unsigned tstep = 2u * hstep;
    const __amdgpu_buffer_rsrc_t rs_voffA = __builtin_amdgcn_make_buffer_rsrc((void*)g.A, 0, (int)((unsigned)g.M * (unsigned)K * 2u), 0x00020000);
    const __amdgpu_buffer_rsrc_t rs_voffB = __builtin_amdgcn_make_buffer_rsrc((void*)g.Bt, 0, (int)((unsigned)g.N * (unsigned)K * 2u), 0x00020000);
    const unsigned ldsw = (unsigned)wid * 1024u;
    const int aoff = lds_byte(wr * 64 + fr, fq * 8), boff = lds_byte(wc * 32 + fr, fq * 8);
#define PG8_SA(b, h) (((b) * 2 + (h)) * HTB)
#define PG8_SB(b, h) ((4 + (b) * 2 + (h)) * HTB)
#define PG8_STAGE(bufoff, goff, voff) do { _Pragma("unroll") for (int _i = 0; _i < 2; ++_i) \
        __builtin_amdgcn_raw_ptr_buffer_load_lds(rs_##voff, (PG8_LAS void*)(lds + (bufoff) + ldsw + _i * 8192), 16, (int)(voff)[_i], (int)(goff), 0, 0); } while (0)
#define PG8_LDA(dst, b, h) do { _Pragma("unroll") for (int m = 0; m < 4; ++m) _Pragma("unroll") for (int k = 0; k < 2; ++k) dst[m][k] = *(const PG8_LAS bf16x8*)(lds + PG8_SA(b, h) + aoff + m * 2048 + k * 1024); } while (0)
#define PG8_LDB(dst, b, h) do { _Pragma("unroll") for (int n = 0; n < 2; ++n) _Pragma("unroll") for (int k = 0; k < 2; ++k) dst[n][k] = *(const PG8_LAS bf16x8*)(lds + PG8_SB(b, h) + boff + n * 2048 + k * 1024); } while (0)
#define PG8_CAT(x, y) __builtin_shufflevector(__builtin_bit_cast(v4i_t, x), __builtin_bit_cast(v4i_t, y), 0, 1, 2, 3, 4, 5, 6, 7)
#define PG8_MMA(ai, bj, At, Bt) do { __builtin_amdgcn_s_setprio(1); _Pragma("unroll") for (int m = 0; m < 4; ++m) _Pragma("unroll") for (int n = 0; n < 2; ++n) { \
        if constexpr (Epi::FP8) acc[ai][bj][m][n] = __builtin_amdgcn_mfma_scale_f32_16x16x128_f8f6f4(PG8_CAT(Bt[n][0], Bt[n][1]), PG8_CAT(At[m][0], At[m][1]), acc[ai][bj][m][n], 0, 0, 0, 0x7f7f7f7f, 0, 0x7f7f7f7f); \
        else { _Pragma("unroll") for (int k = 0; k < 2; ++k) acc[ai][bj][m][n] = __builtin_amdgcn_mfma_f32_16x16x32_bf16(Bt[n][k], At[m][k], acc[ai][bj][m][n], 0, 0, 0); } } \
        __builtin_amdgcn_s_setprio(0); } while (0)
#define PG8_WAIT_V(n) asm volatile("s_waitcnt vmcnt(" #n ")" ::: "memory")
#define PG8_WAIT_L(n) asm volatile("s_waitcnt lgkmcnt(" #n ")" ::: "memory")
#define PG8_BAR __builtin_amdgcn_s_barrier()
#define PG8_SCHED __builtin_amdgcn_sched_barrier(0)
    Unit cur, nxt; int ui = 0;
    if (!S.next(0, cur)) return;
    f32x4 acc[2][2][4][2];
    if constexpr (Epi::INIT_ACC) E.init(acc, cur, wr, wc, fr, fq);
    else {
#pragma unroll
    for (int a = 0; a < 2; ++a)
#pragma unroll
        for (int b = 0; b < 2; ++b)
#pragma unroll
            for (int m = 0; m < 4; ++m)
#pragma unroll
                for (int n = 0; n < 2; ++n) acc[a][b][m][n] = (f32x4){0.f, 0.f, 0.f, 0.f};
    }
    bf16x8 At[4][2], B0[2][2], B1[2][2];
    unsigned cA = (unsigned)cur.pm * tstep, cB = (unsigned)cur.pn * tstep;
    S.a_ready(cur);
    if constexpr (SP2) {
        PG8_STAGE(PG8_SB(0, 0), cB, voffB); PG8_STAGE(PG8_SB(0, 1), cB + hstep, voffB); PG8_STAGE(PG8_SA(0, 0), cA, voffA); PG8_STAGE(PG8_SA(0, 1), cA + hstep, voffA);
        if (wr == 1) PG8_BAR;
        PG8_WAIT_V(2); PG8_BAR;
        PG8_STAGE(PG8_SB(1, 0), cB + kstep, voffB); PG8_STAGE(PG8_SA(1, 0), cA + kstep, voffA); PG8_STAGE(PG8_SB(1, 1), cB + hstep + kstep, voffB);
        PG8_WAIT_V(6); PG8_BAR;
    } else {
        PG8_STAGE(PG8_SB(0, 0), cB, voffB); PG8_STAGE(PG8_SA(0, 0), cA, voffA); PG8_STAGE(PG8_SB(0, 1), cB + hstep, voffB); PG8_STAGE(PG8_SA(0, 1), cA + hstep, voffA);
        if (wr == 1) PG8_BAR;
        PG8_WAIT_V(4); PG8_BAR;
        PG8_STAGE(PG8_SB(1, 0), cB + kstep, voffB); PG8_STAGE(PG8_SA(1, 0), cA + kstep, voffA); PG8_STAGE(PG8_SB(1, 1), cB + hstep + kstep, voffB);
        PG8_WAIT_V(6); PG8_BAR;
    }
    for (;;) {
        const bool has_next = S.next(ui + 1, nxt);
        const unsigned nA = has_next ? (unsigned)nxt.pm * tstep : cA, nB = has_next ? (unsigned)nxt.pn * tstep : cB;
        for (int t = 0; t < nt; t += 2) {
            if constexpr (Epi::HOOK_T >= 0) { if (t == Epi::HOOK_T) E.mid(acc, cur, wr, wc, fr, fq); }
            const bool last = (t == nt - 2);
            const unsigned a1 = cA + (unsigned)(t + 1) * kstep;
            const unsigned a2 = last ? nA : cA + (unsigned)(t + 2) * kstep, b2 = last ? nB : cB + (unsigned)(t + 2) * kstep;
            const unsigned a3 = a2 + kstep, b3 = b2 + kstep;
            if (last && has_next) S.a_ready(nxt);
            if constexpr (SP2) {
            PG8_LDB(B0, 0, 0); PG8_LDB(B1, 0, 1); PG8_SCHED; PG8_LDA(At, 0, 0); PG8_STAGE(PG8_SA(1, 1), a1 + hstep, voffA);
            PG8_WAIT_V(8); PG8_WAIT_L(0); PG8_BAR; PG8_MMA(0, 0, At, B0); PG8_MMA(0, 1, At, B1); PG8_BAR; PG8_SCHED;
            PG8_LDA(At, 0, 1); PG8_STAGE(PG8_SB(0, 0), b2, voffB); PG8_STAGE(PG8_SB(0, 1), b2 + hstep, voffB); PG8_STAGE(PG8_SA(0, 0), a2, voffA);
            PG8_WAIT_V(8); PG8_WAIT_L(0); PG8_BAR; PG8_MMA(1, 0, At, B0); PG8_MMA(1, 1, At, B1); PG8_BAR; PG8_SCHED;
            PG8_LDB(B0, 1, 0); PG8_LDB(B1, 1, 1); PG8_SCHED; PG8_LDA(At, 1, 0); PG8_STAGE(PG8_SA(0, 1), a2 + hstep, voffA);
            PG8_WAIT_V(8); PG8_WAIT_L(0); PG8_BAR; PG8_MMA(0, 0, At, B0); PG8_MMA(0, 1, At, B1); PG8_BAR; PG8_SCHED;
            PG8_LDA(At, 1, 1); PG8_STAGE(PG8_SB(1, 0), b3, voffB); PG8_STAGE(PG8_SB(1, 1), b3 + hstep, voffB); PG8_STAGE(PG8_SA(1, 0), a3, voffA);
            PG8_WAIT_V(8); PG8_WAIT_L(0); PG8_BAR; PG8_MMA(1, 0, At, B0); PG8_MMA(1, 1, At, B1); PG8_BAR; PG8_SCHED;
            } else {
            PG8_LDB(B0, 0, 0); PG8_SCHED; PG8_LDA(At, 0, 0); PG8_STAGE(PG8_SA(1, 1), a1 + hstep, voffA);
            PG8_WAIT_L(8); PG8_BAR; PG8_WAIT_L(0); PG8_MMA(0, 0, At, B0); PG8_BAR; PG8_SCHED;
            PG8_LDB(B1, 0, 1); PG8_STAGE(PG8_SB(0, 0), b2, voffB);
            PG8_BAR; PG8_WAIT_L(0); PG8_MMA(0, 1, At, B1); PG8_BAR;
            PG8_LDA(At, 0, 1); PG8_STAGE(PG8_SA(0, 0), a2, voffA);
            PG8_BAR; PG8_WAIT_L(0); PG8_MMA(1, 0, At, B0); PG8_BAR; PG8_SCHED;
            PG8_STAGE(PG8_SB(0, 1), b2 + hstep, voffB);
            PG8_WAIT_V(6); PG8_BAR; PG8_MMA(1, 1, At, B1); PG8_BAR;
            PG8_LDB(B0, 1, 0); PG8_SCHED; PG8_LDA(At, 1, 0); PG8_STAGE(PG8_SA(0, 1), a2 + hstep, voffA);
            PG8_WAIT_L(8); PG8_BAR; PG8_WAIT_L(0); PG8_MMA(0, 0, At, B0); PG8_BAR; PG8_SCHED;
            PG8_LDB(B1, 1, 1); PG8_STAGE(PG8_SB(1, 0), b3, voffB);
            PG8_BAR; PG8_WAIT_L(0); PG8_MMA(0, 1, At, B1); PG8_BAR;
            PG8_LDA(At, 1, 1); PG8_STAGE(PG8_SA(1, 0), a3, voffA);
            PG8_BAR; PG8_WAIT_L(0); PG8_MMA(1, 0, At, B0); PG8_BAR; PG8_SCHED;
            PG8_STAGE(PG8_SB(1, 1), b3 + hstep, voffB);
            PG8_WAIT_V(6); PG8_BAR; PG8_MMA(1, 1, At, B1); PG8_BAR;
            }
        }
        if constexpr (ALIGN_EPI) { if (wr == 0) PG8_BAR; }
        if constexpr (!Epi::AFTER_DRAIN) { E(acc, cur, wr, wc, fr, fq); S.done(cur); }
        if (!has_next) break;
#pragma unroll
        for (int a = 0; a < 2; ++a)
#pragma unroll
            for (int b = 0; b < 2; ++b)
#pragma unroll
                for (int m = 0; m < 4; ++m)
#pragma unroll
                    for (int n = 0; n < 2; ++n) acc[a][b][m][n] = (f32x4){0.f, 0.f, 0.f, 0.f};
        cur = nxt; cA = nA; cB = nB; ++ui;
        if constexpr (ALIGN_EPI) { if (wr == 1) PG8_BAR; }
    }
    PG8_WAIT_V(0);
    if constexpr (!ALIGN_EPI) { if (wr == 0) PG8_BAR; }
    PG8_BAR;
    if constexpr (Epi::AFTER_DRAIN) { E.fused(acc, cur, wr, wc, fr, fq, lds, wid, lane); S.done(cur); }
#undef PG8_SA
#undef PG8_SB
#undef PG8_STAGE
#undef PG8_LDA
#undef PG8_LDB
#undef PG8_MMA
#undef PG8_CAT
#undef PG8_WAIT_V
#undef PG8_WAIT_L
#undef PG8_BAR
#undef PG8_SCHED
}
}

namespace att {
using bf16 = unsigned short;
constexpr int   D = 128, NW = 8, QBLK = 32, KVBLK = 64;
constexpr float SCALE = 0.088388347648318440f;
constexpr float THR = 8.f;
constexpr int SDEPTH = 2;
constexpr int LDQ = 7680, LDK = 7680;
constexpr int LDY = 1536;
constexpr size_t SHM_V = KVBLK * D * 2, SHM_K = KVBLK * D * 2, SHM_ATTN = 2 * SHM_V + 2 * SHM_K + NW * 64 * 4;
__device__ __forceinline__ float bf2f_(bf16 h) { return __uint_as_float(((unsigned)h) << 16); }
__device__ __forceinline__ bf16 f2bf_(float f) { unsigned u = __float_as_uint(f); return (bf16)((u + 0x7fffu + ((u >> 16) & 1u)) >> 16); }
using bf16x8 = __attribute__((ext_vector_type(8))) short;
using s16x4  = __attribute__((ext_vector_type(4))) short;
using f32x16 = __attribute__((ext_vector_type(16))) float;
using f32x8  = __attribute__((ext_vector_type(8))) float;
using u32x4  = __attribute__((ext_vector_type(4))) unsigned;
using f32x4_ = __attribute__((ext_vector_type(4))) float;
#define KSWZ(row, colB) ((row) * 256 + ((colB) ^ (((row) & 7) << 4)))
#define SBAR() __builtin_amdgcn_sched_barrier(0)
__device__ __forceinline__ int crow(int r, int hi) { return (r & 3) + 8 * (r >> 2) + 4 * hi; }
__device__ __forceinline__ unsigned cvtpk(float lo, float hi) {
  typedef float f32x2_c __attribute__((ext_vector_type(2))); typedef __bf16 bf16x2_c __attribute__((ext_vector_type(2)));
  const f32x2_c v = {lo, hi}; return __builtin_bit_cast(unsigned, __builtin_convertvector(v, bf16x2_c));
}
template <typename TIn> struct Stage;
template <> struct Stage<bf16>  { using T = bf16x8;
  __device__ static __forceinline__ T ld8(const bf16* p) { return *reinterpret_cast<const bf16x8*>(p); }
  __device__ static __forceinline__ bf16x8 tobf(T x) { return x; } };
template <> struct Stage<float> { using T = f32x8;
  __device__ static __forceinline__ T ld8(const float* p) { return *reinterpret_cast<const f32x8*>(p); }
  __device__ static __forceinline__ bf16x8 tobf(T x) {
    u32x4 w = {cvtpk(x[0], x[1]), cvtpk(x[2], x[3]), cvtpk(x[4], x[5]), cvtpk(x[6], x[7])}; return *reinterpret_cast<bf16x8*>(&w); } };

__device__ __forceinline__ void partialSM(f32x16& p0, f32x16& p1, float& m_reg, float& mn, float& alpha) {
  constexpr float C = SCALE * 1.4426950408889634f;
  float pmax = p0[0]; for (int r = 1; r < 16; ++r) pmax = fmaxf(pmax, p0[r]); for (int r = 0; r < 16; ++r) pmax = fmaxf(pmax, p1[r]);
  { auto rr = __builtin_amdgcn_permlane32_swap(__float_as_uint(pmax), __float_as_uint(pmax), false, false);
    pmax = fmaxf(__uint_as_float(rr[0]), __uint_as_float(rr[1])); }
  if (__builtin_expect(__all(pmax - m_reg <= THR / SCALE), 1)) { mn = m_reg; alpha = 1.f; }
  else { mn = fmaxf(m_reg, pmax); alpha = __builtin_amdgcn_exp2f((m_reg - mn) * C); m_reg = mn; }
  float mnC = -mn * C;
  for (int r = 0; r < 16; ++r) p0[r] = fmaf(p0[r], C, mnC); for (int r = 0; r < 16; ++r) p1[r] = fmaf(p1[r], C, mnC);
  for (int r = 0; r < 16; ++r) p0[r] = __builtin_amdgcn_exp2f(p0[r]);
}
__device__ __forceinline__ void finishSM(f32x16& p0, f32x16& p1, float alpha, float& l_reg, bf16x8& pa0, bf16x8& pa1, bf16x8& pa2, bf16x8& pa3) {
  for (int r = 0; r < 16; ++r) p1[r] = __builtin_amdgcn_exp2f(p1[r]);
  float ps = 0; for (int r = 0; r < 16; ++r) ps += p0[r]; for (int r = 0; r < 16; ++r) ps += p1[r];
  { auto rr = __builtin_amdgcn_permlane32_swap(__float_as_uint(ps), __float_as_uint(ps), false, false);
    ps = __uint_as_float(rr[0]) + __uint_as_float(rr[1]); }
  l_reg = l_reg * alpha + ps;
#define PK4(P, BASE, OUT) do { unsigned a0 = cvtpk(P[BASE + 0], P[BASE + 1]), a1 = cvtpk(P[BASE + 2], P[BASE + 3]);   \
    unsigned b0 = cvtpk(P[BASE + 4], P[BASE + 5]), b1 = cvtpk(P[BASE + 6], P[BASE + 7]);                              \
    auto r0 = __builtin_amdgcn_permlane32_swap(a0, b0, false, false); auto r1 = __builtin_amdgcn_permlane32_swap(a1, b1, false, false); \
    u32x4 w = {r0[0], r1[0], r0[1], r1[1]}; OUT = *reinterpret_cast<bf16x8*>(&w); } while (0)
  PK4(p0, 0, pa0); PK4(p0, 8, pa1); PK4(p1, 0, pa2); PK4(p1, 8, pa3);
#undef PK4
}
__device__ __forceinline__ void qkt(f32x16& p0, f32x16& p1, const bf16* Ks, const bf16x8* qr, int r32, int hi) {
  p0 = f32x16{}; p1 = f32x16{};
  for (int d0 = 0; d0 < 8; ++d0) { int cb = (d0 * 16 + hi * 8) * 2;
    bf16x8 b0 = *reinterpret_cast<const bf16x8*>((const char*)Ks + KSWZ(r32, cb));
    bf16x8 b1 = *reinterpret_cast<const bf16x8*>((const char*)Ks + KSWZ(32 + r32, cb));
    p0 = __builtin_amdgcn_mfma_f32_32x32x16_bf16(b0, qr[d0], p0, 0, 0, 0);
    p1 = __builtin_amdgcn_mfma_f32_32x32x16_bf16(b1, qr[d0], p1, 0, 0, 0); }
}
__device__ __forceinline__ int v_st(int k, int c) { const int kk = (k & ~0xC) | ((k & 4) << 1) | ((k & 8) >> 1); return ((kk >> 3) * 4 + (c >> 5)) * 512 + ((kk & 7) * 32 + (c & 31)) * 2; }
__device__ __forceinline__ int v_rd_base(int lane) { return ((lane & 3) << 3) | (((lane >> 2) & 3) << 6) | (((lane >> 4) & 1) << 5) | (((lane >> 5) & 1) << 8); }
constexpr int v_rd_off(int d0, int ks, int half) { return d0 * 512 + ks * 4096 + half * 2048; }
template <int OFF> __device__ __forceinline__ s16x4 tr_read(int vb) {
  s16x4 r; asm volatile("ds_read_b64_tr_b16 %0, %1 offset:%2" : "=&v"(r) : "v"(vb), "i"(OFF) : "memory"); return r;
}
template <int D0> __device__ __forceinline__ void pv_one(f32x16& od, int vb, bf16x8 pa0, bf16x8 pa1, bf16x8 pa2, bf16x8 pa3) {
  const s16x4 l0 = tr_read<v_rd_off(D0, 0, 0)>(vb), h0 = tr_read<v_rd_off(D0, 0, 1)>(vb), l1 = tr_read<v_rd_off(D0, 1, 0)>(vb), h1 = tr_read<v_rd_off(D0, 1, 1)>(vb);
  const s16x4 l2 = tr_read<v_rd_off(D0, 2, 0)>(vb), h2 = tr_read<v_rd_off(D0, 2, 1)>(vb), l3 = tr_read<v_rd_off(D0, 3, 0)>(vb), h3 = tr_read<v_rd_off(D0, 3, 1)>(vb);
  asm volatile("s_waitcnt lgkmcnt(0)" ::: "memory"); SBAR();
#define PK(L, H) (bf16x8){L[0], L[1], L[2], L[3], H[0], H[1], H[2], H[3]}
  od = __builtin_amdgcn_mfma_f32_32x32x16_bf16(pa0, PK(l0, h0), od, 0, 0, 0);
  od = __builtin_amdgcn_mfma_f32_32x32x16_bf16(pa1, PK(l1, h1), od, 0, 0, 0);
  od = __builtin_amdgcn_mfma_f32_32x32x16_bf16(pa2, PK(l2, h2), od, 0, 0, 0);
  od = __builtin_amdgcn_mfma_f32_32x32x16_bf16(pa3, PK(l3, h3), od, 0, 0, 0);
#undef PK
}
__device__ __forceinline__ void pv_d0(f32x16* o, int vb, bf16x8 pa0, bf16x8 pa1, bf16x8 pa2, bf16x8 pa3) {
  pv_one<0>(o[0], vb, pa0, pa1, pa2, pa3); pv_one<1>(o[1], vb, pa0, pa1, pa2, pa3); pv_one<2>(o[2], vb, pa0, pa1, pa2, pa3); pv_one<3>(o[3], vb, pa0, pa1, pa2, pa3);
}

__device__ __forceinline__ void attn_dense_body(const bf16* __restrict__ Qb, const bf16* __restrict__ Kh, const bf16* __restrict__ Vh,
                                                const bf16* __restrict__ Gb, bf16* __restrict__ Yb, int seq, char* lds, const int wave_) {
  using TQ = bf16; using St = Stage<bf16>; using SQ = Stage<TQ>;
  const int wid = wave_, lane = fresh_lane(), tid = wid * 64 + lane, r32 = lane & 31, hi = lane >> 5;
  bf16* V_lds = (bf16*)lds; bf16* K_lds = (bf16*)(lds + 2 * SHM_V);
  float* ws = (float*)(lds + 2 * SHM_V + 2 * SHM_K) + wid * 64; float* li_l = ws; float* al_l = ws + 32;
  float m_reg = -1e30f, l_reg = 0; f32x16 o[4] = {}; bf16x8 qr[8];
  const TQ* Qw = Qb + (long)(wid * QBLK + r32) * LDQ + hi * 8;
#pragma unroll
  for (int d0 = 0; d0 < 8; ++d0) qr[d0] = SQ::tobf(SQ::ld8(Qw + d0 * 16));
  const int sr = tid >> 4, sc = (tid & 15) * 8, vst0 = v_st(sr, sc), vst1 = v_st(32 + sr, sc);
  const unsigned toff = (unsigned)(sr * LDK + sc);
  const int vb0 = (int)(uintptr_t)V_lds + v_rd_base(lane);
  struct { typename St::T vs0, vs1, ks0, ks1; } sr_[SDEPTH];
#define SLOAD(i, k0) do { const bf16* vb_ = Vh + (long)(k0) * LDK; const bf16* kb_ = Kh + (long)(k0) * LDK; \
    sr_[i].vs0 = St::ld8(vb_ + toff); sr_[i].vs1 = St::ld8(vb_ + 32 * LDK + toff); \
    sr_[i].ks0 = St::ld8(kb_ + toff); sr_[i].ks1 = St::ld8(kb_ + 32 * LDK + toff); } while (0)
#define SWRITE(b, i) do { *(bf16x8*)((char*)V_lds + (b) * SHM_V + vst0) = St::tobf(sr_[i].vs0);          \
    *(bf16x8*)((char*)V_lds + (b) * SHM_V + vst1) = St::tobf(sr_[i].vs1); int kc = sc * 2;               \
    *(bf16x8*)((char*)K_lds + (b) * SHM_K + KSWZ(sr, kc)) = St::tobf(sr_[i].ks0);                       \
    *(bf16x8*)((char*)K_lds + (b) * SHM_K + KSWZ(32 + sr, kc)) = St::tobf(sr_[i].ks1); } while (0)
#define SWAIT() do { if constexpr (SDEPTH == 2) asm volatile("s_waitcnt vmcnt(4)" ::: "memory"); else asm volatile("s_waitcnt vmcnt(0)" ::: "memory"); } while (0)
#define RESC(a) do { if (__any((a) < 1.f)) { if (hi == 0) al_l[r32] = (a); asm volatile("s_waitcnt lgkmcnt(0)" ::: "memory"); \
    for (int d = 0; d < 4; ++d) for (int r = 0; r < 16; ++r) o[d][r] *= al_l[crow(r, hi)]; } } while (0)
  f32x16 pA0, pA1, pB0, pB1; float mnA, mnB, alA, alB; bf16x8 pa0, pa1, pa2, pa3; const int NT = seq / KVBLK;
  constexpr int SE = 0, SO = SDEPTH - 1;
  SLOAD(SE, 0); asm volatile("s_waitcnt vmcnt(0)" ::: "memory"); SWRITE(0, SE); __syncthreads();
  qkt(pA0, pA1, K_lds, qr, r32, hi); partialSM(pA0, pA1, m_reg, mnA, alA);
  SLOAD(SO, KVBLK); if constexpr (SDEPTH == 2) { if (2 < NT) SLOAD(SE, 2 * KVBLK); }
  SWAIT(); SWRITE(1, SO); __syncthreads();
  for (int j = 1; j + 1 < NT; j += 2) {
    SBAR(); qkt(pB0, pB1, (bf16*)((char*)K_lds + SHM_K), qr, r32, hi);
    finishSM(pA0, pA1, alA, l_reg, pa0, pa1, pa2, pa3); SBAR();
    SLOAD(SO, (j + SDEPTH) * KVBLK); SBAR();
    pv_d0(o, vb0, pa0, pa1, pa2, pa3); partialSM(pB0, pB1, m_reg, mnB, alB);
    __syncthreads(); SWAIT(); SWRITE(0, SE);
    RESC(alB); __syncthreads();
    SBAR(); qkt(pA0, pA1, K_lds, qr, r32, hi);
    finishSM(pB0, pB1, alB, l_reg, pa0, pa1, pa2, pa3); SBAR();
    if (SDEPTH == 1 || j + 3 < NT) SLOAD(SE, (j + 1 + SDEPTH) * KVBLK); SBAR();
    pv_d0(o, vb0 + (int)SHM_V, pa0, pa1, pa2, pa3); partialSM(pA0, pA1, m_reg, mnA, alA);
    __syncthreads(); SWAIT(); SWRITE(1, SO);
    RESC(alA); __syncthreads();
  }
  SBAR(); qkt(pB0, pB1, (bf16*)((char*)K_lds + SHM_K), qr, r32, hi);
  finishSM(pA0, pA1, alA, l_reg, pa0, pa1, pa2, pa3); SBAR();
  pv_d0(o, vb0, pa0, pa1, pa2, pa3); partialSM(pB0, pB1, m_reg, mnB, alB);
  __syncthreads(); RESC(alB);
  finishSM(pB0, pB1, alB, l_reg, pa0, pa1, pa2, pa3); SBAR();
  pv_d0(o, vb0 + (int)SHM_V, pa0, pa1, pa2, pa3);
  if (hi == 0) li_l[r32] = l_reg; asm volatile("s_waitcnt lgkmcnt(0)" ::: "memory");
  float rli[16];
#pragma unroll
  for (int r = 0; r < 16; ++r) rli[r] = __builtin_amdgcn_rcpf(li_l[crow(r, hi)]);
  __syncthreads();
  { float* stg = (float*)(lds + wid * 16384);
#pragma unroll
    for (int r = 0; r < 16; ++r) { const int orow = crow(r, hi);
#pragma unroll
      for (int d0 = 0; d0 < 4; ++d0) stg[orow * 128 + d0 * 32 + r32] = o[d0][r] * rli[r]; }
    asm volatile("s_waitcnt lgkmcnt(0)" ::: "memory");
    const int ch = lane & 15, rb = lane >> 4;
    const bf16* Gw = Gb + (long)(wid * QBLK + rb) * LDQ + ch * 8; const int yoff = ((wid * QBLK + rb) * LDY + ch * 8) * 2;
    bf16* Yq = Yb; asm volatile("" : "+s"(Yq));
    const __amdgpu_buffer_rsrc_t rsY = __builtin_amdgcn_make_buffer_rsrc((void*)Yq, 0, 0x40000000, 0x00020000);
    u32x4 gq[8];
#pragma unroll
    for (int i = 0; i < 8; ++i) gq[i] = *(const u32x4*)(Gw + (long)(4 * i) * LDQ);
#pragma unroll
    for (int i = 0; i < 8; ++i) { const float* sp = stg + (4 * i + rb) * 128 + ch * 8;
      const f32x4_ a = *(const f32x4_*)sp, b = *(const f32x4_*)(sp + 4); u32x4 w;
      w[0] = cvtpk(a[0] * __uint_as_float(gq[i][0] << 16), a[1] * __uint_as_float(gq[i][0] & 0xffff0000u));
      w[1] = cvtpk(a[2] * __uint_as_float(gq[i][1] << 16), a[3] * __uint_as_float(gq[i][1] & 0xffff0000u));
      w[2] = cvtpk(b[0] * __uint_as_float(gq[i][2] << 16), b[1] * __uint_as_float(gq[i][2] & 0xffff0000u));
      w[3] = cvtpk(b[2] * __uint_as_float(gq[i][3] << 16), b[3] * __uint_as_float(gq[i][3] & 0xffff0000u));
      __builtin_amdgcn_raw_buffer_store_b128(w, rsY, yoff + (4 * i) * LDY * 2, 0, 16); } }
  __syncthreads();
#undef SLOAD
#undef SWRITE
#undef SWAIT
#undef RESC
}

__device__ __forceinline__ void attn_band_unit(const bf16* __restrict__ P, bf16* __restrict__ OG, float* __restrict__ LSE, int g, int b, int h, int blk, int cqb, int ckb, int cvb, int seqlen, int ntok, char* lds, const int wave_) {
  using St = Stage<bf16>;
  const int wid = wave_, lane = fresh_lane(), tid = wid * 64 + lane, r32 = lane & 31, hi = lane >> 5;
  bf16* V_lds = (bf16*)lds; bf16* K_lds = (bf16*)(lds + 2 * SHM_V);
  float* ws = (float*)(lds + 2 * SHM_V + 2 * SHM_K) + wid * 64; float* li_l = ws; float* al_l = ws + 32;
  const int dil = (g == 0) ? 1 : (g == 1 ? 4 : 16), head = g * 4 + h;
  int rq, lq0, ntile, t_lo, res0;
  if (g < 2) { const int kb = (g == 0) ? blk : (blk & 1), nt_all = seqlen / dil / 64; res0 = (g == 0) ? 0 : (blk >> 1);
    rq = res0; lq0 = 256 * kb + 32 * wid; t_lo = (4 * kb - 1 < 0) ? 0 : 4 * kb - 1; const int t_hi = (4 * kb + 5 > nt_all) ? nt_all : 4 * kb + 5; ntile = t_hi - t_lo; }
  else { res0 = 2 * blk; rq = res0 + (wid >> 2); lq0 = 32 * (wid & 3); t_lo = 0; ntile = 4; }
  const long tok0 = (long)b * seqlen;
  const bf16* Pq = P + cqb + head * D; const bf16* Pk = P + ckb + head * D; const bf16* Pv = P + cvb + head * D;
  float m_reg = -1e30f, l_reg = 0; f32x16 o[4] = {}; bf16x8 qr[8];
  { const bf16* Qw = Pq + (tok0 + (long)(lq0 + r32) * dil + rq) * LDQ + hi * 8;
#pragma unroll
    for (int d0 = 0; d0 < 8; ++d0) qr[d0] = St::ld8(Qw + d0 * 16); }
  const int sr = tid >> 4, sc = (tid & 15) * 8, vst0 = v_st(sr, sc), vst1 = v_st(32 + sr, sc);
  const int vb0 = (int)(uintptr_t)V_lds + v_rd_base(lane);
  typename St::T vs0, vs1, ks0, ks1, vt0, vt1, kt0, kt1;
#define TILE_RK(tt) ((g < 2) ? res0 : res0 + ((tt) >> 1))
#define TILE_LK0(tt) ((g < 2) ? 64 * (t_lo + (tt)) : 64 * ((tt) & 1))
#define BLOAD(tt, V0, V1, K0, K1) do { const int rk_ = TILE_RK(tt), lk_ = TILE_LK0(tt); const long ta = (tok0 + (long)(lk_ + sr) * dil + rk_) * LDK + sc, tb = (tok0 + (long)(lk_ + 32 + sr) * dil + rk_) * LDK + sc; \
    V0 = St::ld8(Pv + ta); V1 = St::ld8(Pv + tb); K0 = St::ld8(Pk + ta); K1 = St::ld8(Pk + tb); } while (0)
#define BWRITE(V0, V1, K0, K1) do { *(bf16x8*)((char*)V_lds + vst0) = V0; *(bf16x8*)((char*)V_lds + vst1) = V1; const int kc = sc * 2; \
    *(bf16x8*)((char*)K_lds + KSWZ(sr, kc)) = K0; *(bf16x8*)((char*)K_lds + KSWZ(32 + sr, kc)) = K1; } while (0)
#define BCOMPUTE(tt) do { const int rk = TILE_RK(tt), lk0 = TILE_LK0(tt); \
    const bool need = (rk == rq) && (lk0 + 63 >= lq0 - 64) && (lk0 <= lq0 + 95); \
    if (need) { \
      f32x16 p0, p1; float mn, alpha; bf16x8 pa0, pa1, pa2, pa3; \
      qkt(p0, p1, K_lds, qr, r32, hi); \
      const int dd = lk0 - lq0 - r32 + 4 * hi;                      \
      _Pragma("unroll") for (int r = 0; r < 16; ++r) { const int d0_ = dd + (r & 3) + 8 * (r >> 2), d1_ = d0_ + 32; \
        if (d0_ < -64 || d0_ > 64) p0[r] = -INFINITY; if (d1_ < -64 || d1_ > 64) p1[r] = -INFINITY; } \
      partialSM(p0, p1, m_reg, mn, alpha); \
      if (__any(alpha < 1.f)) { if (hi == 0) al_l[r32] = alpha; asm volatile("s_waitcnt lgkmcnt(0)" ::: "memory"); \
        _Pragma("unroll") for (int d = 0; d < 4; ++d) _Pragma("unroll") for (int r = 0; r < 16; ++r) o[d][r] *= al_l[crow(r, hi)]; } \
      finishSM(p0, p1, alpha, l_reg, pa0, pa1, pa2, pa3); SBAR(); \
      pv_d0(o, vb0, pa0, pa1, pa2, pa3); \
    } } while (0)
  BLOAD(0, vs0, vs1, ks0, ks1); if (ntile > 1) BLOAD(1, vt0, vt1, kt0, kt1);
  for (int tt = 0; tt < ntile; tt += 2) {
    __syncthreads();
    BWRITE(vs0, vs1, ks0, ks1);
    __syncthreads();
    if (tt + 2 < ntile) BLOAD(tt + 2, vs0, vs1, ks0, ks1);
    BCOMPUTE(tt);
    if (tt + 1 < ntile) {
      __syncthreads();
      BWRITE(vt0, vt1, kt0, kt1);
      __syncthreads();
      if (tt + 3 < ntile) BLOAD(tt + 3, vt0, vt1, kt0, kt1);
      BCOMPUTE(tt + 1);
    }
  }
#undef BWRITE
#undef BCOMPUTE
#undef BLOAD
#undef TILE_RK
#undef TILE_LK0
  if (hi == 0) li_l[r32] = l_reg; asm volatile("s_waitcnt lgkmcnt(0)" ::: "memory");
  float rli[16];
#pragma unroll
  for (int r = 0; r < 16; ++r) rli[r] = __builtin_amdgcn_rcpf(li_l[crow(r, hi)]);
  __syncthreads();
  { float* stg = (float*)(lds + wid * 16384);
#pragma unroll
    for (int r = 0; r < 16; ++r) { const int orow = crow(r, hi);
#pragma unroll
      for (int d0 = 0; d0 < 4; ++d0) stg[orow * 128 + d0 * 32 + r32] = o[d0][r] * rli[r]; }
    asm volatile("s_waitcnt lgkmcnt(0)" ::: "memory");
    const int ch = lane & 15, rb = lane >> 4;
    bf16* OGq = OG; asm volatile("" : "+s"(OGq));
    const __amdgpu_buffer_rsrc_t rsOG = __builtin_amdgcn_make_buffer_rsrc((void*)OGq, 0, 3 * 8192 * 512 * 2, 0x00020000);
#pragma unroll
    for (int i = 0; i < 8; ++i) { const int row = 4 * i + rb; const float* sp = stg + row * 128 + ch * 8;
      const f32x4_ a = *(const f32x4_*)sp, b = *(const f32x4_*)(sp + 4); u32x4 w;
      w[0] = cvtpk(a[0], a[1]); w[1] = cvtpk(a[2], a[3]); w[2] = cvtpk(b[0], b[1]); w[3] = cvtpk(b[2], b[3]);
      __builtin_amdgcn_raw_buffer_store_b128(w, rsOG, (int)(((long)g * ntok * 512 + h * D + ch * 8 + (tok0 + (long)(lq0 + row) * dil + rq) * 512) * 2), 0, 16); } }
  if (hi == 0) __hip_atomic_store(LSE + ((long)g * ntok + tok0 + (long)(lq0 + r32) * dil + rq) * 4 + h, m_reg * SCALE + __logf(l_reg), __ATOMIC_RELAXED, __HIP_MEMORY_SCOPE_AGENT);
  __syncthreads();
}
}

typedef unsigned short bf16_t;
constexpr int BATCH = 4, SEQ = 2048, DM = 2048, NTOK = BATCH * SEQ, NC = 11776;
constexpr int C_QA = 0, C_KA = 1024, C_VA = 1280, C_GA = 1536, C_QB = 2560, C_KB = 4096, C_VB = 5632, C_GB = 7168, C_ZA = 7680, C_ZB = 9728;
constexpr float EPS = 1e-6f;
constexpr float H8_SCALE = 4.0f, W8_SCALE = 64.0f;
constexpr size_t MiB = 1u << 20;
constexpr int PITCH = 7680;
constexpr size_t WS_CTL = 0, WS_TAB = 1 * MiB, WS_XB = 1 * MiB + 512 * 1024, WS_WTIN = 2 * MiB, WS_WTAB = 48 * MiB, WS_WTO = 54 * MiB, WS_HB = 64 * MiB, WS_P = 96 * MiB, WS_Y = 216 * MiB, WS_OG = 240 * MiB, WS_LSE = 264 * MiB,
                 WS_SA = 266 * MiB, WS_SB = 298 * MiB, WS_H8 = 330 * MiB, WS_WTZ8 = 346 * MiB, WS_END = 361 * MiB;

#define LAS __attribute__((address_space(3)))
typedef float f32x4 __attribute__((ext_vector_type(4)));
typedef unsigned v4u __attribute__((ext_vector_type(4)));
constexpr int NWAVES = 8;
constexpr int LDS_BYTES = 147456;

__device__ __forceinline__ float bf2f(bf16_t h) { return __uint_as_float(((unsigned)h) << 16); }
__device__ __forceinline__ unsigned f2bf_u(float f) { unsigned u = __float_as_uint(f); return (u + 0x7fffu + ((u >> 16) & 1u)) >> 16; }
__device__ __forceinline__ bf16_t f2bf(float f) { return (bf16_t)f2bf_u(f); }
__device__ __forceinline__ unsigned pk2(float lo, float hi) { return f2bf_u(lo) | (f2bf_u(hi) << 16); }
__device__ __forceinline__ float wave_sum(float v) {
#pragma unroll
    for (int o = 1; o < 64; o <<= 1) v += __shfl_xor(v, o);
    return v;
}

__device__ __forceinline__ int colmap(int kind, int p) {
    const int bj = p >> 7, wc = (p >> 5) & 3, n = (p >> 4) & 1, fq = (p >> 2) & 3, j = p & 3;
    const int gen = 128 * bj + 32 * wc + 8 * fq + 4 * n + j;
    if (kind == 0) return p;
    if (kind == 1) return gen;
    if (kind == 2) return 128 * bj + 64 * (wc >> 1) + 32 * n + 16 * (wc & 1) + 4 * fq + j;
    return wc == 0 ? p : gen;
}
__device__ __forceinline__ int kind_in(int pn) { return pn < 5 ? 2 : ((pn >= 10 && pn < 22) ? 3 : 1); }

struct TrSrc { const float* W; int N; bf16_t* WT; int ldt, koff, kindsel; unsigned char* wt8; int n8; };
__device__ __forceinline__ void tr_load(const TrSrc& t, int item, int lane, f32x4 (&v)[8]) {
    const int nblk = t.N / 32, kb = item / nblk, nb = item % nblk, k0 = 64 * kb, n0 = 32 * nb;
    const int np = n0 + 4 * (lane & 7), pn = np >> 8;
    const int kind = t.kindsel < 0 ? kind_in(pn) : t.kindsel;
    const int pq = np & 255;
    const int scol = (t.wt8 != nullptr && pn >= 30) ? (pq < 128 ? 7680 : 9728) + 128 * (pn - 30) + colmap(1, pq & 127) : (pn << 8) + colmap(kind, pq);
    const float* src = t.W + (size_t)(k0 + (lane >> 3)) * t.N + scol;
#pragma unroll
    for (int i = 0; i < 8; ++i) v[i] = __builtin_nontemporal_load((const f32x4*)(src + (size_t)(8 * i) * t.N));
}
__device__ __forceinline__ void tr_store(const TrSrc& t, int item, int lane, const f32x4 (&v)[8], LAS float* scr) {
    const int nblk = t.N / 32, kb = item / nblk, nb = item % nblk, k0 = 64 * kb, n0 = 32 * nb;
    { LAS float* d = scr + (lane >> 3) * 33 + 4 * (lane & 7);
#pragma unroll
      for (int i = 0; i < 8; ++i) { d[i * 264 + 0] = v[i][0]; d[i * 264 + 1] = v[i][1]; d[i * 264 + 2] = v[i][2]; d[i * 264 + 3] = v[i][3]; } }
    asm volatile("s_waitcnt lgkmcnt(0)" ::: "memory");
    const int c = lane & 7;
    const int pn_ = n0 >> 8; const bool is8 = t.wt8 != nullptr && (n0 >= t.n8 || pn_ < 14);
    const int n8row = n0 >= t.n8 ? n0 - t.n8 + 14 * 256 : n0;
    if (is8) {
#pragma unroll
        for (int j = 0; j < 4; ++j) { const int n = (lane >> 3) + 8 * j; const LAS float* sp = scr + (8 * c) * 33 + n;
            int lo = 0, hi = 0;
            lo = __builtin_amdgcn_cvt_pk_fp8_f32(sp[0 * 33] * W8_SCALE, sp[1 * 33] * W8_SCALE, lo, false); lo = __builtin_amdgcn_cvt_pk_fp8_f32(sp[2 * 33] * W8_SCALE, sp[3 * 33] * W8_SCALE, lo, true);
            hi = __builtin_amdgcn_cvt_pk_fp8_f32(sp[4 * 33] * W8_SCALE, sp[5 * 33] * W8_SCALE, hi, false); hi = __builtin_amdgcn_cvt_pk_fp8_f32(sp[6 * 33] * W8_SCALE, sp[7 * 33] * W8_SCALE, hi, true);
            *(unsigned long long*)(t.wt8 + (size_t)(n8row + n) * t.ldt + k0 + 8 * c) = (unsigned long long)(unsigned)lo | ((unsigned long long)(unsigned)hi << 32); }
    } else {
#pragma unroll
    for (int j = 0; j < 4; ++j) { const int n = (lane >> 3) + 8 * j; const LAS float* sp = scr + (8 * c) * 33 + n;
        v4u o; o.x = pk2(sp[0 * 33], sp[1 * 33]); o.y = pk2(sp[2 * 33], sp[3 * 33]); o.z = pk2(sp[4 * 33], sp[5 * 33]); o.w = pk2(sp[6 * 33], sp[7 * 33]);
        *(v4u*)(t.WT + (size_t)(n0 + n) * t.ldt + t.koff + k0 + 8 * c) = o; }
    }
    asm volatile("s_waitcnt lgkmcnt(0)" ::: "memory");
}
__device__ __forceinline__ void tr_matrix(const TrSrc& t, int nitems, int gw, int NGW, int lane, LAS float* scr) {
    f32x4 a[8], b[8];
    int it = gw;
    if (it < nitems) tr_load(t, it, lane, a);
    for (; it < nitems; it += 2 * NGW) {
        const bool hb = it + NGW < nitems;
        if (hb) tr_load(t, it + NGW, lane, b);
        tr_store(t, it, lane, a, scr);
        if (hb) { if (it + 2 * NGW < nitems) tr_load(t, it + 2 * NGW, lane, a); tr_store(t, it + NGW, lane, b, scr); }
    }
}
__device__ __forceinline__ void rms_row_load(const float* xrow, int lane, f32x4 (&v)[8]) {
    const f32x4* xr = (const f32x4*)xrow + lane;
#pragma unroll
    for (int j = 0; j < 8; ++j) v[j] = __builtin_nontemporal_load(xr + 64 * j);
}
__device__ __forceinline__ void rms_row_store(const f32x4 (&v)[8], const float* gain, bf16_t* orow, unsigned char* orow8, int lane) {
    const f32x4* gr = (const f32x4*)gain + lane; float s = 0.f;
#pragma unroll
    for (int j = 0; j < 8; ++j) s += (v[j].x * v[j].x + v[j].y * v[j].y) + (v[j].z * v[j].z + v[j].w * v[j].w);
    const float rs = rsqrtf(wave_sum(s) * (1.f / DM) + EPS);
    unsigned long long* o8 = (unsigned long long*)orow + lane;
    unsigned* q8 = (unsigned*)orow8 + lane;
#pragma unroll
    for (int j = 0; j < 8; ++j) { const f32x4 g = gr[64 * j]; const f32x4 y = v[j] * rs * g;
        o8[64 * j] = (unsigned long long)pk2(y.x, y.y) | ((unsigned long long)pk2(y.z, y.w) << 32);
        int w = 0; w = __builtin_amdgcn_cvt_pk_fp8_f32(y.x * H8_SCALE, y.y * H8_SCALE, w, false); w = __builtin_amdgcn_cvt_pk_fp8_f32(y.z * H8_SCALE, y.w * H8_SCALE, w, true);
        q8[64 * j] = (unsigned)w; }
}
__device__ __forceinline__ void rms_rows(const float* x, const float* gain, bf16_t* H, unsigned char* H8, int m0, int step, int nrows, int lane) {
    f32x4 a[8], b[8];
    int m = m0;
    if (m < nrows) rms_row_load(x + (size_t)m * DM, lane, a);
    for (; m < nrows; m += 2 * step) {
        const bool hb = m + step < nrows;
        if (hb) rms_row_load(x + (size_t)(m + step) * DM, lane, b);
        rms_row_store(a, gain, H + (size_t)m * DM, H8 + (size_t)m * DM, lane);
        if (hb) { if (m + 2 * step < nrows) rms_row_load(x + (size_t)(m + 2 * step) * DM, lane, a); rms_row_store(b, gain, H + (size_t)(m + step) * DM, H8 + (size_t)(m + step) * DM, lane); }
    }
}

#define XB_TMO      128
#define XB_XCNT(j)  (256  + 64 * (j))
#define XB_XSUB(j)  (1280 + 64 * (j))
#define XB_XGEN(j)  (2304 + 64 * (j))
#define XB_TOP      3328
#define XB_TOPGEN   3392
#define XCD_BAR_WORDS 3456
#define XB_SPIN_CAP (1u << 18)

__device__ __forceinline__ unsigned xb_ld(unsigned* p)              { return __hip_atomic_load(p, __ATOMIC_RELAXED, __HIP_MEMORY_SCOPE_AGENT); }
__device__ __forceinline__ unsigned xb_add(unsigned* p, unsigned v) { return __hip_atomic_fetch_add(p, v, __ATOMIC_RELAXED, __HIP_MEMORY_SCOPE_AGENT); }
__device__ __forceinline__ unsigned xb_xcc_id() { return (unsigned)__builtin_amdgcn_s_getreg((3 << 11) | 20) & 0xFu; }
#define XB_SPIN(cond, bar) do { unsigned _sp = 0; while (cond) { __builtin_amdgcn_s_sleep(1); \
    if ((++_sp & 255u) == 0u) { if (xb_ld(&(bar)[XB_TMO])) break; if (_sp > XB_SPIN_CAP) { atomicAdd(&(bar)[XB_TMO], 1u); break; } } } } while (0)

struct XcdBarrier {
    unsigned* bar; unsigned x;
    volatile LAS unsigned* st;
};

__device__ __forceinline__ XcdBarrier xcd_barrier_post(unsigned* bar, volatile LAS unsigned* st) {
    XcdBarrier b; b.bar = bar; b.x = xb_xcc_id(); b.st = st;
    if (threadIdx.x == 0) (void)xb_add(&bar[XB_XCNT(b.x)], 1u);
    return b;
}
__device__ __forceinline__ void xcd_barrier_complete(unsigned* bar, unsigned x, unsigned& nloc, unsigned& nx) {
    const unsigned G = gridDim.x * gridDim.y * gridDim.z;
    unsigned sum, cnt, mine, sp = 0u;
    for (;;) {
        sum = 0u; cnt = 0u; mine = 0u;
#pragma unroll
        for (unsigned j = 0; j < 16; ++j) { const unsigned c = xb_ld(&bar[XB_XCNT(j)]); sum += c; cnt += (c > 0u) ? 1u : 0u; mine = (j == x) ? c : mine; }
        if (sum == G) break;
        __builtin_amdgcn_s_sleep(1);
        if ((++sp & 255u) == 0u) { if (xb_ld(&bar[XB_TMO])) break; if (sp > XB_SPIN_CAP) { atomicAdd(&bar[XB_TMO], 1u); break; } }
    }
    nloc = mine > 0u ? mine : 1u; nx = cnt > 0u ? cnt : 1u;
}

__device__ __forceinline__ void xcd_barrier(const XcdBarrier& b, const int wave_) {
    asm volatile("s_waitcnt vmcnt(0)" ::: "memory");
    __syncthreads();
    if (wave_ == 0 && fresh_lane() == 0) {
        unsigned* bar = b.bar;
        __builtin_amdgcn_s_waitcnt(0);
        unsigned nloc = b.st[0], nx = b.st[1];
        if (nloc == 0u) { xcd_barrier_complete(bar, b.x, nloc, nx); b.st[0] = nloc; b.st[1] = nx; }
        const unsigned old = xb_add(&bar[XB_XSUB(b.x)], 1u);
        const unsigned gen = old / nloc;
        if (old + 1u == (gen + 1u) * nloc) {
            __builtin_amdgcn_fence(__ATOMIC_RELEASE, "agent");
            asm volatile("s_waitcnt vmcnt(0)" ::: "memory");
            const unsigned og = xb_add(&bar[XB_TOP], 1u);
            const unsigned tg = og / nx;
            if (og + 1u == (tg + 1u) * nx) xb_add(&bar[XB_TOPGEN], 1u);
            else XB_SPIN(xb_ld(&bar[XB_TOPGEN]) == tg, bar);
            __builtin_amdgcn_fence(__ATOMIC_ACQUIRE, "agent");
            xb_add(&bar[XB_XGEN(b.x)], 1u);
            asm volatile("s_waitcnt vmcnt(0)" ::: "memory");
        } else {
            XB_SPIN(xb_ld(&bar[XB_XGEN(b.x)]) == gen, bar);
            __builtin_amdgcn_fence(__ATOMIC_ACQUIRE, "agent");
            asm volatile("s_waitcnt vmcnt(0)" ::: "memory");
        }
    }
    __syncthreads();
}

struct Args { const float* in[10]; float* out; unsigned char* ws; int ph_lo, ph_hi; };

__global__ void __launch_bounds__(NWAVES * 64, 2) mk_fwd(Args args) {
    extern __shared__ __attribute__((aligned(16))) unsigned char lds[];
    const int wave = __builtin_amdgcn_readfirstlane((int)threadIdx.x >> 6);
#define TID_LANE const int lane = fresh_lane(); const int tid = wave * 64 + lane; (void)tid; (void)lane;
    const int G = gridDim.x, bx = blockIdx.x;
    const int vcu = (G % 8 == 0) ? (bx % 8) * (G / 8) + bx / 8 : bx;
    unsigned char* ws = args.ws;
    const float* x = args.in[0]; const float* ng = args.in[1]; const float* w_in = args.in[2];
    bf16_t* WT_IN = (bf16_t*)(ws + WS_WTIN); bf16_t* HB = (bf16_t*)(ws + WS_HB); bf16_t* P = (bf16_t*)(ws + WS_P);
    float* COSA = (float*)(ws + WS_TAB); float* SINA = COSA + 2048; float* COSP = COSA + 4096; float* SINP = COSP + 32768;
    bf16_t* OG = (bf16_t*)(ws + WS_OG); float* LSE = (float*)(ws + WS_LSE); unsigned* CTL = (unsigned*)(ws + WS_CTL) + 4096;
    bf16_t* WT_AB = (bf16_t*)(ws + WS_WTAB); bf16_t* WT_O = (bf16_t*)(ws + WS_WTO); bf16_t* Y = (bf16_t*)(ws + WS_Y); bf16_t* MG = HB; unsigned char* H8 = ws + WS_H8; unsigned char* WTZ8 = ws + WS_WTZ8; bf16_t* SA = (bf16_t*)(ws + WS_SA); bf16_t* SB = (bf16_t*)(ws + WS_SB); float* XB = (float*)(ws + WS_XB); unsigned* PCNT = (unsigned*)(ws + WS_CTL) + 8192; unsigned* PC2 = (unsigned*)(ws + WS_CTL) + 10240;
    const int lo = args.ph_lo, hi = args.ph_hi;
    volatile LAS unsigned* MISC = (volatile LAS unsigned*)((LAS unsigned char*)lds + 131072 + 320);
    if (threadIdx.x < 32) MISC[threadIdx.x] = 0u;
    __syncthreads();
    XcdBarrier bar = xcd_barrier_post((unsigned*)(ws + WS_CTL), MISC + 8);
#define GRID_BAR() xcd_barrier(bar, wave)
#define IN(k) (lo <= (k) && (k) < hi)
#define BOTH(k) (IN(k) && IN((k) + 1))
    if (IN(0)) { TID_LANE
        LAS float* scr = (LAS float*)((LAS unsigned char*)lds + wave * 16384);
        const int gw = vcu * NWAVES + wave, NGW = G * NWAVES;
        constexpr int I_IN = (DM / 64) * (NC / 32);
        { const TrSrc t{w_in, NC, WT_IN, DM, 0, -1, WTZ8, 7680}; tr_matrix(t, I_IN, gw, NGW, lane, scr); }
        for (int i = bx * (NWAVES * 64) + tid; i < 2048 + 32768; i += G * NWAVES * 64) {
            if (i < 2048) { const int pos = i >> 5, fi = i & 31; const float a = (float)pos * (1.0f / powf(10000.0f, (float)fi / 32.0f)); COSA[i] = cosf(a); SINA[i] = sinf(a); }
            else { const int k = i - 2048, pos = k >> 4, fi = k & 15; const float a = (float)pos * (1.0f / powf(500000.0f, (float)fi / 16.0f)); COSP[k] = cosf(a); SINP[k] = sinf(a); }
        }
        rms_rows(x, ng, HB, H8, gw, NGW, NTOK, lane);
        if (BOTH(0)) GRID_BAR();
    }
    if (IN(1)) { TID_LANE
        const float dsc = 1.0f / (H8_SCALE * W8_SCALE);
        {
            pg8::Gemm g{HB, WT_IN + (size_t)14 * 256 * DM, NTOK, 16 * 256, DM}; pg8::StaticOrder S; S.init(NTOK, 16 * 256, G, bx, 8);
            pg8::EpiIn<false> E{P, PITCH, COSA, SINA, COSP, SINP, args.in[3], args.in[4], args.in[5], SA, SB, (LAS float*)((LAS unsigned char*)lds + 131072 + 1024), EPS, 1.0f};
            pg8::gemm_phase<pg8::EpiIn<false>, pg8::StaticOrder, true, true>((LAS unsigned char*)lds, g, S, E, wave);
        }
        {
            pg8::Gemm g8{(const bf16_t*)H8, (const bf16_t*)WTZ8, NTOK, 30 * 256, DM / 2}; pg8::StaticOrder S8; S8.init(NTOK, 30 * 256, G, bx, 4);
            pg8::EpiIn<true> E8{P, PITCH, COSA, SINA, COSP, SINP, args.in[3], args.in[4], args.in[5], SA, SB, (LAS float*)((LAS unsigned char*)lds + 131072 + 1024), EPS, dsc};
            pg8::gemm_phase<pg8::EpiIn<true>, pg8::StaticOrder, true, true>((LAS unsigned char*)lds, g8, S8, E8, wave);
        }
        const int nheavy = ((NTOK / 256) * 30) % G;
        {
            const int first = nheavy > 0 ? nheavy : 0, nidle = G - first;
            if (bx >= first) {
                LAS float* scr = (LAS float*)((LAS unsigned char*)lds + wave * 16384);
                const int gw2 = (bx - first) * NWAVES + wave, NGW2 = nidle * NWAVES;
                constexpr int I_A = (1024 / 64) * (DM / 32), I_B = (512 / 64) * (DM / 32), I_O = (DM / 64) * (DM / 32);
                { const TrSrc t{args.in[6], DM, WT_AB, 1536, 0, 1, nullptr, 0}; tr_matrix(t, I_A, gw2, NGW2, lane, scr); }
                { const TrSrc t{args.in[7], DM, WT_AB, 1536, 1024, 1, nullptr, 0}; tr_matrix(t, I_B, gw2, NGW2, lane, scr); }
                { const TrSrc t{args.in[8], DM, WT_O, DM, 0, 0, nullptr, 0}; tr_matrix(t, I_O, gw2, NGW2, lane, scr); }
            }
        }
        if (BOTH(1)) GRID_BAR();
    }
    if (IN(2)) { TID_LANE
        for (int u = bx; u < 384; u += G) {
            const int blk = u & 7, h = (u >> 3) & 3, b = (u >> 5) & 3, g = u >> 7;
            att::attn_band_unit(P, OG, LSE, g, b, h, blk, C_QB, C_KB, C_VB, SEQ, NTOK, (char*)lds, wave);
        }
        asm volatile("s_waitcnt vmcnt(0)" ::: "memory"); __syncthreads();
        if (tid == 0) __hip_atomic_fetch_add(CTL, 1u, __ATOMIC_RELAXED, __HIP_MEMORY_SCOPE_AGENT);
        for (int u = bx; u < 256; u += G) {
            const int pair = u & 7, inner = u >> 3, b = pair >> 1, hkv = pair & 1, hq = hkv * 4 + (inner >> 3), qb = inner & 7;
            const size_t row0 = (size_t)b * SEQ + qb * 256;
            att::attn_dense_body(P + row0 * PITCH + C_QA + hq * 128, P + (size_t)b * SEQ * PITCH + C_KA + hkv * 128, P + (size_t)b * SEQ * PITCH + C_VA + hkv * 128,
                                 P + row0 * PITCH + C_GA + hq * 128, Y + row0 * 1536 + hq * 128, SEQ, (char*)lds, wave);
            if (G == 256) { asm volatile("s_waitcnt vmcnt(0)" ::: "memory"); __syncthreads();
                if (tid == 0) __hip_atomic_fetch_add(PC2 + 64 * (b * 8 + qb), 1u, __ATOMIC_RELAXED, __HIP_MEMORY_SCOPE_AGENT); }
        }
        const int mfirst = (384 - G > 0 && 384 - G < G) ? 384 - G : 0, nmerge = G - mfirst;
        if (bx >= mfirst) {
            if (tid == 0) { unsigned spins = 0; while (__hip_atomic_load(CTL, __ATOMIC_RELAXED, __HIP_MEMORY_SCOPE_AGENT) < (unsigned)G) { __builtin_amdgcn_s_sleep(4); if (++spins > (1u << 24)) break; }
                __builtin_amdgcn_fence(__ATOMIC_ACQUIRE, "agent"); asm volatile("s_waitcnt vmcnt(0)" ::: "memory"); }
            __syncthreads();
            const int mj = bx - mfirst, mbase = (G == 256) ? (256 * (mj >> 2) + 64 * (mj & 3)) * 64 : mj * (NWAVES * 64), mend = (G == 256) ? mbase + 64 * 64 : NTOK * 64, mstep = (G == 256) ? NWAVES * 64 : nmerge * NWAVES * 64;
            const __amdgpu_buffer_rsrc_t rsYm = __builtin_amdgcn_make_buffer_rsrc((void*)Y, 0, NTOK * 1536 * 2, 0x00020000);
            for (int c0 = mbase + tid; c0 < mend; c0 += 2 * mstep) {
                v4u a0[2], a1[2], a2[2], gz[2]; float e0[2], e1[2], e2[2]; int tok[2], c8[2]; bool ok[2];
#pragma unroll
                for (int q = 0; q < 2; ++q) { const int ci = c0 + q * mstep; ok[q] = ci < mend; const int cj = ok[q] ? ci : c0; tok[q] = cj >> 6; c8[q] = (cj & 63) * 8; const int h = c8[q] >> 7;
                    e0[q] = LSE[((size_t)0 * NTOK + tok[q]) * 4 + h]; e1[q] = LSE[((size_t)1 * NTOK + tok[q]) * 4 + h]; e2[q] = LSE[((size_t)2 * NTOK + tok[q]) * 4 + h];
                    a0[q] = *(const v4u*)(OG + ((size_t)0 * NTOK + tok[q]) * 512 + c8[q]); a1[q] = *(const v4u*)(OG + ((size_t)1 * NTOK + tok[q]) * 512 + c8[q]); a2[q] = *(const v4u*)(OG + ((size_t)2 * NTOK + tok[q]) * 512 + c8[q]);
                    gz[q] = *(const v4u*)(P + (size_t)tok[q] * PITCH + C_GB + c8[q]); }
#pragma unroll
                for (int q = 0; q < 2; ++q) { const float mx = fmaxf(e0[q], fmaxf(e1[q], e2[q])); float w0 = __expf(e0[q] - mx), w1 = __expf(e1[q] - mx), w2 = __expf(e2[q] - mx); const float inv = 1.f / (w0 + w1 + w2); w0 *= inv; w1 *= inv; w2 *= inv;
                    v4u w;
#pragma unroll
                    for (int e = 0; e < 4; ++e) {
                        const float lo = w0 * __uint_as_float(a0[q][e] << 16) + w1 * __uint_as_float(a1[q][e] << 16) + w2 * __uint_as_float(a2[q][e] << 16);
                        const float hh = w0 * __uint_as_float(a0[q][e] & 0xffff0000u) + w1 * __uint_as_float(a1[q][e] & 0xffff0000u) + w2 * __uint_as_float(a2[q][e] & 0xffff0000u);
                        w[e] = pk2(lo * __uint_as_float(gz[q][e] << 16), hh * __uint_as_float(gz[q][e] & 0xffff0000u)); }
                    if (ok[q]) __builtin_amdgcn_raw_buffer_store_b128(w, rsYm, (int)(((size_t)tok[q] * 1536 + 1024 + c8[q]) * 2), 0, 16); }
            }
            if (G == 256) { asm volatile("s_waitcnt vmcnt(0)" ::: "memory"); __syncthreads(); if (tid == 0) __hip_atomic_fetch_add(PC2 + 64 * (mj >> 2), 1u, __ATOMIC_RELAXED, __HIP_MEMORY_SCOPE_AGENT); }
        }
        if (BOTH(2) && G != 256) GRID_BAR();
    }
    if (IN(3)) {
        pg8::Gemm g{Y, WT_AB, NTOK, DM, 1536}; pg8::StaticOrder S; S.init(NTOK, DM, G, bx, 4);
        if (G == 256 && IN(2)) {
            pg8::Unit u2; if (S.next(0, u2)) {
                unsigned* pc2 = PC2 + 64 * u2.pm;
                if (wave == 0 && fresh_lane() == 0) { unsigned spins = 0; while (__hip_atomic_load(pc2, __ATOMIC_RELAXED, __HIP_MEMORY_SCOPE_AGENT) < 12u) { __builtin_amdgcn_s_sleep(2); if (++spins > (1u << 22)) break; }
                    __builtin_amdgcn_fence(__ATOMIC_ACQUIRE, "agent"); asm volatile("s_waitcnt vmcnt(0)" ::: "memory"); }
                __syncthreads(); } }
        pg8::EpiMerge2 E{SA, SB, MG, DM};
        pg8::gemm_phase<pg8::EpiMerge2, pg8::StaticOrder, true, true>((LAS unsigned char*)lds, g, S, E, wave);
        if (BOTH(3)) {
            pg8::Unit u3; const bool has = S.next(0, u3);
            if (G == 256 && has) {
                unsigned* pc3 = (unsigned*)(ws + WS_CTL) + 5120 + 64 * u3.pm;
                asm volatile("s_waitcnt vmcnt(0)" ::: "memory"); __syncthreads();
                if (wave == 0 && fresh_lane() == 0) {
                    __hip_atomic_fetch_add(pc3, 1u, __ATOMIC_RELAXED, __HIP_MEMORY_SCOPE_AGENT);
                    unsigned spins = 0; while (__hip_atomic_load(pc3, __ATOMIC_RELAXED, __HIP_MEMORY_SCOPE_AGENT) < 8u) { __builtin_amdgcn_s_sleep(2); if (++spins > (1u << 22)) break; }
                    __builtin_amdgcn_fence(__ATOMIC_ACQUIRE, "agent"); asm volatile("s_waitcnt vmcnt(0)" ::: "memory"); }
                __syncthreads();
            } else GRID_BAR();
        }
    }
    if (IN(4)) {
        pg8::Gemm g{MG, WT_O, NTOK, DM, DM}; pg8::StaticOrder S; S.init(NTOK, DM, G, bx, 4);
        pg8::EpiResidNorm E{x, args.out, DM, args.in[9], XB, PCNT, 8, EPS};
        if (G == 256) pg8::gemm_phase<pg8::EpiResidNorm, pg8::StaticOrder, false, true>((LAS unsigned char*)lds, g, S, E, wave);
    }
#undef IN
#undef BOTH
}


extern "C" void kernel_launch(void* const* d_in, const int* in_sizes, int n_in, void* d_out, int out_size, void* d_ws, size_t ws_size, hipStream_t stream) {
    static int grid = 0;
    if (grid == 0) {
        if (n_in != 10 || in_sizes[0] != NTOK * DM || out_size != NTOK * DM || ws_size < WS_END) { fprintf(stderr, "kernel_launch: unexpected shapes / workspace (%zu)\n", ws_size); grid = -1; return; }
        int dev = 0, cus = 0, per_cu = 0;
        if (hipGetDevice(&dev) != hipSuccess || hipDeviceGetAttribute(&cus, hipDeviceAttributeMultiprocessorCount, dev) != hipSuccess) { grid = -1; return; }
        if (hipFuncSetAttribute((const void*)mk_fwd, hipFuncAttributeMaxDynamicSharedMemorySize, LDS_BYTES) != hipSuccess) { fprintf(stderr, "kernel_launch: hipFuncSetAttribute failed\n"); grid = -1; return; }
        if (hipOccupancyMaxActiveBlocksPerMultiprocessor(&per_cu, (const void*)mk_fwd, NWAVES * 64, LDS_BYTES) != hipSuccess || per_cu < 1) { fprintf(stderr, "kernel_launch: occupancy query says %d\n", per_cu); grid = -1; return; }
        grid = cus;
    }
    if (grid < 0) return;
    if (hipMemsetAsync((char*)d_ws + WS_CTL, 0, 131072, stream) != hipSuccess) { fprintf(stderr, "kernel_launch: memset failed\n"); return; }
    Args a{};
    for (int i = 0; i < 10; ++i) a.in[i] = (const float*)d_in[i];
    a.out = (float*)d_out; a.ws = (unsigned char*)d_ws; a.ph_lo = 0; a.ph_hi = 5;
    void* kargs[] = {&a};
    hipError_t e = hipLaunchCooperativeKernel((const void*)mk_fwd, dim3(grid), dim3(NWAVES * 64), kargs, LDS_BYTES, stream);
    if (e != hipSuccess) fprintf(stderr, "kernel_launch: cooperative launch failed: %s (grid %d)\n", hipGetErrorString(e), grid);
}
```

```cpp
#include <hip/hip_runtime.h>
#include <cstdio>
#include <cstdint>
#include <cmath>
__device__ __forceinline__ int fresh_lane() { int l; asm volatile("v_mbcnt_lo_u32_b32 %0, -1, 0\n\tv_mbcnt_hi_u32_b32 %0, -1, %0" : "=v"(l)); return l; }
namespace pg8 {
#define PG8_LAS __attribute__((address_space(3)))
typedef unsigned short bf16_t;
typedef short bf16x8 __attribute__((ext_vector_type(8)));
typedef float f32x4 __attribute__((ext_vector_type(4)));
typedef unsigned u32x4 __attribute__((ext_vector_type(4)));
typedef int v4i_t __attribute__((ext_vector_type(4)));
constexpr int BM = 256, BK = 64, HALF = 128, HTB = HALF * BK * 2  , STAGE_BYTES = 8 * HTB, NXCD = 8;

__host__ __device__ __forceinline__ int lds_byte(int r, int c) { const int st = (r >> 4) * 2 + (c >> 5), rr = r & 15, cc = c & 31, ob = rr * 64 + cc * 2; return st * 1024 + (ob ^ (((ob >> 9) & 1) << 5)); }
__host__ __device__ __forceinline__ void stage_rc(int b, int& R, int& C) { const int st = b / 1024, sb = b % 1024, swz = sb ^ (((sb >> 9) & 1) << 5); R = (st >> 1) * 16 + swz / 64; C = (st & 1) * 32 + (swz % 64) / 2; }
__host__ __device__ __forceinline__ int perm32(int rho) { const int n = rho >> 4, i = rho & 15; return 8 * (i >> 2) + 4 * n + (i & 3); }

struct Unit { int pm, pn; };
struct Gemm { const bf16_t* A; const bf16_t* Bt; int M, N, K; };

struct StaticOrder {
    int nM, nN, nwg, G, c, WGM;
    __host__ __device__ void init(int M, int N, int G_, int c_, int wgm = 4) { nM = M / BM; nN = N / BM; nwg = nM * nN; G = G_; c = c_; WGM = wgm; }
    __host__ __device__ bool next(int i, Unit& u) const { const long L = (long)i * G + c; if (L >= nwg) return false; unit_of((int)L, u); return true; }
    __host__ __device__ bool unit_of(int L, Unit& u) const {
        int wgid = L; { const int q = nwg / NXCD, r = nwg % NXCD, xcd = wgid % NXCD, off = wgid / NXCD; wgid = (xcd < r ? xcd * (q + 1) : r * (q + 1) + (xcd - r) * q) + off; }
        const int nig = WGM * nN, gid = wgid / nig, fm = gid * WGM, gsz = (nM - fm) < WGM ? (nM - fm) : WGM;
        u.pm = fm + ((wgid % nig) % gsz); u.pn = (wgid % nig) / gsz; return true;
    }
    __device__ __forceinline__ void a_ready(const Unit&) const {}
    __device__ __forceinline__ void done(const Unit&) const {}
};


typedef float f32x2_cv __attribute__((ext_vector_type(2))); typedef __bf16 bf16x2_cv __attribute__((ext_vector_type(2)));
__device__ __forceinline__ unsigned cvt_pk_bf16(float lo, float hi) { const f32x2_cv v = {lo, hi}; return __builtin_bit_cast(unsigned, __builtin_convertvector(v, bf16x2_cv)); }
typedef float f32x2 __attribute__((ext_vector_type(2)));

template <bool F8> struct EpiIn {
    static constexpr bool PERM = false, AFTER_DRAIN = false, FP8 = F8, INIT_ACC = false; static constexpr int HOOK_T = -1;
    bf16_t* O; int ldc; const float* cosa; const float* sina; const float* cosp; const float* sinp; const float* qg; const float* kg; const float* bias; bf16_t* SA; bf16_t* SB; PG8_LAS float* red; float eps; float sc;
    __device__ __forceinline__ static unsigned long long pk4(const f32x4 v) { return (unsigned long long)cvt_pk_bf16(v[0], v[1]) | ((unsigned long long)cvt_pk_bf16(v[2], v[3]) << 32); }
    __device__ __forceinline__ void operator()(const f32x4 (&acc)[2][2][4][2], const Unit& u, int wr, int wc, int fr_, int fq_) const {
        (void)fr_; (void)fq_; const int ln_ = fresh_lane(), fr = ln_ & 15, fq = ln_ >> 4;
        const int pn = F8 ? (u.pn < 14 ? u.pn : u.pn + 16) : u.pn + 14; const int row0 = u.pm * BM + wr * 64 + fr;
        if (pn < 5) {
#pragma unroll
            for (int ai = 0; ai < 2; ++ai)
#pragma unroll
                for (int m = 0; m < 4; ++m)
#pragma unroll
                    for (int bj = 0; bj < 2; ++bj) { const f32x4 v0 = (acc[ai][bj][m][0] * sc), v1 = (acc[ai][bj][m][1] * sc);
                        float ss = (v0[0] * v0[0] + v0[1] * v0[1]) + (v0[2] * v0[2] + v0[3] * v0[3]) + (v1[0] * v1[0] + v1[1] * v1[1]) + (v1[2] * v1[2] + v1[3] * v1[3]);
                        ss += __shfl_xor(ss, 16); ss += __shfl_xor(ss, 32);
                        if (fq == 0) red[(ai * HALF + wr * 64 + m * 16 + fr) * 8 + bj * 4 + wc] = ss; }
            asm volatile("s_waitcnt lgkmcnt(0)" ::: "memory"); __builtin_amdgcn_s_barrier(); asm volatile("" ::: "memory");
            const int half = wc >> 1, i0 = 16 * (wc & 1) + 4 * fq;
            const float* g = (pn < 4) ? qg : kg;
            const float qs = (pn < 4) ? 0.12751743082459868f : 1.f;
            const f32x4 g0 = *(const f32x4*)(g + 64 * half + i0) * qs, g1 = *(const f32x4*)(g + 64 * half + 32 + i0) * qs;
#pragma unroll
            for (int ai = 0; ai < 2; ++ai)
#pragma unroll
                for (int m = 0; m < 4; ++m) { const int row = row0 + ai * HALF + m * 16, sq = row & 2047, pos = half ? (sq & 63) : (sq >> 6);
                    const f32x4 c = *(const f32x4*)(cosa + pos * 32 + i0), sn = *(const f32x4*)(sina + pos * 32 + i0);
#pragma unroll
                    for (int bj = 0; bj < 2; ++bj) { const f32x4 pr = *(const PG8_LAS f32x4*)(red + (ai * HALF + wr * 64 + m * 16 + fr) * 8 + bj * 4);
                        const float rs = rsqrtf(((pr[0] + pr[1]) + (pr[2] + pr[3])) * (1.f / 128.f) + eps);
                        const f32x4 y0 = (acc[ai][bj][m][0] * sc) * rs * g0, y1 = (acc[ai][bj][m][1] * sc) * rs * g1;
                        const f32x4 lo = y0 * c - y1 * sn, hi = y0 * sn + y1 * c;
                        bf16_t* p = O + (size_t)row * ldc + pn * BM + bj * HALF + 64 * half + i0;
                        *(unsigned long long*)p = pk4(lo); *(unsigned long long*)(p + 32) = pk4(hi); } }
        } else if (pn >= 10 && pn < 22 && wc == 0) {
            const int i0 = 4 * fq;
#pragma unroll
            for (int ai = 0; ai < 2; ++ai)
#pragma unroll
                for (int m = 0; m < 4; ++m) { const int row = row0 + ai * HALF + m * 16, sq = row & 2047;
                    const f32x4 c = *(const f32x4*)(cosp + sq * 16 + i0), sn = *(const f32x4*)(sinp + sq * 16 + i0);
#pragma unroll
                    for (int bj = 0; bj < 2; ++bj) { const f32x4 y0 = (acc[ai][bj][m][0] * sc), y1 = (acc[ai][bj][m][1] * sc);
                        const f32x4 lo = y0 * c - y1 * sn, hi = y0 * sn + y1 * c;
                        bf16_t* p = O + (size_t)row * ldc + pn * BM + bj * HALF + i0;
                        *(unsigned long long*)p = pk4(lo); *(unsigned long long*)(p + 16) = pk4(hi); } }
        } else if (pn >= 30) {
            const int gq = pn - 30;
            const float* bs = bias + gq * HALF + wc * 32 + 8 * fq;
            const f32x4 a0 = *(const f32x4*)bs, a1 = *(const f32x4*)(bs + 4), b0 = *(const f32x4*)(bs + 2048), b1 = *(const f32x4*)(bs + 2048 + 4);
            const size_t fo = ((((size_t)(u.pm * 8 + (gq >> 1)) * 8 + (wr * 4 + wc)) * 16 + (gq & 1) * 4) * 64 + (fq * 16 + fr)) * 8;
#pragma unroll
            for (int ai = 0; ai < 2; ++ai)
#pragma unroll
                for (int m = 0; m < 4; ++m) { const f32x4 za0 = (acc[ai][0][m][0] * sc) + a0, za1 = (acc[ai][0][m][1] * sc) + a1, zb0 = (acc[ai][1][m][0] * sc) + b0, zb1 = (acc[ai][1][m][1] * sc) + b1;
                    float rr[8], ss[8];
#pragma unroll
                    for (int e = 0; e < 4; ++e) { const float ea0 = 1.f + __builtin_amdgcn_exp2f(za0[e] * -1.4426950408889634f), ea1 = 1.f + __builtin_amdgcn_exp2f(za1[e] * -1.4426950408889634f);
                        const float eb0 = 1.f + __builtin_amdgcn_exp2f(zb0[e] * -1.4426950408889634f), eb1 = 1.f + __builtin_amdgcn_exp2f(zb1[e] * -1.4426950408889634f);
                        rr[e] = eb0 * __builtin_amdgcn_rcpf(ea0); rr[4 + e] = eb1 * __builtin_amdgcn_rcpf(ea1); ss[e] = __builtin_amdgcn_rcpf(eb0); ss[4 + e] = __builtin_amdgcn_rcpf(eb1); }
                    u32x4 w; w.x = cvt_pk_bf16(rr[0], rr[1]); w.y = cvt_pk_bf16(rr[2], rr[3]); w.z = cvt_pk_bf16(rr[4], rr[5]); w.w = cvt_pk_bf16(rr[6], rr[7]);
                    __builtin_nontemporal_store(w, (u32x4*)(SA + fo + (ai * 8 + m) * 512));
                    w.x = cvt_pk_bf16(ss[0], ss[1]); w.y = cvt_pk_bf16(ss[2], ss[3]); w.z = cvt_pk_bf16(ss[4], ss[5]); w.w = cvt_pk_bf16(ss[6], ss[7]);
                    __builtin_nontemporal_store(w, (u32x4*)(SB + fo + (ai * 8 + m) * 512)); }
        } else {
            const bool act = (pn >= 6 && pn < 10) || pn == 28 || pn == 29;
            const int col0 = pn * BM + wc * 32 + 8 * fq;
#pragma unroll
            for (int ai = 0; ai < 2; ++ai)
#pragma unroll
                for (int m = 0; m < 4; ++m) { bf16_t* rowp = O + (size_t)(row0 + ai * HALF + m * 16) * ldc + col0;
#pragma unroll
                    for (int bj = 0; bj < 2; ++bj) { f32x4 v0 = (acc[ai][bj][m][0] * sc), v1 = (acc[ai][bj][m][1] * sc);
                        if (act) {
#pragma unroll
                            for (int e = 0; e < 4; ++e) { v0[e] = v0[e] * __builtin_amdgcn_rcpf(1.f + __builtin_amdgcn_exp2f(v0[e] * -1.4426950408889634f)); v1[e] = v1[e] * __builtin_amdgcn_rcpf(1.f + __builtin_amdgcn_exp2f(v1[e] * -1.4426950408889634f)); } }
                        u32x4 w; w.x = cvt_pk_bf16(v0[0], v0[1]); w.y = cvt_pk_bf16(v0[2], v0[3]); w.z = cvt_pk_bf16(v1[0], v1[1]); w.w = cvt_pk_bf16(v1[2], v1[3]);
                        *(u32x4*)(rowp + bj * HALF) = w; } }
        }
    }
};
struct EpiMerge2 {
    static constexpr bool PERM = false, AFTER_DRAIN = false, FP8 = false; static constexpr int HOOK_T = 16; static constexpr bool INIT_ACC = false;
    const bf16_t* SA; const bf16_t* SB; bf16_t* O; int ldc;
    __device__ __forceinline__ void mid(f32x4 (&acc)[2][2][4][2], const Unit& u, int wr, int wc, int fr, int fq) const {
        int lane = fq * 16 + fr; asm volatile("" : "+v"(lane));
        const size_t base = ((((size_t)(u.pm * 8 + u.pn) * 8 + (wr * 4 + wc)) * 16) * 64 + lane) * 8;
#pragma unroll
        for (int f = 0; f < 16; ++f) { const int ai = f >> 3, bj = (f >> 2) & 1, m = f & 3;
            const u32x4 a = __builtin_nontemporal_load((const u32x4*)(SA + base + f * 512));
            f32x4 r0, r1;
#pragma unroll
            for (int e = 0; e < 4; ++e) { const float q_lo = __uint_as_float(a[e] << 16), q_hi = __uint_as_float(a[e] & 0xffff0000u);
                if (e < 2) { r0[2 * e] = q_lo; r0[2 * e + 1] = q_hi; } else { r1[2 * e - 4] = q_lo; r1[2 * e - 3] = q_hi; } }
            acc[ai][bj][m][0] *= r0; acc[ai][bj][m][1] *= r1; }
    }
    __device__ __forceinline__ void operator()(const f32x4 (&acc)[2][2][4][2], const Unit& u, int wr, int wc, int fr_, int fq_) const {
        (void)fr_; (void)fq_; const int ln_ = fresh_lane(), fr = ln_ & 15, fq = ln_ >> 4;
        const int lane = fq * 16 + fr, row0 = u.pm * BM + wr * 64 + fr, col0 = u.pn * BM + wc * 32 + 8 * fq;
        const size_t base = ((((size_t)(u.pm * 8 + u.pn) * 8 + (wr * 4 + wc)) * 16) * 64 + lane) * 8;
        bf16_t* Oq = O; asm volatile("" : "+s"(Oq));
        const __amdgpu_buffer_rsrc_t rsO = __builtin_amdgcn_make_buffer_rsrc((void*)Oq, 0, 8192 * 2048 * 2, 0x00020000);
#pragma unroll
        for (int f = 0; f < 16; ++f) { const int ai = f >> 3, bj = (f >> 2) & 1, m = f & 3;
            const u32x4 b = __builtin_nontemporal_load((const u32x4*)(SB + base + f * 512));
            const f32x4 v0 = acc[ai][bj][m][0], v1 = acc[ai][bj][m][1];
            u32x4 w; w.x = cvt_pk_bf16(v0[0] * __uint_as_float(b[0] << 16), v0[1] * __uint_as_float(b[0] & 0xffff0000u)); w.y = cvt_pk_bf16(v0[2] * __uint_as_float(b[1] << 16), v0[3] * __uint_as_float(b[1] & 0xffff0000u));
            w.z = cvt_pk_bf16(v1[0] * __uint_as_float(b[2] << 16), v1[1] * __uint_as_float(b[2] & 0xffff0000u)); w.w = cvt_pk_bf16(v1[2] * __uint_as_float(b[3] << 16), v1[3] * __uint_as_float(b[3] & 0xffff0000u));
            __builtin_amdgcn_raw_buffer_store_b128(w, rsO, (int)(((size_t)(row0 + ai * HALF + m * 16) * ldc + col0 + bj * HALF) * 2), 0, 16); }
    }
};
struct EpiResidNorm {
    static constexpr bool PERM = false, AFTER_DRAIN = true, FP8 = false, INIT_ACC = true; static constexpr int HOOK_T = -1;
    const float* base; float* out; int ldc; const float* gain; float* xb; unsigned* cnt; int ntn; float eps;
    __device__ __forceinline__ void init(f32x4 (&acc)[2][2][4][2], const Unit& u, int wr, int wc, int fr, int fq) const {
        const int row0 = u.pm * BM + wr * 64 + fr, col0 = u.pn * BM + wc * 32 + 4 * fq;
#pragma unroll
        for (int ai = 0; ai < 2; ++ai)
#pragma unroll
            for (int m = 0; m < 4; ++m) { const size_t off = (size_t)(row0 + ai * HALF + m * 16) * ldc + col0;
#pragma unroll
                for (int bj = 0; bj < 2; ++bj)
#pragma unroll
                    for (int n = 0; n < 2; ++n) acc[ai][bj][m][n] = __builtin_nontemporal_load((const f32x4*)(base + off + bj * HALF + n * 16)); }
    }
    __device__ __forceinline__ void fused(f32x4 (&acc)[2][2][4][2], const Unit& u, int wr, int wc, int fr_, int fq_, PG8_LAS unsigned char* lds, int wid, int lane) const {
        (void)fr_; (void)fq_; const int ln_ = fresh_lane(), fr = ln_ & 15, fq = ln_ >> 4;
        PG8_LAS float* Pp = (PG8_LAS float*)lds;
        PG8_LAS float* Sr = (PG8_LAS float*)(lds + 4096);
        const int row0 = u.pm * BM + wr * 64 + fr, col0 = u.pn * BM + wc * 32 + 4 * fq;
#pragma unroll
        for (int ai = 0; ai < 2; ++ai)
#pragma unroll
            for (int m = 0; m < 4; ++m) { float ss = 0.f;
#pragma unroll
                for (int bj = 0; bj < 2; ++bj)
#pragma unroll
                    for (int n = 0; n < 2; ++n) { const f32x4 o = acc[ai][bj][m][n];
                        ss += (o[0] * o[0] + o[1] * o[1]) + (o[2] * o[2] + o[3] * o[3]); }
                ss += __shfl_xor(ss, 16); ss += __shfl_xor(ss, 32);
                if (fq == 0) Pp[(ai * HALF + wr * 64 + m * 16 + fr) * 4 + wc] = ss; }
        asm volatile("s_waitcnt lgkmcnt(0)" ::: "memory"); __builtin_amdgcn_s_barrier(); asm volatile("" ::: "memory");
        const int tid = wid * 64 + lane;
        if (tid < 256) { const f32x4 p = *(const PG8_LAS f32x4*)(Pp + tid * 4);
            __hip_atomic_store(xb + (size_t)(u.pm * BM + tid) * 8 + u.pn, (p[0] + p[1]) + (p[2] + p[3]), __ATOMIC_RELAXED, __HIP_MEMORY_SCOPE_AGENT); }
        asm volatile("s_waitcnt vmcnt(0)" ::: "memory"); __builtin_amdgcn_s_barrier(); asm volatile("" ::: "memory");
        if (tid == 0) __hip_atomic_fetch_add(cnt + 64 * u.pm, 1u, __ATOMIC_RELAXED, __HIP_MEMORY_SCOPE_AGENT);
        if (wid == 0) { unsigned spins = 0;
            while ((unsigned)__builtin_amdgcn_readfirstlane(__hip_atomic_load(cnt + 64 * u.pm, __ATOMIC_RELAXED, __HIP_MEMORY_SCOPE_AGENT)) < (unsigned)ntn) { __builtin_amdgcn_s_sleep(2); if (++spins > (1u << 22)) break; }
            __builtin_amdgcn_fence(__ATOMIC_ACQUIRE, "agent"); }
        asm volatile("s_waitcnt vmcnt(0) lgkmcnt(0)" ::: "memory"); __builtin_amdgcn_s_barrier(); asm volatile("" ::: "memory");
        if (tid < 256) { const float* slot = xb + (size_t)(u.pm * BM + tid) * 8; float tot = 0.f;
#pragma unroll
            for (int t = 0; t < 8; ++t) tot += __hip_atomic_load(slot + t, __ATOMIC_RELAXED, __HIP_MEMORY_SCOPE_AGENT);
            Sr[tid] = rsqrtf(tot * (1.0f / 2048.0f) + eps); }
        asm volatile("s_waitcnt lgkmcnt(0)" ::: "memory"); __builtin_amdgcn_s_barrier(); asm volatile("" ::: "memory");
#pragma unroll
        for (int bj = 0; bj < 2; ++bj)
#pragma unroll
            for (int n = 0; n < 2; ++n) { const f32x4 g = *(const f32x4*)(gain + col0 + bj * HALF + n * 16);
#pragma unroll
                for (int ai = 0; ai < 2; ++ai)
#pragma unroll
                    for (int m = 0; m < 4; ++m) { const int rl = ai * HALF + wr * 64 + m * 16 + fr; const float rs = Sr[rl];
                        __builtin_nontemporal_store(acc[ai][bj][m][n] * rs * g, (f32x4*)(out + (size_t)(u.pm * BM + rl) * ldc + col0 + bj * HALF + n * 16)); } }
    }
};

template <class Epi, class Sched, bool ALIGN_EPI = false, bool SP2 = false>
__device__ __forceinline__ void gemm_phase(PG8_LAS unsigned char* lds, const Gemm g, const Sched& S, const Epi& E, const int wave_) {
    const int wid = wave_, lane = fresh_lane(), tid = wid * 64 + lane, wr = wid >> 2, wc = wid & 3, fr = lane & 15, fq = lane >> 4;
    const int K = g.K, nt = K / BK;
    unsigned voffA[2], voffB[2];
#pragma unroll
    for (int i = 0; i < 2; ++i) { int R, C; stage_rc(tid * 16 + i * 8192, R, C); const int Rb = Epi::PERM ? ((R & ~31) + perm32(R & 31)) : R;
        voffA[i] = (unsigned)(R * K + C) * 2u; voffB[i] = (unsigned)(Rb * K + C) * 2u; }
    const unsigned kstep = (unsigned)(BK * 2);
    const unsigned hstep = (unsigned)HALF * (unsigned)K * 2u;
    const unsigned tstep = 2u * hstep;
    const __amdgpu_buffer_rsrc_t rs_voffA = __builtin_amdgcn_make_buffer_rsrc((void*)g.A, 0, (int)((unsigned)g.M * (unsigned)K * 2u), 0x00020000);
    const __amdgpu_buffer_rsrc_t rs_voffB = __builtin_amdgcn_make_buffer_rsrc((void*)g.Bt, 0, (int)((unsigned)g.N * (unsigned)K * 2u), 0x00020000);
    const unsigned ldsw = (unsigned)wid * 1024u;
    const int aoff = lds_byte(wr * 64 + fr, fq * 8), boff = lds_byte(wc * 32 + fr, fq * 8);
#define PG8_SA(b, h) (((b) * 2 + (h)) * HTB)
#define PG8_SB(b, h) ((4 + (b) * 2 + (h)) * HTB)
#define PG8_STAGE(bufoff, goff, voff) do { _Pragma("unroll") for (int _i = 0; _i < 2; ++_i) \
        __builtin_amdgcn_raw_ptr_buffer_load_lds(rs_##voff, (PG8_LAS void*)(lds + (bufoff) + ldsw + _i * 8192), 16, (int)(voff)[_i], (int)(goff), 0, 0); } while (0)
#define PG8_LDA(dst, b, h) do { _Pragma("unroll") for (int m = 0; m < 4; ++m) _Pragma("unroll") for (int k = 0; k < 2; ++k) dst[m][k] = *(const PG8_LAS bf16x8*)(lds + PG8_SA(b, h) + aoff + m * 2048 + k * 1024); } while (0)
#define PG8_LDB(dst, b, h) do { _Pragma("unroll") for (int n = 0; n < 2; ++n) _Pragma("unroll") for (int k = 0; k < 2; ++k) dst[n][k] = *(const PG8_LAS bf16x8*)(lds + PG8_SB(b, h) + boff + n * 2048 + k * 1024); } while (0)
#define PG8_CAT(x, y) __builtin_shufflevector(__builtin_bit_cast(v4i_t, x), __builtin_bit_cast(v4i_t, y), 0, 1, 2, 3, 4, 5, 6, 7)
#define PG8_MMA(ai, bj, At, Bt) do { __builtin_amdgcn_s_setprio(1); _Pragma("unroll") for (int m = 0; m < 4; ++m) _Pragma("unroll") for (int n = 0; n < 2; ++n) { \
        if constexpr (Epi::FP8) acc[ai][bj][m][n] = __builtin_amdgcn_mfma_scale_f32_16x16x128_f8f6f4(PG8_CAT(Bt[n][0], Bt[n][1]), PG8_CAT(At[m][0], At[m][1]), acc[ai][bj][m][n], 0, 0, 0, 0x7f7f7f7f, 0, 0x7f7f7f7f); \
        else { _Pragma("unroll") for (int k = 0; k < 2; ++k) acc[ai][bj][m][n] = __builtin_amdgcn_mfma_f32_16x16x32_bf16(Bt[n][k], At[m][k], acc[ai][bj][m][n], 0, 0, 0); } } \
        __builtin_amdgcn_s_setprio(0); } while (0)
#define PG8_WAIT_V(n) asm volatile("s_waitcnt vmcnt(" #n ")" ::: "memory")
#define PG8_WAIT_L(n) asm volatile("s_waitcnt lgkmcnt(" #n ")" ::: "memory")
#define PG8_BAR __builtin_amdgcn_s_barrier()
#define PG8_SCHED __builtin_amdgcn_sched_barrier(0)
    Unit cur, nxt; int ui = 0;
    if (!S.next(0, cur)) return;
    f32x4 acc[2][2][4][2];
    if constexpr (Epi::INIT_ACC) E.init(acc, cur, wr, wc, fr, fq);
    else {
#pragma unroll
    for (int a = 0; a < 2; ++a)
#pragma unroll
        for (int b = 0; b < 2; ++b)
#pragma unroll
            for (int m = 0; m < 4; ++m)
#pragma unroll
                for (int n = 0; n < 2; ++n) acc[a][b][m][n] = (f32x4){0.f, 0.f, 0.f, 0.f};
    }
    bf16x8 At[4][2], B0[2][2], B1[2][2];
    unsigned cA = (unsigned)cur.pm * tstep, cB = (unsigned)cur.pn * tstep;
    S.a_ready(cur);
    if constexpr (SP2) {
        PG8_STAGE(PG8_SB(0, 0), cB, voffB); PG8_STAGE(PG8_SB(0, 1), cB + hstep, voffB); PG8_STAGE(PG8_SA(0, 0), cA, voffA); PG8_STAGE(PG8_SA(0, 1), cA + hstep, voffA);
        if (wr == 1) PG8_BAR;
        PG8_WAIT_V(2); PG8_BAR;
        PG8_STAGE(PG8_SB(1, 0), cB + kstep, voffB); PG8_STAGE(PG8_SA(1, 0), cA + kstep, voffA); PG8_STAGE(PG8_SB(1, 1), cB + hstep + kstep, voffB);
        PG8_WAIT_V(6); PG8_BAR;
    } else {
        PG8_STAGE(PG8_SB(0, 0), cB, voffB); PG8_STAGE(PG8_SA(0, 0), cA, voffA); PG8_STAGE(PG8_SB(0, 1), cB + hstep, voffB); PG8_STAGE(PG8_SA(0, 1), cA + hstep, voffA);
        if (wr == 1) PG8_BAR;
        PG8_WAIT_V(4); PG8_BAR;
        PG8_STAGE(PG8_SB(1, 0), cB + kstep, voffB); PG8_STAGE(PG8_SA(1, 0), cA + kstep, voffA); PG8_STAGE(PG8_SB(1, 1), cB + hstep + kstep, voffB);
        PG8_WAIT_V(6); PG8_BAR;
    }
    for (;;) {
        const bool has_next = S.next(ui + 1, nxt);
        const unsigned nA = has_next ? (unsigned)nxt.pm * tstep : cA, nB = has_next ? (unsigned)nxt.pn * tstep : cB;
        for (int t = 0; t < nt; t += 2) {
            if constexpr (Epi::HOOK_T >= 0) { if (t == Epi::HOOK_T) E.mid(acc, cur, wr, wc, fr, fq); }
            const bool last = (t == nt - 2);
            const unsigned a1 = cA + (unsigned)(t + 1) * kstep;
            const unsigned a2 = last ? nA : cA + (unsigned)(t + 2) * kstep, b2 = last ? nB : cB + (unsigned)(t + 2) * kstep;
            const unsigned a3 = a2 + kstep, b3 = b2 + kstep;
            if (last && has_next) S.a_ready(nxt);
            if constexpr (SP2) {
            PG8_LDB(B0, 0, 0); PG8_LDB(B1, 0, 1); PG8_SCHED; PG8_LDA(At, 0, 0); PG8_STAGE(PG8_SA(1, 1), a1 + hstep, voffA);
            PG8_WAIT_V(8); PG8_WAIT_L(0); PG8_BAR; PG8_MMA(0, 0, At, B0); PG8_MMA(0, 1, At, B1); PG8_BAR; PG8_SCHED;
            PG8_LDA(At, 0, 1); PG8_STAGE(PG8_SB(0, 0), b2, voffB); PG8_STAGE(PG8_SB(0, 1), b2 + hstep, voffB); PG8_STAGE(PG8_SA(0, 0), a2, voffA);
            PG8_WAIT_V(8); PG8_WAIT_L(0); PG8_BAR; PG8_MMA(1, 0, At, B0); PG8_MMA(1, 1, At, B1); PG8_BAR; PG8_SCHED;
            PG8_LDB(B0, 1, 0); PG8_LDB(B1, 1, 1); PG8_SCHED; PG8_LDA(At, 1, 0); PG8_STAGE(PG8_SA(0, 1), a2 + hstep, voffA);
            PG8_WAIT_V(8); PG8_WAIT_L(0); PG8_BAR; PG8_MMA(0, 0, At, B0); PG8_MMA(0, 1, At, B1); PG8_BAR; PG8_SCHED;
            PG8_LDA(At, 1, 1); PG8_STAGE(PG8_SB(1, 0), b3, voffB); PG8_STAGE(PG8_SB(1, 1), b3 + hstep, voffB); PG8_STAGE(PG8_SA(1, 0), a3, voffA);
            PG8_WAIT_V(8); PG8_WAIT_L(0); PG8_BAR; PG8_MMA(1, 0, At, B0); PG8_MMA(1, 1, At, B1); PG8_BAR; PG8_SCHED;
            } else {
            PG8_LDB(B0, 0, 0); PG8_SCHED; PG8_LDA(At, 0, 0); PG8_STAGE(PG8_SA(1, 1), a1 + hstep, voffA);
            PG8_WAIT_L(8); PG8_BAR; PG8_WAIT_L(0); PG8_MMA(0, 0, At, B0); PG8_BAR; PG8_SCHED;
            PG8_LDB(B1, 0, 1); PG8_STAGE(PG8_SB(0, 0), b2, voffB);
            PG8_BAR; PG8_WAIT_L(0); PG8_MMA(0, 1, At, B1); PG8_BAR;
            PG8_LDA(At, 0, 1); PG8_STAGE(PG8_SA(0, 0), a2, voffA);
            PG8_BAR; PG8_WAIT_L(0); PG8_MMA(1, 0, At, B0); PG8_BAR; PG8_SCHED;
            PG8_STAGE(PG8_SB(0, 1), b2 + hstep, voffB);
            PG8_WAIT_V(6); PG8_BAR; PG8_MMA(1, 1, At, B1); PG8_BAR;
            PG8_LDB(B0, 1, 0); PG8_SCHED; PG8_LDA(At, 1, 0); PG8_STAGE(PG8_SA(0, 1), a2 + hstep, voffA);
            PG8_WAIT_L(8); PG8_BAR; PG8_WAIT_L(0); PG8_MMA(0, 0, At, B0); PG8_BAR; PG8_SCHED;
            PG8_LDB(B1, 1, 1); PG8_STAGE(PG8_SB(1, 0), b3, voffB);
            PG8_BAR; PG8_WAIT_L(0); PG8_MMA(0, 1, At, B1); PG8_BAR;
            PG8_LDA(At, 1, 1); PG8_STAGE(PG8_SA(1, 0), a3, voffA);
            PG8_BAR; PG8_WAIT_L(0); PG8_MMA(1, 0, At, B0); PG8_BAR; PG8_SCHED;
            PG8_STAGE(PG8_SB(1, 1), b3 + hstep, voffB);
            PG8_WAIT_V(6); PG8_BAR; PG8_MMA(1, 1, At, B1); PG8_BAR;
            }
        }
        if constexpr (ALIGN_EPI) { if (wr == 0) PG8_BAR; }
        if constexpr (!Epi::AFTER_DRAIN) { E(acc, cur, wr, wc, fr, fq); S.done(cur); }
        if (!has_next) break;
#pragma unroll
        for (int a = 0; a < 2; ++a)
#pragma unroll
            for (int b = 0; b < 2; ++b)
#pragma unroll
                for (int m = 0; m < 4; ++m)
#pragma unroll
                    for (int n = 0; n < 2; ++n) acc[a][b][m][n] = (f32x4){0.f, 0.f, 0.f, 0.f};
        cur = nxt; cA = nA; cB = nB; ++ui;
        if constexpr (ALIGN_EPI) { if (wr == 1) PG8_BAR; }
    }
    PG8_WAIT_V(0);
    if constexpr (!ALIGN_EPI) { if (wr == 0) PG8_BAR; }
    PG8_BAR;
    if constexpr (Epi::AFTER_DRAIN) { E.fused(acc, cur, wr, wc, fr, fq, lds, wid, lane); S.done(cur); }
#undef PG8_SA
#undef PG8_SB
#undef PG8_STAGE
#undef PG8_LDA
#undef PG8_LDB
#undef PG8_MMA
#undef PG8_CAT
#undef PG8_WAIT_V
#undef PG8_WAIT_L
#undef PG8_BAR
#undef PG8_SCHED
}
}

namespace att {
using bf16 = unsigned short;
constexpr int   D = 128, NW = 8, QBLK = 32, KVBLK = 64;
constexpr float SCALE = 0.088388347648318440f;
constexpr float THR = 8.f;
constexpr int SDEPTH = 2;
constexpr int LDQ = 7680, LDK = 7680;
constexpr int LDY = 1536;
constexpr size_t SHM_V = KVBLK * D * 2, SHM_K = KVBLK * D * 2, SHM_ATTN = 2 * SHM_V + 2 * SHM_K + NW * 64 * 4;
__device__ __forceinline__ float bf2f_(bf16 h) { return __uint_as_float(((unsigned)h) << 16); }
__device__ __forceinline__ bf16 f2bf_(float f) { unsigned u = __float_as_uint(f); return (bf16)((u + 0x7fffu + ((u >> 16) & 1u)) >> 16); }
using bf16x8 = __attribute__((ext_vector_type(8))) short;
using s16x4  = __attribute__((ext_vector_type(4))) short;
using f32x16 = __attribute__((ext_vector_type(16))) float;
using f32x8  = __attribute__((ext_vector_type(8))) float;
using u32x4  = __attribute__((ext_vector_type(4))) unsigned;
using f32x4_ = __attribute__((ext_vector_type(4))) float;
#define KSWZ(row, colB) ((row) * 256 + ((colB) ^ (((row) & 7) << 4)))
#define SBAR() __builtin_amdgcn_sched_barrier(0)
__device__ __forceinline__ int crow(int r, int hi) { return (r & 3) + 8 * (r >> 2) + 4 * hi; }
__device__ __forceinline__ unsigned cvtpk(float lo, float hi) {
  typedef float f32x2_c __attribute__((ext_vector_type(2))); typedef __bf16 bf16x2_c __attribute__((ext_vector_type(2)));
  const f32x2_c v = {lo, hi}; return __builtin_bit_cast(unsigned, __builtin_convertvector(v, bf16x2_c));
}
template <typename TIn> struct Stage;
template <> struct Stage<bf16>  { using T = bf16x8;
  __device__ static __forceinline__ T ld8(const bf16* p) { return *reinterpret_cast<const bf16x8*>(p); }
  __device__ static __forceinline__ bf16x8 tobf(T x) { return x; } };
template <> struct Stage<float> { using T = f32x8;
  __device__ static __forceinline__ T ld8(const float* p) { return *reinterpret_cast<const f32x8*>(p); }
  __device__ static __forceinline__ bf16x8 tobf(T x) {
    u32x4 w = {cvtpk(x[0], x[1]), cvtpk(x[2], x[3]), cvtpk(x[4], x[5]), cvtpk(x[6], x[7])}; return *reinterpret_cast<bf16x8*>(&w); } };

template <bool PRE = false> __device__ __forceinline__ void partialSM(f32x16& p0, f32x16& p1, float& m_reg, float& mn, float& alpha) {
  constexpr float C = PRE ? 1.f : SCALE * 1.4426950408889634f;
  float pmax = p0[0]; for (int r = 1; r < 16; ++r) pmax = fmaxf(pmax, p0[r]); for (int r = 0; r < 16; ++r) pmax = fmaxf(pmax, p1[r]);
  { auto rr = __builtin_amdgcn_permlane32_swap(__float_as_uint(pmax), __float_as_uint(pmax), false, false);
    pmax = fmaxf(__uint_as_float(rr[0]), __uint_as_float(rr[1])); }
  if (__builtin_expect(__all(pmax - m_reg <= (PRE ? THR * 1.4426950408889634f : THR / SCALE)), 1)) { mn = m_reg; alpha = 1.f; }
  else { mn = fmaxf(m_reg, pmax); alpha = __builtin_amdgcn_exp2f((m_reg - mn) * C); m_reg = mn; }
  float mnC = -mn * C;
  for (int r = 0; r < 16; ++r) p0[r] = fmaf(p0[r], C, mnC); for (int r = 0; r < 16; ++r) p1[r] = fmaf(p1[r], C, mnC);
  for (int r = 0; r < 16; ++r) p0[r] = __builtin_amdgcn_exp2f(p0[r]);
}
__device__ __forceinline__ void finishSM(f32x16& p0, f32x16& p1, float alpha, float& l_reg, bf16x8& pa0, bf16x8& pa1, bf16x8& pa2, bf16x8& pa3) {
  for (int r = 0; r < 16; ++r) p1[r] = __builtin_amdgcn_exp2f(p1[r]);
  float ps = 0; for (int r = 0; r < 16; ++r) ps += p0[r]; for (int r = 0; r < 16; ++r) ps += p1[r];
  { auto rr = __builtin_amdgcn_permlane32_swap(__float_as_uint(ps), __float_as_uint(ps), false, false);
    ps = __uint_as_float(rr[0]) + __uint_as_float(rr[1]); }
  l_reg = l_reg * alpha + ps;
#define PK4(P, BASE, OUT) do { unsigned a0 = cvtpk(P[BASE + 0], P[BASE + 1]), a1 = cvtpk(P[BASE + 2], P[BASE + 3]);   \
    unsigned b0 = cvtpk(P[BASE + 4], P[BASE + 5]), b1 = cvtpk(P[BASE + 6], P[BASE + 7]);                              \
    auto r0 = __builtin_amdgcn_permlane32_swap(a0, b0, false, false); auto r1 = __builtin_amdgcn_permlane32_swap(a1, b1, false, false); \
    u32x4 w = {r0[0], r1[0], r0[1], r1[1]}; OUT = *reinterpret_cast<bf16x8*>(&w); } while (0)
  PK4(p0, 0, pa0); PK4(p0, 8, pa1); PK4(p1, 0, pa2); PK4(p1, 8, pa3);
#undef PK4
}
__device__ __forceinline__ void half_f(f32x16& p, float& l_reg, bf16x8& o0, bf16x8& o1) {
  for (int r = 0; r < 16; ++r) p[r] = __builtin_amdgcn_exp2f(p[r]);
  float ps = 0; for (int r = 0; r < 16; ++r) ps += p[r];
  l_reg += ps;
#define PK4(P, BASE, OUT) do { unsigned a0 = cvtpk(P[BASE + 0], P[BASE + 1]), a1 = cvtpk(P[BASE + 2], P[BASE + 3]);   \
    unsigned b0 = cvtpk(P[BASE + 4], P[BASE + 5]), b1 = cvtpk(P[BASE + 6], P[BASE + 7]);                              \
    auto r0 = __builtin_amdgcn_permlane32_swap(a0, b0, false, false); auto r1 = __builtin_amdgcn_permlane32_swap(a1, b1, false, false); \
    u32x4 w = {r0[0], r1[0], r0[1], r1[1]}; OUT = *reinterpret_cast<bf16x8*>(&w); } while (0)
  PK4(p, 0, o0); PK4(p, 8, o1);
#undef PK4
}
__device__ __forceinline__ void qkt(f32x16& p0, f32x16& p1, const bf16* Ks, const bf16x8* qr, int r32, int hi) {
  p0 = f32x16{}; p1 = f32x16{};
  for (int d0 = 0; d0 < 8; ++d0) { int cb = (d0 * 16 + hi * 8) * 2;
    bf16x8 b0 = *reinterpret_cast<const bf16x8*>((const char*)Ks + KSWZ(r32, cb));
    bf16x8 b1 = *reinterpret_cast<const bf16x8*>((const char*)Ks + KSWZ(32 + r32, cb));
    p0 = __builtin_amdgcn_mfma_f32_32x32x16_bf16(b0, qr[d0], p0, 0, 0, 0);
    p1 = __builtin_amdgcn_mfma_f32_32x32x16_bf16(b1, qr[d0], p1, 0, 0, 0); }
}
__device__ __forceinline__ int v_st(int k, int c) { const int kk = (k & ~0xC) | ((k & 4) << 1) | ((k & 8) >> 1); return ((kk >> 3) * 4 + (c >> 5)) * 512 + ((kk & 7) * 32 + (c & 31)) * 2; }
__device__ __forceinline__ int v_rd_base(int lane) { return ((lane & 3) << 3) | (((lane >> 2) & 3) << 6) | (((lane >> 4) & 1) << 5) | (((lane >> 5) & 1) << 8); }
constexpr int v_rd_off(int d0, int ks, int half) { return d0 * 512 + ks * 4096 + half * 2048; }
template <int OFF> __device__ __forceinline__ s16x4 tr_read(int vb) {
  s16x4 r; asm volatile("ds_read_b64_tr_b16 %0, %1 offset:%2" : "=&v"(r) : "v"(vb), "i"(OFF) : "memory"); return r;
}
template <int D0> __device__ __forceinline__ void pv_one(f32x16& od, int vb, bf16x8 pa0, bf16x8 pa1, bf16x8 pa2, bf16x8 pa3) {
  const s16x4 l0 = tr_read<v_rd_off(D0, 0, 0)>(vb), h0 = tr_read<v_rd_off(D0, 0, 1)>(vb), l1 = tr_read<v_rd_off(D0, 1, 0)>(vb), h1 = tr_read<v_rd_off(D0, 1, 1)>(vb);
  const s16x4 l2 = tr_read<v_rd_off(D0, 2, 0)>(vb), h2 = tr_read<v_rd_off(D0, 2, 1)>(vb), l3 = tr_read<v_rd_off(D0, 3, 0)>(vb), h3 = tr_read<v_rd_off(D0, 3, 1)>(vb);
  asm volatile("s_waitcnt lgkmcnt(0)" ::: "memory"); SBAR();
#define PK(L, H) (bf16x8){L[0], L[1], L[2], L[3], H[0], H[1], H[2], H[3]}
  od = __builtin_amdgcn_mfma_f32_32x32x16_bf16(pa0, PK(l0, h0), od, 0, 0, 0);
  od = __builtin_amdgcn_mfma_f32_32x32x16_bf16(pa1, PK(l1, h1), od, 0, 0, 0);
  od = __builtin_amdgcn_mfma_f32_32x32x16_bf16(pa2, PK(l2, h2), od, 0, 0, 0);
  od = __builtin_amdgcn_mfma_f32_32x32x16_bf16(pa3, PK(l3, h3), od, 0, 0, 0);
#undef PK
}
__device__ __forceinline__ void pv_d0(f32x16* o, int vb, bf16x8 pa0, bf16x8 pa1, bf16x8 pa2, bf16x8 pa3) {
  pv_one<0>(o[0], vb, pa0, pa1, pa2, pa3); pv_one<1>(o[1], vb, pa0, pa1, pa2, pa3); pv_one<2>(o[2], vb, pa0, pa1, pa2, pa3); pv_one<3>(o[3], vb, pa0, pa1, pa2, pa3);
}

template <bool FAST> __device__ __forceinline__ void attn_dense_body(const bf16* __restrict__ Qb, const bf16* __restrict__ Kh, const bf16* __restrict__ Vh,
                                                const bf16* __restrict__ Gb, bf16* __restrict__ Yb, int seq, char* lds, const int wave_) {
  using TQ = bf16; using St = Stage<bf16>; using SQ = Stage<TQ>;
  constexpr int SDEPTH = FAST ? 2 : 2;
  const int wid = wave_, lane = fresh_lane(), tid = wid * 64 + lane, r32 = lane & 31, hi = lane >> 5;
  bf16* V_lds = (bf16*)lds; bf16* K_lds = (bf16*)(lds + 2 * SHM_V);
  float* ws = (float*)(lds + 2 * SHM_V + 2 * SHM_K) + wid * 64; float* li_l = ws; float* al_l = ws + 32;
  float m_reg = -1e30f, l_reg = 0; f32x16 o[4] = {}; bf16x8 qr[8];
  const TQ* Qw = Qb + (long)(wid * QBLK + r32) * LDQ + hi * 8;
#pragma unroll
  for (int d0 = 0; d0 < 8; ++d0) qr[d0] = SQ::tobf(SQ::ld8(Qw + d0 * 16));
  const int sr = tid >> 4, sc = (tid & 15) * 8, vst0 = v_st(sr, sc), vst1 = v_st(32 + sr, sc);
  const unsigned toff = (unsigned)(sr * LDK + sc);
  const int vb0 = (int)(uintptr_t)V_lds + v_rd_base(lane);
  struct { typename St::T vs0, vs1, ks0, ks1; } sr_[SDEPTH];
#define SLOAD(i, k0) do { const bf16* vb_ = Vh + (long)(k0) * LDK; const bf16* kb_ = Kh + (long)(k0) * LDK; \
    sr_[i].vs0 = St::ld8(vb_ + toff); sr_[i].vs1 = St::ld8(vb_ + 32 * LDK + toff); \
    sr_[i].ks0 = St::ld8(kb_ + toff); sr_[i].ks1 = St::ld8(kb_ + 32 * LDK + toff); } while (0)
#define SWRITE(b, i) do { *(bf16x8*)((char*)V_lds + (b) * SHM_V + vst0) = St::tobf(sr_[i].vs0);          \
    *(bf16x8*)((char*)V_lds + (b) * SHM_V + vst1) = St::tobf(sr_[i].vs1); int kc = sc * 2;               \
    *(bf16x8*)((char*)K_lds + (b) * SHM_K + KSWZ(sr, kc)) = St::tobf(sr_[i].ks0);                       \
    *(bf16x8*)((char*)K_lds + (b) * SHM_K + KSWZ(32 + sr, kc)) = St::tobf(sr_[i].ks1); } while (0)
#define SWAIT() do { if constexpr (SDEPTH == 2) asm volatile("s_waitcnt vmcnt(4)" ::: "memory"); else asm volatile("s_waitcnt vmcnt(0)" ::: "memory"); } while (0)
#define RESC(a) do { if (__any((a) < 1.f)) { if (hi == 0) al_l[r32] = (a); asm volatile("s_waitcnt lgkmcnt(0)" ::: "memory"); \
    for (int d = 0; d < 4; ++d) for (int r = 0; r < 16; ++r) o[d][r] *= al_l[crow(r, hi)]; } } while (0)
  f32x16 pA0, pA1, pB0, pB1; float mnA, mnB, alA, alB; bf16x8 pa0, pa1, pa2, pa3, na0, na1; const int NT = seq / KVBLK;
  constexpr int SE = 0, SO = SDEPTH - 1;
  SLOAD(SE, 0); asm volatile("s_waitcnt vmcnt(0)" ::: "memory"); SWRITE(0, SE); __syncthreads();
  qkt(pA0, pA1, K_lds, qr, r32, hi); if constexpr (FAST) half_f(pA0, l_reg, na0, na1); else partialSM<true>(pA0, pA1, m_reg, mnA, alA);
  SLOAD(SO, KVBLK); if constexpr (SDEPTH == 2) { if (2 < NT) SLOAD(SE, 2 * KVBLK); }
  SWAIT(); SWRITE(1, SO); __syncthreads();
  for (int j = 1; j + 1 < NT; j += 2) {
    SBAR(); qkt(pB0, pB1, (bf16*)((char*)K_lds + SHM_K), qr, r32, hi);
    if constexpr (FAST) { pa0 = na0; pa1 = na1; half_f(pA1, l_reg, pa2, pa3); } else finishSM(pA0, pA1, alA, l_reg, pa0, pa1, pa2, pa3); SBAR();
    SLOAD(SO, (j + SDEPTH) * KVBLK); SBAR();
    pv_d0(o, vb0, pa0, pa1, pa2, pa3); if constexpr (FAST) half_f(pB0, l_reg, na0, na1); else partialSM<true>(pB0, pB1, m_reg, mnB, alB);
    __syncthreads(); SWAIT(); SWRITE(0, SE);
    if constexpr (!FAST) RESC(alB); __syncthreads();
    SBAR(); qkt(pA0, pA1, K_lds, qr, r32, hi);
    if constexpr (FAST) { pa0 = na0; pa1 = na1; half_f(pB1, l_reg, pa2, pa3); } else finishSM(pB0, pB1, alB, l_reg, pa0, pa1, pa2, pa3); SBAR();
    if (SDEPTH == 1 || j + 3 < NT) SLOAD(SE, (j + 1 + SDEPTH) * KVBLK); SBAR();
    pv_d0(o, vb0 + (int)SHM_V, pa0, pa1, pa2, pa3); if constexpr (FAST) half_f(pA0, l_reg, na0, na1); else partialSM<true>(pA0, pA1, m_reg, mnA, alA);
    __syncthreads(); SWAIT(); SWRITE(1, SO);
    if constexpr (!FAST) RESC(alA); __syncthreads();
  }
  SBAR(); qkt(pB0, pB1, (bf16*)((char*)K_lds + SHM_K), qr, r32, hi);
  if constexpr (FAST) { pa0 = na0; pa1 = na1; half_f(pA1, l_reg, pa2, pa3); } else finishSM(pA0, pA1, alA, l_reg, pa0, pa1, pa2, pa3); SBAR();
  pv_d0(o, vb0, pa0, pa1, pa2, pa3); if constexpr (FAST) half_f(pB0, l_reg, na0, na1); else partialSM<true>(pB0, pB1, m_reg, mnB, alB);
  __syncthreads(); if constexpr (!FAST) RESC(alB);
  if constexpr (FAST) { pa0 = na0; pa1 = na1; half_f(pB1, l_reg, pa2, pa3); } else finishSM(pB0, pB1, alB, l_reg, pa0, pa1, pa2, pa3); SBAR();
  pv_d0(o, vb0 + (int)SHM_V, pa0, pa1, pa2, pa3);
  if constexpr (FAST) { auto rr = __builtin_amdgcn_permlane32_swap(__float_as_uint(l_reg), __float_as_uint(l_reg), false, false); l_reg = __uint_as_float(rr[0]) + __uint_as_float(rr[1]); }
  if (hi == 0) li_l[r32] = l_reg; asm volatile("s_waitcnt lgkmcnt(0)" ::: "memory");
  float rli[16];
#pragma unroll
  for (int r = 0; r < 16; ++r) rli[r] = __builtin_amdgcn_rcpf(li_l[crow(r, hi)]);
  __syncthreads();
  { float* stg = (float*)(lds + wid * 16384);
#pragma unroll
    for (int r = 0; r < 16; ++r) { const int orow = crow(r, hi);
#pragma unroll
      for (int d0 = 0; d0 < 4; ++d0) stg[orow * 128 + d0 * 32 + r32] = o[d0][r] * rli[r]; }
    asm volatile("s_waitcnt lgkmcnt(0)" ::: "memory");
    const int ch = lane & 15, rb = lane >> 4;
    const bf16* Gw = Gb + (long)(wid * QBLK + rb) * LDQ + ch * 8; const int yoff = ((wid * QBLK + rb) * LDY + ch * 8) * 2;
    bf16* Yq = Yb; asm volatile("" : "+s"(Yq));
    const __amdgpu_buffer_rsrc_t rsY = __builtin_amdgcn_make_buffer_rsrc((void*)Yq, 0, 0x40000000, 0x00020000);
    u32x4 gq[8];
#pragma unroll
    for (int i = 0; i < 8; ++i) gq[i] = *(const u32x4*)(Gw + (long)(4 * i) * LDQ);
#pragma unroll
    for (int i = 0; i < 8; ++i) { const float* sp = stg + (4 * i + rb) * 128 + ch * 8;
      const f32x4_ a = *(const f32x4_*)sp, b = *(const f32x4_*)(sp + 4); u32x4 w;
      w[0] = cvtpk(a[0] * __uint_as_float(gq[i][0] << 16), a[1] * __uint_as_float(gq[i][0] & 0xffff0000u));
      w[1] = cvtpk(a[2] * __uint_as_float(gq[i][1] << 16), a[3] * __uint_as_float(gq[i][1] & 0xffff0000u));
      w[2] = cvtpk(b[0] * __uint_as_float(gq[i][2] << 16), b[1] * __uint_as_float(gq[i][2] & 0xffff0000u));
      w[3] = cvtpk(b[2] * __uint_as_float(gq[i][3] << 16), b[3] * __uint_as_float(gq[i][3] & 0xffff0000u));
      __builtin_amdgcn_raw_buffer_store_b128(w, rsY, yoff + (4 * i) * LDY * 2, 0, 16); } }
  __syncthreads();
#undef SLOAD
#undef SWRITE
#undef SWAIT
#undef RESC
}

__device__ __forceinline__ void attn_band_unit(const bf16* __restrict__ P, bf16* __restrict__ OG, float* __restrict__ LSE, int g, int b, int h, int blk, int cqb, int ckb, int cvb, int seqlen, int ntok, char* lds, const int wave_) {
  using St = Stage<bf16>;
  const int wid = wave_, lane = fresh_lane(), tid = wid * 64 + lane, r32 = lane & 31, hi = lane >> 5;
  bf16* V_lds = (bf16*)lds; bf16* K_lds = (bf16*)(lds + 2 * SHM_V);
  float* ws = (float*)(lds + 2 * SHM_V + 2 * SHM_K) + wid * 64; float* li_l = ws; float* al_l = ws + 32;
  const int dil = (g == 0) ? 1 : (g == 1 ? 4 : 16), head = g * 4 + h;
  int rq, lq0, ntile, t_lo, res0;
  if (g < 2) { const int kb = (g == 0) ? blk : (blk & 1), nt_all = seqlen / dil / 64; res0 = (g == 0) ? 0 : (blk >> 1);
    rq = res0; lq0 = 256 * kb + 32 * wid; t_lo = (4 * kb - 1 < 0) ? 0 : 4 * kb - 1; const int t_hi = (4 * kb + 5 > nt_all) ? nt_all : 4 * kb + 5; ntile = t_hi - t_lo; }
  else { res0 = 2 * blk; rq = res0 + (wid >> 2); lq0 = 32 * (wid & 3); t_lo = 0; ntile = 4; }
  const long tok0 = (long)b * seqlen;
  const bf16* Pq = P + cqb + head * D; const bf16* Pk = P + ckb + head * D; const bf16* Pv = P + cvb + head * D;
  float m_reg = -1e30f, l_reg = 0; f32x16 o[4] = {}; bf16x8 qr[8];
  { const bf16* Qw = Pq + (tok0 + (long)(lq0 + r32) * dil + rq) * LDQ + hi * 8;
#pragma unroll
    for (int d0 = 0; d0 < 8; ++d0) qr[d0] = St::ld8(Qw + d0 * 16); }
  const int sr = tid >> 4, sc = (tid & 15) * 8, vst0 = v_st(sr, sc), vst1 = v_st(32 + sr, sc);
  const int vb0 = (int)(uintptr_t)V_lds + v_rd_base(lane);
  typename St::T vs0, vs1, ks0, ks1, vt0, vt1, kt0, kt1;
#define TILE_RK(tt) ((g < 2) ? res0 : res0 + ((tt) >> 1))
#define TILE_LK0(tt) ((g < 2) ? 64 * (t_lo + (tt)) : 64 * ((tt) & 1))
#define BLOAD(tt, V0, V1, K0, K1) do { const int rk_ = TILE_RK(tt), lk_ = TILE_LK0(tt); const long ta = (tok0 + (long)(lk_ + sr) * dil + rk_) * LDK + sc, tb = (tok0 + (long)(lk_ + 32 + sr) * dil + rk_) * LDK + sc; \
    V0 = St::ld8(Pv + ta); V1 = St::ld8(Pv + tb); K0 = St::ld8(Pk + ta); K1 = St::ld8(Pk + tb); } while (0)
#define BWRITE(V0, V1, K0, K1) do { *(bf16x8*)((char*)V_lds + vst0) = V0; *(bf16x8*)((char*)V_lds + vst1) = V1; const int kc = sc * 2; \
    *(bf16x8*)((char*)K_lds + KSWZ(sr, kc)) = K0; *(bf16x8*)((char*)K_lds + KSWZ(32 + sr, kc)) = K1; } while (0)
#define BCOMPUTE(tt) do { const int rk = TILE_RK(tt), lk0 = TILE_LK0(tt); \
    const bool need = (rk == rq) && (lk0 + 63 >= lq0 - 64) && (lk0 <= lq0 + 95); \
    if (need) { \
      f32x16 p0, p1; float mn, alpha; bf16x8 pa0, pa1, pa2, pa3; \
      qkt(p0, p1, K_lds, qr, r32, hi); \
      const int dd = lk0 - lq0 - r32 + 4 * hi;                      \
      _Pragma("unroll") for (int r = 0; r < 16; ++r) { const int d0_ = dd + (r & 3) + 8 * (r >> 2), d1_ = d0_ + 32; \
        if (d0_ < -64 || d0_ > 64) p0[r] = -INFINITY; if (d1_ < -64 || d1_ > 64) p1[r] = -INFINITY; } \
      partialSM(p0, p1, m_reg, mn, alpha); \
      if (__any(alpha < 1.f)) { if (hi == 0) al_l[r32] = alpha; asm volatile("s_waitcnt lgkmcnt(0)" ::: "memory"); \
        _Pragma("unroll") for (int d = 0; d < 4; ++d) _Pragma("unroll") for (int r = 0; r < 16; ++r) o[d][r] *= al_l[crow(r, hi)]; } \
      finishSM(p0, p1, alpha, l_reg, pa0, pa1, pa2, pa3); SBAR(); \
      pv_d0(o, vb0, pa0, pa1, pa2, pa3); \
    } } while (0)
  BLOAD(0, vs0, vs1, ks0, ks1); if (ntile > 1) BLOAD(1, vt0, vt1, kt0, kt1);
  for (int tt = 0; tt < ntile; tt += 2) {
    __syncthreads();
    BWRITE(vs0, vs1, ks0, ks1);
    __syncthreads();
    if (tt + 2 < ntile) BLOAD(tt + 2, vs0, vs1, ks0, ks1);
    BCOMPUTE(tt);
    if (tt + 1 < ntile) {
      __syncthreads();
      BWRITE(vt0, vt1, kt0, kt1);
      __syncthreads();
      if (tt + 3 < ntile) BLOAD(tt + 3, vt0, vt1, kt0, kt1);
      BCOMPUTE(tt + 1);
    }
  }
#undef BWRITE
#undef BCOMPUTE
#undef BLOAD
#undef TILE_RK
#undef TILE_LK0
  if (hi == 0) li_l[r32] = l_reg; asm volatile("s_waitcnt lgkmcnt(0)" ::: "memory");
  float rli[16];
#pragma unroll
  for (int r = 0; r < 16; ++r) rli[r] = __builtin_amdgcn_rcpf(li_l[crow(r, hi)]);
  __syncthreads();
  { float* stg = (float*)(lds + wid * 16384);
#pragma unroll
    for (int r = 0; r < 16; ++r) { const int orow = crow(r, hi);
#pragma unroll
      for (int d0 = 0; d0 < 4; ++d0) stg[orow * 128 + d0 * 32 + r32] = o[d0][r] * rli[r]; }
    asm volatile("s_waitcnt lgkmcnt(0)" ::: "memory");
    const int ch = lane & 15, rb = lane >> 4;
    bf16* OGq = OG; asm volatile("" : "+s"(OGq));
    const __amdgpu_buffer_rsrc_t rsOG = __builtin_amdgcn_make_buffer_rsrc((void*)OGq, 0, 3 * 8192 * 512 * 2, 0x00020000);
#pragma unroll
    for (int i = 0; i < 8; ++i) { const int row = 4 * i + rb; const float* sp = stg + row * 128 + ch * 8;
      const f32x4_ a = *(const f32x4_*)sp, b = *(const f32x4_*)(sp + 4); u32x4 w;
      w[0] = cvtpk(a[0], a[1]); w[1] = cvtpk(a[2], a[3]); w[2] = cvtpk(b[0], b[1]); w[3] = cvtpk(b[2], b[3]);
      __builtin_amdgcn_raw_buffer_store_b128(w, rsOG, (int)(((long)g * ntok * 512 + h * D + ch * 8 + (tok0 + (long)(lq0 + row) * dil + rq) * 512) * 2), 0, 16); } }
  if (hi == 0) __hip_atomic_store(LSE + ((long)g * ntok + tok0 + (long)(lq0 + r32) * dil + rq) * 4 + h, m_reg * SCALE + __logf(l_reg), __ATOMIC_RELAXED, __HIP_MEMORY_SCOPE_AGENT);
  __syncthreads();
}
}

typedef unsigned short bf16_t;
constexpr int BATCH = 4, SEQ = 2048, DM = 2048, NTOK = BATCH * SEQ, NC = 11776;
constexpr int C_QA = 0, C_KA = 1024, C_VA = 1280, C_GA = 1536, C_QB = 2560, C_KB = 4096, C_VB = 5632, C_GB = 7168, C_ZA = 7680, C_ZB = 9728;
constexpr float EPS = 1e-6f;
constexpr float H8_SCALE = 4.0f, W8_SCALE = 64.0f;
constexpr size_t MiB = 1u << 20;
constexpr int PITCH = 7680;
constexpr size_t WS_CTL = 0, WS_TAB = 1 * MiB, WS_XB = 1 * MiB + 512 * 1024, WS_WTIN = 2 * MiB, WS_WTAB = 48 * MiB, WS_WTO = 54 * MiB, WS_HB = 64 * MiB, WS_P = 96 * MiB, WS_Y = 216 * MiB, WS_OG = 240 * MiB, WS_LSE = 264 * MiB,
                 WS_SA = 266 * MiB, WS_SB = 298 * MiB, WS_H8 = 330 * MiB, WS_WTZ8 = 346 * MiB, WS_END = 361 * MiB;

#define LAS __attribute__((address_space(3)))
typedef float f32x4 __attribute__((ext_vector_type(4)));
typedef unsigned v4u __attribute__((ext_vector_type(4)));
constexpr int NWAVES = 8;
constexpr int LDS_BYTES = 147456;

__device__ __forceinline__ float bf2f(bf16_t h) { return __uint_as_float(((unsigned)h) << 16); }
__device__ __forceinline__ unsigned f2bf_u(float f) { unsigned u = __float_as_uint(f); return (u + 0x7fffu + ((u >> 16) & 1u)) >> 16; }
__device__ __forceinline__ bf16_t f2bf(float f) { return (bf16_t)f2bf_u(f); }
__device__ __forceinline__ unsigned pk2(float lo, float hi) { return f2bf_u(lo) | (f2bf_u(hi) << 16); }
__device__ __forceinline__ float wave_sum(float v) {
#pragma unroll
    for (int o = 1; o < 64; o <<= 1) v += __shfl_xor(v, o);
    return v;
}

__device__ __forceinline__ int colmap(int kind, int p) {
    const int bj = p >> 7, wc = (p >> 5) & 3, n = (p >> 4) & 1, fq = (p >> 2) & 3, j = p & 3;
    const int gen = 128 * bj + 32 * wc + 8 * fq + 4 * n + j;
    if (kind == 0) return p;
    if (kind == 1) return gen;
    if (kind == 2) return 128 * bj + 64 * (wc >> 1) + 32 * n + 16 * (wc & 1) + 4 * fq + j;
    return wc == 0 ? p : gen;
}
__device__ __forceinline__ int kind_in(int pn) { return pn < 5 ? 2 : ((pn >= 10 && pn < 22) ? 3 : 1); }

struct TrSrc { const float* W; int N; bf16_t* WT; int ldt, koff, kindsel; unsigned char* wt8; int n8; };
__device__ __forceinline__ void tr_load(const TrSrc& t, int item, int lane, f32x4 (&v)[8]) {
    const int nblk = t.N / 32, kb = item / nblk, nb = item % nblk, k0 = 64 * kb, n0 = 32 * nb;
    const int np = n0 + 4 * (lane & 7), pn = np >> 8;
    const int kind = t.kindsel < 0 ? kind_in(pn) : t.kindsel;
    const int pq = np & 255;
    const int scol = (t.wt8 != nullptr && pn >= 30) ? (pq < 128 ? 7680 : 9728) + 128 * (pn - 30) + colmap(1, pq & 127) : (pn << 8) + colmap(kind, pq);
    const float* src = t.W + (size_t)(k0 + (lane >> 3)) * t.N + scol;
#pragma unroll
    for (int i = 0; i < 8; ++i) v[i] = __builtin_nontemporal_load((const f32x4*)(src + (size_t)(8 * i) * t.N));
}
__device__ __forceinline__ void tr_store(const TrSrc& t, int item, int lane, const f32x4 (&v)[8], LAS float* scr) {
    const int nblk = t.N / 32, kb = item / nblk, nb = item % nblk, k0 = 64 * kb, n0 = 32 * nb;
    { LAS float* d = scr + (lane >> 3) * 33 + 4 * (lane & 7);
#pragma unroll
      for (int i = 0; i < 8; ++i) { d[i * 264 + 0] = v[i][0]; d[i * 264 + 1] = v[i][1]; d[i * 264 + 2] = v[i][2]; d[i * 264 + 3] = v[i][3]; } }
    asm volatile("s_waitcnt lgkmcnt(0)" ::: "memory");
    const int c = lane & 7;
    const int pn_ = n0 >> 8; const bool is8 = t.wt8 != nullptr && (n0 >= t.n8 || pn_ < 14);
    const int n8row = n0 >= t.n8 ? n0 - t.n8 + 14 * 256 : n0;
    if (is8) {
#pragma unroll
        for (int j = 0; j < 4; ++j) { const int n = (lane >> 3) + 8 * j; const LAS float* sp = scr + (8 * c) * 33 + n;
            int lo = 0, hi = 0;
            lo = __builtin_amdgcn_cvt_pk_fp8_f32(sp[0 * 33] * W8_SCALE, sp[1 * 33] * W8_SCALE, lo, false); lo = __builtin_amdgcn_cvt_pk_fp8_f32(sp[2 * 33] * W8_SCALE, sp[3 * 33] * W8_SCALE, lo, true);
            hi = __builtin_amdgcn_cvt_pk_fp8_f32(sp[4 * 33] * W8_SCALE, sp[5 * 33] * W8_SCALE, hi, false); hi = __builtin_amdgcn_cvt_pk_fp8_f32(sp[6 * 33] * W8_SCALE, sp[7 * 33] * W8_SCALE, hi, true);
            *(unsigned long long*)(t.wt8 + (size_t)(n8row + n) * t.ldt + k0 + 8 * c) = (unsigned long long)(unsigned)lo | ((unsigned long long)(unsigned)hi << 32); }
    } else {
#pragma unroll
    for (int j = 0; j < 4; ++j) { const int n = (lane >> 3) + 8 * j; const LAS float* sp = scr + (8 * c) * 33 + n;
        v4u o; o.x = pk2(sp[0 * 33], sp[1 * 33]); o.y = pk2(sp[2 * 33], sp[3 * 33]); o.z = pk2(sp[4 * 33], sp[5 * 33]); o.w = pk2(sp[6 * 33], sp[7 * 33]);
        *(v4u*)(t.WT + (size_t)(n0 + n) * t.ldt + t.koff + k0 + 8 * c) = o; }
    }
    asm volatile("s_waitcnt lgkmcnt(0)" ::: "memory");
}
__device__ __forceinline__ void tr_matrix(const TrSrc& t, int nitems, int gw, int NGW, int lane, LAS float* scr) {
    f32x4 a[8], b[8];
    int it = gw;
    if (it < nitems) tr_load(t, it, lane, a);
    for (; it < nitems; it += 2 * NGW) {
        const bool hb = it + NGW < nitems;
        if (hb) tr_load(t, it + NGW, lane, b);
        tr_store(t, it, lane, a, scr);
        if (hb) { if (it + 2 * NGW < nitems) tr_load(t, it + 2 * NGW, lane, a); tr_store(t, it + NGW, lane, b, scr); }
    }
}
__device__ __forceinline__ void rms_row_load(const float* xrow, int lane, f32x4 (&v)[8]) {
    const f32x4* xr = (const f32x4*)xrow + lane;
#pragma unroll
    for (int j = 0; j < 8; ++j) v[j] = __builtin_nontemporal_load(xr + 64 * j);
}
__device__ __forceinline__ void rms_row_store(const f32x4 (&v)[8], const float* gain, bf16_t* orow, unsigned char* orow8, int lane) {
    const f32x4* gr = (const f32x4*)gain + lane; float s = 0.f;
#pragma unroll
    for (int j = 0; j < 8; ++j) s += (v[j].x * v[j].x + v[j].y * v[j].y) + (v[j].z * v[j].z + v[j].w * v[j].w);
    const float rs = rsqrtf(wave_sum(s) * (1.f / DM) + EPS);
    unsigned long long* o8 = (unsigned long long*)orow + lane;
    unsigned* q8 = (unsigned*)orow8 + lane;
#pragma unroll
    for (int j = 0; j < 8; ++j) { const f32x4 g = gr[64 * j]; const f32x4 y = v[j] * rs * g;
        o8[64 * j] = (unsigned long long)pk2(y.x, y.y) | ((unsigned long long)pk2(y.z, y.w) << 32);
        int w = 0; w = __builtin_amdgcn_cvt_pk_fp8_f32(y.x * H8_SCALE, y.y * H8_SCALE, w, false); w = __builtin_amdgcn_cvt_pk_fp8_f32(y.z * H8_SCALE, y.w * H8_SCALE, w, true);
        q8[64 * j] = (unsigned)w; }
}
__device__ __forceinline__ void rms_rows(const float* x, const float* gain, bf16_t* H, unsigned char* H8, int m0, int step, int nrows, int lane) {
    f32x4 a[8], b[8];
    int m = m0;
    if (m < nrows) rms_row_load(x + (size_t)m * DM, lane, a);
    for (; m < nrows; m += 2 * step) {
        const bool hb = m + step < nrows;
        if (hb) rms_row_load(x + (size_t)(m + step) * DM, lane, b);
        rms_row_store(a, gain, H + (size_t)m * DM, H8 + (size_t)m * DM, lane);
        if (hb) { if (m + 2 * step < nrows) rms_row_load(x + (size_t)(m + 2 * step) * DM, lane, a); rms_row_store(b, gain, H + (size_t)(m + step) * DM, H8 + (size_t)(m + step) * DM, lane); }
    }
}

#define XB_TMO      128
#define XB_XCNT(j)  (256  + 64 * (j))
#define XB_XSUB(j)  (1280 + 64 * (j))
#define XB_XGEN(j)  (2304 + 64 * (j))
#define XB_TOP      3328
#define XB_TOPGEN   3392
#define XCD_BAR_WORDS 3456
#define XB_SPIN_CAP (1u << 18)

__device__ __forceinline__ unsigned xb_ld(unsigned* p)              { return __hip_atomic_load(p, __ATOMIC_RELAXED, __HIP_MEMORY_SCOPE_AGENT); }
__device__ __forceinline__ unsigned xb_add(unsigned* p, unsigned v) { return __hip_atomic_fetch_add(p, v, __ATOMIC_RELAXED, __HIP_MEMORY_SCOPE_AGENT); }
__device__ __forceinline__ unsigned xb_xcc_id() { return (unsigned)__builtin_amdgcn_s_getreg((3 << 11) | 20) & 0xFu; }
#define XB_SPIN(cond, bar) do { unsigned _sp = 0; while (cond) { __builtin_amdgcn_s_sleep(1); \
    if ((++_sp & 255u) == 0u) { if (xb_ld(&(bar)[XB_TMO])) break; if (_sp > XB_SPIN_CAP) { atomicAdd(&(bar)[XB_TMO], 1u); break; } } } } while (0)

struct XcdBarrier {
    unsigned* bar; unsigned x;
    volatile LAS unsigned* st;
};

__device__ __forceinline__ XcdBarrier xcd_barrier_post(unsigned* bar, volatile LAS unsigned* st) {
    XcdBarrier b; b.bar = bar; b.x = xb_xcc_id(); b.st = st;
    if (threadIdx.x == 0) (void)xb_add(&bar[XB_XCNT(b.x)], 1u);
    return b;
}
__device__ __forceinline__ void xcd_barrier_complete(unsigned* bar, unsigned x, unsigned& nloc, unsigned& nx) {
    const unsigned G = gridDim.x * gridDim.y * gridDim.z;
    unsigned sum, cnt, mine, sp = 0u;
    for (;;) {
        sum = 0u; cnt = 0u; mine = 0u;
#pragma unroll
        for (unsigned j = 0; j < 16; ++j) { const unsigned c = xb_ld(&bar[XB_XCNT(j)]); sum += c; cnt += (c > 0u) ? 1u : 0u; mine = (j == x) ? c : mine; }
        if (sum == G) break;
        __builtin_amdgcn_s_sleep(1);
        if ((++sp & 255u) == 0u) { if (xb_ld(&bar[XB_TMO])) break; if (sp > XB_SPIN_CAP) { atomicAdd(&bar[XB_TMO], 1u); break; } }
    }
    nloc = mine > 0u ? mine : 1u; nx = cnt > 0u ? cnt : 1u;
}

__device__ __forceinline__ void xcd_barrier(const XcdBarrier& b, const int wave_) {
    asm volatile("s_waitcnt vmcnt(0)" ::: "memory");
    __syncthreads();
    if (wave_ == 0 && fresh_lane() == 0) {
        unsigned* bar = b.bar;
        __builtin_amdgcn_s_waitcnt(0);
        unsigned nloc = b.st[0], nx = b.st[1];
        if (nloc == 0u) { xcd_barrier_complete(bar, b.x, nloc, nx); b.st[0] = nloc; b.st[1] = nx; }
        const unsigned old = xb_add(&bar[XB_XSUB(b.x)], 1u);
        const unsigned gen = old / nloc;
        if (old + 1u == (gen + 1u) * nloc) {
            __builtin_amdgcn_fence(__ATOMIC_RELEASE, "agent");
            asm volatile("s_waitcnt vmcnt(0)" ::: "memory");
            const unsigned og = xb_add(&bar[XB_TOP], 1u);
            const unsigned tg = og / nx;
            if (og + 1u == (tg + 1u) * nx) xb_add(&bar[XB_TOPGEN], 1u);
            else XB_SPIN(xb_ld(&bar[XB_TOPGEN]) == tg, bar);
            __builtin_amdgcn_fence(__ATOMIC_ACQUIRE, "agent");
            xb_add(&bar[XB_XGEN(b.x)], 1u);
            asm volatile("s_waitcnt vmcnt(0)" ::: "memory");
        } else {
            XB_SPIN(xb_ld(&bar[XB_XGEN(b.x)]) == gen, bar);
            __builtin_amdgcn_fence(__ATOMIC_ACQUIRE, "agent");
            asm volatile("s_waitcnt vmcnt(0)" ::: "memory");
        }
    }
    __syncthreads();
}

struct Args { const float* in[10]; float* out; unsigned char* ws; int ph_lo, ph_hi; };

__global__ void __launch_bounds__(NWAVES * 64, 2) mk_fwd(Args args) {
    extern __shared__ __attribute__((aligned(16))) unsigned char lds[];
    const int wave = __builtin_amdgcn_readfirstlane((int)threadIdx.x >> 6);
#define TID_LANE const int lane = fresh_lane(); const int tid = wave * 64 + lane; (void)tid; (void)lane;
    const int G = gridDim.x, bx = blockIdx.x;
    const int vcu = (G % 8 == 0) ? (bx % 8) * (G / 8) + bx / 8 : bx;
    unsigned char* ws = args.ws;
    const float* x = args.in[0]; const float* ng = args.in[1]; const float* w_in = args.in[2];
    bf16_t* WT_IN = (bf16_t*)(ws + WS_WTIN); bf16_t* HB = (bf16_t*)(ws + WS_HB); bf16_t* P = (bf16_t*)(ws + WS_P);
    float* COSA = (float*)(ws + WS_TAB); float* SINA = COSA + 2048; float* COSP = COSA + 4096; float* SINP = COSP + 32768;
    bf16_t* OG = (bf16_t*)(ws + WS_OG); float* LSE = (float*)(ws + WS_LSE); unsigned* CTL = (unsigned*)(ws + WS_CTL) + 4096;
    bf16_t* WT_AB = (bf16_t*)(ws + WS_WTAB); bf16_t* WT_O = (bf16_t*)(ws + WS_WTO); bf16_t* Y = (bf16_t*)(ws + WS_Y); bf16_t* MG = HB; unsigned char* H8 = ws + WS_H8; unsigned char* WTZ8 = ws + WS_WTZ8; bf16_t* SA = (bf16_t*)(ws + WS_SA); bf16_t* SB = (bf16_t*)(ws + WS_SB); float* XB = (float*)(ws + WS_XB); unsigned* PCNT = (unsigned*)(ws + WS_CTL) + 8192; unsigned* PC2 = (unsigned*)(ws + WS_CTL) + 10240;
    const int lo = args.ph_lo, hi = args.ph_hi;
    volatile LAS unsigned* MISC = (volatile LAS unsigned*)((LAS unsigned char*)lds + 131072 + 320);
    if (threadIdx.x < 32) MISC[threadIdx.x] = 0u;
    __syncthreads();
    XcdBarrier bar = xcd_barrier_post((unsigned*)(ws + WS_CTL), MISC + 8);
#define GRID_BAR() xcd_barrier(bar, wave)
#define IN(k) (lo <= (k) && (k) < hi)
#define BOTH(k) (IN(k) && IN((k) + 1))
    if (IN(0)) { TID_LANE
        LAS float* scr = (LAS float*)((LAS unsigned char*)lds + wave * 16384);
        const int gw = vcu * NWAVES + wave, NGW = G * NWAVES;
        constexpr int I_IN = (DM / 64) * (NC / 32);
        { const TrSrc t{w_in, NC, WT_IN, DM, 0, -1, WTZ8, 7680}; tr_matrix(t, I_IN, gw, NGW, lane, scr); }
        for (int i = bx * (NWAVES * 64) + tid; i < 2048 + 32768; i += G * NWAVES * 64) {
            if (i < 2048) { const int pos = i >> 5, fi = i & 31; const float a = (float)pos * (1.0f / powf(10000.0f, (float)fi / 32.0f)); COSA[i] = cosf(a); SINA[i] = sinf(a); }
            else { const int k = i - 2048, pos = k >> 4, fi = k & 15; const float a = (float)pos * (1.0f / powf(500000.0f, (float)fi / 16.0f)); COSP[k] = cosf(a); SINP[k] = sinf(a); }
        }
        rms_rows(x, ng, HB, H8, gw, NGW, NTOK, lane);
        if (BOTH(0)) GRID_BAR();
    }
    if (IN(1)) { TID_LANE
        const float dsc = 1.0f / (H8_SCALE * W8_SCALE);
        {
            pg8::Gemm g{HB, WT_IN + (size_t)14 * 256 * DM, NTOK, 16 * 256, DM}; pg8::StaticOrder S; S.init(NTOK, 16 * 256, G, bx, 8);
            pg8::EpiIn<false> E{P, PITCH, COSA, SINA, COSP, SINP, args.in[3], args.in[4], args.in[5], SA, SB, (LAS float*)((LAS unsigned char*)lds + 131072 + 1024), EPS, 1.0f};
            pg8::gemm_phase<pg8::EpiIn<false>, pg8::StaticOrder, true, true>((LAS unsigned char*)lds, g, S, E, wave);
        }
        {
            pg8::Gemm g8{(const bf16_t*)H8, (const bf16_t*)WTZ8, NTOK, 30 * 256, DM / 2}; pg8::StaticOrder S8; S8.init(NTOK, 30 * 256, G, bx, 4);
            pg8::EpiIn<true> E8{P, PITCH, COSA, SINA, COSP, SINP, args.in[3], args.in[4], args.in[5], SA, SB, (LAS float*)((LAS unsigned char*)lds + 131072 + 1024), EPS, dsc};
            pg8::gemm_phase<pg8::EpiIn<true>, pg8::StaticOrder, true, true>((LAS unsigned char*)lds, g8, S8, E8, wave);
        }
        const int nheavy = ((NTOK / 256) * 30) % G;
        {
            const int first = nheavy > 0 ? nheavy : 0, nidle = G - first;
            if (bx >= first) {
                LAS float* scr = (LAS float*)((LAS unsigned char*)lds + wave * 16384);
                const int gw2 = (bx - first) * NWAVES + wave, NGW2 = nidle * NWAVES;
                constexpr int I_A = (1024 / 64) * (DM / 32), I_B = (512 / 64) * (DM / 32), I_O = (DM / 64) * (DM / 32);
                { const TrSrc t{args.in[6], DM, WT_AB, 1536, 0, 1, nullptr, 0}; tr_matrix(t, I_A, gw2, NGW2, lane, scr); }
                { const TrSrc t{args.in[7], DM, WT_AB, 1536, 1024, 1, nullptr, 0}; tr_matrix(t, I_B, gw2, NGW2, lane, scr); }
                { const TrSrc t{args.in[8], DM, WT_O, DM, 0, 0, nullptr, 0}; tr_matrix(t, I_O, gw2, NGW2, lane, scr); }
            }
        }
        if (BOTH(1)) GRID_BAR();
    }
    if (IN(2)) { TID_LANE
        float gmq = 0.f, gmk = 0.f;
        { const int gl_ = fresh_lane(); const float* gqp = args.in[3]; const float* gkp = args.in[4]; gmq = fmaxf(fabsf(gqp[gl_]), fabsf(gqp[gl_ + 64])); gmk = fmaxf(fabsf(gkp[gl_]), fabsf(gkp[gl_ + 64]));
#pragma unroll
          for (int o = 32; o > 0; o >>= 1) { gmq = fmaxf(gmq, __shfl_xor(gmq, o)); gmk = fmaxf(gmk, __shfl_xor(gmk, o)); } }
        const bool bounded = __builtin_amdgcn_readfirstlane((16.33f * 1.02f * gmq * gmk <= 60.f) ? 1 : 0) != 0;
        for (int u = bx; u < 384; u += G) {
            const int blk = u & 7, h = (u >> 3) & 3, b = (u >> 5) & 3, g = u >> 7;
            att::attn_band_unit(P, OG, LSE, g, b, h, blk, C_QB, C_KB, C_VB, SEQ, NTOK, (char*)lds, wave);
        }
        asm volatile("s_waitcnt vmcnt(0)" ::: "memory"); __syncthreads();
        if (tid == 0) __hip_atomic_fetch_add(CTL, 1u, __ATOMIC_RELAXED, __HIP_MEMORY_SCOPE_AGENT);
        for (int u = bx; u < 256; u += G) {
            const int pair = u & 7, inner = u >> 3, b = pair >> 1, hkv = pair & 1, hq = hkv * 4 + (inner >> 3), qb = inner & 7;
            const size_t row0 = (size_t)b * SEQ + qb * 256;
            if (bounded) att::attn_dense_body<true>(P + row0 * PITCH + C_QA + hq * 128, P + (size_t)b * SEQ * PITCH + C_KA + hkv * 128, P + (size_t)b * SEQ * PITCH + C_VA + hkv * 128,
                                 P + row0 * PITCH + C_GA + hq * 128, Y + row0 * 1536 + hq * 128, SEQ, (char*)lds, wave);
            else att::attn_dense_body<false>(P + row0 * PITCH + C_QA + hq * 128, P + (size_t)b * SEQ * PITCH + C_KA + hkv * 128, P + (size_t)b * SEQ * PITCH + C_VA + hkv * 128,
                                 P + row0 * PITCH + C_GA + hq * 128, Y + row0 * 1536 + hq * 128, SEQ, (char*)lds, wave);
            if (G == 256) { asm volatile("s_waitcnt vmcnt(0)" ::: "memory"); __syncthreads();
                if (wave == 0 && fresh_lane() == 0) __hip_atomic_fetch_add(PC2 + 64 * (b * 8 + qb), 1u, __ATOMIC_RELAXED, __HIP_MEMORY_SCOPE_AGENT); }
        }
        const int mfirst = (384 - G > 0 && 384 - G < G) ? 384 - G : 0, nmerge = G - mfirst;
        if (bx >= mfirst) {
            const int tid = wave * 64 + fresh_lane();
            if (tid == 0) { unsigned spins = 0; while (__hip_atomic_load(CTL, __ATOMIC_RELAXED, __HIP_MEMORY_SCOPE_AGENT) < (unsigned)G) { __builtin_amdgcn_s_sleep(4); if (++spins > (1u << 24)) break; }
                __builtin_amdgcn_fence(__ATOMIC_ACQUIRE, "agent"); asm volatile("s_waitcnt vmcnt(0)" ::: "memory"); }
            __syncthreads();
            const int mj = bx - mfirst, mbase = (G == 256) ? (256 * (mj >> 2) + 64 * (mj & 3)) * 64 : mj * (NWAVES * 64), mend = (G == 256) ? mbase + 64 * 64 : NTOK * 64, mstep = (G == 256) ? NWAVES * 64 : nmerge * NWAVES * 64;
            const __amdgpu_buffer_rsrc_t rsYm = __builtin_amdgcn_make_buffer_rsrc((void*)Y, 0, NTOK * 1536 * 2, 0x00020000);
            for (int c0 = mbase + tid; c0 < mend; c0 += 2 * mstep) {
                v4u a0[2], a1[2], a2[2], gz[2]; float e0[2], e1[2], e2[2]; int tok[2], c8[2]; bool ok[2];
#pragma unroll
                for (int q = 0; q < 2; ++q) { const int ci = c0 + q * mstep; ok[q] = ci < mend; const int cj = ok[q] ? ci : c0; tok[q] = cj >> 6; c8[q] = (cj & 63) * 8; const int h = c8[q] >> 7;
                    e0[q] = LSE[((size_t)0 * NTOK + tok[q]) * 4 + h]; e1[q] = LSE[((size_t)1 * NTOK + tok[q]) * 4 + h]; e2[q] = LSE[((size_t)2 * NTOK + tok[q]) * 4 + h];
                    a0[q] = *(const v4u*)(OG + ((size_t)0 * NTOK + tok[q]) * 512 + c8[q]); a1[q] = *(const v4u*)(OG + ((size_t)1 * NTOK + tok[q]) * 512 + c8[q]); a2[q] = *(const v4u*)(OG + ((size_t)2 * NTOK + tok[q]) * 512 + c8[q]);
                    gz[q] = *(const v4u*)(P + (size_t)tok[q] * PITCH + C_GB + c8[q]); }
#pragma unroll
                for (int q = 0; q < 2; ++q) { const float mx = fmaxf(e0[q], fmaxf(e1[q], e2[q])); float w0 = __expf(e0[q] - mx), w1 = __expf(e1[q] - mx), w2 = __expf(e2[q] - mx); const float inv = 1.f / (w0 + w1 + w2); w0 *= inv; w1 *= inv; w2 *= inv;
                    v4u w;
#pragma unroll
                    for (int e = 0; e < 4; ++e) {
                        const float lo = w0 * __uint_as_float(a0[q][e] << 16) + w1 * __uint_as_float(a1[q][e] << 16) + w2 * __uint_as_float(a2[q][e] << 16);
                        const float hh = w0 * __uint_as_float(a0[q][e] & 0xffff0000u) + w1 * __uint_as_float(a1[q][e] & 0xffff0000u) + w2 * __uint_as_float(a2[q][e] & 0xffff0000u);
                        w[e] = pk2(lo * __uint_as_float(gz[q][e] << 16), hh * __uint_as_float(gz[q][e] & 0xffff0000u)); }
                    if (ok[q]) __builtin_amdgcn_raw_buffer_store_b128(w, rsYm, (int)(((size_t)tok[q] * 1536 + 1024 + c8[q]) * 2), 0, 16); }
            }
            if (G == 256) { asm volatile("s_waitcnt vmcnt(0)" ::: "memory"); __syncthreads(); if (tid == 0) __hip_atomic_fetch_add(PC2 + 64 * (mj >> 2), 1u, __ATOMIC_RELAXED, __HIP_MEMORY_SCOPE_AGENT); }
        }
        if (BOTH(2) && G != 256) GRID_BAR();
    }
    if (IN(3)) {
        pg8::Gemm g{Y, WT_AB, NTOK, DM, 1536}; pg8::StaticOrder S; S.init(NTOK, DM, G, bx, 4);
        if (G == 256 && IN(2)) {
            pg8::Unit u2; if (S.next(0, u2)) {
                unsigned* pc2 = PC2 + 64 * u2.pm;
                if (wave == 0 && fresh_lane() == 0) { unsigned spins = 0; while (__hip_atomic_load(pc2, __ATOMIC_RELAXED, __HIP_MEMORY_SCOPE_AGENT) < 12u) { __builtin_amdgcn_s_sleep(2); if (++spins > (1u << 22)) break; }
                    __builtin_amdgcn_fence(__ATOMIC_ACQUIRE, "agent"); asm volatile("s_waitcnt vmcnt(0)" ::: "memory"); }
                __syncthreads(); } }
        pg8::EpiMerge2 E{SA, SB, MG, DM};
        pg8::gemm_phase<pg8::EpiMerge2, pg8::StaticOrder, true, true>((LAS unsigned char*)lds, g, S, E, wave);
        if (BOTH(3)) {
            pg8::Unit u3; const bool has = S.next(0, u3);
            if (G == 256 && has) {
                unsigned* pc3 = (unsigned*)(ws + WS_CTL) + 5120 + 64 * u3.pm;
                asm volatile("s_waitcnt vmcnt(0)" ::: "memory"); __syncthreads();
                if (wave == 0 && fresh_lane() == 0) {
                    __hip_atomic_fetch_add(pc3, 1u, __ATOMIC_RELAXED, __HIP_MEMORY_SCOPE_AGENT);
                    unsigned spins = 0; while (__hip_atomic_load(pc3, __ATOMIC_RELAXED, __HIP_MEMORY_SCOPE_AGENT) < 8u) { __builtin_amdgcn_s_sleep(2); if (++spins > (1u << 22)) break; }
                    __builtin_amdgcn_fence(__ATOMIC_ACQUIRE, "agent"); asm volatile("s_waitcnt vmcnt(0)" ::: "memory"); }
                __syncthreads();
            } else GRID_BAR();
        }
    }
    if (IN(4)) {
        pg8::Gemm g{MG, WT_O, NTOK, DM, DM}; pg8::StaticOrder S; S.init(NTOK, DM, G, bx, 4);
        pg8::EpiResidNorm E{x, args.out, DM, args.in[9], XB, PCNT, 8, EPS};
        if (G == 256) pg8::gemm_phase<pg8::EpiResidNorm, pg8::StaticOrder, false, true>((LAS unsigned char*)lds, g, S, E, wave);
    }
#undef IN
#undef BOTH
}


extern "C" void kernel_launch(void* const* d_in, const int* in_sizes, int n_in, void* d_out, int out_size, void* d_ws, size_t ws_size, hipStream_t stream) {
    static int grid = 0;
    if (grid == 0) {
        if (n_in != 10 || in_sizes[0] != NTOK * DM || out_size != NTOK * DM || ws_size < WS_END) { fprintf(stderr, "kernel_launch: unexpected shapes / workspace (%zu)\n", ws_size); grid = -1; return; }
        int dev = 0, cus = 0, per_cu = 0;
        if (hipGetDevice(&dev) != hipSuccess || hipDeviceGetAttribute(&cus, hipDeviceAttributeMultiprocessorCount, dev) != hipSuccess) { grid = -1; return; }
        if (hipFuncSetAttribute((const void*)mk_fwd, hipFuncAttributeMaxDynamicSharedMemorySize, LDS_BYTES) != hipSuccess) { fprintf(stderr, "kernel_launch: hipFuncSetAttribute failed\n"); grid = -1; return; }
        if (hipOccupancyMaxActiveBlocksPerMultiprocessor(&per_cu, (const void*)mk_fwd, NWAVES * 64, LDS_BYTES) != hipSuccess || per_cu < 1) { fprintf(stderr, "kernel_launch: occupancy query says %d\n", per_cu); grid = -1; return; }
        grid = cus;
    }
    if (grid < 0) return;
    if (hipMemsetAsync((char*)d_ws + WS_CTL, 0, 131072, stream) != hipSuccess) { fprintf(stderr, "kernel_launch: memset failed\n"); return; }
    Args a{};
    for (int i = 0; i < 10; ++i) a.in[i] = (const float*)d_in[i];
    a.out = (float*)d_out; a.ws = (unsigned char*)d_ws; a.ph_lo = 0; a.ph_hi = 5;
    void* kargs[] = {&a};
    hipError_t e = hipLaunchCooperativeKernel((const void*)mk_fwd, dim3(grid), dim3(NWAVES * 64), kargs, LDS_BYTES, stream);
    if (e != hipSuccess) fprintf(stderr, "kernel_launch: cooperative launch failed: %s (grid %d)\n", hipGetErrorString(e), grid);
}
```

```cpp
#include <hip/hip_runtime.h>
#include <cstdio>
#include <cstdint>
#include <cmath>
__device__ __forceinline__ int fresh_lane() { int l; asm volatile("v_mbcnt_lo_u32_b32 %0, -1, 0\n\tv_mbcnt_hi_u32_b32 %0, -1, %0" : "=v"(l)); return l; }
constexpr int BF_T0 = 28, BF_NT = 2;
constexpr float YA8_SCALE = 128.0f, WA8_SCALE = 64.0f;
constexpr long K8_FROM_P = -94l * 1048576l;
constexpr int YPITCH = 2048;
namespace pg8 {
#define PG8_LAS __attribute__((address_space(3)))
typedef unsigned short bf16_t;
typedef short bf16x8 __attribute__((ext_vector_type(8)));
typedef float f32x4 __attribute__((ext_vector_type(4)));
typedef unsigned u32x4 __attribute__((ext_vector_type(4)));
typedef int v4i_t __attribute__((ext_vector_type(4)));
constexpr int BM = 256, BK = 64, HALF = 128, HTB = HALF * BK * 2  , STAGE_BYTES = 8 * HTB, NXCD = 8;

__host__ __device__ __forceinline__ int lds_byte(int r, int c) { const int st = (r >> 4) * 2 + (c >> 5), rr = r & 15, cc = c & 31, ob = rr * 64 + cc * 2; return st * 1024 + (ob ^ (((ob >> 9) & 1) << 5)); }
__host__ __device__ __forceinline__ void stage_rc(int b, int& R, int& C) { const int st = b / 1024, sb = b % 1024, swz = sb ^ (((sb >> 9) & 1) << 5); R = (st >> 1) * 16 + swz / 64; C = (st & 1) * 32 + (swz % 64) / 2; }
__host__ __device__ __forceinline__ int perm32(int rho) { const int n = rho >> 4, i = rho & 15; return 8 * (i >> 2) + 4 * n + (i & 3); }

struct Unit { int pm, pn; };
struct Gemm { const bf16_t* A; const bf16_t* Bt; int M, N, K; };

struct StaticOrder {
    int nM, nN, nwg, G, c, WGM;
    __host__ __device__ void init(int M, int N, int G_, int c_, int wgm = 4) { nM = M / BM; nN = N / BM; nwg = nM * nN; G = G_; c = c_; WGM = wgm; }
    __host__ __device__ bool next(int i, Unit& u) const { const long L = (long)i * G + c; if (L >= nwg) return false; unit_of((int)L, u); return true; }
    __host__ __device__ bool unit_of(int L, Unit& u) const {
        int wgid = L; { const int q = nwg / NXCD, r = nwg % NXCD, xcd = wgid % NXCD, off = wgid / NXCD; wgid = (xcd < r ? xcd * (q + 1) : r * (q + 1) + (xcd - r) * q) + off; }
        const int nig = WGM * nN, gid = wgid / nig, fm = gid * WGM, gsz = (nM - fm) < WGM ? (nM - fm) : WGM;
        u.pm = fm + ((wgid % nig) % gsz); u.pn = (wgid % nig) / gsz; return true;
    }
    __device__ __forceinline__ void a_ready(const Unit&) const {}
    __device__ __forceinline__ void done(const Unit&) const {}
};
struct SkewOrder { StaticOrder S; int nfull, nlast;
    __device__ __forceinline__ bool next(int i, Unit& u) const { long L;
        if (i < nfull) L = (long)i * S.G + S.c; else { if (S.c >= nlast) return false; L = (long)nfull * S.G + (long)(i - nfull) * nlast + S.c; }
        if (L >= S.nwg) return false; S.unit_of((int)L, u); return true; }
    __device__ __forceinline__ void a_ready(const Unit&) const {}
    __device__ __forceinline__ void done(const Unit&) const {} };

typedef float f32x2_cv __attribute__((ext_vector_type(2))); typedef __bf16 bf16x2_cv __attribute__((ext_vector_type(2)));
__device__ __forceinline__ unsigned cvt_pk_bf16(float lo, float hi) { const f32x2_cv v = {lo, hi}; return __builtin_bit_cast(unsigned, __builtin_convertvector(v, bf16x2_cv)); }
typedef float f32x2 __attribute__((ext_vector_type(2)));

template <bool F8> struct EpiIn {
    static constexpr bool PERM = false, AFTER_DRAIN = false, FP8 = F8, INIT_ACC = false; static constexpr int HOOK_T = -1, TSW = 0;
    bf16_t* O; int ldc; const float* cosa; const float* sina; const float* cosp; const float* sinp; const float* qg; const float* kg; const float* bias; bf16_t* SA; bf16_t* SB; PG8_LAS float* red; float eps; float sc;
    __device__ __forceinline__ static unsigned long long pk4(const f32x4 v) { return (unsigned long long)cvt_pk_bf16(v[0], v[1]) | ((unsigned long long)cvt_pk_bf16(v[2], v[3]) << 32); }
    __device__ __forceinline__ void operator()(const f32x4 (&acc)[2][2][4][2], const Unit& u, int wr, int wc, int fr_, int fq_) const {
        (void)fr_; (void)fq_; const int ln_ = fresh_lane(), fr = ln_ & 15, fq = ln_ >> 4;
        const int pn = F8 ? (u.pn < BF_T0 ? u.pn : u.pn + BF_NT) : u.pn + BF_T0; const int row0 = u.pm * BM + wr * 64 + fr;
        if (pn < 5) {
#pragma unroll
            for (int ai = 0; ai < 2; ++ai)
#pragma unroll
                for (int m = 0; m < 4; ++m)
#pragma unroll
                    for (int bj = 0; bj < 2; ++bj) { const f32x4 v0 = (acc[ai][bj][m][0] * sc), v1 = (acc[ai][bj][m][1] * sc);
                        float ss = (v0[0] * v0[0] + v0[1] * v0[1]) + (v0[2] * v0[2] + v0[3] * v0[3]) + (v1[0] * v1[0] + v1[1] * v1[1]) + (v1[2] * v1[2] + v1[3] * v1[3]);
                        ss += __shfl_xor(ss, 16); ss += __shfl_xor(ss, 32);
                        if (fq == 0) red[(ai * HALF + wr * 64 + m * 16 + fr) * 8 + bj * 4 + wc] = ss; }
            asm volatile("s_waitcnt lgkmcnt(0)" ::: "memory"); __builtin_amdgcn_s_barrier(); asm volatile("" ::: "memory");
            const int sg = ((fq & 1) << 1) | (fq >> 1), half = wc >> 1, i0 = 16 * (wc & 1) + 4 * sg;
            const float* g = (pn < 4) ? qg : kg;
            const float qs = (pn < 4) ? 0.12751743082459868f : 1.f;
            const f32x4 g0 = *(const f32x4*)(g + 64 * half + i0) * qs, g1 = *(const f32x4*)(g + 64 * half + 32 + i0) * qs;
#pragma unroll
            for (int ai = 0; ai < 2; ++ai)
#pragma unroll
                for (int m = 0; m < 4; ++m) { const int row = row0 + ai * HALF + m * 16, sq = row & 2047, pos = half ? (sq & 63) : (sq >> 6);
                    const u32x4 cs_ = *(const u32x4*)((const bf16_t*)cosa + (size_t)(pos * 8 + (i0 >> 2)) * 8);
                    const f32x4 c = {__uint_as_float(cs_[0] << 16), __uint_as_float(cs_[0] & 0xffff0000u), __uint_as_float(cs_[1] << 16), __uint_as_float(cs_[1] & 0xffff0000u)}, sn = {__uint_as_float(cs_[2] << 16), __uint_as_float(cs_[2] & 0xffff0000u), __uint_as_float(cs_[3] << 16), __uint_as_float(cs_[3] & 0xffff0000u)};
#pragma unroll
                    for (int bj = 0; bj < 2; ++bj) { const f32x4 pr = *(const PG8_LAS f32x4*)(red + (ai * HALF + wr * 64 + m * 16 + fr) * 8 + bj * 4);
                        const float rs = rsqrtf(((pr[0] + pr[1]) + (pr[2] + pr[3])) * (1.f / 128.f) + eps);
                        const f32x4 y0 = (acc[ai][bj][m][0] * sc) * rs * g0, y1 = (acc[ai][bj][m][1] * sc) * rs * g1;
                        const f32x4 lo = y0 * c - y1 * sn, hi = y0 * sn + y1 * c;
                        bf16_t* p = O + (size_t)row * ldc + pn * BM + bj * HALF + 64 * half + i0;
                        {
                            const unsigned long long l8 = pk4(lo), h8 = pk4(hi);
                            const auto r0 = __builtin_amdgcn_permlane32_swap((unsigned)l8, (unsigned)h8, false, false), r1 = __builtin_amdgcn_permlane32_swap((unsigned)(l8 >> 32), (unsigned)(h8 >> 32), false, false);
                            const u32x4 w = {r0[0], r1[0], r0[1], r1[1]};
                            *(u32x4*)(fq < 2 ? p : p + 28) = w; }
                        if (pn == 4) { int w0 = 0, w1 = 0;
                            w0 = __builtin_amdgcn_cvt_pk_fp8_f32(lo[0] * 4.f, lo[1] * 4.f, w0, false); w0 = __builtin_amdgcn_cvt_pk_fp8_f32(lo[2] * 4.f, lo[3] * 4.f, w0, true);
                            w1 = __builtin_amdgcn_cvt_pk_fp8_f32(hi[0] * 4.f, hi[1] * 4.f, w1, false); w1 = __builtin_amdgcn_cvt_pk_fp8_f32(hi[2] * 4.f, hi[3] * 4.f, w1, true);
                            unsigned char* q8 = (unsigned char*)O + K8_FROM_P + (size_t)row * 256 + bj * HALF + 64 * half + i0;
                            const auto rq = __builtin_amdgcn_permlane32_swap((unsigned)w0, (unsigned)w1, false, false);
                            *(unsigned long long*)(fq < 2 ? q8 : q8 + 28) = (unsigned long long)rq[0] | ((unsigned long long)rq[1] << 32); } } }
        } else if (pn >= 10 && pn < 22 && wc == 0) {
            const int i0 = 4 * (((fq & 1) << 1) | (fq >> 1));
#pragma unroll
            for (int ai = 0; ai < 2; ++ai)
#pragma unroll
                for (int m = 0; m < 4; ++m) { const int row = row0 + ai * HALF + m * 16, sq = row & 2047;
                    const u32x4 cs_ = *(const u32x4*)((const bf16_t*)cosp + (size_t)(sq * 4 + (i0 >> 2)) * 8);
                    const f32x4 c = {__uint_as_float(cs_[0] << 16), __uint_as_float(cs_[0] & 0xffff0000u), __uint_as_float(cs_[1] << 16), __uint_as_float(cs_[1] & 0xffff0000u)}, sn = {__uint_as_float(cs_[2] << 16), __uint_as_float(cs_[2] & 0xffff0000u), __uint_as_float(cs_[3] << 16), __uint_as_float(cs_[3] & 0xffff0000u)};
#pragma unroll
                    for (int bj = 0; bj < 2; ++bj) { const f32x4 y0 = (acc[ai][bj][m][0] * sc), y1 = (acc[ai][bj][m][1] * sc);
                        const f32x4 lo = y0 * c - y1 * sn, hi = y0 * sn + y1 * c;
                        bf16_t* p = O + (size_t)row * ldc + pn * BM + bj * HALF + i0;
                        const unsigned long long l8 = pk4(lo), h8 = pk4(hi);
                        const auto r0 = __builtin_amdgcn_permlane32_swap((unsigned)l8, (unsigned)h8, false, false), r1 = __builtin_amdgcn_permlane32_swap((unsigned)(l8 >> 32), (unsigned)(h8 >> 32), false, false);
                        const u32x4 w = {r0[0], r1[0], r0[1], r1[1]};
                        *(u32x4*)(fq < 2 ? p : p + 12) = w; } }
        } else if (pn >= 30) {
            const int gq = pn - 30;
            const float* bs = bias + gq * HALF + wc * 32 + 8 * fq;
            const f32x4 a0 = *(const f32x4*)bs, a1 = *(const f32x4*)(bs + 4), b0 = *(const f32x4*)(bs + 2048), b1 = *(const f32x4*)(bs + 2048 + 4);
            const size_t fo = ((((size_t)(u.pm * 8 + (gq >> 1)) * 8 + (wr * 4 + wc)) * 16 + (gq & 1) * 4) * 64 + (fq * 16 + fr)) * 8;
#pragma unroll
            for (int ai = 0; ai < 2; ++ai)
#pragma unroll
                for (int m = 0; m < 4; ++m) { const f32x4 za0 = (acc[ai][0][m][0] * sc) + a0, za1 = (acc[ai][0][m][1] * sc) + a1, zb0 = (acc[ai][1][m][0] * sc) + b0, zb1 = (acc[ai][1][m][1] * sc) + b1;
                    float rr[8], ss[8];
#pragma unroll
                    for (int e = 0; e < 4; ++e) { const float ea0 = 1.f + __builtin_amdgcn_exp2f(za0[e] * -1.4426950408889634f), ea1 = 1.f + __builtin_amdgcn_exp2f(za1[e] * -1.4426950408889634f);
                        const float eb0 = 1.f + __builtin_amdgcn_exp2f(zb0[e] * -1.4426950408889634f), eb1 = 1.f + __builtin_amdgcn_exp2f(zb1[e] * -1.4426950408889634f);
                        rr[e] = eb0 * __builtin_amdgcn_rcpf(ea0) * (1.0f / (YA8_SCALE * WA8_SCALE)); rr[4 + e] = eb1 * __builtin_amdgcn_rcpf(ea1) * (1.0f / (YA8_SCALE * WA8_SCALE));   ss[e] = __builtin_amdgcn_rcpf(eb0); ss[4 + e] = __builtin_amdgcn_rcpf(eb1); }
                    u32x4 w; w.x = cvt_pk_bf16(rr[0], rr[1]); w.y = cvt_pk_bf16(rr[2], rr[3]); w.z = cvt_pk_bf16(rr[4], rr[5]); w.w = cvt_pk_bf16(rr[6], rr[7]);
                    __builtin_nontemporal_store(w, (u32x4*)(SA + fo + (ai * 8 + m) * 512));
                    w.x = cvt_pk_bf16(ss[0], ss[1]); w.y = cvt_pk_bf16(ss[2], ss[3]); w.z = cvt_pk_bf16(ss[4], ss[5]); w.w = cvt_pk_bf16(ss[6], ss[7]);
                    __builtin_nontemporal_store(w, (u32x4*)(SB + fo + (ai * 8 + m) * 512)); }
        } else {
            const bool act = (pn >= 6 && pn < 10) || pn == 28 || pn == 29;
            const int col0 = pn * BM + wc * 32 + 8 * fq;
#pragma unroll
            for (int ai = 0; ai < 2; ++ai)
#pragma unroll
                for (int m = 0; m < 4; ++m) { bf16_t* rowp = O + (size_t)(row0 + ai * HALF + m * 16) * ldc + col0;
#pragma unroll
                    for (int bj = 0; bj < 2; ++bj) { f32x4 v0 = (acc[ai][bj][m][0] * sc), v1 = (acc[ai][bj][m][1] * sc);
                        if (act) {
#pragma unroll
                            for (int e = 0; e < 4; ++e) { v0[e] = v0[e] * __builtin_amdgcn_rcpf(1.f + __builtin_amdgcn_exp2f(v0[e] * -1.4426950408889634f)); v1[e] = v1[e] * __builtin_amdgcn_rcpf(1.f + __builtin_amdgcn_exp2f(v1[e] * -1.4426950408889634f)); } }
                        u32x4 w; w.x = cvt_pk_bf16(v0[0], v0[1]); w.y = cvt_pk_bf16(v0[2], v0[3]); w.z = cvt_pk_bf16(v1[0], v1[1]); w.w = cvt_pk_bf16(v1[2], v1[3]);
                        *(u32x4*)(rowp + bj * HALF) = w; } }
        }
    }
};
struct EpiMerge2 {
    static constexpr bool PERM = false, AFTER_DRAIN = false, FP8 = false; static constexpr int HOOK_T = 8, TSW = 8; static constexpr bool INIT_ACC = false;
    const bf16_t* SA; const bf16_t* SB; bf16_t* O; int ldc;
    __device__ __forceinline__ void mid(f32x4 (&acc)[2][2][4][2], const Unit& u, int wr, int wc, int fr, int fq) const {
        int lane = fq * 16 + fr; asm volatile("" : "+v"(lane));
        const size_t base = ((((size_t)(u.pm * 8 + u.pn) * 8 + (wr * 4 + wc)) * 16) * 64 + lane) * 8;
#pragma unroll
        for (int f = 0; f < 16; ++f) { const int ai = f >> 3, bj = (f >> 2) & 1, m = f & 3;
            const u32x4 a = __builtin_nontemporal_load((const u32x4*)(SA + base + f * 512));
            f32x4 r0, r1;
#pragma unroll
            for (int e = 0; e < 4; ++e) { const float q_lo = __uint_as_float(a[e] << 16), q_hi = __uint_as_float(a[e] & 0xffff0000u);
                if (e < 2) { r0[2 * e] = q_lo; r0[2 * e + 1] = q_hi; } else { r1[2 * e - 4] = q_lo; r1[2 * e - 3] = q_hi; } }
            acc[ai][bj][m][0] *= r0; acc[ai][bj][m][1] *= r1; }
    }
    __device__ __forceinline__ void operator()(const f32x4 (&acc)[2][2][4][2], const Unit& u, int wr, int wc, int fr_, int fq_) const {
        (void)fr_; (void)fq_; const int ln_ = fresh_lane(), fr = ln_ & 15, fq = ln_ >> 4;
        const int lane = fq * 16 + fr, row0 = u.pm * BM + wr * 64 + fr, col0 = u.pn * BM + wc * 32 + 8 * fq;
        const size_t base = ((((size_t)(u.pm * 8 + u.pn) * 8 + (wr * 4 + wc)) * 16) * 64 + lane) * 8;
        bf16_t* Oq = O; asm volatile("" : "+s"(Oq));
        const __amdgpu_buffer_rsrc_t rsO = __builtin_amdgcn_make_buffer_rsrc((void*)Oq, 0, 8192 * 2048 * 2, 0x00020000);
#pragma unroll
        for (int f = 0; f < 16; ++f) { const int ai = f >> 3, bj = (f >> 2) & 1, m = f & 3;
            const u32x4 b = __builtin_nontemporal_load((const u32x4*)(SB + base + f * 512));
            const f32x4 v0 = acc[ai][bj][m][0], v1 = acc[ai][bj][m][1];
            u32x4 w; w.x = cvt_pk_bf16(v0[0] * __uint_as_float(b[0] << 16), v0[1] * __uint_as_float(b[0] & 0xffff0000u)); w.y = cvt_pk_bf16(v0[2] * __uint_as_float(b[1] << 16), v0[3] * __uint_as_float(b[1] & 0xffff0000u));
            w.z = cvt_pk_bf16(v1[0] * __uint_as_float(b[2] << 16), v1[1] * __uint_as_float(b[2] & 0xffff0000u)); w.w = cvt_pk_bf16(v1[2] * __uint_as_float(b[3] << 16), v1[3] * __uint_as_float(b[3] & 0xffff0000u));
            __builtin_amdgcn_raw_buffer_store_b128(w, rsO, (int)(((size_t)(row0 + ai * HALF + m * 16) * ldc + col0 + bj * HALF) * 2), 0, 16); }
    }
};
struct EpiResidNorm {
    static constexpr bool PERM = false, AFTER_DRAIN = true, FP8 = false, INIT_ACC = true; static constexpr int HOOK_T = -1, TSW = 0;
    const float* base; float* out; int ldc; const float* gain; float* xb; unsigned* cnt; int ntn; float eps;
    __device__ __forceinline__ void init(f32x4 (&acc)[2][2][4][2], const Unit& u, int wr, int wc, int fr, int fq) const {
        const int row0 = u.pm * BM + wr * 64 + fr, col0 = u.pn * BM + wc * 32 + 4 * fq;
#pragma unroll
        for (int ai = 0; ai < 2; ++ai)
#pragma unroll
            for (int m = 0; m < 4; ++m) { const size_t off = (size_t)(row0 + ai * HALF + m * 16) * ldc + col0;
#pragma unroll
                for (int bj = 0; bj < 2; ++bj)
#pragma unroll
                    for (int n = 0; n < 2; ++n) acc[ai][bj][m][n] = __builtin_nontemporal_load((const f32x4*)(base + off + bj * HALF + n * 16)); }
    }
    __device__ __forceinline__ void fused(f32x4 (&acc)[2][2][4][2], const Unit& u, int wr, int wc, int fr_, int fq_, PG8_LAS unsigned char* lds, int wid, int lane) const {
        (void)fr_; (void)fq_; const int ln_ = fresh_lane(), fr = ln_ & 15, fq = ln_ >> 4;
        PG8_LAS float* Pp = (PG8_LAS float*)lds;
        PG8_LAS float* Sr = (PG8_LAS float*)(lds + 4096);
        const int row0 = u.pm * BM + wr * 64 + fr, col0 = u.pn * BM + wc * 32 + 4 * fq;
#pragma unroll
        for (int ai = 0; ai < 2; ++ai)
#pragma unroll
            for (int m = 0; m < 4; ++m) { float ss = 0.f;
#pragma unroll
                for (int bj = 0; bj < 2; ++bj)
#pragma unroll
                    for (int n = 0; n < 2; ++n) { const f32x4 o = acc[ai][bj][m][n];
                        ss += (o[0] * o[0] + o[1] * o[1]) + (o[2] * o[2] + o[3] * o[3]); }
                ss += __shfl_xor(ss, 16); ss += __shfl_xor(ss, 32);
                if (fq == 0) Pp[(ai * HALF + wr * 64 + m * 16 + fr) * 4 + wc] = ss; }
        asm volatile("s_waitcnt lgkmcnt(0)" ::: "memory"); __builtin_amdgcn_s_barrier(); asm volatile("" ::: "memory");
        const int tid = wid * 64 + lane;
        if (tid < 256) { const f32x4 p = *(const PG8_LAS f32x4*)(Pp + tid * 4);
            __hip_atomic_store(xb + (size_t)(u.pm * BM + tid) * 8 + u.pn, (p[0] + p[1]) + (p[2] + p[3]), __ATOMIC_RELAXED, __HIP_MEMORY_SCOPE_AGENT); }
        asm volatile("s_waitcnt vmcnt(0)" ::: "memory"); __builtin_amdgcn_s_barrier(); asm volatile("" ::: "memory");
        if (tid == 0) __hip_atomic_fetch_add(cnt + 64 * u.pm, 1u, __ATOMIC_RELAXED, __HIP_MEMORY_SCOPE_AGENT);
        if (wid == 0) { unsigned spins = 0;
            while ((unsigned)__builtin_amdgcn_readfirstlane(__hip_atomic_load(cnt + 64 * u.pm, __ATOMIC_RELAXED, __HIP_MEMORY_SCOPE_AGENT)) < (unsigned)ntn) { __builtin_amdgcn_s_sleep(2); if (++spins > (1u << 22)) break; }
            __builtin_amdgcn_fence(__ATOMIC_ACQUIRE, "agent"); }
        asm volatile("s_waitcnt vmcnt(0) lgkmcnt(0)" ::: "memory"); __builtin_amdgcn_s_barrier(); asm volatile("" ::: "memory");
        if (tid < 256) { const float* slot = xb + (size_t)(u.pm * BM + tid) * 8; float tot = 0.f;
#pragma unroll
            for (int t = 0; t < 8; ++t) tot += __hip_atomic_load(slot + t, __ATOMIC_RELAXED, __HIP_MEMORY_SCOPE_AGENT);
            Sr[tid] = rsqrtf(tot * (1.0f / 2048.0f) + eps); }
        asm volatile("s_waitcnt lgkmcnt(0)" ::: "memory"); __builtin_amdgcn_s_barrier(); asm volatile("" ::: "memory");
#pragma unroll
        for (int bj = 0; bj < 2; ++bj)
#pragma unroll
            for (int n = 0; n < 2; ++n) { const f32x4 g = *(const f32x4*)(gain + col0 + bj * HALF + n * 16);
#pragma unroll
                for (int ai = 0; ai < 2; ++ai)
#pragma unroll
                    for (int m = 0; m < 4; ++m) { const int rl = ai * HALF + wr * 64 + m * 16 + fr; const float rs = Sr[rl];
                        __builtin_nontemporal_store(acc[ai][bj][m][n] * rs * g, (f32x4*)(out + (size_t)(u.pm * BM + rl) * ldc + col0 + bj * HALF + n * 16)); } }
    }
};

template <class Epi, class Sched, bool ALIGN_EPI = false, bool SP2 = false>
__device__ __forceinline__ void gemm_phase(PG8_LAS unsigned char* lds, const Gemm g, const Sched& S, const Epi& E, const int wave_) {
    const int wid = wave_, lane = fresh_lane(), tid = wid * 64 + lane, wr = wid >> 2, wc = wid & 3, fr = lane & 15, fq = lane >> 4;
    const int K = g.K, nt = K / BK;
    unsigned voffA[2], voffB[2];
#pragma unroll
    for (int i = 0; i < 2; ++i) { int R, C; stage_rc(tid * 16 + i * 8192, R, C); const int Rb = Epi::PERM ? ((R & ~31) + perm32(R & 31)) : R;
        voffA[i] = (unsigned)(R * K + C) * 2u; voffB[i] = (unsigned)(Rb * K + C) * 2u; }
    const unsigned kstep = (unsigned)(BK * 2);
    const unsigned hstep = (unsigned)HALF * (unsigned)K * 2u;
    const unsigned tstep = 2u * hstep;
    const __amdgpu_buffer_rsrc_t rs_voffA = __builtin_amdgcn_make_buffer_rsrc((void*)g.A, 0, (int)((unsigned)g.M * (unsigned)K * 2u), 0x00020000);
    const __amdgpu_buffer_rsrc_t rs_voffB = __builtin_amdgcn_make_buffer_rsrc((void*)g.Bt, 0, (int)((unsigned)g.N * (unsigned)K * 2u), 0x00020000);
    const unsigned ldsw = (unsigned)wid * 1024u;
    const int aoff = lds_byte(wr * 64 + fr, fq * 8), boff = lds_byte(wc * 32 + fr, fq * 8);
#define PG8_SA(b, h) (((b) * 2 + (h)) * HTB)
#define PG8_SB(b, h) ((4 + (b) * 2 + (h)) * HTB)
#define PG8_STAGE(bufoff, goff, voff) do { _Pragma("unroll") for (int _i = 0; _i < 2; ++_i) \
        __builtin_amdgcn_raw_ptr_buffer_load_lds(rs_##voff, (PG8_LAS void*)(lds + (bufoff) + ldsw + _i * 8192), 16, (int)(voff)[_i], (int)(goff), 0, 0); } while (0)
#define PG8_LDA(dst, b, h) do { _Pragma("unroll") for (int m = 0; m < 4; ++m) _Pragma("unroll") for (int k = 0; k < 2; ++k) dst[m][k] = *(const PG8_LAS bf16x8*)(lds + PG8_SA(b, h) + aoff + m * 2048 + k * 1024); } while (0)
#define PG8_LDB(dst, b, h) do { _Pragma("unroll") for (int n = 0; n < 2; ++n) _Pragma("unroll") for (int k = 0; k < 2; ++k) dst[n][k] = *(const PG8_LAS bf16x8*)(lds + PG8_SB(b, h) + boff + n * 2048 + k * 1024); } while (0)
#define PG8_CAT(x, y) __builtin_shufflevector(__builtin_bit_cast(v4i_t, x), __builtin_bit_cast(v4i_t, y), 0, 1, 2, 3, 4, 5, 6, 7)
#define PG8_MMA8(ai, bj, At, Bt) do { __builtin_amdgcn_s_setprio(1); _Pragma("unroll") for (int m = 0; m < 4; ++m) _Pragma("unroll") for (int n = 0; n < 2; ++n) \
        acc[ai][bj][m][n] = __builtin_amdgcn_mfma_scale_f32_16x16x128_f8f6f4(PG8_CAT(Bt[n][0], Bt[n][1]), PG8_CAT(At[m][0], At[m][1]), acc[ai][bj][m][n], 0, 0, 0, 0x7f7f7f7f, 0, 0x7f7f7f7f); \
        __builtin_amdgcn_s_setprio(0); } while (0)
#define PG8_MMA16(ai, bj, At, Bt) do { __builtin_amdgcn_s_setprio(1); _Pragma("unroll") for (int m = 0; m < 4; ++m) _Pragma("unroll") for (int n = 0; n < 2; ++n) { \
        _Pragma("unroll") for (int k = 0; k < 2; ++k) acc[ai][bj][m][n] = __builtin_amdgcn_mfma_f32_16x16x32_bf16(Bt[n][k], At[m][k], acc[ai][bj][m][n], 0, 0, 0); } \
        __builtin_amdgcn_s_setprio(0); } while (0)
#define PG8_MMA(ai, bj, At, Bt) do { if constexpr (Epi::FP8) PG8_MMA8(ai, bj, At, Bt); else PG8_MMA16(ai, bj, At, Bt); } while (0)
#define PG8_WAIT_V(n) asm volatile("s_waitcnt vmcnt(" #n ")" ::: "memory")
#define PG8_WAIT_L(n) asm volatile("s_waitcnt lgkmcnt(" #n ")" ::: "memory")
#define PG8_BAR __builtin_amdgcn_s_barrier()
#define PG8_SCHED __builtin_amdgcn_sched_barrier(0)
    Unit cur, nxt; int ui = 0;
    if (!S.next(0, cur)) return;
    f32x4 acc[2][2][4][2];
    if constexpr (Epi::INIT_ACC) E.init(acc, cur, wr, wc, fr, fq);
    else {
#pragma unroll
    for (int a = 0; a < 2; ++a)
#pragma unroll
        for (int b = 0; b < 2; ++b)
#pragma unroll
            for (int m = 0; m < 4; ++m)
#pragma unroll
                for (int n = 0; n < 2; ++n) acc[a][b][m][n] = (f32x4){0.f, 0.f, 0.f, 0.f};
    }
    bf16x8 At[4][2], B0[2][2], B1[2][2];
    unsigned cA = (unsigned)cur.pm * tstep, cB = (unsigned)cur.pn * tstep;
    S.a_ready(cur);
    if constexpr (SP2) {
        PG8_STAGE(PG8_SB(0, 0), cB, voffB); PG8_STAGE(PG8_SB(0, 1), cB + hstep, voffB); PG8_STAGE(PG8_SA(0, 0), cA, voffA); PG8_STAGE(PG8_SA(0, 1), cA + hstep, voffA);
        if (wr == 1) PG8_BAR;
        PG8_WAIT_V(2); PG8_BAR;
        PG8_STAGE(PG8_SB(1, 0), cB + kstep, voffB); PG8_STAGE(PG8_SA(1, 0), cA + kstep, voffA); PG8_STAGE(PG8_SB(1, 1), cB + hstep + kstep, voffB);
        PG8_WAIT_V(6); PG8_BAR;
    } else {
        PG8_STAGE(PG8_SB(0, 0), cB, voffB); PG8_STAGE(PG8_SA(0, 0), cA, voffA); PG8_STAGE(PG8_SB(0, 1), cB + hstep, voffB); PG8_STAGE(PG8_SA(0, 1), cA + hstep, voffA);
        if (wr == 1) PG8_BAR;
        PG8_WAIT_V(4); PG8_BAR;
        PG8_STAGE(PG8_SB(1, 0), cB + kstep, voffB); PG8_STAGE(PG8_SA(1, 0), cA + kstep, voffA); PG8_STAGE(PG8_SB(1, 1), cB + hstep + kstep, voffB);
        PG8_WAIT_V(6); PG8_BAR;
    }
    for (;;) {
        const bool has_next = S.next(ui + 1, nxt);
        const unsigned nA = has_next ? (unsigned)nxt.pm * tstep : cA, nB = has_next ? (unsigned)nxt.pn * tstep : cB;
        static_assert(SP2, "only the two-super-phase K-loop is kept");
#define PG8_SP2_ITER(MMA) do { \
            PG8_LDB(B0, 0, 0); PG8_LDB(B1, 0, 1); PG8_SCHED; PG8_LDA(At, 0, 0); PG8_STAGE(PG8_SA(1, 1), a1 + hstep, voffA); \
            PG8_WAIT_V(8); PG8_WAIT_L(0); PG8_BAR; MMA(0, 0, At, B0); MMA(0, 1, At, B1); PG8_BAR; PG8_SCHED; \
            PG8_LDA(At, 0, 1); PG8_STAGE(PG8_SB(0, 0), b2, voffB); PG8_STAGE(PG8_SB(0, 1), b2 + hstep, voffB); PG8_STAGE(PG8_SA(0, 0), a2, voffA); \
            PG8_WAIT_V(8); PG8_WAIT_L(0); PG8_BAR; MMA(1, 0, At, B0); MMA(1, 1, At, B1); PG8_BAR; PG8_SCHED; \
            PG8_LDB(B0, 1, 0); PG8_LDB(B1, 1, 1); PG8_SCHED; PG8_LDA(At, 1, 0); PG8_STAGE(PG8_SA(0, 1), a2 + hstep, voffA); \
            PG8_WAIT_V(8); PG8_WAIT_L(0); PG8_BAR; MMA(0, 0, At, B0); MMA(0, 1, At, B1); PG8_BAR; PG8_SCHED; \
            PG8_LDA(At, 1, 1); PG8_STAGE(PG8_SB(1, 0), b3, voffB); PG8_STAGE(PG8_SB(1, 1), b3 + hstep, voffB); PG8_STAGE(PG8_SA(1, 0), a3, voffA); \
            PG8_WAIT_V(8); PG8_WAIT_L(0); PG8_BAR; MMA(1, 0, At, B0); MMA(1, 1, At, B1); PG8_BAR; PG8_SCHED; } while (0)
#define PG8_KLOOP(T0, T1, MMA, HOOKED) _Pragma("nounroll") for (int t = (T0); t < (T1); t += 2) { \
            if constexpr (HOOKED) { if (t == Epi::HOOK_T) E.mid(acc, cur, wr, wc, fr, fq); } \
            const bool last = (t == nt - 2); \
            const unsigned a1 = cA + (unsigned)(t + 1) * kstep;                                        \
            const unsigned a2 = last ? nA : cA + (unsigned)(t + 2) * kstep, b2 = last ? nB : cB + (unsigned)(t + 2) * kstep;     \
            const unsigned a3 = a2 + kstep, b3 = b2 + kstep;                                         \
            if (last && has_next) S.a_ready(nxt); \
            PG8_SP2_ITER(MMA); }
        if constexpr (Epi::TSW > 0) {
            int tsw_ = Epi::TSW; asm volatile("" : "+s"(tsw_));
            PG8_KLOOP(0, tsw_, PG8_MMA8, false)
            PG8_KLOOP(tsw_, nt, PG8_MMA16, true)
        } else {
            PG8_KLOOP(0, nt, PG8_MMA, (Epi::HOOK_T >= 0))
        }
#undef PG8_KLOOP
#undef PG8_SP2_ITER
        if constexpr (ALIGN_EPI) { if (wr == 0) PG8_BAR; }
        if constexpr (!Epi::AFTER_DRAIN) { E(acc, cur, wr, wc, fr, fq); S.done(cur); }
        if (!has_next) break;
#pragma unroll
        for (int a = 0; a < 2; ++a)
#pragma unroll
            for (int b = 0; b < 2; ++b)
#pragma unroll
                for (int m = 0; m < 4; ++m)
#pragma unroll
                    for (int n = 0; n < 2; ++n) acc[a][b][m][n] = (f32x4){0.f, 0.f, 0.f, 0.f};
        cur = nxt; cA = nA; cB = nB; ++ui;
        if constexpr (ALIGN_EPI) { if (wr == 1) PG8_BAR; }
    }
    PG8_WAIT_V(0);
    if constexpr (!ALIGN_EPI) { if (wr == 0) PG8_BAR; }
    PG8_BAR;
    if constexpr (Epi::AFTER_DRAIN) { E.fused(acc, cur, wr, wc, fr, fq, lds, wid, lane); S.done(cur); }
#undef PG8_SA
#undef PG8_SB
#undef PG8_STAGE
#undef PG8_LDA
#undef PG8_LDB
#undef PG8_MMA
#undef PG8_MMA8
#undef PG8_MMA16
#undef PG8_CAT
#undef PG8_WAIT_V
#undef PG8_WAIT_L
#undef PG8_BAR
#undef PG8_SCHED
}
}

namespace att {
using bf16 = unsigned short;
constexpr int   D = 128, NW = 8, QBLK = 32, KVBLK = 64;
constexpr float SCALE = 0.088388347648318440f;
constexpr float THR = 8.f;
constexpr int SDEPTH = 2;
constexpr int LDQ = 7680, LDK = 7680;
constexpr int LDY = 1536;
constexpr size_t SHM_V = KVBLK * D * 2, SHM_K = KVBLK * D * 2, SHM_ATTN = 2 * SHM_V + 2 * SHM_K + NW * 64 * 4;
__device__ __forceinline__ float bf2f_(bf16 h) { return __uint_as_float(((unsigned)h) << 16); }
__device__ __forceinline__ bf16 f2bf_(float f) { unsigned u = __float_as_uint(f); return (bf16)((u + 0x7fffu + ((u >> 16) & 1u)) >> 16); }
using bf16x8 = __attribute__((ext_vector_type(8))) short;
using s16x4  = __attribute__((ext_vector_type(4))) short;
using f32x16 = __attribute__((ext_vector_type(16))) float;
using f32x8  = __attribute__((ext_vector_type(8))) float;
using u32x4  = __attribute__((ext_vector_type(4))) unsigned;
using f32x4_ = __attribute__((ext_vector_type(4))) float;
#define KSWZ(row, colB) ((row) * 256 + ((colB) ^ (((row) & 7) << 4)))
#define SBAR() __builtin_amdgcn_sched_barrier(0)
__device__ __forceinline__ int crow(int r, int hi) { return (r & 3) + 8 * (r >> 2) + 4 * hi; }
__device__ __forceinline__ unsigned cvtpk(float lo, float hi) {
  typedef float f32x2_c __attribute__((ext_vector_type(2))); typedef __bf16 bf16x2_c __attribute__((ext_vector_type(2)));
  const f32x2_c v = {lo, hi}; return __builtin_bit_cast(unsigned, __builtin_convertvector(v, bf16x2_c));
}
template <typename TIn> struct Stage;
template <> struct Stage<bf16>  { using T = bf16x8;
  __device__ static __forceinline__ T ld8(const bf16* p) { return *reinterpret_cast<const bf16x8*>(p); }
  __device__ static __forceinline__ bf16x8 tobf(T x) { return x; } };
template <> struct Stage<float> { using T = f32x8;
  __device__ static __forceinline__ T ld8(const float* p) { return *reinterpret_cast<const f32x8*>(p); }
  __device__ static __forceinline__ bf16x8 tobf(T x) {
    u32x4 w = {cvtpk(x[0], x[1]), cvtpk(x[2], x[3]), cvtpk(x[4], x[5]), cvtpk(x[6], x[7])}; return *reinterpret_cast<bf16x8*>(&w); } };

template <bool PRE = false> __device__ __forceinline__ void partialSM(f32x16& p0, f32x16& p1, float& m_reg, float& mn, float& alpha) {
  constexpr float C = PRE ? 1.f : SCALE * 1.4426950408889634f;
  float pmax = p0[0]; for (int r = 1; r < 16; ++r) pmax = fmaxf(pmax, p0[r]); for (int r = 0; r < 16; ++r) pmax = fmaxf(pmax, p1[r]);
  { auto rr = __builtin_amdgcn_permlane32_swap(__float_as_uint(pmax), __float_as_uint(pmax), false, false);
    pmax = fmaxf(__uint_as_float(rr[0]), __uint_as_float(rr[1])); }
  if (__builtin_expect(__all(pmax - m_reg <= (PRE ? THR * 1.4426950408889634f : THR / SCALE)), 1)) { mn = m_reg; alpha = 1.f; }
  else { mn = fmaxf(m_reg, pmax); alpha = __builtin_amdgcn_exp2f((m_reg - mn) * C); m_reg = mn; }
  float mnC = -mn * C;
  for (int r = 0; r < 16; ++r) p0[r] = fmaf(p0[r], C, mnC); for (int r = 0; r < 16; ++r) p1[r] = fmaf(p1[r], C, mnC);
  for (int r = 0; r < 16; ++r) p0[r] = __builtin_amdgcn_exp2f(p0[r]);
}
__device__ __forceinline__ void finishSM(f32x16& p0, f32x16& p1, float alpha, float& l_reg, bf16x8& pa0, bf16x8& pa1, bf16x8& pa2, bf16x8& pa3) {
  for (int r = 0; r < 16; ++r) p1[r] = __builtin_amdgcn_exp2f(p1[r]);
  float ps = 0; for (int r = 0; r < 16; ++r) ps += p0[r]; for (int r = 0; r < 16; ++r) ps += p1[r];
  { auto rr = __builtin_amdgcn_permlane32_swap(__float_as_uint(ps), __float_as_uint(ps), false, false);
    ps = __uint_as_float(rr[0]) + __uint_as_float(rr[1]); }
  l_reg = l_reg * alpha + ps;
#define PK4(P, BASE, OUT) do { unsigned a0 = cvtpk(P[BASE + 0], P[BASE + 1]), a1 = cvtpk(P[BASE + 2], P[BASE + 3]);   \
    unsigned b0 = cvtpk(P[BASE + 4], P[BASE + 5]), b1 = cvtpk(P[BASE + 6], P[BASE + 7]);                              \
    auto r0 = __builtin_amdgcn_permlane32_swap(a0, b0, false, false); auto r1 = __builtin_amdgcn_permlane32_swap(a1, b1, false, false); \
    u32x4 w = {r0[0], r1[0], r0[1], r1[1]}; OUT = *reinterpret_cast<bf16x8*>(&w); } while (0)
  PK4(p0, 0, pa0); PK4(p0, 8, pa1); PK4(p1, 0, pa2); PK4(p1, 8, pa3);
#undef PK4
}
__device__ __forceinline__ void half_f(f32x16& p, float& l_reg, bf16x8& o0, bf16x8& o1) {
  for (int r = 0; r < 16; ++r) p[r] = __builtin_amdgcn_exp2f(p[r]);
  float ps = 0; for (int r = 0; r < 16; ++r) ps += p[r];
  l_reg += ps;
#define PK4(P, BASE, OUT) do { unsigned a0 = cvtpk(P[BASE + 0], P[BASE + 1]), a1 = cvtpk(P[BASE + 2], P[BASE + 3]);   \
    unsigned b0 = cvtpk(P[BASE + 4], P[BASE + 5]), b1 = cvtpk(P[BASE + 6], P[BASE + 7]);                              \
    auto r0 = __builtin_amdgcn_permlane32_swap(a0, b0, false, false); auto r1 = __builtin_amdgcn_permlane32_swap(a1, b1, false, false); \
    u32x4 w = {r0[0], r1[0], r0[1], r1[1]}; OUT = *reinterpret_cast<bf16x8*>(&w); } while (0)
  PK4(p, 0, o0); PK4(p, 8, o1);
#undef PK4
}
__device__ __forceinline__ void qkt(f32x16& p0, f32x16& p1, const bf16* Ks, const bf16x8* qr, int r32, int hi) {
  p0 = f32x16{}; p1 = f32x16{};
  for (int d0 = 0; d0 < 8; ++d0) { int cb = (d0 * 16 + hi * 8) * 2;
    bf16x8 b0 = *reinterpret_cast<const bf16x8*>((const char*)Ks + KSWZ(r32, cb));
    bf16x8 b1 = *reinterpret_cast<const bf16x8*>((const char*)Ks + KSWZ(32 + r32, cb));
    p0 = __builtin_amdgcn_mfma_f32_32x32x16_bf16(b0, qr[d0], p0, 0, 0, 0);
    p1 = __builtin_amdgcn_mfma_f32_32x32x16_bf16(b1, qr[d0], p1, 0, 0, 0); }
}
__device__ __forceinline__ int v_st(int k, int c) { const int kk = (k & ~0xC) | ((k & 4) << 1) | ((k & 8) >> 1); return ((kk >> 3) * 4 + (c >> 5)) * 512 + ((kk & 7) * 32 + (c & 31)) * 2; }
__device__ __forceinline__ int v_rd_base(int lane) { return ((lane & 3) << 3) | (((lane >> 2) & 3) << 6) | (((lane >> 4) & 1) << 5) | (((lane >> 5) & 1) << 8); }
constexpr int v_rd_off(int d0, int ks, int half) { return d0 * 512 + ks * 4096 + half * 2048; }
template <int OFF> __device__ __forceinline__ s16x4 tr_read(int vb) {
  s16x4 r; asm volatile("ds_read_b64_tr_b16 %0, %1 offset:%2" : "=&v"(r) : "v"(vb), "i"(OFF) : "memory"); return r;
}
template <int D0> __device__ __forceinline__ void pv_one(f32x16& od, int vb, bf16x8 pa0, bf16x8 pa1, bf16x8 pa2, bf16x8 pa3) {
  const s16x4 l0 = tr_read<v_rd_off(D0, 0, 0)>(vb), h0 = tr_read<v_rd_off(D0, 0, 1)>(vb), l1 = tr_read<v_rd_off(D0, 1, 0)>(vb), h1 = tr_read<v_rd_off(D0, 1, 1)>(vb);
  const s16x4 l2 = tr_read<v_rd_off(D0, 2, 0)>(vb), h2 = tr_read<v_rd_off(D0, 2, 1)>(vb), l3 = tr_read<v_rd_off(D0, 3, 0)>(vb), h3 = tr_read<v_rd_off(D0, 3, 1)>(vb);
  asm volatile("s_waitcnt lgkmcnt(0)" ::: "memory"); SBAR();
#define PK(L, H) (bf16x8){L[0], L[1], L[2], L[3], H[0], H[1], H[2], H[3]}
  od = __builtin_amdgcn_mfma_f32_32x32x16_bf16(pa0, PK(l0, h0), od, 0, 0, 0);
  od = __builtin_amdgcn_mfma_f32_32x32x16_bf16(pa1, PK(l1, h1), od, 0, 0, 0);
  od = __builtin_amdgcn_mfma_f32_32x32x16_bf16(pa2, PK(l2, h2), od, 0, 0, 0);
  od = __builtin_amdgcn_mfma_f32_32x32x16_bf16(pa3, PK(l3, h3), od, 0, 0, 0);
#undef PK
}
__device__ __forceinline__ void pv_d0(f32x16* o, int vb, bf16x8 pa0, bf16x8 pa1, bf16x8 pa2, bf16x8 pa3) {
  pv_one<0>(o[0], vb, pa0, pa1, pa2, pa3); pv_one<1>(o[1], vb, pa0, pa1, pa2, pa3); pv_one<2>(o[2], vb, pa0, pa1, pa2, pa3); pv_one<3>(o[3], vb, pa0, pa1, pa2, pa3);
}

typedef int v8i_a __attribute__((ext_vector_type(8)));
#define KSWZ8(row, byte) ((row) * 128 + (((((byte) >> 4) ^ (((row) >> 1) & 7))) << 4) + ((byte) & 15))
__device__ __forceinline__ int f8x4(unsigned a, unsigned b, float sc) { int w = 0;
  w = __builtin_amdgcn_cvt_pk_fp8_f32(__uint_as_float(a << 16) * sc, __uint_as_float(a & 0xffff0000u) * sc, w, false);
  w = __builtin_amdgcn_cvt_pk_fp8_f32(__uint_as_float(b << 16) * sc, __uint_as_float(b & 0xffff0000u) * sc, w, true); return w; }
__device__ __forceinline__ void qkt8(f32x16& p0, f32x16& p1, const char* Ks, const v8i_a* qf, int r32, int hi) {
  p0 = f32x16{}; p1 = f32x16{};
  const int sw = (r32 >> 1) & 7;
#pragma unroll
  for (int kb = 0; kb < 2; ++kb) { const int c0 = 4 * kb + 2 * hi;
    const char* r0 = Ks + r32 * 128; const char* r1 = r0 + 32 * 128;
    const u32x4 x0 = *reinterpret_cast<const u32x4*>(r0 + ((c0 ^ sw) << 4)), x1 = *reinterpret_cast<const u32x4*>(r0 + (((c0 + 1) ^ sw) << 4));
    const u32x4 y0 = *reinterpret_cast<const u32x4*>(r1 + ((c0 ^ sw) << 4)), y1 = *reinterpret_cast<const u32x4*>(r1 + (((c0 + 1) ^ sw) << 4));
    const v8i_a a0 = {(int)x0[0], (int)x0[1], (int)x0[2], (int)x0[3], (int)x1[0], (int)x1[1], (int)x1[2], (int)x1[3]};
    const v8i_a a1 = {(int)y0[0], (int)y0[1], (int)y0[2], (int)y0[3], (int)y1[0], (int)y1[1], (int)y1[2], (int)y1[3]};
    p0 = __builtin_amdgcn_mfma_scale_f32_32x32x64_f8f6f4(a0, qf[kb], p0, 0, 0, 0, 0x7d7d7d7d, 0, 0x7c7c7c7c);
    p1 = __builtin_amdgcn_mfma_scale_f32_32x32x64_f8f6f4(a1, qf[kb], p1, 0, 0, 0, 0x7d7d7d7d, 0, 0x7c7c7c7c); }
}
__device__ __forceinline__ void pv_half_f(f32x16* o, int vb, bf16x8 pa0, bf16x8 pa1, bf16x8 pa2, bf16x8 pa3, f32x16& p, float& l_reg, bf16x8& o0, bf16x8& o1) {
  pv_one<0>(o[0], vb, pa0, pa1, pa2, pa3);
#pragma unroll
  for (int r = 0; r < 4; ++r) p[r] = __builtin_amdgcn_exp2f(p[r]);
  pv_one<1>(o[1], vb, pa0, pa1, pa2, pa3);
#pragma unroll
  for (int r = 4; r < 8; ++r) p[r] = __builtin_amdgcn_exp2f(p[r]);
  pv_one<2>(o[2], vb, pa0, pa1, pa2, pa3);
#pragma unroll
  for (int r = 8; r < 12; ++r) p[r] = __builtin_amdgcn_exp2f(p[r]);
  pv_one<3>(o[3], vb, pa0, pa1, pa2, pa3);
#pragma unroll
  for (int r = 12; r < 16; ++r) p[r] = __builtin_amdgcn_exp2f(p[r]);
  float ps = 0;
#pragma unroll
  for (int r = 0; r < 16; ++r) ps += p[r];
  l_reg += ps;
#define PK4(P, BASE, OUT) do { unsigned a0 = cvtpk(P[BASE + 0], P[BASE + 1]), a1 = cvtpk(P[BASE + 2], P[BASE + 3]);   \
    unsigned b0 = cvtpk(P[BASE + 4], P[BASE + 5]), b1 = cvtpk(P[BASE + 6], P[BASE + 7]);                              \
    auto r0 = __builtin_amdgcn_permlane32_swap(a0, b0, false, false); auto r1 = __builtin_amdgcn_permlane32_swap(a1, b1, false, false); \
    u32x4 w = {r0[0], r1[0], r0[1], r1[1]}; OUT = *reinterpret_cast<bf16x8*>(&w); } while (0)
  PK4(p, 0, o0); PK4(p, 8, o1);
#undef PK4
}
template <bool FAST> __device__ __forceinline__ void attn_dense_body(const bf16* __restrict__ Qb, const bf16* __restrict__ Kh, const bf16* __restrict__ Vh,
                                                const bf16* __restrict__ Gb, bf16* __restrict__ Yb, const unsigned char* __restrict__ K8h, int seq, char* lds, const int wave_) {
  using TQ = bf16; using St = Stage<bf16>; using SQ = Stage<TQ>;
  constexpr int SDEPTH = FAST ? 2 : 1;
  const int wid = wave_, lane = fresh_lane(), tid = wid * 64 + lane, r32 = lane & 31, hi = lane >> 5;
  bf16* V_lds = (bf16*)lds; bf16* K_lds = (bf16*)(lds + 2 * SHM_V);
  float* ws = (float*)(lds + 2 * SHM_V + 2 * SHM_K) + wid * 64; float* li_l = ws; float* al_l = ws + 32;
  float m_reg = -1e30f, l_reg = 0; f32x16 o[4] = {}; bf16x8 qr[8];
  v8i_a qf[2];
  if constexpr (FAST) {
    const TQ* Qf = Qb + (long)(wid * QBLK + r32) * LDQ + hi * 32;
#pragma unroll
    for (int kb = 0; kb < 2; ++kb) { const u32x4 x0 = *(const u32x4*)(Qf + 64 * kb), x1 = *(const u32x4*)(Qf + 64 * kb + 8), x2 = *(const u32x4*)(Qf + 64 * kb + 16), x3 = *(const u32x4*)(Qf + 64 * kb + 24);
      qf[kb] = v8i_a{f8x4(x0[0], x0[1], 8.f), f8x4(x0[2], x0[3], 8.f), f8x4(x1[0], x1[1], 8.f), f8x4(x1[2], x1[3], 8.f), f8x4(x2[0], x2[1], 8.f), f8x4(x2[2], x2[3], 8.f), f8x4(x3[0], x3[1], 8.f), f8x4(x3[2], x3[3], 8.f)}; }
  } else {
  const TQ* Qw = Qb + (long)(wid * QBLK + r32) * LDQ + hi * 8;
#pragma unroll
  for (int d0 = 0; d0 < 8; ++d0) qr[d0] = SQ::tobf(SQ::ld8(Qw + d0 * 16));
  }
#define QKT(P0, P1, KP) do { if constexpr (FAST) qkt8(P0, P1, (const char*)(KP), qf, r32, hi); else qkt(P0, P1, (KP), qr, r32, hi); } while (0)
  const int sr = tid >> 4, sc = (tid & 15) * 8, vst0 = v_st(sr, sc), vst1 = v_st(32 + sr, sc);
  const unsigned toff = (unsigned)(sr * LDK + sc);
  const int vb0 = (int)(uintptr_t)V_lds + v_rd_base(lane);
  struct { typename St::T vs0, vs1, ks0, ks1; u32x4 k8; } sr_[SDEPTH];
#define SLOAD(i, k0) do { const bf16* vb_ = Vh + (long)(k0) * LDK; const bf16* kb_ = Kh + (long)(k0) * LDK; \
    sr_[i].vs0 = St::ld8(vb_ + toff); sr_[i].vs1 = St::ld8(vb_ + 32 * LDK + toff); \
    if constexpr (FAST) sr_[i].k8 = *(const u32x4*)(K8h + (long)((k0) + (tid >> 3)) * 256 + (tid & 7) * 16); else { \
    sr_[i].ks0 = St::ld8(kb_ + toff); sr_[i].ks1 = St::ld8(kb_ + 32 * LDK + toff); } } while (0)
#define SWRITE(b, i) do { *(bf16x8*)((char*)V_lds + (b) * SHM_V + vst0) = St::tobf(sr_[i].vs0);          \
    *(bf16x8*)((char*)V_lds + (b) * SHM_V + vst1) = St::tobf(sr_[i].vs1); int kc = sc * 2;               \
    if constexpr (FAST) { *(u32x4*)((char*)K_lds + (b) * SHM_K + KSWZ8(tid >> 3, (tid & 7) * 16)) = sr_[i].k8; } else {                                          \
    *(bf16x8*)((char*)K_lds + (b) * SHM_K + KSWZ(sr, kc)) = St::tobf(sr_[i].ks0);                       \
    *(bf16x8*)((char*)K_lds + (b) * SHM_K + KSWZ(32 + sr, kc)) = St::tobf(sr_[i].ks1); } } while (0)
#define SWAIT() do { if constexpr (SDEPTH == 2) { if constexpr (FAST) asm volatile("s_waitcnt vmcnt(3)" ::: "memory"); else asm volatile("s_waitcnt vmcnt(4)" ::: "memory"); } else asm volatile("s_waitcnt vmcnt(0)" ::: "memory"); } while (0)
#define RESC(a) do { if (__any((a) < 1.f)) { if (hi == 0) al_l[r32] = (a); asm volatile("s_waitcnt lgkmcnt(0)" ::: "memory"); \
    for (int d = 0; d < 4; ++d) for (int r = 0; r < 16; ++r) o[d][r] *= al_l[crow(r, hi)]; } } while (0)
  f32x16 pA0, pA1, pB0, pB1; float mnA, mnB, alA, alB; bf16x8 pa0, pa1, pa2, pa3, na0, na1; const int NT = seq / KVBLK;
  constexpr int SE = 0, SO = SDEPTH - 1;
  SLOAD(SE, 0); asm volatile("s_waitcnt vmcnt(0)" ::: "memory"); SWRITE(0, SE); __syncthreads();
  QKT(pA0, pA1, K_lds); if constexpr (FAST) half_f(pA0, l_reg, na0, na1); else partialSM<true>(pA0, pA1, m_reg, mnA, alA);
  SLOAD(SO, KVBLK); if constexpr (SDEPTH == 2) { if (2 < NT) SLOAD(SE, 2 * KVBLK); }
  SWAIT(); SWRITE(1, SO); __syncthreads();
  for (int j = 1; j + 1 < NT; j += 2) {
    SBAR(); QKT(pB0, pB1, (bf16*)((char*)K_lds + SHM_K));
    if constexpr (FAST) { pa0 = na0; pa1 = na1; half_f(pA1, l_reg, pa2, pa3); } else finishSM(pA0, pA1, alA, l_reg, pa0, pa1, pa2, pa3); SBAR();
    SLOAD(SO, (j + SDEPTH) * KVBLK); SBAR();
    if constexpr (FAST) pv_half_f(o, vb0, pa0, pa1, pa2, pa3, pB0, l_reg, na0, na1); else { pv_d0(o, vb0, pa0, pa1, pa2, pa3); partialSM<true>(pB0, pB1, m_reg, mnB, alB); }
    __syncthreads(); SWAIT(); SWRITE(0, SE);
    if constexpr (!FAST) RESC(alB); __syncthreads();
    SBAR(); QKT(pA0, pA1, K_lds);
    if constexpr (FAST) { pa0 = na0; pa1 = na1; half_f(pB1, l_reg, pa2, pa3); } else finishSM(pB0, pB1, alB, l_reg, pa0, pa1, pa2, pa3); SBAR();
    if (SDEPTH == 1 || j + 3 < NT) SLOAD(SE, (j + 1 + SDEPTH) * KVBLK); SBAR();
    if constexpr (FAST) pv_half_f(o, vb0 + (int)SHM_V, pa0, pa1, pa2, pa3, pA0, l_reg, na0, na1); else { pv_d0(o, vb0 + (int)SHM_V, pa0, pa1, pa2, pa3); partialSM<true>(pA0, pA1, m_reg, mnA, alA); }
    __syncthreads(); SWAIT(); SWRITE(1, SO);
    if constexpr (!FAST) RESC(alA); __syncthreads();
  }
  SBAR(); QKT(pB0, pB1, (bf16*)((char*)K_lds + SHM_K));
  if constexpr (FAST) { pa0 = na0; pa1 = na1; half_f(pA1, l_reg, pa2, pa3); } else finishSM(pA0, pA1, alA, l_reg, pa0, pa1, pa2, pa3); SBAR();
  if constexpr (FAST) pv_half_f(o, vb0, pa0, pa1, pa2, pa3, pB0, l_reg, na0, na1); else { pv_d0(o, vb0, pa0, pa1, pa2, pa3); partialSM<true>(pB0, pB1, m_reg, mnB, alB); }
  __syncthreads(); if constexpr (!FAST) RESC(alB);
  if constexpr (FAST) { pa0 = na0; pa1 = na1; half_f(pB1, l_reg, pa2, pa3); } else finishSM(pB0, pB1, alB, l_reg, pa0, pa1, pa2, pa3); SBAR();
  pv_d0(o, vb0 + (int)SHM_V, pa0, pa1, pa2, pa3);
  if constexpr (FAST) { auto rr = __builtin_amdgcn_permlane32_swap(__float_as_uint(l_reg), __float_as_uint(l_reg), false, false); l_reg = __uint_as_float(rr[0]) + __uint_as_float(rr[1]); }
  if (hi == 0) li_l[r32] = l_reg; asm volatile("s_waitcnt lgkmcnt(0)" ::: "memory");
  float rli[16];
#pragma unroll
  for (int r = 0; r < 16; ++r) rli[r] = __builtin_amdgcn_rcpf(li_l[crow(r, hi)]);
  __syncthreads();
  { float* stg = (float*)(lds + wid * 16384);
#pragma unroll
    for (int r = 0; r < 16; ++r) { const int orow = crow(r, hi);
#pragma unroll
      for (int d0 = 0; d0 < 4; ++d0) stg[orow * 128 + d0 * 32 + r32] = o[d0][r] * rli[r]; }
    asm volatile("s_waitcnt lgkmcnt(0)" ::: "memory");
    const int ch = lane & 15, rb = lane >> 4;
    const bf16* Gw = Gb + (long)(wid * QBLK + rb) * LDQ + ch * 8; const int yoff = (wid * QBLK + rb) * YPITCH + ch * 8;
    bf16* Yq = Yb; asm volatile("" : "+s"(Yq));
    const __amdgpu_buffer_rsrc_t rsY = __builtin_amdgcn_make_buffer_rsrc((void*)Yq, 0, 0x40000000, 0x00020000);
    u32x4 gq[8];
#pragma unroll
    for (int i = 0; i < 8; ++i) gq[i] = *(const u32x4*)(Gw + (long)(4 * i) * LDQ);
#pragma unroll
    for (int i = 0; i < 8; ++i) { const float* sp = stg + (4 * i + rb) * 128 + ch * 8;
      const f32x4_ a = *(const f32x4_*)sp * YA8_SCALE, b = *(const f32x4_*)(sp + 4) * YA8_SCALE; int w0 = 0, w1 = 0;
      w0 = __builtin_amdgcn_cvt_pk_fp8_f32(a[0] * __uint_as_float(gq[i][0] << 16), a[1] * __uint_as_float(gq[i][0] & 0xffff0000u), w0, false);
      w0 = __builtin_amdgcn_cvt_pk_fp8_f32(a[2] * __uint_as_float(gq[i][1] << 16), a[3] * __uint_as_float(gq[i][1] & 0xffff0000u), w0, true);
      w1 = __builtin_amdgcn_cvt_pk_fp8_f32(b[0] * __uint_as_float(gq[i][2] << 16), b[1] * __uint_as_float(gq[i][2] & 0xffff0000u), w1, false);
      w1 = __builtin_amdgcn_cvt_pk_fp8_f32(b[2] * __uint_as_float(gq[i][3] << 16), b[3] * __uint_as_float(gq[i][3] & 0xffff0000u), w1, true);
      typedef unsigned u32x2_ __attribute__((ext_vector_type(2))); const u32x2_ w = {(unsigned)w0, (unsigned)w1};
      __builtin_amdgcn_raw_buffer_store_b64(w, rsY, yoff + (4 * i) * YPITCH, 0, 16); } }
  __syncthreads();
#undef SLOAD
#undef QKT
#undef SWRITE
#undef SWAIT
#undef RESC
}

__device__ __forceinline__ void attn_band_unit(const bf16* __restrict__ P, bf16* __restrict__ OG, float* __restrict__ LSE, int g, int b, int h, int blk, int cqb, int ckb, int cvb, int seqlen, int ntok, char* lds, const int wave_) {
  using St = Stage<bf16>;
  const int wid = wave_, lane = fresh_lane(), tid = wid * 64 + lane, r32 = lane & 31, hi = lane >> 5;
  bf16* V_lds = (bf16*)lds; bf16* K_lds = (bf16*)(lds + 2 * SHM_V);
  float* ws = (float*)(lds + 2 * SHM_V + 2 * SHM_K) + wid * 64; float* li_l = ws; float* al_l = ws + 32;
  const int dil = (g == 0) ? 1 : (g == 1 ? 4 : 16), head = g * 4 + h;
  int rq, lq0, ntile, t_lo, res0;
  if (g < 2) { const int kb = (g == 0) ? blk : (blk & 1), nt_all = seqlen / dil / 64; res0 = (g == 0) ? 0 : (blk >> 1);
    rq = res0; lq0 = 256 * kb + 32 * wid; t_lo = (4 * kb - 1 < 0) ? 0 : 4 * kb - 1; const int t_hi = (4 * kb + 5 > nt_all) ? nt_all : 4 * kb + 5; ntile = t_hi - t_lo; }
  else { res0 = 2 * blk; rq = res0 + (wid >> 2); lq0 = 32 * (wid & 3); t_lo = 0; ntile = 4; }
  const long tok0 = (long)b * seqlen;
  const bf16* Pq = P + cqb + head * D; const bf16* Pk = P + ckb + head * D; const bf16* Pv = P + cvb + head * D;
  float m_reg = -1e30f, l_reg = 0; f32x16 o[4] = {}; bf16x8 qr[8];
  { const bf16* Qw = Pq + (tok0 + (long)(lq0 + r32) * dil + rq) * LDQ + hi * 8;
#pragma unroll
    for (int d0 = 0; d0 < 8; ++d0) qr[d0] = St::ld8(Qw + d0 * 16); }
  const int sr = tid >> 4, sc = (tid & 15) * 8, vst0 = v_st(sr, sc), vst1 = v_st(32 + sr, sc);
  const int vb0 = (int)(uintptr_t)V_lds + v_rd_base(lane);
  typename St::T vs0, vs1, ks0, ks1, vt0, vt1, kt0, kt1;
#define TILE_RK(tt) ((g < 2) ? res0 : res0 + ((tt) >> 1))
#define TILE_LK0(tt) ((g < 2) ? 64 * (t_lo + (tt)) : 64 * ((tt) & 1))
#define BLOAD(tt, V0, V1, K0, K1) do { const int rk_ = TILE_RK(tt), lk_ = TILE_LK0(tt); const long ta = (tok0 + (long)(lk_ + sr) * dil + rk_) * LDK + sc, tb = (tok0 + (long)(lk_ + 32 + sr) * dil + rk_) * LDK + sc; \
    V0 = St::ld8(Pv + ta); V1 = St::ld8(Pv + tb); K0 = St::ld8(Pk + ta); K1 = St::ld8(Pk + tb); } while (0)
#define BWRITE(V0, V1, K0, K1) do { *(bf16x8*)((char*)V_lds + vst0) = V0; *(bf16x8*)((char*)V_lds + vst1) = V1; const int kc = sc * 2; \
    *(bf16x8*)((char*)K_lds + KSWZ(sr, kc)) = K0; *(bf16x8*)((char*)K_lds + KSWZ(32 + sr, kc)) = K1; } while (0)
#define BCOMPUTE(tt) do { const int rk = TILE_RK(tt), lk0 = TILE_LK0(tt); \
    const bool need = (rk == rq) && (lk0 + 63 >= lq0 - 64) && (lk0 <= lq0 + 95); \
    if (need) { \
      f32x16 p0, p1; float mn, alpha; bf16x8 pa0, pa1, pa2, pa3; \
      qkt(p0, p1, K_lds, qr, r32, hi); \
      const int dd = lk0 - lq0 - r32 + 4 * hi;                      \
      _Pragma("unroll") for (int r = 0; r < 16; ++r) { const int d0_ = dd + (r & 3) + 8 * (r >> 2), d1_ = d0_ + 32; \
        if (d0_ < -64 || d0_ > 64) p0[r] = -INFINITY; if (d1_ < -64 || d1_ > 64) p1[r] = -INFINITY; } \
      partialSM(p0, p1, m_reg, mn, alpha); \
      if (__any(alpha < 1.f)) { if (hi == 0) al_l[r32] = alpha; asm volatile("s_waitcnt lgkmcnt(0)" ::: "memory"); \
        _Pragma("unroll") for (int d = 0; d < 4; ++d) _Pragma("unroll") for (int r = 0; r < 16; ++r) o[d][r] *= al_l[crow(r, hi)]; } \
      finishSM(p0, p1, alpha, l_reg, pa0, pa1, pa2, pa3); SBAR(); \
      pv_d0(o, vb0, pa0, pa1, pa2, pa3); \
    } } while (0)
  BLOAD(0, vs0, vs1, ks0, ks1); if (ntile > 1) BLOAD(1, vt0, vt1, kt0, kt1);
  for (int tt = 0; tt < ntile; tt += 2) {
    __syncthreads();
    BWRITE(vs0, vs1, ks0, ks1);
    __syncthreads();
    if (tt + 2 < ntile) BLOAD(tt + 2, vs0, vs1, ks0, ks1);
    BCOMPUTE(tt);
    if (tt + 1 < ntile) {
      __syncthreads();
      BWRITE(vt0, vt1, kt0, kt1);
      __syncthreads();
      if (tt + 3 < ntile) BLOAD(tt + 3, vt0, vt1, kt0, kt1);
      BCOMPUTE(tt + 1);
    }
  }
#undef BWRITE
#undef BCOMPUTE
#undef BLOAD
#undef TILE_RK
#undef TILE_LK0
  if (hi == 0) li_l[r32] = l_reg; asm volatile("s_waitcnt lgkmcnt(0)" ::: "memory");
  float rli[16];
#pragma unroll
  for (int r = 0; r < 16; ++r) rli[r] = __builtin_amdgcn_rcpf(li_l[crow(r, hi)]);
  __syncthreads();
  { float* stg = (float*)(lds + wid * 16384);
#pragma unroll
    for (int r = 0; r < 16; ++r) { const int orow = crow(r, hi);
#pragma unroll
      for (int d0 = 0; d0 < 4; ++d0) stg[orow * 128 + d0 * 32 + r32] = o[d0][r] * rli[r]; }
    asm volatile("s_waitcnt lgkmcnt(0)" ::: "memory");
    const int ch = lane & 15, rb = lane >> 4;
    bf16* OGq = OG; asm volatile("" : "+s"(OGq));
    const __amdgpu_buffer_rsrc_t rsOG = __builtin_amdgcn_make_buffer_rsrc((void*)OGq, 0, 3 * 8192 * 512 * 2, 0x00020000);
#pragma unroll
    for (int i = 0; i < 8; ++i) { const int row = 4 * i + rb; const float* sp = stg + row * 128 + ch * 8;
      const f32x4_ a = *(const f32x4_*)sp, b = *(const f32x4_*)(sp + 4); u32x4 w;
      w[0] = cvtpk(a[0], a[1]); w[1] = cvtpk(a[2], a[3]); w[2] = cvtpk(b[0], b[1]); w[3] = cvtpk(b[2], b[3]);
      __builtin_amdgcn_raw_buffer_store_b128(w, rsOG, (int)(((long)g * ntok * 512 + h * D + ch * 8 + (tok0 + (long)(lq0 + row) * dil + rq) * 512) * 2), 0, 16); } }
  if (hi == 0) __hip_atomic_store(LSE + ((long)g * ntok + tok0 + (long)(lq0 + r32) * dil + rq) * 4 + h, m_reg * SCALE + __logf(l_reg), __ATOMIC_RELAXED, __HIP_MEMORY_SCOPE_AGENT);
  __syncthreads();
}
}

typedef unsigned short bf16_t;
constexpr int BATCH = 4, SEQ = 2048, DM = 2048, NTOK = BATCH * SEQ, NC = 11776;
constexpr int C_QA = 0, C_KA = 1024, C_VA = 1280, C_GA = 1536, C_QB = 2560, C_KB = 4096, C_VB = 5632, C_GB = 7168, C_ZA = 7680, C_ZB = 9728;
constexpr float EPS = 1e-6f;
constexpr float H8_SCALE = 4.0f, W8_SCALE = 64.0f;
constexpr size_t MiB = 1u << 20;
constexpr int PITCH = 7680;
constexpr size_t WS_CTL = 0, WS_TAB = 1 * MiB, WS_XB = 1 * MiB + 512 * 1024, WS_WTIN = 2 * MiB, WS_WTAB = 48 * MiB, WS_WTO = 54 * MiB, WS_HB = 64 * MiB, WS_P = 96 * MiB, WS_Y = 216 * MiB, WS_OG = 240 * MiB, WS_LSE = 264 * MiB,
                 WS_SA = 266 * MiB, WS_SB = 298 * MiB, WS_H8 = 330 * MiB, WS_WTZ8 = 346 * MiB, WS_END = 368 * MiB;

#define LAS __attribute__((address_space(3)))
typedef float f32x4 __attribute__((ext_vector_type(4)));
typedef unsigned v4u __attribute__((ext_vector_type(4)));
constexpr int NWAVES = 8;
static_assert((long)WS_WTIN - (long)WS_P == K8_FROM_P, "K8_FROM_P");
constexpr int LDS_BYTES = 147456;

__device__ __forceinline__ float bf2f(bf16_t h) { return __uint_as_float(((unsigned)h) << 16); }
__device__ __forceinline__ unsigned f2bf_u(float f) { unsigned u = __float_as_uint(f); return (u + 0x7fffu + ((u >> 16) & 1u)) >> 16; }
__device__ __forceinline__ bf16_t f2bf(float f) { return (bf16_t)f2bf_u(f); }
__device__ __forceinline__ unsigned pk2(float lo, float hi) { return f2bf_u(lo) | (f2bf_u(hi) << 16); }
__device__ __forceinline__ bf16_t f2bf16(float f) { const unsigned u = __float_as_uint(f); return (bf16_t)((u + 0x7fffu + ((u >> 16) & 1u)) >> 16); }
__device__ __forceinline__ float wave_sum(float v) {
#pragma unroll
    for (int o = 1; o < 64; o <<= 1) v += __shfl_xor(v, o);
    return v;
}

__device__ __forceinline__ int colmap(int kind, int p) {
    const int bj = p >> 7, wc = (p >> 5) & 3, n = (p >> 4) & 1, fq = (p >> 2) & 3, j = p & 3;
    const int gen = 128 * bj + 32 * wc + 8 * fq + 4 * n + j;
    if (kind == 0) return p;
    if (kind == 1) return gen;
    const int sg = ((fq & 1) << 1) | (fq >> 1);
    if (kind == 2) return 128 * bj + 64 * (wc >> 1) + 32 * n + 16 * (wc & 1) + 4 * sg + j;
    return wc == 0 ? 128 * bj + 16 * n + 4 * sg + j : gen;
}
__device__ __forceinline__ int kind_in(int pn) { return pn < 5 ? 2 : ((pn >= 10 && pn < 22) ? 3 : 1); }

struct TrSrc { const float* W; int N; bf16_t* WT; int ldt, koff, kindsel; unsigned char* wt8; int n8; };
__device__ __forceinline__ void tr_load(const TrSrc& t, int item, int lane, f32x4 (&v)[8]) {
    const int nblk = t.N / 32, kb = item / nblk, nb = item % nblk, k0 = 64 * kb, n0 = 32 * nb;
    const int np = n0 + 4 * (lane & 7), pn = np >> 8;
    const int kind = t.kindsel < 0 ? kind_in(pn) : t.kindsel;
    const int pq = np & 255;
    const int scol = (t.wt8 != nullptr && t.n8 != 1 && pn >= 30) ? (pq < 128 ? 7680 : 9728) + 128 * (pn - 30) + colmap(1, pq & 127) : (pn << 8) + colmap(kind, pq);
    const float* src = t.W + (size_t)(k0 + (lane >> 3)) * t.N + scol;
#pragma unroll
    for (int i = 0; i < 8; ++i) v[i] = __builtin_nontemporal_load((const f32x4*)(src + (size_t)(8 * i) * t.N));
}
__device__ __forceinline__ void tr_store(const TrSrc& t, int item, int lane, const f32x4 (&v)[8], LAS float* scr) {
    const int nblk = t.N / 32, kb = item / nblk, nb = item % nblk, k0 = 64 * kb, n0 = 32 * nb;
    { LAS float* d = scr + (lane >> 3) * 33 + 4 * (lane & 7);
#pragma unroll
      for (int i = 0; i < 8; ++i) { d[i * 264 + 0] = v[i][0]; d[i * 264 + 1] = v[i][1]; d[i * 264 + 2] = v[i][2]; d[i * 264 + 3] = v[i][3]; } }
    asm volatile("s_waitcnt lgkmcnt(0)" ::: "memory");
    const int c = lane & 7;
    const int pn_ = n0 >> 8; const bool is8 = t.wt8 != nullptr && (t.n8 == 1 || pn_ < BF_T0 || pn_ >= BF_T0 + BF_NT);
    const int n8row = (t.n8 == 1 || pn_ < BF_T0) ? n0 : n0 - BF_NT * 256;
    if (is8) {
#pragma unroll
        for (int j = 0; j < 4; ++j) { const int n = (lane >> 3) + 8 * j; const LAS float* sp = scr + (8 * c) * 33 + n;
            int lo = 0, hi = 0;
            lo = __builtin_amdgcn_cvt_pk_fp8_f32(sp[0 * 33] * W8_SCALE, sp[1 * 33] * W8_SCALE, lo, false); lo = __builtin_amdgcn_cvt_pk_fp8_f32(sp[2 * 33] * W8_SCALE, sp[3 * 33] * W8_SCALE, lo, true);
            hi = __builtin_amdgcn_cvt_pk_fp8_f32(sp[4 * 33] * W8_SCALE, sp[5 * 33] * W8_SCALE, hi, false); hi = __builtin_amdgcn_cvt_pk_fp8_f32(sp[6 * 33] * W8_SCALE, sp[7 * 33] * W8_SCALE, hi, true);
            *(unsigned long long*)(t.wt8 + (size_t)(n8row + n) * t.ldt + k0 + 8 * c) = (unsigned long long)(unsigned)lo | ((unsigned long long)(unsigned)hi << 32); }
    } else {
#pragma unroll
    for (int j = 0; j < 4; ++j) { const int n = (lane >> 3) + 8 * j; const LAS float* sp = scr + (8 * c) * 33 + n;
        v4u o; o.x = pk2(sp[0 * 33], sp[1 * 33]); o.y = pk2(sp[2 * 33], sp[3 * 33]); o.z = pk2(sp[4 * 33], sp[5 * 33]); o.w = pk2(sp[6 * 33], sp[7 * 33]);
        *(v4u*)(t.WT + (size_t)(n0 + n) * t.ldt + t.koff + k0 + 8 * c) = o; }
    }
    asm volatile("s_waitcnt lgkmcnt(0)" ::: "memory");
}
__device__ __forceinline__ void tr_matrix(const TrSrc& t, int nitems, int gw, int NGW, int lane, LAS float* scr) {
    f32x4 a[8], b[8];
    int it = gw;
    if (it < nitems) tr_load(t, it, lane, a);
    for (; it < nitems; it += 2 * NGW) {
        const bool hb = it + NGW < nitems;
        if (hb) tr_load(t, it + NGW, lane, b);
        tr_store(t, it, lane, a, scr);
        if (hb) { if (it + 2 * NGW < nitems) tr_load(t, it + 2 * NGW, lane, a); tr_store(t, it + NGW, lane, b, scr); }
    }
}
__device__ __forceinline__ void rms_row_load(const float* xrow, int lane, f32x4 (&v)[8]) {
    const f32x4* xr = (const f32x4*)xrow + lane;
#pragma unroll
    for (int j = 0; j < 8; ++j) v[j] = __builtin_nontemporal_load(xr + 64 * j);
}
__device__ __forceinline__ void rms_row_store(const f32x4 (&v)[8], const float* gain, bf16_t* orow, unsigned char* orow8, int lane) {
    const f32x4* gr = (const f32x4*)gain + lane; float s = 0.f;
#pragma unroll
    for (int j = 0; j < 8; ++j) s += (v[j].x * v[j].x + v[j].y * v[j].y) + (v[j].z * v[j].z + v[j].w * v[j].w);
    const float rs = rsqrtf(wave_sum(s) * (1.f / DM) + EPS);
    unsigned long long* o8 = (unsigned long long*)orow + lane;
    unsigned* q8 = (unsigned*)orow8 + lane;
#pragma unroll
    for (int j = 0; j < 8; ++j) { const f32x4 g = gr[64 * j]; const f32x4 y = v[j] * rs * g;
        o8[64 * j] = (unsigned long long)pk2(y.x, y.y) | ((unsigned long long)pk2(y.z, y.w) << 32);
        int w = 0; w = __builtin_amdgcn_cvt_pk_fp8_f32(y.x * H8_SCALE, y.y * H8_SCALE, w, false); w = __builtin_amdgcn_cvt_pk_fp8_f32(y.z * H8_SCALE, y.w * H8_SCALE, w, true);
        q8[64 * j] = (unsigned)w; }
}
__device__ __forceinline__ void rms_rows(const float* x, const float* gain, bf16_t* H, unsigned char* H8, int m0, int step, int nrows, int lane) {
    f32x4 a[8], b[8];
    int m = m0;
    if (m < nrows) rms_row_load(x + (size_t)m * DM, lane, a);
    for (; m < nrows; m += 2 * step) {
        const bool hb = m + step < nrows;
        if (hb) rms_row_load(x + (size_t)(m + step) * DM, lane, b);
        rms_row_store(a, gain, H + (size_t)m * DM, H8 + (size_t)m * DM, lane);
        if (hb) { if (m + 2 * step < nrows) rms_row_load(x + (size_t)(m + 2 * step) * DM, lane, a); rms_row_store(b, gain, H + (size_t)(m + step) * DM, H8 + (size_t)(m + step) * DM, lane); }
    }
}

#define XB_TMO      128
#define XB_XCNT(j)  (256  + 64 * (j))
#define XB_XSUB(j)  (1280 + 64 * (j))
#define XB_XGEN(j)  (2304 + 64 * (j))
#define XB_TOP      3328
#define XB_TOPGEN   3392
#define XCD_BAR_WORDS 3456
#define XB_SPIN_CAP (1u << 18)

__device__ __forceinline__ unsigned xb_ld(unsigned* p)              { return __hip_atomic_load(p, __ATOMIC_RELAXED, __HIP_MEMORY_SCOPE_AGENT); }
__device__ __forceinline__ unsigned xb_add(unsigned* p, unsigned v) { return __hip_atomic_fetch_add(p, v, __ATOMIC_RELAXED, __HIP_MEMORY_SCOPE_AGENT); }
__device__ __forceinline__ unsigned xb_xcc_id() { return (unsigned)__builtin_amdgcn_s_getreg((3 << 11) | 20) & 0xFu; }
#define XB_SPIN(cond, bar) do { unsigned _sp = 0; while (cond) { __builtin_amdgcn_s_sleep(1); \
    if ((++_sp & 255u) == 0u) { if (xb_ld(&(bar)[XB_TMO])) break; if (_sp > XB_SPIN_CAP) { atomicAdd(&(bar)[XB_TMO], 1u); break; } } } } while (0)

struct XcdBarrier {
    unsigned* bar; unsigned x;
    volatile LAS unsigned* st;
};

__device__ __forceinline__ XcdBarrier xcd_barrier_post(unsigned* bar, volatile LAS unsigned* st) {
    XcdBarrier b; b.bar = bar; b.x = xb_xcc_id(); b.st = st;
    if (threadIdx.x == 0) (void)xb_add(&bar[XB_XCNT(b.x)], 1u);
    return b;
}
__device__ __forceinline__ void xcd_barrier_complete(unsigned* bar, unsigned x, unsigned& nloc, unsigned& nx) {
    const unsigned G = gridDim.x * gridDim.y * gridDim.z;
    unsigned sum, cnt, mine, sp = 0u;
    for (;;) {
        sum = 0u; cnt = 0u; mine = 0u;
#pragma unroll
        for (unsigned j = 0; j < 16; ++j) { const unsigned c = xb_ld(&bar[XB_XCNT(j)]); sum += c; cnt += (c > 0u) ? 1u : 0u; mine = (j == x) ? c : mine; }
        if (sum == G) break;
        __builtin_amdgcn_s_sleep(1);
        if ((++sp & 255u) == 0u) { if (xb_ld(&bar[XB_TMO])) break; if (sp > XB_SPIN_CAP) { atomicAdd(&bar[XB_TMO], 1u); break; } }
    }
    nloc = mine > 0u ? mine : 1u; nx = cnt > 0u ? cnt : 1u;
}

__device__ __forceinline__ void xcd_barrier(const XcdBarrier& b, const int wave_) {
    asm volatile("s_waitcnt vmcnt(0)" ::: "memory");
    __syncthreads();
    if (wave_ == 0 && fresh_lane() == 0) {
        unsigned* bar = b.bar;
        __builtin_amdgcn_s_waitcnt(0);
        unsigned nloc = b.st[0], nx = b.st[1];
        if (nloc == 0u) { xcd_barrier_complete(bar, b.x, nloc, nx); b.st[0] = nloc; b.st[1] = nx; }
        const unsigned old = xb_add(&bar[XB_XSUB(b.x)], 1u);
        const unsigned gen = old / nloc;
        if (old + 1u == (gen + 1u) * nloc) {
            __builtin_amdgcn_fence(__ATOMIC_RELEASE, "agent");
            asm volatile("s_waitcnt vmcnt(0)" ::: "memory");
            const unsigned og = xb_add(&bar[XB_TOP], 1u);
            const unsigned tg = og / nx;
            if (og + 1u == (tg + 1u) * nx) xb_add(&bar[XB_TOPGEN], 1u);
            else XB_SPIN(xb_ld(&bar[XB_TOPGEN]) == tg, bar);
            __builtin_amdgcn_fence(__ATOMIC_ACQUIRE, "agent");
            xb_add(&bar[XB_XGEN(b.x)], 1u);
            asm volatile("s_waitcnt vmcnt(0)" ::: "memory");
        } else {
            XB_SPIN(xb_ld(&bar[XB_XGEN(b.x)]) == gen, bar);
            __builtin_amdgcn_fence(__ATOMIC_ACQUIRE, "agent");
            asm volatile("s_waitcnt vmcnt(0)" ::: "memory");
        }
    }
    __syncthreads();
}

struct Args { const float* in[10]; float* out; unsigned char* ws; int ph_lo, ph_hi; };

__global__ void __launch_bounds__(NWAVES * 64, 2) mk_fwd(Args args) {
    extern __shared__ __attribute__((aligned(16))) unsigned char lds[];
    const int wave = __builtin_amdgcn_readfirstlane((int)threadIdx.x >> 6);
#define TID_LANE const int lane = fresh_lane(); const int tid = wave * 64 + lane; (void)tid; (void)lane;
    const int G = gridDim.x, bx = blockIdx.x;
    const int vcu = (G % 8 == 0) ? (bx % 8) * (G / 8) + bx / 8 : bx;
    unsigned char* ws = args.ws;
    const float* x = args.in[0]; const float* ng = args.in[1]; const float* w_in = args.in[2];
    bf16_t* WT_IN = (bf16_t*)(ws + WS_WTIN); bf16_t* HB = (bf16_t*)(ws + WS_HB); bf16_t* P = (bf16_t*)(ws + WS_P);
    float* COSA = (float*)(ws + WS_TAB); float* SINA = COSA + 2048; float* COSP = COSA + 4096; float* SINP = COSP + 32768;
    bf16_t* OG = (bf16_t*)(ws + WS_OG); float* LSE = (float*)(ws + WS_LSE); unsigned* CTL = (unsigned*)(ws + WS_CTL) + 4096;
    bf16_t* WT_AB = (bf16_t*)(ws + WS_WTAB); bf16_t* WT_O = (bf16_t*)(ws + WS_WTO); bf16_t* Y = (bf16_t*)(ws + WS_Y); bf16_t* MG = HB; unsigned char* H8 = ws + WS_H8; unsigned char* WTZ8 = ws + WS_WTZ8; unsigned char* K8 = ws + WS_WTIN;   bf16_t* SA = (bf16_t*)(ws + WS_SA); bf16_t* SB = (bf16_t*)(ws + WS_SB); float* XB = (float*)(ws + WS_XB); unsigned* PCNT = (unsigned*)(ws + WS_CTL) + 8192; unsigned* PC2 = (unsigned*)(ws + WS_CTL) + 10240;
    const int lo = args.ph_lo, hi = args.ph_hi;
    volatile LAS unsigned* MISC = (volatile LAS unsigned*)((LAS unsigned char*)lds + 131072 + 320);
    if (threadIdx.x < 32) MISC[threadIdx.x] = 0u;
    __syncthreads();
    XcdBarrier bar = xcd_barrier_post((unsigned*)(ws + WS_CTL), MISC + 8);
#define GRID_BAR() xcd_barrier(bar, wave)
#define IN(k) (lo <= (k) && (k) < hi)
#define BOTH(k) (IN(k) && IN((k) + 1))
    if (IN(0)) { TID_LANE
        LAS float* scr = (LAS float*)((LAS unsigned char*)lds + wave * 16384);
        const int gw = vcu * NWAVES + wave, NGW = G * NWAVES;
        constexpr int I_IN = (DM / 64) * (NC / 32);
        { const TrSrc t{w_in, NC, WT_IN, DM, 0, -1, WTZ8, 7680}; tr_matrix(t, I_IN, gw, NGW, lane, scr); }
        for (int i = bx * (NWAVES * 64) + tid; i < 2048 + 32768; i += G * NWAVES * 64) {
            if (i < 2048) { const int pos = i >> 5, fi = i & 31; const float a = (float)pos * (1.0f / powf(10000.0f, (float)fi / 32.0f)); { bf16_t* e = (bf16_t*)COSA + (size_t)(pos * 8 + (fi >> 2)) * 8 + (fi & 3); e[0] = f2bf16(cosf(a)); e[4] = f2bf16(sinf(a)); } }
            else { const int k = i - 2048, pos = k >> 4, fi = k & 15; const float a = (float)pos * (1.0f / powf(500000.0f, (float)fi / 16.0f)); { bf16_t* e = (bf16_t*)COSP + (size_t)(pos * 4 + (fi >> 2)) * 8 + (fi & 3); e[0] = f2bf16(cosf(a)); e[4] = f2bf16(sinf(a)); } }
        }
        rms_rows(x, ng, HB, H8, gw, NGW, NTOK, lane);
        if (BOTH(0)) GRID_BAR();
    }
    if (IN(1)) { TID_LANE
        const float dsc = 1.0f / (H8_SCALE * W8_SCALE);
        const bool skew = (G == 256 && BF_NT == 2);
        if constexpr (BF_NT > 0) {
            pg8::Gemm g{HB, WT_IN + (size_t)BF_T0 * 256 * DM, NTOK, BF_NT * 256, DM}; pg8::StaticOrder S;
            if (skew) S.init(NTOK, BF_NT * 256, 64, bx - 192, 4); else S.init(NTOK, BF_NT * 256, G, bx, 8);
            pg8::EpiIn<false> E{P, PITCH, COSA, SINA, COSP, SINP, args.in[3], args.in[4], args.in[5], SA, SB, (LAS float*)((LAS unsigned char*)lds + 131072 + 1024), EPS, 1.0f};
            if (!skew || bx >= 192) pg8::gemm_phase<pg8::EpiIn<false>, pg8::StaticOrder, true, true>((LAS unsigned char*)lds, g, S, E, wave);
        }
        {
            pg8::Gemm g8{(const bf16_t*)H8, (const bf16_t*)WTZ8, NTOK, (46 - BF_NT) * 256, DM / 2}; pg8::StaticOrder S8; S8.init(NTOK, (46 - BF_NT) * 256, G, bx, 4);
            pg8::EpiIn<true> E8{P, PITCH, COSA, SINA, COSP, SINP, args.in[3], args.in[4], args.in[5], SA, SB, (LAS float*)((LAS unsigned char*)lds + 131072 + 1024), EPS, dsc};
            const pg8::SkewOrder K8{S8, skew ? 4 : (1 << 20), skew ? 192 : G};
            pg8::gemm_phase<pg8::EpiIn<true>, pg8::SkewOrder, true, true>((LAS unsigned char*)lds, g8, K8, E8, wave);
        }
        const int nheavy = ((NTOK / 256) * (46 - BF_NT)) % G;
        {
            const int first = skew ? 0 : (nheavy > 0 ? nheavy : 0), nidle = G - first;
            if (bx >= first) {
                LAS float* scr = (LAS float*)((LAS unsigned char*)lds + wave * 16384);
                const int gw2 = (bx - first) * NWAVES + wave, NGW2 = nidle * NWAVES;
                const int ln2 = fresh_lane();
                constexpr int I_A = (1024 / 64) * (DM / 32), I_B = (512 / 64) * (DM / 32), I_O = (DM / 64) * (DM / 32);
                { const TrSrc t{args.in[6], DM, WT_AB, YPITCH, 0, 1, (unsigned char*)WT_AB, 1}; tr_matrix(t, I_A, gw2, NGW2, ln2, scr); }
                { const TrSrc t{args.in[7], DM, WT_AB, YPITCH / 2, 512, 1, nullptr, 0}; tr_matrix(t, I_B, gw2, NGW2, ln2, scr); }
                { const TrSrc t{args.in[8], DM, WT_O, DM, 0, 0, nullptr, 0}; tr_matrix(t, I_O, gw2, NGW2, ln2, scr); }
            }
        }
        if (BOTH(1)) GRID_BAR();
    }
    if (IN(2)) { TID_LANE
        float gmq = 0.f, gmk = 0.f;
        { const int gl_ = fresh_lane(); const float* gqp = args.in[3]; const float* gkp = args.in[4]; gmq = fmaxf(fabsf(gqp[gl_]), fabsf(gqp[gl_ + 64])); gmk = fmaxf(fabsf(gkp[gl_]), fabsf(gkp[gl_ + 64]));
#pragma unroll
          for (int o = 32; o > 0; o >>= 1) { gmq = fmaxf(gmq, __shfl_xor(gmq, o)); gmk = fmaxf(gmk, __shfl_xor(gmk, o)); } }
        const bool bounded = __builtin_amdgcn_readfirstlane((16.33f * 1.14f * gmq * gmk <= 60.f && gmq <= 32.f && gmk <= 8.f) ? 1 : 0) != 0;
        for (int u = bx; u < 384; u += G) {
            const int blk = u & 7, h = (u >> 3) & 3, b = (u >> 5) & 3, g = u >> 7;
            att::attn_band_unit(P, OG, LSE, g, b, h, blk, C_QB, C_KB, C_VB, SEQ, NTOK, (char*)lds, wave);
        }
        asm volatile("s_waitcnt vmcnt(0)" ::: "memory"); __syncthreads();
        if (tid == 0) __hip_atomic_fetch_add(CTL, 1u, __ATOMIC_RELAXED, __HIP_MEMORY_SCOPE_AGENT);
        for (int u = bx; u < 256; u += G) {
            const int pair = u & 7, inner = u >> 3, b = pair >> 1, hkv = pair & 1, hq = hkv * 4 + (inner >> 3), qb = inner & 7;
            const size_t row0 = (size_t)b * SEQ + qb * 256;
            if (bounded) att::attn_dense_body<true>(P + row0 * PITCH + C_QA + hq * 128, P + (size_t)b * SEQ * PITCH + C_KA + hkv * 128, P + (size_t)b * SEQ * PITCH + C_VA + hkv * 128,
                                 P + row0 * PITCH + C_GA + hq * 128, (bf16_t*)((unsigned char*)Y + row0 * YPITCH + hq * 128), K8 + (size_t)b * SEQ * 256 + hkv * 128, SEQ, (char*)lds, wave);
            else att::attn_dense_body<false>(P + row0 * PITCH + C_QA + hq * 128, P + (size_t)b * SEQ * PITCH + C_KA + hkv * 128, P + (size_t)b * SEQ * PITCH + C_VA + hkv * 128,
                                 P + row0 * PITCH + C_GA + hq * 128, (bf16_t*)((unsigned char*)Y + row0 * YPITCH + hq * 128), K8 + (size_t)b * SEQ * 256 + hkv * 128, SEQ, (char*)lds, wave);
            if (G == 256) { asm volatile("s_waitcnt vmcnt(0)" ::: "memory"); __syncthreads();
                if (wave == 0 && fresh_lane() == 0) __hip_atomic_fetch_add(PC2 + 64 * (b * 8 + qb), 1u, __ATOMIC_RELAXED, __HIP_MEMORY_SCOPE_AGENT); }
        }
        const int mfirst = (384 - G > 0 && 384 - G < G) ? 384 - G : 0, nmerge = G - mfirst;
        if (bx >= mfirst) {
            const int tid = wave * 64 + fresh_lane();
            if (tid == 0) { unsigned spins = 0; while (__hip_atomic_load(CTL, __ATOMIC_RELAXED, __HIP_MEMORY_SCOPE_AGENT) < (unsigned)G) { __builtin_amdgcn_s_sleep(4); if (++spins > (1u << 24)) break; }
                __builtin_amdgcn_fence(__ATOMIC_ACQUIRE, "agent"); asm volatile("s_waitcnt vmcnt(0)" ::: "memory"); }
            __syncthreads();
            const int mj = bx - mfirst, mbase = (G == 256) ? (256 * (mj >> 2) + 64 * (mj & 3)) * 64 : mj * (NWAVES * 64), mend = (G == 256) ? mbase + 64 * 64 : NTOK * 64, mstep = (G == 256) ? NWAVES * 64 : nmerge * NWAVES * 64;
            const __amdgpu_buffer_rsrc_t rsYm = __builtin_amdgcn_make_buffer_rsrc((void*)Y, 0, NTOK * YPITCH, 0x00020000);
            for (int c0 = mbase + tid; c0 < mend; c0 += 2 * mstep) {
                v4u a0[2], a1[2], a2[2], gz[2]; float e0[2], e1[2], e2[2]; int tok[2], c8[2]; bool ok[2];
#pragma unroll
                for (int q = 0; q < 2; ++q) { const int ci = c0 + q * mstep; ok[q] = ci < mend; const int cj = ok[q] ? ci : c0; tok[q] = cj >> 6; c8[q] = (cj & 63) * 8; const int h = c8[q] >> 7;
                    e0[q] = LSE[((size_t)0 * NTOK + tok[q]) * 4 + h]; e1[q] = LSE[((size_t)1 * NTOK + tok[q]) * 4 + h]; e2[q] = LSE[((size_t)2 * NTOK + tok[q]) * 4 + h];
                    a0[q] = *(const v4u*)(OG + ((size_t)0 * NTOK + tok[q]) * 512 + c8[q]); a1[q] = *(const v4u*)(OG + ((size_t)1 * NTOK + tok[q]) * 512 + c8[q]); a2[q] = *(const v4u*)(OG + ((size_t)2 * NTOK + tok[q]) * 512 + c8[q]);
                    gz[q] = *(const v4u*)(P + (size_t)tok[q] * PITCH + C_GB + c8[q]); }
#pragma unroll
                for (int q = 0; q < 2; ++q) { const float mx = fmaxf(e0[q], fmaxf(e1[q], e2[q])); float w0 = __expf(e0[q] - mx), w1 = __expf(e1[q] - mx), w2 = __expf(e2[q] - mx); const float inv = 1.f / (w0 + w1 + w2); w0 *= inv; w1 *= inv; w2 *= inv;
                    v4u w;
#pragma unroll
                    for (int e = 0; e < 4; ++e) {
                        const float lo = w0 * __uint_as_float(a0[q][e] << 16) + w1 * __uint_as_float(a1[q][e] << 16) + w2 * __uint_as_float(a2[q][e] << 16);
                        const float hh = w0 * __uint_as_float(a0[q][e] & 0xffff0000u) + w1 * __uint_as_float(a1[q][e] & 0xffff0000u) + w2 * __uint_as_float(a2[q][e] & 0xffff0000u);
                        w[e] = pk2(lo * __uint_as_float(gz[q][e] << 16), hh * __uint_as_float(gz[q][e] & 0xffff0000u)); }
                    if (ok[q]) __builtin_amdgcn_raw_buffer_store_b128(w, rsYm, (int)((size_t)tok[q] * YPITCH + 1024 + c8[q] * 2), 0, 16); }
            }
            if (G == 256) { asm volatile("s_waitcnt vmcnt(0)" ::: "memory"); __syncthreads(); if (tid == 0) __hip_atomic_fetch_add(PC2 + 64 * (mj >> 2), 1u, __ATOMIC_RELAXED, __HIP_MEMORY_SCOPE_AGENT); }
        }
        if (BOTH(2) && G != 256) GRID_BAR();
    }
    if (IN(3)) {
        pg8::Gemm g{Y, WT_AB, NTOK, DM, YPITCH / 2}; pg8::StaticOrder S; S.init(NTOK, DM, G, bx, 4);
        if (G == 256 && IN(2)) {
            pg8::Unit u2; if (S.next(0, u2)) {
                unsigned* pc2 = PC2 + 64 * u2.pm;
                if (wave == 0 && fresh_lane() == 0) { unsigned spins = 0; while (__hip_atomic_load(pc2, __ATOMIC_RELAXED, __HIP_MEMORY_SCOPE_AGENT) < 12u) { __builtin_amdgcn_s_sleep(2); if (++spins > (1u << 22)) break; }
                    __builtin_amdgcn_fence(__ATOMIC_ACQUIRE, "agent"); asm volatile("s_waitcnt vmcnt(0)" ::: "memory"); }
                __syncthreads(); } }
        pg8::EpiMerge2 E{SA, SB, MG, DM};
        pg8::gemm_phase<pg8::EpiMerge2, pg8::StaticOrder, true, true>((LAS unsigned char*)lds, g, S, E, wave);
        if (BOTH(3)) {
            pg8::Unit u3; const bool has = S.next(0, u3);
            if (G == 256 && has) {
                unsigned* pc3 = (unsigned*)(ws + WS_CTL) + 5120 + 64 * u3.pm;
                asm volatile("s_waitcnt vmcnt(0)" ::: "memory"); __syncthreads();
                if (wave == 0 && fresh_lane() == 0) {
                    __hip_atomic_fetch_add(pc3, 1u, __ATOMIC_RELAXED, __HIP_MEMORY_SCOPE_AGENT);
                    unsigned spins = 0; while (__hip_atomic_load(pc3, __ATOMIC_RELAXED, __HIP_MEMORY_SCOPE_AGENT) < 8u) { __builtin_amdgcn_s_sleep(2); if (++spins > (1u << 22)) break; }
                    __builtin_amdgcn_fence(__ATOMIC_ACQUIRE, "agent"); asm volatile("s_waitcnt vmcnt(0)" ::: "memory"); }
                __syncthreads();
            } else GRID_BAR();
        }
    }
    if (IN(4)) {
        pg8::Gemm g{MG, WT_O, NTOK, DM, DM}; pg8::StaticOrder S; S.init(NTOK, DM, G, bx, 4);
        pg8::EpiResidNorm E{x, args.out, DM, args.in[9], XB, PCNT, 8, EPS};
        if (G == 256) pg8::gemm_phase<pg8::EpiResidNorm, pg8::StaticOrder, false, true>((LAS unsigned char*)lds, g, S, E, wave);
    }
#undef IN
#undef BOTH
}


extern "C" void kernel_launch(void* const* d_in, const int* in_sizes, int n_in, void* d_out, int out_size, void* d_ws, size_t ws_size, hipStream_t stream) {
    static int grid = 0;
    if (grid == 0) {
        if (n_in != 10 || in_sizes[0] != NTOK * DM || out_size != NTOK * DM || ws_size < WS_END) { fprintf(stderr, "kernel_launch: unexpected shapes / workspace (%zu)\n", ws_size); grid = -1; return; }
        int dev = 0, cus = 0, per_cu = 0;
        if (hipGetDevice(&dev) != hipSuccess || hipDeviceGetAttribute(&cus, hipDeviceAttributeMultiprocessorCount, dev) != hipSuccess) { grid = -1; return; }
        if (hipFuncSetAttribute((const void*)mk_fwd, hipFuncAttributeMaxDynamicSharedMemorySize, LDS_BYTES) != hipSuccess) { fprintf(stderr, "kernel_launch: hipFuncSetAttribute failed\n"); grid = -1; return; }
        if (hipOccupancyMaxActiveBlocksPerMultiprocessor(&per_cu, (const void*)mk_fwd, NWAVES * 64, LDS_BYTES) != hipSuccess || per_cu < 1) { fprintf(stderr, "kernel_launch: occupancy query says %d\n", per_cu); grid = -1; return; }
        grid = cus;
    }
    if (grid < 0) return;
    if (hipMemsetAsync((char*)d_ws + WS_CTL, 0, 131072, stream) != hipSuccess) { fprintf(stderr, "kernel_launch: memset failed\n"); return; }
    Args a{};
    for (int i = 0; i < 10; ++i) a.in[i] = (const float*)d_in[i];
    a.out = (float*)d_out; a.ws = (unsigned char*)d_ws; a.ph_lo = 0; a.ph_hi = 5;
    void* kargs[] = {&a};
    hipError_t e = hipLaunchCooperativeKernel((const void*)mk_fwd, dim3(grid), dim3(NWAVES * 64), kargs, LDS_BYTES, stream);
    if (e != hipSuccess) fprintf(stderr, "kernel_launch: cooperative launch failed: %s (grid %d)\n", hipGetErrorString(e), grid);
}
```
